# Optimizing an MI355X kernel written in HIP

```python
import jax
import jax.numpy as jnp
from jax import lax
import numpy as np

D_MODEL = 2048
BATCH = 1
SEQ = 8192
DEPTH = 2

GRID_W = 64
CTX_LEN = 256
HEAD_DIM = 128

NA_HEADS = 4
WIN_H = 8
WIN_W = 16
SG_GROUPS = 4
SG_CHUNK = 128
GQA_Q_HEADS = 8
GQA_KV_HEADS = 2
ROPE_THETA = 10000.0
ROPE_PAIRS = HEAD_DIM // 4
Q_BLOCK = 128

NA_WIDTH = NA_HEADS * HEAD_DIM
SG_WIDTH = SG_GROUPS * HEAD_DIM
GQA_WIDTH = GQA_Q_HEADS * HEAD_DIM
KV_WIDTH = GQA_KV_HEADS * HEAD_DIM
MIX_WIDTH = NA_WIDTH + SG_WIDTH + GQA_WIDTH
IN_WIDTH = 3 * NA_WIDTH + 2 * SG_WIDTH + GQA_WIDTH + 2 * KV_WIDTH
SPLITS = (NA_WIDTH, 2 * NA_WIDTH, 3 * NA_WIDTH, 3 * NA_WIDTH + 2 * SG_WIDTH,
          3 * NA_WIDTH + 2 * SG_WIDTH + GQA_WIDTH,
          3 * NA_WIDTH + 2 * SG_WIDTH + GQA_WIDTH + KV_WIDTH)

N_EXPERTS = 32
N_GROUPS = 4
EXPERTS_PER_GROUP = N_EXPERTS // N_GROUPS
TOP_K = 2
D_EXPERT = 1024
MOE_BLOCK = 128

ALPHA = (2 * DEPTH) ** 0.25
BETA = (8 * DEPTH) ** -0.25
LN_EPS = 1e-6

kernel_name = 'hybrid_dit_natten_sgmlp_gqa_moe'


def layer_norm(x, gain=None, bias=None):
    xf = x.astype(jnp.float32)
    mu = jnp.mean(xf, axis=-1, keepdims=True)
    var = jnp.mean(jnp.square(xf - mu), axis=-1, keepdims=True)
    y = (xf - mu) * lax.rsqrt(var + LN_EPS)
    if gain is not None:
        y = y * gain.astype(jnp.float32) + bias.astype(jnp.float32)
    return y.astype(x.dtype)


def rms_norm(x, gain):
    xf = x.astype(jnp.float32)
    y = xf * lax.rsqrt(jnp.mean(jnp.square(xf), axis=-1, keepdims=True) + LN_EPS)
    return (y * gain.astype(jnp.float32)).astype(x.dtype)


def modulate(x, shift, scale):
    return layer_norm(x) * (1 + scale) + shift


def axial_rope_tables(seq_len):
    t = jnp.arange(seq_len, dtype=jnp.int32)
    row = (t // GRID_W).astype(jnp.float32)
    col = (t % GRID_W).astype(jnp.float32)
    inv_freq = ROPE_THETA ** (-jnp.arange(ROPE_PAIRS, dtype=jnp.float32) / ROPE_PAIRS)
    ang = jnp.stack([row[:, None] * inv_freq, col[:, None] * inv_freq], axis=1)
    return jnp.cos(ang), jnp.sin(ang)


def axial_rope(x, cos, sin):
    b, s, h, _ = x.shape
    xf = x.astype(jnp.float32).reshape(b, s, h, 2, 2, ROPE_PAIRS)
    x1, x2 = xf[..., 0, :], xf[..., 1, :]
    cs, sn = cos[None, :, None], sin[None, :, None]
    out = jnp.stack([x1 * cs - x2 * sn, x2 * cs + x1 * sn], axis=-2)
    return out.reshape(b, s, h, HEAD_DIM).astype(x.dtype)


def attend(q, k, v):
    b, lq, hq, d = q.shape
    hkv = k.shape[2]
    qg = q.reshape(b, lq, hkv, hq // hkv, d)
    s = jnp.einsum('bqkgd,bskd->bkgqs', qg, k).astype(jnp.float32) * (d ** -0.5)
    p = jax.nn.softmax(s, axis=-1).astype(v.dtype)
    return jnp.einsum('bkgqs,bskd->bqkgd', p, v).reshape(b, lq, hq, d)


def gqa_latent(q, k, v, k_ctx, v_ctx):
    b, s, hq, d = q.shape
    keys = jnp.concatenate([k, k_ctx], axis=1)
    vals = jnp.concatenate([v, v_ctx], axis=1)
    q_blocks = q.reshape(b, s // Q_BLOCK, Q_BLOCK, hq, d).transpose(1, 0, 2, 3, 4)
    out = lax.map(lambda qb: attend(qb, keys, vals), q_blocks)
    return out.transpose(1, 0, 2, 3, 4).reshape(b, s, hq, d)


def neighbourhood_attention(q, k, v, k_ctx, v_ctx, rpb):
    b, s, h, d = q.shape
    rows = s // GRID_W
    kh = min(WIN_H, rows)
    n_loc = kh * WIN_W
    qg = q.reshape(b, rows, GRID_W, h, d)
    kg = k.reshape(b, rows, GRID_W, h, d)
    vg = v.reshape(b, rows, GRID_W, h, d)
    col = jnp.arange(GRID_W)
    col_idx = jnp.clip(col - WIN_W // 2, 0, GRID_W - WIN_W)[:, None] + jnp.arange(WIN_W)
    dcol = col_idx - col[:, None] + (WIN_W - 1)
    scale = d ** -0.5

    def one_row(r):
        row_start = jnp.clip(r - WIN_H // 2, 0, rows - kh)
        k_win = lax.dynamic_slice_in_dim(kg, row_start, kh, axis=1)[:, :, col_idx]
        v_win = lax.dynamic_slice_in_dim(vg, row_start, kh, axis=1)[:, :, col_idx]
        q_r = lax.dynamic_index_in_dim(qg, r, axis=1, keepdims=False)
        drow = row_start + jnp.arange(kh) - r + (WIN_H - 1)
        bias = rpb[:, drow[:, None, None], dcol[None]].transpose(0, 2, 1, 3)
        s_loc = jnp.einsum('bqhd,brqwhd->bhqrw', q_r, k_win).astype(jnp.float32) * scale + bias.astype(jnp.float32)
        s_ctx = jnp.einsum('bqhd,blhd->bhql', q_r, k_ctx).astype(jnp.float32) * scale
        scores = jnp.concatenate([s_loc.reshape(b, h, GRID_W, n_loc), s_ctx], axis=-1)
        p = jax.nn.softmax(scores, axis=-1).astype(v.dtype)
        o_loc = jnp.einsum('bhqrw,brqwhd->bqhd', p[..., :n_loc].reshape(b, h, GRID_W, kh, WIN_W), v_win)
        o_ctx = jnp.einsum('bhql,blhd->bqhd', p[..., n_loc:], v_ctx)
        return o_loc + o_ctx

    out = lax.map(one_row, jnp.arange(rows))
    return out.transpose(1, 0, 2, 3, 4).reshape(b, s, h, d)


def spatial_gating(z, ln_g, ln_b, w_s, b_s):
    b, s, _ = z.shape
    u, v = jnp.split(z, 2, axis=-1)
    v = v.reshape(b, s // SG_CHUNK, SG_CHUNK, SG_GROUPS, HEAD_DIM)
    v = layer_norm(v, ln_g, ln_b)
    v = jnp.einsum('gij,bcjgd->bcigd', w_s, v) + b_s.T[:, :, None]
    return u * v.reshape(b, s, SG_WIDTH)


def project(h, w_in):
    b, s, _ = h.shape
    na_q, na_k, na_v, sg_z, g_q, g_k, g_v = jnp.split(h @ w_in, SPLITS, axis=-1)
    heads = lambda t, n: t.reshape(b, s, n, HEAD_DIM)
    return (heads(na_q, NA_HEADS), heads(na_k, NA_HEADS), heads(na_v, NA_HEADS), jax.nn.gelu(sg_z),
            heads(g_q, GQA_Q_HEADS), heads(g_k, GQA_KV_HEADS), heads(g_v, GQA_KV_HEADS))


def mixing_sublayer(h_lat, h_ctx, cos, sin, w_in, rpb, sg_ln_g, sg_ln_b, sg_w, sg_b,
                    q_norm_g, k_norm_g, w_out, with_ctx_out):
    b, s, _ = h_lat.shape
    aq, ak, av, sz, gq, gk, gv = project(h_lat, w_in)
    caq, cak, cav, csz, cgq, cgk, cgv = project(h_ctx, w_in)
    gq = axial_rope(rms_norm(gq, q_norm_g), cos, sin)
    gk = axial_rope(rms_norm(gk, k_norm_g), cos, sin)
    cgk = rms_norm(cgk, k_norm_g)
    o_na = neighbourhood_attention(aq, ak, av, cak, cav, rpb)
    o_sg = spatial_gating(sz, sg_ln_g, sg_ln_b, sg_w, sg_b)
    o_gq = gqa_latent(gq, gk, gv, cgk, cgv)
    y_lat = jnp.concatenate([o_na.reshape(b, s, NA_WIDTH), o_sg, o_gq.reshape(b, s, GQA_WIDTH)], axis=-1) @ w_out
    if not with_ctx_out:
        return y_lat, None
    l = h_ctx.shape[1]
    c_na = attend(caq, cak, cav)
    c_sg = spatial_gating(csz, sg_ln_g, sg_ln_b, sg_w, sg_b)
    c_gq = attend(rms_norm(cgq, q_norm_g), cgk, cgv)
    y_ctx = jnp.concatenate([c_na.reshape(b, l, NA_WIDTH), c_sg, c_gq.reshape(b, l, GQA_WIDTH)], axis=-1) @ w_out
    return y_lat, y_ctx


def moe_ffn(h, router_w, router_bias, w_gate, w_up, w_down):
    n, d = h.shape
    scores = jax.nn.sigmoid((h @ router_w).astype(jnp.float32))
    sel = scores + router_bias.astype(jnp.float32)
    grp_score = lax.top_k(sel.reshape(n, N_GROUPS, EXPERTS_PER_GROUP), 2)[0].sum(-1)
    best = jnp.argmax(grp_score, axis=-1)
    in_grp = (jnp.arange(N_EXPERTS) // EXPERTS_PER_GROUP)[None, :] == best[:, None]
    _, top_idx = lax.top_k(jnp.where(in_grp, sel, -jnp.inf), TOP_K)
    top_s = jnp.take_along_axis(scores, top_idx, axis=-1)
    gates = (top_s / jnp.sum(top_s, axis=-1, keepdims=True)).astype(h.dtype)

    nk = n * TOP_K
    flat_e = top_idx.reshape(nk)
    flat_tok = jnp.repeat(jnp.arange(n, dtype=jnp.int32), TOP_K)
    order = jnp.argsort(flat_e)
    se = flat_e[order]
    counts = jnp.bincount(flat_e, length=N_EXPERTS)
    padded = (counts + MOE_BLOCK - 1) // MOE_BLOCK * MOE_BLOCK
    pad_end = jnp.cumsum(padded)
    pad_start = pad_end - padded
    start = jnp.cumsum(counts) - counts
    dest = pad_start[se] + jnp.arange(nk) - start[se]
    n_blocks = (nk + N_EXPERTS * (MOE_BLOCK - 1) + MOE_BLOCK - 1) // MOE_BLOCK
    cap = n_blocks * MOE_BLOCK
    slot_tok = jnp.full((cap,), n, jnp.int32).at[dest].set(flat_tok[order])
    slot_gate = jnp.zeros((cap,), h.dtype).at[dest].set(gates.reshape(nk)[order])
    block_e = jnp.minimum(jnp.searchsorted(pad_end, jnp.arange(n_blocks) * MOE_BLOCK, side='right'), N_EXPERTS - 1)
    h_pad = jnp.concatenate([h, jnp.zeros((1, d), h.dtype)], axis=0)

    def one_block(args):
        e, tok = args
        xb = h_pad[tok]
        return (jax.nn.silu(xb @ w_gate[e]) * (xb @ w_up[e])) @ w_down[e]

    y = lax.map(one_block, (block_e, slot_tok.reshape(n_blocks, MOE_BLOCK))).reshape(cap, d)
    out = jnp.zeros((n + 1, d), h.dtype).at[slot_tok].add(y * slot_gate[:, None])
    return out[:n]


def setup_inputs(seed: int = 0) -> dict:
    key = jax.random.key(seed)
    ks = jax.random.split(key, 24)
    nrm = lambda k, shape, std: jax.random.normal(k, shape, jnp.float32) * std
    L = DEPTH
    return {
        'x': nrm(ks[0], (BATCH, SEQ, D_MODEL), 1.0),
        'c': nrm(ks[1], (BATCH, D_MODEL), 1.0),
        'ctx': nrm(ks[2], (BATCH, CTX_LEN, D_MODEL), 1.0),
        'c_ctx': nrm(ks[3], (D_MODEL,), 1.0),
        'ada_w': nrm(ks[4], (L, D_MODEL, 6 * D_MODEL), 0.5 * D_MODEL ** -0.5),
        'ada_b': nrm(ks[5], (L, 6 * D_MODEL), 0.02),
        'w_in': nrm(ks[6], (L, D_MODEL, IN_WIDTH), D_MODEL ** -0.5),
        'na_rpb': nrm(ks[7], (L, NA_HEADS, 2 * WIN_H - 1, 2 * WIN_W - 1), 0.1),
        'sg_ln_g': 1.0 + nrm(ks[8], (L, SG_GROUPS, HEAD_DIM), 0.1),
        'sg_ln_b': nrm(ks[9], (L, SG_GROUPS, HEAD_DIM), 0.02),
        'sg_w': nrm(ks[10], (L, SG_GROUPS, SG_CHUNK, SG_CHUNK), SG_CHUNK ** -0.5),
        'sg_b': 1.0 + nrm(ks[11], (L, SG_GROUPS, SG_CHUNK), 0.1),
        'q_norm_g': 1.0 + nrm(ks[12], (L, HEAD_DIM), 0.1),
        'k_norm_g': 1.0 + nrm(ks[13], (L, HEAD_DIM), 0.1),
        'w_out': nrm(ks[14], (L, MIX_WIDTH, D_MODEL), BETA * MIX_WIDTH ** -0.5),
        'ln_mix_g': 1.0 + nrm(ks[15], (L, D_MODEL), 0.1),
        'ln_mix_b': nrm(ks[16], (L, D_MODEL), 0.02),
        'router_w': nrm(ks[17], (D_MODEL, N_EXPERTS), D_MODEL ** -0.5),
        'router_bias': nrm(ks[18], (N_EXPERTS,), 0.01),
        'moe_w_gate': nrm(ks[19], (L, N_EXPERTS, D_MODEL, D_EXPERT), D_MODEL ** -0.5),
        'moe_w_up': nrm(ks[20], (L, N_EXPERTS, D_MODEL, D_EXPERT), D_MODEL ** -0.5),
        'moe_w_down': nrm(ks[21], (L, N_EXPERTS, D_EXPERT, D_MODEL), BETA * D_EXPERT ** -0.5),
        'ln_ffn_g': 1.0 + nrm(ks[22], (L, D_MODEL), 0.1),
        'ln_ffn_b': nrm(ks[23], (L, D_MODEL), 0.02),
    }


def reference(x, c, ctx, c_ctx, ada_w, ada_b, w_in, na_rpb, sg_ln_g, sg_ln_b, sg_w, sg_b,
              q_norm_g, k_norm_g, w_out, ln_mix_g, ln_mix_b, router_w, router_bias,
              moe_w_gate, moe_w_up, moe_w_down, ln_ffn_g, ln_ffn_b):
    b, s, d = x.shape
    cos, sin = axial_rope_tables(s)
    xc = ctx
    for layer in range(DEPTH):
        last = layer == DEPTH - 1
        mod_lat = jnp.split(jax.nn.silu(c) @ ada_w[layer] + ada_b[layer], 6, axis=-1)
        sh1, sc1, g1, sh2, sc2, g2 = [m[:, None] for m in mod_lat]
        csh1, csc1, cg1, csh2, csc2, cg2 = jnp.split(jax.nn.silu(c_ctx) @ ada_w[layer] + ada_b[layer], 6, axis=-1)

        y_lat, y_ctx = mixing_sublayer(modulate(x, sh1, sc1), modulate(xc, csh1, csc1), cos, sin,
                                       w_in[layer], na_rpb[layer], sg_ln_g[layer], sg_ln_b[layer],
                                       sg_w[layer], sg_b[layer], q_norm_g[layer], k_norm_g[layer],
                                       w_out[layer], not last)
        x = layer_norm(ALPHA * x + g1 * y_lat, ln_mix_g[layer], ln_mix_b[layer])
        h_lat = modulate(x, sh2, sc2).reshape(b * s, d)
        if last:
            y = moe_ffn(h_lat, router_w, router_bias, moe_w_gate[layer], moe_w_up[layer], moe_w_down[layer])
            x = layer_norm(ALPHA * x + g2 * y.reshape(b, s, d), ln_ffn_g[layer], ln_ffn_b[layer])
        else:
            l = xc.shape[1]
            xc = layer_norm(ALPHA * xc + cg1 * y_ctx, ln_mix_g[layer], ln_mix_b[layer])
            h_ctx = modulate(xc, csh2, csc2).reshape(b * l, d)
            y = moe_ffn(jnp.concatenate([h_lat, h_ctx], axis=0), router_w, router_bias,
                        moe_w_gate[layer], moe_w_up[layer], moe_w_down[layer])
            x = layer_norm(ALPHA * x + g2 * y[:b * s].reshape(b, s, d), ln_ffn_g[layer], ln_ffn_b[layer])
            xc = layer_norm(ALPHA * xc + cg2 * y[b * s:].reshape(b, l, d), ln_ffn_g[layer], ln_ffn_b[layer])
    return x
```

```cpp
#include <hip/hip_runtime.h>
#include <cstdio>
#include <cstdint>

#ifndef MK_ONE_LAUNCH
#define MK_ONE_LAUNCH 1
#endif

constexpr int DM = 2048, SEQ = 8192, CTXL = 256, NROW = SEQ + CTXL;
constexpr int INW = 4096, NEXP = 32, DEXP = 1024, GRIDW = 64;
constexpr float ALPHA = 1.41421356237309515f;
constexpr float LN_EPS = 1e-6f;
#ifdef CHK
constexpr int NPH = 20;
#else
constexpr int NPH = 18;
#endif
constexpr int MOE_CAP_TILES = 98;
constexpr int NWAVES = 8, NTHR = 512;

constexpr size_t MiB = 1u << 20;
constexpr size_t WS_CTL = 0, CTL_ZERO_BYTES = 1 * MiB;
constexpr size_t WS_MOD = 1 * MiB;
constexpr size_t WS_ROPE = 1 * MiB + 256 * 1024;
constexpr size_t WS_TOKE = 2 * MiB;
constexpr size_t WS_TOKP = WS_TOKE + 128 * 1024;
constexpr size_t WS_TOKG = WS_TOKP + 128 * 1024;
constexpr size_t WS_LIST = 3 * MiB;
constexpr size_t WS_WIN = 8 * MiB;
constexpr size_t WS_WOUT = 40 * MiB;
constexpr size_t WS_WGU = 64 * MiB;
constexpr size_t WS_WD = 576 * MiB;
constexpr size_t WS_H1 = 832 * MiB;
constexpr size_t WS_PROJ = 866 * MiB;
constexpr size_t WS_MIX = 932 * MiB;
constexpr size_t WS_Y1 = 966 * MiB;
constexpr size_t WS_XS = 1032 * MiB;
constexpr size_t WS_H2 = 1098 * MiB;
constexpr size_t WS_GA = 1132 * MiB;
constexpr size_t WS_YS = 1182 * MiB;
constexpr size_t WS_END = 1378 * MiB;
constexpr int CW_BAR = 4096;
constexpr int CW_CNT = 8192;
constexpr int LDS_PART = 131072;
constexpr int LDS_SC = 147456;
constexpr int LDS_TILE = 151552;
constexpr int LDS_MISC = 153600;
constexpr int LDS_BYTES = 155648;

#define GAS __attribute__((address_space(1)))
#define LAS __attribute__((address_space(3)))
typedef unsigned short bf16_t;
typedef float f32x4 __attribute__((ext_vector_type(4)));
typedef float f32x2 __attribute__((ext_vector_type(2)));
typedef float f32x16 __attribute__((ext_vector_type(16)));
typedef short bf16x8 __attribute__((ext_vector_type(8)));
typedef short s16x4 __attribute__((ext_vector_type(4)));
typedef unsigned u32x4 __attribute__((ext_vector_type(4)));
typedef unsigned u32x2 __attribute__((ext_vector_type(2)));

__device__ __forceinline__ unsigned cvt_pk_bf16(float lo, float hi) { unsigned r; asm volatile("v_cvt_pk_bf16_f32 %0, %1, %2" : "=v"(r) : "v"(lo), "v"(hi)); return r; }
__device__ __forceinline__ bf16_t f2bf(float f) { unsigned u = __builtin_bit_cast(unsigned, f); return (bf16_t)((u + 0x7fffu + ((u >> 16) & 1u)) >> 16); }
__device__ __forceinline__ float bf2f(bf16_t b) { return __builtin_bit_cast(float, ((unsigned)b) << 16); }
__device__ __forceinline__ float wave_sum(float v) {
#pragma unroll
    for (int o = 1; o < 64; o <<= 1) v += __shfl_xor(v, o);
    return v;
}
__device__ __forceinline__ float sigmoidf_(float x) { return 1.0f / (1.0f + expf(-x)); }
__device__ __forceinline__ float gelu_tanh_fast(float x) { const float u = x * (1.0f + 0.044715f * x * x) * 1.5957691216057308f; return x * __builtin_amdgcn_rcpf(1.0f + __expf(-u)); }
__device__ __forceinline__ float silu_fast(float x) { return x * __builtin_amdgcn_rcpf(1.0f + __expf(-x)); }

#define XB_TMO      128
#define XB_XCNT(j)  (256  + 64 * (j))
#define XB_XSUB(j)  (1280 + 64 * (j))
#define XB_XGEN(j)  (2304 + 64 * (j))
#define XB_TOP      3328
#define XB_TOPGEN   3392
#define XCD_BAR_WORDS 3456
#define XB_SPIN_CAP (1u << 20)
__device__ __forceinline__ unsigned xb_ld(unsigned* p)              { return __hip_atomic_load(p, __ATOMIC_RELAXED, __HIP_MEMORY_SCOPE_AGENT); }
__device__ __forceinline__ unsigned xb_add(unsigned* p, unsigned v) { return __hip_atomic_fetch_add(p, v, __ATOMIC_RELAXED, __HIP_MEMORY_SCOPE_AGENT); }
__device__ __forceinline__ unsigned xb_xcc_id() { return (unsigned)__builtin_amdgcn_s_getreg((3 << 11) | 20) & 0xFu; }
#define XB_SPIN(cond, bar) do { unsigned _sp = 0; while (cond) { __builtin_amdgcn_s_sleep(1); \
    if ((++_sp & 255u) == 0u) { if (xb_ld(&(bar)[XB_TMO])) break; if (_sp > XB_SPIN_CAP) { atomicAdd(&(bar)[XB_TMO], 1u); break; } } } } while (0)
struct XcdBarrier { unsigned* bar; unsigned x; volatile LAS unsigned* st; };
__device__ __forceinline__ XcdBarrier xcd_barrier_post(unsigned* bar, volatile LAS unsigned* st) {
    XcdBarrier b; b.bar = bar; b.x = xb_xcc_id(); b.st = st;
    if (threadIdx.x == 0) (void)xb_add(&bar[XB_XCNT(b.x)], 1u);
    return b;
}
__device__ __forceinline__ void xcd_barrier_complete(unsigned* bar, unsigned x, unsigned& nloc, unsigned& nx) {
    const unsigned G = gridDim.x * gridDim.y * gridDim.z;
    unsigned sum, cnt, mine, sp = 0u;
    for (;;) {
        sum = 0u; cnt = 0u; mine = 0u;
#pragma unroll
        for (unsigned j = 0; j < 16; ++j) { const unsigned c = xb_ld(&bar[XB_XCNT(j)]); sum += c; cnt += (c > 0u) ? 1u : 0u; mine = (j == x) ? c : mine; }
        if (sum == G) break;
        __builtin_amdgcn_s_sleep(1);
        if ((++sp & 255u) == 0u) { if (xb_ld(&bar[XB_TMO])) break; if (sp > XB_SPIN_CAP) { atomicAdd(&bar[XB_TMO], 1u); break; } }
    }
    nloc = mine > 0u ? mine : 1u; nx = cnt > 0u ? cnt : 1u;
}
__device__ __forceinline__ void xcd_barrier(const XcdBarrier& b) {
    asm volatile("s_waitcnt vmcnt(0)" ::: "memory");
    __syncthreads();
    if (threadIdx.x == 0) {
        unsigned* bar = b.bar;
        __builtin_amdgcn_s_waitcnt(0);
        unsigned nloc = b.st[0], nx = b.st[1];
        if (nloc == 0u) { xcd_barrier_complete(bar, b.x, nloc, nx); b.st[0] = nloc; b.st[1] = nx; }
        const unsigned old = xb_add(&bar[XB_XSUB(b.x)], 1u);
        const unsigned gen = old / nloc;
        if (old + 1u == (gen + 1u) * nloc) {
            __builtin_amdgcn_fence(__ATOMIC_RELEASE, "agent");
            asm volatile("s_waitcnt vmcnt(0)" ::: "memory");
            const unsigned og = xb_add(&bar[XB_TOP], 1u);
            const unsigned tg = og / nx;
            if (og + 1u == (tg + 1u) * nx) xb_add(&bar[XB_TOPGEN], 1u);
            else XB_SPIN(xb_ld(&bar[XB_TOPGEN]) == tg, bar);
            __builtin_amdgcn_fence(__ATOMIC_ACQUIRE, "agent");
            xb_add(&bar[XB_XGEN(b.x)], 1u);
            asm volatile("s_waitcnt vmcnt(0)" ::: "memory");
        } else {
            XB_SPIN(xb_ld(&bar[XB_XGEN(b.x)]) == gen, bar);
            __builtin_amdgcn_fence(__ATOMIC_ACQUIRE, "agent");
            asm volatile("s_waitcnt vmcnt(0)" ::: "memory");
        }
    }
    __syncthreads();
}

struct Args { const float* in[24]; float* out; unsigned char* ws; int ph_lo, ph_hi; };
struct Frame {
    LAS unsigned char* lds;
    int tid, lane, wave, G, bid;
    const float* const* in;
    float* out; unsigned char* ws;
};
__device__ __forceinline__ Frame launder(const Frame& F0) {
    Frame F = F0; int t = F0.tid; asm volatile("" : "+v"(t)); F.tid = t; F.lane = t & 63; F.wave = __builtin_amdgcn_readfirstlane(t >> 6);
    unsigned long long w = (unsigned long long)F0.ws; asm volatile("" : "+s"(w)); F.ws = (unsigned char*)w;
    unsigned l = (unsigned)(uintptr_t)F0.lds; asm volatile("" : "+s"(l)); F.lds = (LAS unsigned char*)(uintptr_t)l;
    int g = F0.G, b = F0.bid; asm volatile("" : "+s"(g), "+s"(b)); F.G = g; F.bid = b;
    return F;
}
#define IN_X 0
#define IN_C 1
#define IN_CTX 2
#define IN_CCTX 3
#define IN_ADAW 4
#define IN_ADAB 5
#define IN_WIN 6
#define IN_RPB 7
#define IN_SGLNG 8
#define IN_SGLNB 9
#define IN_SGW 10
#define IN_SGB 11
#define IN_QNG 12
#define IN_KNG 13
#define IN_WOUT 14
#define IN_LNMG 15
#define IN_LNMB 16
#define IN_RW 17
#define IN_RB 18
#define IN_WG 19
#define IN_WU 20
#define IN_WDN 21
#define IN_LNFG 22
#define IN_LNFB 23

__device__ __forceinline__ void p0_mod(const Frame& F) {
    LAS float* sl = (LAS float*)F.lds;
    LAS float* red = sl + 4096;
    const float* c = F.in[IN_C]; const float* cc = F.in[IN_CCTX];
    for (int t = F.tid; t < DM; t += NTHR) { const float a = c[t]; sl[t] = a * sigmoidf_(a); const float b = cc[t]; sl[DM + t] = b * sigmoidf_(b); }
    __syncthreads();
    float* MOD = (float*)(F.ws + WS_MOD);
    for (int item = F.bid; item < 256; item += F.G) {
        const int l = item >> 7, nb = item & 127, col0 = nb * 96;
        f32x2 a0 = {0.f, 0.f}, a1 = {0.f, 0.f};
        if (F.lane < 48) {
            const float* wp = F.in[IN_ADAW] + (size_t)l * DM * 12288 + (size_t)(F.wave * 256) * 12288 + col0 + 2 * F.lane;
            const LAS float* s0 = sl + F.wave * 256; const LAS float* s1 = sl + DM + F.wave * 256;
#pragma unroll 8
            for (int k = 0; k < 256; ++k) { const f32x2 w = *(const f32x2*)(wp + (size_t)k * 12288); a0 += s0[k] * w; a1 += s1[k] * w; }
            red[(F.wave * 2 + 0) * 96 + 2 * F.lane] = a0.x; red[(F.wave * 2 + 0) * 96 + 2 * F.lane + 1] = a0.y;
            red[(F.wave * 2 + 1) * 96 + 2 * F.lane] = a1.x; red[(F.wave * 2 + 1) * 96 + 2 * F.lane + 1] = a1.y;
        }
        __syncthreads();
        if (F.tid < 192) { const int v = F.tid / 96, q = F.tid % 96; float s = 0.f;
#pragma unroll
            for (int w = 0; w < 8; ++w) s += red[(w * 2 + v) * 96 + q];
            MOD[(size_t)(l * 2 + v) * 12288 + col0 + q] = s + F.in[IN_ADAB][l * 12288 + col0 + q]; }
        __syncthreads();
    }
}
__device__ __forceinline__ void tr_item(const float* W, int K, int N, bf16_t* WT, int k0, int n0, int drow0, LAS float* scr, int lane) {
#pragma unroll 8
    for (int i = 0; i < 32; ++i) { const int kk = 2 * i + (lane >> 5); scr[kk * 33 + (lane & 31)] = W[(size_t)(k0 + kk) * N + n0 + (lane & 31)]; }
    asm volatile("s_waitcnt lgkmcnt(0)" ::: "memory");
    const int c = lane & 7;
#pragma unroll
    for (int j = 0; j < 4; ++j) { const int n = (lane >> 3) + 8 * j; const LAS float* s = scr + (8 * c) * 33 + n;
        u32x4 o; o.x = cvt_pk_bf16(s[0 * 33], s[1 * 33]); o.y = cvt_pk_bf16(s[2 * 33], s[3 * 33]); o.z = cvt_pk_bf16(s[4 * 33], s[5 * 33]); o.w = cvt_pk_bf16(s[6 * 33], s[7 * 33]);
        *(u32x4*)(WT + (size_t)(drow0 + n) * K + k0 + 8 * c) = o; }
    asm volatile("s_waitcnt lgkmcnt(0)" ::: "memory");
}
__device__ __forceinline__ void p0_transposes(const Frame& F) {
    LAS float* scr = (LAS float*)(F.lds + 32768 + F.wave * 8704);
    const int gw = F.bid * NWAVES + F.wave, NGW = F.G * NWAVES;
    constexpr int NDENSE = 2 * 6144, NITEMS = NDENSE + 64 * 3072;
    for (int it = gw; it < NITEMS; it += NGW) {
        if (it < NDENSE) {
            const int l = it / 6144, r = it % 6144;
            if (r < 4096) { const int kb = r >> 7, nb = r & 127; tr_item(F.in[IN_WIN] + (size_t)l * DM * INW, DM, INW, (bf16_t*)(F.ws + WS_WIN) + (size_t)l * INW * DM, kb * 64, nb * 32, nb * 32, scr, F.lane); }
            else { const int r2 = r - 4096, kb = r2 >> 6, nb = r2 & 63; tr_item(F.in[IN_WOUT] + (size_t)l * DM * DM, DM, DM, (bf16_t*)(F.ws + WS_WOUT) + (size_t)l * DM * DM, kb * 64, nb * 32, nb * 32, scr, F.lane); }
        } else {
            const int m = it - NDENSE, le = m / 3072, r = m % 3072, which = r >> 10, r2 = r & 1023;
            if (which < 2) { const int kb = r2 >> 5, nb = r2 & 31, n0 = nb * 32;
                const float* W = F.in[which == 0 ? IN_WG : IN_WU] + (size_t)le * DM * DEXP;
                tr_item(W, DM, DEXP, (bf16_t*)(F.ws + WS_WGU) + (size_t)le * 2048 * DM, kb * 64, n0, (n0 >> 7) * 256 + (n0 & 127) + which * 128, scr, F.lane); }
            else { const int kb = r2 >> 6, nb = r2 & 63;
                tr_item(F.in[IN_WDN] + (size_t)le * DEXP * DM, DEXP, DM, (bf16_t*)(F.ws + WS_WD) + (size_t)le * DM * DEXP, kb * 64, nb * 32, nb * 32, scr, F.lane); }
        }
    }
}
__device__ __forceinline__ void p0_rope(const Frame& F) {
    const int g = F.bid * NTHR + F.tid;
    if (g < 128 * 32) { const int pos = g >> 5, i = g & 31; const float inv = powf(10000.0f, -(float)i / 32.0f); const float ang = (float)pos * inv;
        float* R = (float*)(F.ws + WS_ROPE); R[2 * g] = cosf(ang); R[2 * g + 1] = sinf(ang); }
}

__device__ __forceinline__ const float* xrow_ptr(const Frame& F, int l, int r) {
    if (l == 0) return r < SEQ ? F.in[IN_X] + (size_t)r * DM : F.in[IN_CTX] + (size_t)(r - SEQ) * DM;
    return (const float*)(F.ws + WS_XS) + (size_t)r * DM;
}
__device__ __forceinline__ void ln_stats(const f32x4 (&v)[8], float& mean, float& rstd) {
    float s = 0.f;
#pragma unroll
    for (int j = 0; j < 8; ++j) s += (v[j].x + v[j].y) + (v[j].z + v[j].w);
    mean = wave_sum(s) * (1.0f / DM);
    float q = 0.f;
#pragma unroll
    for (int j = 0; j < 8; ++j) { const f32x4 d = v[j] - mean; q += (d.x * d.x + d.y * d.y) + (d.z * d.z + d.w * d.w); }
    rstd = 1.0f / sqrtf(wave_sum(q) * (1.0f / DM) + LN_EPS);
}
template <bool TO_LDS>
__device__ __forceinline__ void modulate_store(const f32x4 (&v)[8], const float* sh, const float* sc, bf16_t* orow, LAS float* lrow, int lane) {
    float mean, rstd; ln_stats(v, mean, rstd);
#pragma unroll
    for (int j = 0; j < 8; ++j) { const int col = 4 * lane + 256 * j; const f32x4 s1 = *(const f32x4*)(sc + col), s0 = *(const f32x4*)(sh + col);
        const f32x4 h = (v[j] - mean) * rstd * (1.0f + s1) + s0;
        u32x2 w; w.x = cvt_pk_bf16(h.x, h.y); w.y = cvt_pk_bf16(h.z, h.w); *(u32x2*)(orow + col) = w;
        if (TO_LDS) *(LAS f32x4*)(lrow + col) = h; }
}
__device__ __forceinline__ void p_modulate1(const Frame& F, int l, int nrows) {
    const int gw = F.bid * NWAVES + F.wave, NGW = F.G * NWAVES;
    const float* MOD = (const float*)(F.ws + WS_MOD);
    bf16_t* H1 = (bf16_t*)(F.ws + WS_H1);
    for (int r = gw; r < nrows; r += NGW) {
        const float* xr = xrow_ptr(F, l, r); const int v = r >= SEQ; const float* m = MOD + (size_t)(l * 2 + v) * 12288;
        f32x4 x[8];
#pragma unroll
        for (int j = 0; j < 8; ++j) x[j] = *(const f32x4*)(xr + 4 * F.lane + 256 * j);
        modulate_store<false>(x, m, m + DM, H1 + (size_t)r * DM, (LAS float*)nullptr, F.lane);
    }
}

namespace pg8 {
constexpr int BM = 256, BK = 64, HALF = 128, HTB = HALF * BK * 2, STAGE_BYTES = 8 * HTB, NXCD = 8, WGM = 8;
__device__ __forceinline__ int lds_byte(int r, int c) { const int st = (r >> 4) * 2 + (c >> 5), rr = r & 15, cc = c & 31, ob = rr * 64 + cc * 2; return st * 1024 + (ob ^ (((ob >> 9) & 1) << 5)); }
__device__ __forceinline__ void stage_rc(int b, int& R, int& C) { const int st = b / 1024, sb = b % 1024, swz = sb ^ (((sb >> 9) & 1) << 5); R = (st >> 1) * 16 + swz / 64; C = (st & 1) * 32 + (swz % 64) / 2; }
__device__ __forceinline__ int perm32(int rho) { const int n = rho >> 4, i = rho & 15; return 8 * (i >> 2) + 4 * n + (i & 3); }
struct Unit { int pm, pn, e, mt; };
struct StaticOrder {
    int nM, nN, nwg, G, c, K; const bf16_t* Bt;
    __device__ __forceinline__ void init(int M, int N, int K_, const bf16_t* Bt_, int G_, int c_) { nM = M / BM; nN = N / BM; nwg = nM * nN; G = G_; c = c_; K = K_; Bt = Bt_; }
    __device__ __forceinline__ bool next(int i, Unit& u) const {
        const long L = (long)i * G + c; if (L >= nwg) return false;
        int wgid = (int)L; { const int q = nwg / NXCD, r = nwg % NXCD, xcd = wgid % NXCD, off = wgid / NXCD; wgid = (xcd < r ? xcd * (q + 1) : r * (q + 1) + (xcd - r) * q) + off; }
        const int nig = WGM * nN, gid = wgid / nig, fm = gid * WGM, gsz = (nM - fm) < WGM ? (nM - fm) : WGM;
        u.pm = fm + ((wgid % nig) % gsz); u.pn = (wgid % nig) / gsz; u.e = 0; u.mt = 0; return true;
    }
    __device__ __forceinline__ unsigned a_off(const Unit& u, int h, int R) const { return (unsigned)((u.pm * BM + h * HALF + R) * K) * 2u; }
    __device__ __forceinline__ const char* b_base(const Unit& u) const { return (const char*)Bt + (size_t)u.pn * BM * K * 2; }
};
template <bool GATHER> struct MoeOrder {
    const LAS int* tileEM; int ntiles, G, c, K; const int* list; const int* cnt; const bf16_t* Bt;
    __device__ __forceinline__ bool next(int i, Unit& u) const {
        const int L = i * G + c; if (L >= ntiles * 8) return false;
        const int tile = L >> 3; const int em = tileEM[tile]; u.pm = tile; u.pn = L & 7; u.e = em >> 8; u.mt = em & 255; return true;
    }
    __device__ __forceinline__ unsigned a_off(const Unit& u, int h, int R) const {
        if (GATHER) { const int slot = u.mt * BM + h * HALF + R; const int n = cnt[u.e]; int tok = 0; if (slot < n) tok = list[u.e * NROW + slot]; return (unsigned)(tok * K) * 2u; }
        return (unsigned)((u.pm * BM + h * HALF + R) * K) * 2u;
    }
    __device__ __forceinline__ const char* b_base(const Unit& u) const { return (const char*)Bt + ((size_t)u.e * 2048 + (size_t)u.pn * BM) * K * 2; }
};
struct EpiF32 {
    static constexpr bool PERM = false;
    float* C; int ldc;
    __device__ __forceinline__ void operator()(const f32x4 (&acc)[2][2][4][2], const Unit& u, int wr, int wc, int fr, int fq) const {
        const int row0 = u.pm * BM + wr * 64 + fr, col0 = u.pn * BM + wc * 32 + 4 * fq;
#pragma unroll
        for (int ai = 0; ai < 2; ++ai)
#pragma unroll
            for (int m = 0; m < 4; ++m) { float* rowp = C + (size_t)(row0 + ai * HALF + m * 16) * ldc + col0;
#pragma unroll
                for (int bj = 0; bj < 2; ++bj)
#pragma unroll
                    for (int n = 0; n < 2; ++n) *(f32x4*)(rowp + bj * HALF + n * 16) = acc[ai][bj][m][n]; }
    }
};
struct EpiProj {
    static constexpr bool PERM = true;
    bf16_t* O;
    __device__ __forceinline__ void operator()(const f32x4 (&acc)[2][2][4][2], const Unit& u, int wr, int wc, int fr, int fq) const {
        const int row0 = u.pm * BM + wr * 64 + fr, col0 = u.pn * BM + wc * 32 + 8 * fq; const bool g = (u.pn >= 6 && u.pn <= 9);
#pragma unroll
        for (int ai = 0; ai < 2; ++ai)
#pragma unroll
            for (int m = 0; m < 4; ++m) { bf16_t* rowp = O + (size_t)(row0 + ai * HALF + m * 16) * INW + col0;
#pragma unroll
                for (int bj = 0; bj < 2; ++bj) { f32x4 v0 = acc[ai][bj][m][0], v1 = acc[ai][bj][m][1];
                    if (g) {
#pragma unroll
                        for (int j = 0; j < 4; ++j) { v0[j] = gelu_tanh_fast(v0[j]); v1[j] = gelu_tanh_fast(v1[j]); } }
                    u32x4 w; w.x = cvt_pk_bf16(v0[0], v0[1]); w.y = cvt_pk_bf16(v0[2], v0[3]); w.z = cvt_pk_bf16(v1[0], v1[1]); w.w = cvt_pk_bf16(v1[2], v1[3]);
                    *(u32x4*)(rowp + bj * HALF) = w; } }
    }
};
struct EpiSwiGLU {
    static constexpr bool PERM = true;
    bf16_t* O;
    __device__ __forceinline__ void operator()(const f32x4 (&acc)[2][2][4][2], const Unit& u, int wr, int wc, int fr, int fq) const {
        const int row0 = u.pm * BM + wr * 64 + fr, col0 = u.pn * HALF + wc * 32 + 8 * fq;
#pragma unroll
        for (int ai = 0; ai < 2; ++ai)
#pragma unroll
            for (int m = 0; m < 4; ++m) { bf16_t* rowp = O + (size_t)(row0 + ai * HALF + m * 16) * DEXP + col0;
                f32x4 v0, v1;
#pragma unroll
                for (int j = 0; j < 4; ++j) { v0[j] = silu_fast(acc[ai][0][m][0][j]) * acc[ai][1][m][0][j]; v1[j] = silu_fast(acc[ai][0][m][1][j]) * acc[ai][1][m][1][j]; }
                u32x4 w; w.x = cvt_pk_bf16(v0[0], v0[1]); w.y = cvt_pk_bf16(v0[2], v0[3]); w.z = cvt_pk_bf16(v1[0], v1[1]); w.w = cvt_pk_bf16(v1[2], v1[3]);
                *(u32x4*)rowp = w; }
    }
};

template <class Epi, class Sched>
__device__ __forceinline__ void gemm_phase(LAS unsigned char* lds, int tid, const bf16_t* Amat, int K, const Sched& S, const Epi& E) {
    const int wid = __builtin_amdgcn_readfirstlane(tid >> 6), lane = tid & 63, wr = wid >> 2, wc = wid & 3, fr = lane & 15, fq = lane >> 4;
    const int nt = K / BK;
    int Rl[2], Cl[2]; unsigned voffB[2];
#pragma unroll
    for (int i = 0; i < 2; ++i) { int R, C; stage_rc(tid * 16 + i * 8192, R, C); Rl[i] = R; Cl[i] = C; const int Rb = Epi::PERM ? ((R & ~31) + perm32(R & 31)) : R; voffB[i] = (unsigned)(Rb * K + C) * 2u; }
    const size_t kstep = (size_t)(BK * 2);
    const size_t hstep = (size_t)HALF * K * 2;
    const unsigned ldsw = (unsigned)wid * 1024u;
    const int aoff = lds_byte(wr * 64 + fr, fq * 8), boff = lds_byte(wc * 32 + fr, fq * 8);
    const char* Ab = (const char*)Amat;
#define PG8_SA(b, h) (((b) * 2 + (h)) * HTB)
#define PG8_SB(b, h) ((4 + (b) * 2 + (h)) * HTB)
#define PG8_STAGE(bufoff, gbase, voff) do { _Pragma("unroll") for (int _i = 0; _i < 2; ++_i) \
        __builtin_amdgcn_global_load_lds((const unsigned*)((const char*)(gbase) + (voff)[_i]), (LAS unsigned*)(lds + (bufoff) + ldsw + _i * 8192), 16, 0, 0); } while (0)
#define PG8_LDA(dst, b, h) do { _Pragma("unroll") for (int m = 0; m < 4; ++m) _Pragma("unroll") for (int k = 0; k < 2; ++k) dst[m][k] = *(const LAS bf16x8*)(lds + PG8_SA(b, h) + aoff + m * 2048 + k * 1024); } while (0)
#define PG8_LDB(dst, b, h) do { _Pragma("unroll") for (int n = 0; n < 2; ++n) _Pragma("unroll") for (int k = 0; k < 2; ++k) dst[n][k] = *(const LAS bf16x8*)(lds + PG8_SB(b, h) + boff + n * 2048 + k * 1024); } while (0)
#define PG8_MMA(ai, bj, At, Bt) do { __builtin_amdgcn_s_setprio(1); _Pragma("unroll") for (int m = 0; m < 4; ++m) _Pragma("unroll") for (int n = 0; n < 2; ++n) _Pragma("unroll") for (int k = 0; k < 2; ++k) \
        acc[ai][bj][m][n] = __builtin_amdgcn_mfma_f32_16x16x32_bf16(Bt[n][k], At[m][k], acc[ai][bj][m][n], 0, 0, 0); __builtin_amdgcn_s_setprio(0); } while (0)
#define PG8_WAIT_V(n) asm volatile("s_waitcnt vmcnt(" #n ")" ::: "memory")
#define PG8_WAIT_L(n) asm volatile("s_waitcnt lgkmcnt(" #n ")" ::: "memory")
#define PG8_BAR __builtin_amdgcn_s_barrier()
#define PG8_SCHED __builtin_amdgcn_sched_barrier(0)
#define PG8_AOFFS(dst, u) do { _Pragma("unroll") for (int _h = 0; _h < 2; ++_h) _Pragma("unroll") for (int _i = 0; _i < 2; ++_i) dst[_h][_i] = S.a_off(u, _h, Rl[_i]) + (unsigned)Cl[_i] * 2u; \
        asm volatile("" : "+v"(dst[0][0]), "+v"(dst[0][1]), "+v"(dst[1][0]), "+v"(dst[1][1])); } while (0)
    Unit cur, nxt; int ui = 0;
    if (!S.next(0, cur)) return;
    f32x4 acc[2][2][4][2];
#pragma unroll
    for (int a = 0; a < 2; ++a)
#pragma unroll
        for (int b = 0; b < 2; ++b)
#pragma unroll
            for (int m = 0; m < 4; ++m)
#pragma unroll
                for (int n = 0; n < 2; ++n) acc[a][b][m][n] = (f32x4){0.f, 0.f, 0.f, 0.f};
    bf16x8 At[4][2], B0[2][2], B1[2][2];
    unsigned vA[2][2], vAn[2][2];
    PG8_AOFFS(vA, cur);
    const char* cB = S.b_base(cur);
    PG8_STAGE(PG8_SB(0, 0), cB, voffB); PG8_STAGE(PG8_SA(0, 0), Ab, vA[0]); PG8_STAGE(PG8_SB(0, 1), cB + hstep, voffB); PG8_STAGE(PG8_SA(0, 1), Ab, vA[1]);
    if (wr == 1) PG8_BAR;
    PG8_WAIT_V(4); PG8_BAR;
    PG8_STAGE(PG8_SB(1, 0), cB + kstep, voffB); PG8_STAGE(PG8_SA(1, 0), Ab + kstep, vA[0]); PG8_STAGE(PG8_SB(1, 1), cB + hstep + kstep, voffB);
    PG8_WAIT_V(6); PG8_BAR;
    for (;;) {
        const bool has_next = S.next(ui + 1, nxt);
        const char* nB = cB;
        if (has_next) { PG8_AOFFS(vAn, nxt); nB = S.b_base(nxt); }
        else {
#pragma unroll
            for (int h = 0; h < 2; ++h)
#pragma unroll
                for (int i = 0; i < 2; ++i) vAn[h][i] = vA[h][i]; }
        for (int t = 0; t < nt; t += 2) {
            const bool last = (t == nt - 2);
            const char* a1 = Ab + (size_t)(t + 1) * kstep;
            const char* a2 = last ? Ab : Ab + (size_t)(t + 2) * kstep; const char* b2 = last ? nB : cB + (size_t)(t + 2) * kstep;
            const char* a3 = a2 + kstep; const char* b3 = b2 + kstep;
            unsigned o2[2][2];
#pragma unroll
            for (int h = 0; h < 2; ++h)
#pragma unroll
                for (int i = 0; i < 2; ++i) o2[h][i] = last ? vAn[h][i] : vA[h][i];
            PG8_LDB(B0, 0, 0); PG8_SCHED; PG8_LDA(At, 0, 0); PG8_STAGE(PG8_SA(1, 1), a1, vA[1]);
            PG8_WAIT_L(8); PG8_BAR; PG8_WAIT_L(0); PG8_MMA(0, 0, At, B0); PG8_BAR; PG8_SCHED;
            PG8_LDB(B1, 0, 1); PG8_STAGE(PG8_SB(0, 0), b2, voffB);
            PG8_BAR; PG8_WAIT_L(0); PG8_MMA(0, 1, At, B1); PG8_BAR;
            PG8_LDA(At, 0, 1); PG8_STAGE(PG8_SA(0, 0), a2, o2[0]);
            PG8_BAR; PG8_WAIT_L(0); PG8_MMA(1, 0, At, B0); PG8_BAR; PG8_SCHED;
            PG8_STAGE(PG8_SB(0, 1), b2 + hstep, voffB);
            PG8_WAIT_V(6); PG8_BAR; PG8_MMA(1, 1, At, B1); PG8_BAR;
            PG8_LDB(B0, 1, 0); PG8_SCHED; PG8_LDA(At, 1, 0); PG8_STAGE(PG8_SA(0, 1), a2, o2[1]);
            PG8_WAIT_L(8); PG8_BAR; PG8_WAIT_L(0); PG8_MMA(0, 0, At, B0); PG8_BAR; PG8_SCHED;
            PG8_LDB(B1, 1, 1); PG8_STAGE(PG8_SB(1, 0), b3, voffB);
            PG8_BAR; PG8_WAIT_L(0); PG8_MMA(0, 1, At, B1); PG8_BAR;
            PG8_LDA(At, 1, 1); PG8_STAGE(PG8_SA(1, 0), a3, o2[0]);
            PG8_BAR; PG8_WAIT_L(0); PG8_MMA(1, 0, At, B0); PG8_BAR; PG8_SCHED;
            PG8_STAGE(PG8_SB(1, 1), b3 + hstep, voffB);
            PG8_WAIT_V(6); PG8_BAR; PG8_MMA(1, 1, At, B1); PG8_BAR;
        }
        E(acc, cur, wr, wc, fr, fq);
        if (!has_next) break;
#pragma unroll
        for (int a = 0; a < 2; ++a)
#pragma unroll
            for (int b = 0; b < 2; ++b)
#pragma unroll
                for (int m = 0; m < 4; ++m)
#pragma unroll
                    for (int n = 0; n < 2; ++n) acc[a][b][m][n] = (f32x4){0.f, 0.f, 0.f, 0.f};
        cur = nxt; cB = nB; ++ui;
#pragma unroll
        for (int h = 0; h < 2; ++h)
#pragma unroll
            for (int i = 0; i < 2; ++i) vA[h][i] = vAn[h][i];
    }
    PG8_WAIT_V(0);
    if (wr == 0) PG8_BAR;
    PG8_BAR;
#undef PG8_SA
#undef PG8_SB
#undef PG8_STAGE
#undef PG8_LDA
#undef PG8_LDB
#undef PG8_MMA
#undef PG8_WAIT_V
#undef PG8_WAIT_L
#undef PG8_BAR
#undef PG8_SCHED
#undef PG8_AOFFS
}
}

__device__ __forceinline__ void p_rmsrope(const Frame& F, int l, int nrows) {
    const int gw = F.bid * NWAVES + F.wave, NGW = F.G * NWAVES;
    bf16_t* P = (bf16_t*)(F.ws + WS_PROJ);
    const float* R = (const float*)(F.ws + WS_ROPE);
    const int i = F.lane & 31, ax = F.lane >> 5, d1 = ax * 64 + i, d2 = d1 + 32;
    const float gq1 = F.in[IN_QNG][l * 128 + d1], gq2 = F.in[IN_QNG][l * 128 + d2], gk1 = F.in[IN_KNG][l * 128 + d1], gk2 = F.in[IN_KNG][l * 128 + d2];
    for (int r = gw; r < nrows; r += NGW) {
        float cs = 1.f, sn = 0.f;
        if (r < SEQ) { const int pos = ax == 0 ? (r >> 6) : (r & 63); cs = R[2 * (pos * 32 + i)]; sn = R[2 * (pos * 32 + i) + 1]; }
#pragma unroll
        for (int hh = 0; hh < 10; ++hh) {
            bf16_t* p = P + (size_t)r * INW + (hh < 8 ? 2560 + hh * 128 : 3584 + (hh - 8) * 128);
            float x1 = bf2f(p[d1]), x2 = bf2f(p[d2]);
            const float ss = wave_sum(x1 * x1 + x2 * x2);
            const float rinv = 1.0f / sqrtf(ss * (1.0f / 128.0f) + LN_EPS);
            x1 = x1 * rinv * (hh < 8 ? gq1 : gk1); x2 = x2 * rinv * (hh < 8 ? gq2 : gk2);
            p[d1] = f2bf(x1 * cs - x2 * sn); p[d2] = f2bf(x2 * cs + x1 * sn);
        }
    }
}

namespace att {
constexpr int D = 128, NW = 8, QBLK = 32, KVBLK = 64;
constexpr float SCALE = 0.088388347648318440f;
constexpr float THR = 8.f;
constexpr int LDQ = INW, LDK = INW, LDO = DM;
constexpr size_t SHM_V = KVBLK * D * 2, SHM_K = KVBLK * D * 2, SHM_ATTN = 2 * SHM_V + 2 * SHM_K + NW * 64 * 4;
#define KSWZ(row, colB) ((row) * 256 + ((colB) ^ (((row) & 7) << 4)))
#define SBAR() __builtin_amdgcn_sched_barrier(0)
__device__ __forceinline__ int crow(int r, int hi) { return (r & 3) + 8 * (r >> 2) + 4 * hi; }
__device__ __forceinline__ unsigned cvtpk(float lo, float hi) { unsigned r; asm volatile("v_cvt_pk_bf16_f32 %0, %1, %2" : "=v"(r) : "v"(lo), "v"(hi)); return r; }
__device__ __forceinline__ void partialSM(f32x16& p0, f32x16& p1, float& m_reg, float& mn, float& alpha) {
  constexpr float C = SCALE * 1.4426950408889634f;
  float pmax = p0[0];
#pragma unroll
  for (int r = 1; r < 16; ++r) pmax = fmaxf(pmax, p0[r]);
#pragma unroll
  for (int r = 0; r < 16; ++r) pmax = fmaxf(pmax, p1[r]);
  { auto rr = __builtin_amdgcn_permlane32_swap(__float_as_uint(pmax), __float_as_uint(pmax), false, false);
    pmax = fmaxf(__uint_as_float(rr[0]), __uint_as_float(rr[1])); }
  if (__builtin_expect(__all(pmax - m_reg <= THR / SCALE), 1)) { mn = m_reg; alpha = 1.f; }
  else { mn = fmaxf(m_reg, pmax); alpha = __builtin_amdgcn_exp2f((m_reg - mn) * C); m_reg = mn; }
  float mnC = -mn * C;
#pragma unroll
  for (int r = 0; r < 16; ++r) p0[r] = fmaf(p0[r], C, mnC);
#pragma unroll
  for (int r = 0; r < 16; ++r) p1[r] = fmaf(p1[r], C, mnC);
#pragma unroll
  for (int r = 0; r < 16; ++r) p0[r] = __builtin_amdgcn_exp2f(p0[r]);
}
__device__ __forceinline__ void finishSM(f32x16& p0, f32x16& p1, float alpha, float& l_reg, bf16x8& pa0, bf16x8& pa1, bf16x8& pa2, bf16x8& pa3) {
#pragma unroll
  for (int r = 0; r < 16; ++r) p1[r] = __builtin_amdgcn_exp2f(p1[r]);
  float ps = 0;
#pragma unroll
  for (int r = 0; r < 16; ++r) ps += p0[r];
#pragma unroll
  for (int r = 0; r < 16; ++r) ps += p1[r];
  { auto rr = __builtin_amdgcn_permlane32_swap(__float_as_uint(ps), __float_as_uint(ps), false, false);
    ps = __uint_as_float(rr[0]) + __uint_as_float(rr[1]); }
  l_reg = l_reg * alpha + ps;
#define PK4(P, BASE, OUT) do { unsigned a0 = cvtpk(P[BASE + 0], P[BASE + 1]), a1 = cvtpk(P[BASE + 2], P[BASE + 3]);   \
    unsigned b0 = cvtpk(P[BASE + 4], P[BASE + 5]), b1 = cvtpk(P[BASE + 6], P[BASE + 7]);                              \
    auto r0 = __builtin_amdgcn_permlane32_swap(a0, b0, false, false); auto r1 = __builtin_amdgcn_permlane32_swap(a1, b1, false, false); \
    u32x4 w = {r0[0], r1[0], r0[1], r1[1]}; OUT = *reinterpret_cast<bf16x8*>(&w); } while (0)
  PK4(p0, 0, pa0); PK4(p0, 8, pa1); PK4(p1, 0, pa2); PK4(p1, 8, pa3);
#undef PK4
}
__device__ __forceinline__ void qkt(f32x16& p0, f32x16& p1, const bf16_t* Ks, const bf16x8* qr, int r32, int hi) {
  p0 = f32x16{}; p1 = f32x16{};
#pragma unroll
  for (int d0 = 0; d0 < 8; ++d0) { int cb = (d0 * 16 + hi * 8) * 2;
    bf16x8 b0 = *reinterpret_cast<const bf16x8*>((const char*)Ks + KSWZ(r32, cb));
    bf16x8 b1 = *reinterpret_cast<const bf16x8*>((const char*)Ks + KSWZ(32 + r32, cb));
    p0 = __builtin_amdgcn_mfma_f32_32x32x16_bf16(b0, qr[d0], p0, 0, 0, 0);
    p1 = __builtin_amdgcn_mfma_f32_32x32x16_bf16(b1, qr[d0], p1, 0, 0, 0); }
}
__device__ __forceinline__ int v_st(int k, int c) { const int kk = (k & ~0xC) | ((k & 4) << 1) | ((k & 8) >> 1); return ((kk >> 3) * 4 + (c >> 5)) * 512 + ((kk & 7) * 32 + (c & 31)) * 2; }
__device__ __forceinline__ int v_rd_base(int lane) { return ((lane & 3) << 3) | (((lane >> 2) & 3) << 6) | (((lane >> 4) & 1) << 5) | (((lane >> 5) & 1) << 8); }
constexpr int v_rd_off(int d0, int ks, int half) { return d0 * 512 + ks * 4096 + half * 2048; }
template <int OFF> __device__ __forceinline__ s16x4 tr_read(int vb) {
  s16x4 r; asm volatile("ds_read_b64_tr_b16 %0, %1 offset:%2" : "=&v"(r) : "v"(vb), "i"(OFF) : "memory"); return r;
}
template <int D0> __device__ __forceinline__ void pv_one(f32x16& od, int vb, bf16x8 pa0, bf16x8 pa1, bf16x8 pa2, bf16x8 pa3) {
  const s16x4 l0 = tr_read<v_rd_off(D0, 0, 0)>(vb), h0 = tr_read<v_rd_off(D0, 0, 1)>(vb), l1 = tr_read<v_rd_off(D0, 1, 0)>(vb), h1 = tr_read<v_rd_off(D0, 1, 1)>(vb);
  const s16x4 l2 = tr_read<v_rd_off(D0, 2, 0)>(vb), h2 = tr_read<v_rd_off(D0, 2, 1)>(vb), l3 = tr_read<v_rd_off(D0, 3, 0)>(vb), h3 = tr_read<v_rd_off(D0, 3, 1)>(vb);
  asm volatile("s_waitcnt lgkmcnt(0)" ::: "memory"); SBAR();
#define PK(L, H) (bf16x8){L[0], L[1], L[2], L[3], H[0], H[1], H[2], H[3]}
  od = __builtin_amdgcn_mfma_f32_32x32x16_bf16(pa0, PK(l0, h0), od, 0, 0, 0);
  od = __builtin_amdgcn_mfma_f32_32x32x16_bf16(pa1, PK(l1, h1), od, 0, 0, 0);
  od = __builtin_amdgcn_mfma_f32_32x32x16_bf16(pa2, PK(l2, h2), od, 0, 0, 0);
  od = __builtin_amdgcn_mfma_f32_32x32x16_bf16(pa3, PK(l3, h3), od, 0, 0, 0);
#undef PK
}
__device__ __forceinline__ void pv_d0(f32x16* o, int vb, bf16x8 pa0, bf16x8 pa1, bf16x8 pa2, bf16x8 pa3) {
  pv_one<0>(o[0], vb, pa0, pa1, pa2, pa3); pv_one<1>(o[1], vb, pa0, pa1, pa2, pa3); pv_one<2>(o[2], vb, pa0, pa1, pa2, pa3); pv_one<3>(o[3], vb, pa0, pa1, pa2, pa3);
}
struct MapLinear { long base; __device__ __forceinline__ long operator()(int t) const { return base + (long)t * KVBLK; } };
struct MapNA { int rs0; __device__ __forceinline__ long operator()(int t) const { return t < 4 ? (long)SEQ + t * 64 : (long)(rs0 + t - 4) * 64; } };
struct HookNone { __device__ __forceinline__ void operator()(f32x16&, f32x16&, int, int) const {} };
struct HookNA {
  const LAS float* bias; int qr, rs, rs0, cbase  , bbase  ;
  __device__ __forceinline__ void operator()(f32x16& p0, f32x16& p1, int tile, int hi) const {
    if (tile < 4) return;
    const int kr = rs0 + tile - 4; const bool rowok = (kr >= rs) && (kr <= rs + 7);
    int drow = kr - qr + 7; drow = drow < 0 ? 0 : (drow > 14 ? 14 : drow);
    const float ninf = -__builtin_inff();
    const LAS float* bp = bias + drow * 31 + bbase;
#pragma unroll
    for (int r = 0; r < 16; ++r) {
      const int kc = (r & 3) + 8 * (r >> 2);
      const bool ok0 = rowok && (unsigned)(kc + cbase) <= 15u, ok1 = rowok && (unsigned)(kc + 32 + cbase) <= 15u;
      p0[r] = ok0 ? p0[r] + bp[kc] : ninf; p1[r] = ok1 ? p1[r] + bp[kc + 32] : ninf;
    }
  }
};
template <int SDEPTH, class Map, class Hook>
__device__ __forceinline__ void attn_body(const bf16_t* __restrict__ Qb, const bf16_t* __restrict__ Kh, const bf16_t* __restrict__ Vh,
                                          bf16_t* __restrict__ Ob, int NT, const Map map, const Hook hook, char* lds, int tid) {
  const int wid = tid >> 6, lane = tid & 63, r32 = lane & 31, hi = lane >> 5;
  bf16_t* V_lds = (bf16_t*)lds; bf16_t* K_lds = (bf16_t*)(lds + 2 * SHM_V);
  float* ws = (float*)(lds + 2 * SHM_V + 2 * SHM_K) + wid * 64; float* li_l = ws; float* al_l = ws + 32;
  float m_reg = -1e30f, l_reg = 0; f32x16 o[4] = {}; bf16x8 qr[8];
  const bf16_t* Qw = Qb + (long)(wid * QBLK + r32) * LDQ + hi * 8;
#pragma unroll
  for (int d0 = 0; d0 < 8; ++d0) qr[d0] = *reinterpret_cast<const bf16x8*>(Qw + d0 * 16);
  const int sr = tid >> 4, sc = (tid & 15) * 8, vst0 = v_st(sr, sc), vst1 = v_st(32 + sr, sc);
  const int vb0 = (int)(uintptr_t)V_lds + v_rd_base(lane);
  struct { bf16x8 vs0, vs1, ks0, ks1; } sr_[SDEPTH];
#define SLOAD(i, tile) do { const long _k0 = map(tile); sr_[i].vs0 = *reinterpret_cast<const bf16x8*>(&Vh[(_k0 + sr) * LDK + sc]); sr_[i].vs1 = *reinterpret_cast<const bf16x8*>(&Vh[(_k0 + 32 + sr) * LDK + sc]); \
    sr_[i].ks0 = *reinterpret_cast<const bf16x8*>(&Kh[(_k0 + sr) * LDK + sc]); sr_[i].ks1 = *reinterpret_cast<const bf16x8*>(&Kh[(_k0 + 32 + sr) * LDK + sc]); } while (0)
#define SWRITE(b, i) do { *(bf16x8*)((char*)V_lds + (b) * SHM_V + vst0) = sr_[i].vs0;          \
    *(bf16x8*)((char*)V_lds + (b) * SHM_V + vst1) = sr_[i].vs1; int kc = sc * 2;               \
    *(bf16x8*)((char*)K_lds + (b) * SHM_K + KSWZ(sr, kc)) = sr_[i].ks0;                       \
    *(bf16x8*)((char*)K_lds + (b) * SHM_K + KSWZ(32 + sr, kc)) = sr_[i].ks1; } while (0)
#define SWAIT() do { if constexpr (SDEPTH == 2) asm volatile("s_waitcnt vmcnt(4)" ::: "memory"); else asm volatile("s_waitcnt vmcnt(0)" ::: "memory"); } while (0)
#define RESC(a) do { if (__any((a) < 1.f)) { if (hi == 0) al_l[r32] = (a); asm volatile("s_waitcnt lgkmcnt(0)" ::: "memory"); \
    _Pragma("unroll") for (int d = 0; d < 4; ++d) _Pragma("unroll") for (int r = 0; r < 16; ++r) o[d][r] *= al_l[crow(r, hi)]; } } while (0)
  f32x16 pA0, pA1, pB0, pB1; float mnA, mnB, alA, alB; bf16x8 pa0, pa1, pa2, pa3;
  constexpr int SE = 0, SO = SDEPTH - 1;
  SLOAD(SE, 0); asm volatile("s_waitcnt vmcnt(0)" ::: "memory"); SWRITE(0, SE); __syncthreads();
  qkt(pA0, pA1, K_lds, qr, r32, hi); hook(pA0, pA1, 0, hi); partialSM(pA0, pA1, m_reg, mnA, alA);
  SLOAD(SO, 1); if constexpr (SDEPTH == 2) { if (2 < NT) SLOAD(SE, 2); }
  SWAIT(); SWRITE(1, SO); __syncthreads();
  for (int j = 1; j + 1 < NT; j += 2) {
    SBAR(); qkt(pB0, pB1, (bf16_t*)((char*)K_lds + SHM_K), qr, r32, hi);
    finishSM(pA0, pA1, alA, l_reg, pa0, pa1, pa2, pa3); SBAR();
    SLOAD(SO, j + SDEPTH); SBAR();
    pv_d0(o, vb0, pa0, pa1, pa2, pa3); hook(pB0, pB1, j, hi); partialSM(pB0, pB1, m_reg, mnB, alB);
    __syncthreads(); SWAIT(); SWRITE(0, SE);
    RESC(alB); __syncthreads();
    SBAR(); qkt(pA0, pA1, K_lds, qr, r32, hi);
    finishSM(pB0, pB1, alB, l_reg, pa0, pa1, pa2, pa3); SBAR();
    if (SDEPTH == 1 || j + 3 < NT) SLOAD(SE, j + 1 + SDEPTH); SBAR();
    pv_d0(o, vb0 + (int)SHM_V, pa0, pa1, pa2, pa3); hook(pA0, pA1, j + 1, hi); partialSM(pA0, pA1, m_reg, mnA, alA);
    __syncthreads(); SWAIT(); SWRITE(1, SO);
    RESC(alA); __syncthreads();
  }
  SBAR(); qkt(pB0, pB1, (bf16_t*)((char*)K_lds + SHM_K), qr, r32, hi);
  finishSM(pA0, pA1, alA, l_reg, pa0, pa1, pa2, pa3); SBAR();
  pv_d0(o, vb0, pa0, pa1, pa2, pa3); hook(pB0, pB1, NT - 1, hi); partialSM(pB0, pB1, m_reg, mnB, alB);
  __syncthreads(); RESC(alB);
  finishSM(pB0, pB1, alB, l_reg, pa0, pa1, pa2, pa3); SBAR();
  pv_d0(o, vb0 + (int)SHM_V, pa0, pa1, pa2, pa3);
  if (hi == 0) li_l[r32] = l_reg; asm volatile("s_waitcnt lgkmcnt(0)" ::: "memory");
  float rli[16];
#pragma unroll
  for (int r = 0; r < 16; ++r) rli[r] = __builtin_amdgcn_rcpf(li_l[crow(r, hi)]);
  bf16_t* Ow = Ob + (long)(wid * QBLK) * LDO;
#pragma unroll
  for (int r = 0; r < 16; ++r) { int orow = crow(r, hi);
#pragma unroll
    for (int d0 = 0; d0 < 4; ++d0) Ow[(long)orow * LDO + d0 * 32 + r32] = f2bf(o[d0][r] * rli[r]); }
  __syncthreads();
#undef SLOAD
#undef SWRITE
#undef SWAIT
#undef RESC
}
}

__device__ __forceinline__ void sg_unit(const Frame& F, int l, int c, int g) {
    LAS float* wS = (LAS float*)F.lds;
    LAS float* vn = wS + 128 * 128;
    const bf16_t* P = (const bf16_t*)(F.ws + WS_PROJ);
    const float* W = F.in[IN_SGW] + (size_t)(l * 4 + g) * 128 * 128;
    for (int t = F.tid; t < 128 * 128 / 4; t += NTHR) *(LAS f32x4*)(wS + 4 * t) = *(const f32x4*)(W + 4 * t);
    {
        const float g0 = F.in[IN_SGLNG][(l * 4 + g) * 128 + 2 * F.lane], g1 = F.in[IN_SGLNG][(l * 4 + g) * 128 + 2 * F.lane + 1];
        const float b0 = F.in[IN_SGLNB][(l * 4 + g) * 128 + 2 * F.lane], b1 = F.in[IN_SGLNB][(l * 4 + g) * 128 + 2 * F.lane + 1];
        for (int jj = 0; jj < 16; ++jj) { const int j = F.wave * 16 + jj; const size_t p = (size_t)(c * 128 + j);
            const unsigned u = *(const unsigned*)(P + p * INW + 1536 + 512 + g * 128 + 2 * F.lane);
            const float x0 = bf2f((bf16_t)(u & 0xffffu)), x1 = bf2f((bf16_t)(u >> 16));
            const float mean = wave_sum(x0 + x1) * (1.0f / 128.0f); const float e0 = x0 - mean, e1 = x1 - mean;
            const float rstd = 1.0f / sqrtf(wave_sum(e0 * e0 + e1 * e1) * (1.0f / 128.0f) + LN_EPS);
            vn[j * 128 + 2 * F.lane] = e0 * rstd * g0 + b0; vn[j * 128 + 2 * F.lane + 1] = e1 * rstd * g1 + b1; }
    }
    __syncthreads();
    const int ti = F.tid >> 4, td = F.tid & 15, i0 = 4 * ti, d0 = 8 * td;
    f32x4 acc[4][2];
#pragma unroll
    for (int a = 0; a < 4; ++a) { acc[a][0] = (f32x4){0.f, 0.f, 0.f, 0.f}; acc[a][1] = (f32x4){0.f, 0.f, 0.f, 0.f}; }
    for (int j = 0; j < 128; j += 4) {
        f32x4 w[4];
#pragma unroll
        for (int a = 0; a < 4; ++a) w[a] = *(const LAS f32x4*)(wS + (i0 + a) * 128 + j);
#pragma unroll
        for (int q = 0; q < 4; ++q) { const f32x4 v0 = *(const LAS f32x4*)(vn + (j + q) * 128 + d0), v1 = *(const LAS f32x4*)(vn + (j + q) * 128 + d0 + 4);
#pragma unroll
            for (int a = 0; a < 4; ++a) { acc[a][0] += w[a][q] * v0; acc[a][1] += w[a][q] * v1; } }
    }
    bf16_t* MIXp = (bf16_t*)(F.ws + WS_MIX);
#pragma unroll
    for (int a = 0; a < 4; ++a) { const int i = i0 + a; const size_t p = (size_t)(c * 128 + i); const float bs = F.in[IN_SGB][(l * 4 + g) * 128 + i];
        const u32x4 uu = *(const u32x4*)(P + p * INW + 1536 + g * 128 + d0);
        float uf[8];
#pragma unroll
        for (int q = 0; q < 4; ++q) { uf[2 * q] = bf2f((bf16_t)(uu[q] & 0xffffu)); uf[2 * q + 1] = bf2f((bf16_t)(uu[q] >> 16)); }
        u32x4 o; o.x = cvt_pk_bf16((acc[a][0].x + bs) * uf[0], (acc[a][0].y + bs) * uf[1]); o.y = cvt_pk_bf16((acc[a][0].z + bs) * uf[2], (acc[a][0].w + bs) * uf[3]);
        o.z = cvt_pk_bf16((acc[a][1].x + bs) * uf[4], (acc[a][1].y + bs) * uf[5]); o.w = cvt_pk_bf16((acc[a][1].z + bs) * uf[6], (acc[a][1].w + bs) * uf[7]);
        *(u32x4*)(MIXp + p * DM + 512 + g * 128 + d0) = o; }
    __syncthreads();
}

__device__ __forceinline__ void p_att_dense(const Frame& F, int l) {
    const bf16_t* P = (const bf16_t*)(F.ws + WS_PROJ); bf16_t* MIXp = (bf16_t*)(F.ws + WS_MIX);
    const int total = 256 + ((l == 0) ? 12 : 0);
    for (int u = F.bid; u < total; u += F.G) {
        int qrow, qcol, kcol, vcol, ocol, nt; long kbase;
        if (u < 256) { const int h = u & 7, qb = u >> 3, kvh = h >> 2; qrow = qb * 256; qcol = 2560 + h * 128; kcol = 3584 + kvh * 128; vcol = 3840 + kvh * 128; ocol = 1024 + h * 128; nt = NROW / 64; kbase = 0; }
        else { const int v = u - 256; qrow = SEQ; nt = 4; kbase = SEQ;
            if (v < 4) { qcol = v * 128; kcol = 512 + v * 128; vcol = 1024 + v * 128; ocol = v * 128; }
            else { const int h = v - 4, kvh = h >> 2; qcol = 2560 + h * 128; kcol = 3584 + kvh * 128; vcol = 3840 + kvh * 128; ocol = 1024 + h * 128; } }
        att::attn_body<2>(P + (size_t)qrow * INW + qcol, P + kcol, P + vcol, MIXp + (size_t)qrow * DM + ocol, nt, att::MapLinear{kbase}, att::HookNone{}, (char*)F.lds, F.tid);
    }
}
__device__ __forceinline__ void p_att_na(const Frame& F, int l) {
    const bf16_t* P = (const bf16_t*)(F.ws + WS_PROJ); bf16_t* MIXp = (bf16_t*)(F.ws + WS_MIX);
    LAS float* bt = (LAS float*)(F.lds + LDS_SC);
    for (int v = F.bid; v < 128; v += F.G) {
        const int h = v & 3, qb = v >> 2, R0 = qb * 4;
        const float* rpb = F.in[IN_RPB] + (size_t)(l * 4 + h) * 15 * 31;
        for (int t = F.tid; t < 640; t += NTHR) { const int q = t - 48; bt[t] = (q >= 0 && q < 15 * 31) ? rpb[q] * (1.0f / att::SCALE) : 0.f; }
        __syncthreads();
        int rs0 = R0 - 4; rs0 = rs0 < 0 ? 0 : (rs0 > 116 ? 116 : rs0);
        const int qr = R0 + (F.wave >> 1), qc = (F.wave & 1) * 32 + (F.lane & 31);
        int rs = qr - 4; rs = rs < 0 ? 0 : (rs > 120 ? 120 : rs);
        int cs = qc - 8; cs = cs < 0 ? 0 : (cs > 48 ? 48 : cs);
        att::attn_body<1>(P + (size_t)(qb * 256) * INW + h * 128, P + 512 + h * 128, P + 1024 + h * 128,
                       MIXp + (size_t)(qb * 256) * DM + h * 128, 16, att::MapNA{rs0}, att::HookNA{bt, qr, rs, rs0, 4 * (F.lane >> 5) - cs, 48 + 15 - qc + 4 * (F.lane >> 5)}, (char*)F.lds, F.tid);
    }
}
__device__ __forceinline__ void p_att_sg(const Frame& F, int l) {
    const int nsg = (l == 0) ? 264 : 256;
    for (int v = F.bid; v < nsg; v += F.G) sg_unit(F, l, v >> 2, v & 3);
}

__device__ __forceinline__ void p_mixln_router(const Frame& F, int l, int nrows) {
    LAS float* hs = (LAS float*)F.lds;
    LAS float* part = (LAS float*)(F.lds + LDS_PART);
    LAS float* scS = (LAS float*)(F.lds + LDS_SC);
    LAS float* selS = scS + 512;
    const float* MOD = (const float*)(F.ws + WS_MOD);
    const float* Y1 = (const float*)(F.ws + WS_Y1);
    float* XS = (float*)(F.ws + WS_XS);
    bf16_t* H2 = (bf16_t*)(F.ws + WS_H2);
    const float* RW = F.in[IN_RW]; const float* RB = F.in[IN_RB];
    const float* lg = F.in[IN_LNMG] + l * DM; const float* lb = F.in[IN_LNMB] + l * DM;
    int* cnt = (int*)(F.ws + WS_CTL) + CW_CNT + l * 32;
    int* tokE = (int*)(F.ws + WS_TOKE); int* tokP = (int*)(F.ws + WS_TOKP); float* tokG = (float*)(F.ws + WS_TOKG); int* list = (int*)(F.ws + WS_LIST);
    const int rpw = (nrows + F.G - 1) / F.G;
    const int rbeg = F.bid * rpw, rend = (rbeg + rpw < nrows) ? rbeg + rpw : nrows;
    for (int t0 = rbeg; t0 < rend; t0 += 16) {
        const int nr = (rend - t0 < 16) ? rend - t0 : 16;
#pragma unroll 1
        for (int s = 0; s < 2; ++s) {
            const int lr = F.wave * 2 + s;
            if (lr < nr) {
                const int r = t0 + lr; const int v = r >= SEQ; const float* m = MOD + (size_t)(l * 2 + v) * 12288;
                const float* xr = xrow_ptr(F, l, r); const float* yr = Y1 + (size_t)r * DM;
                f32x4 z[8];
#pragma unroll
                for (int j = 0; j < 8; ++j) { const int col = 4 * F.lane + 256 * j; z[j] = ALPHA * *(const f32x4*)(xr + col) + *(const f32x4*)(m + 2 * DM + col) * *(const f32x4*)(yr + col); }
                float mean, rstd; ln_stats(z, mean, rstd);
#pragma unroll
                for (int j = 0; j < 8; ++j) { const int col = 4 * F.lane + 256 * j; z[j] = (z[j] - mean) * rstd * *(const f32x4*)(lg + col) + *(const f32x4*)(lb + col); *(f32x4*)(XS + (size_t)r * DM + col) = z[j]; }
                modulate_store<true>(z, m + 3 * DM, m + 4 * DM, H2 + (size_t)r * DM, hs + lr * DM, F.lane);
            } else {
#pragma unroll
                for (int j = 0; j < 8; ++j) *(LAS f32x4*)(hs + lr * DM + 4 * F.lane + 256 * j) = (f32x4){0.f, 0.f, 0.f, 0.f};
            }
        }
        __syncthreads();
        {
            const int e = F.lane & 31, rh = F.lane >> 5; float a[8];
#pragma unroll
            for (int q = 0; q < 8; ++q) a[q] = 0.f;
            const float* wp = RW + (size_t)(F.wave * 256) * 32 + e;
            for (int k4 = 0; k4 < 64; ++k4) {
                const float w0 = wp[(4 * k4 + 0) * 32], w1 = wp[(4 * k4 + 1) * 32], w2 = wp[(4 * k4 + 2) * 32], w3 = wp[(4 * k4 + 3) * 32];
#pragma unroll
                for (int q = 0; q < 8; ++q) { const f32x4 hv = *(const LAS f32x4*)(hs + (rh * 8 + q) * DM + F.wave * 256 + 4 * k4); a[q] += hv.x * w0 + hv.y * w1 + hv.z * w2 + hv.w * w3; }
            }
#pragma unroll
            for (int q = 0; q < 8; ++q) part[(F.wave * 16 + rh * 8 + q) * 32 + e] = a[q];
        }
        __syncthreads();
        { const int row = F.tid >> 5, e = F.tid & 31; float s = 0.f;
#pragma unroll
          for (int w = 0; w < 8; ++w) s += part[(w * 16 + row) * 32 + e];
          const float sc = sigmoidf_(s); scS[row * 32 + e] = sc; selS[row * 32 + e] = sc + RB[e]; }
        __syncthreads();
        if (F.tid < nr) {
            const int row = F.tid, r = t0 + row; const LAS float* sel = selS + row * 32; const LAS float* sc = scS + row * 32;
            int best = 0; float bestv = -__builtin_inff();
            for (int g = 0; g < 4; ++g) { float m1 = -__builtin_inff(), m2 = -__builtin_inff();
                for (int q = 0; q < 8; ++q) { const float x = sel[g * 8 + q]; if (x > m1) { m2 = m1; m1 = x; } else if (x > m2) m2 = x; }
                const float gs = m1 + m2; if (gs > bestv) { bestv = gs; best = g; } }
            int i1 = 0, i2 = 0; float m1 = -__builtin_inff(), m2 = -__builtin_inff();
            for (int q = 0; q < 8; ++q) { const float x = sel[best * 8 + q]; if (x > m1) { m2 = m1; i2 = i1; m1 = x; i1 = q; } else if (x > m2) { m2 = x; i2 = q; } }
            const int e1 = best * 8 + i1, e2 = best * 8 + i2; const float s1 = sc[e1], s2 = sc[e2], den = s1 + s2;
            const int p1 = atomicAdd(cnt + e1, 1), p2 = atomicAdd(cnt + e2, 1);
            list[e1 * NROW + p1] = r; list[e2 * NROW + p2] = r;
            tokE[2 * r] = e1; tokE[2 * r + 1] = e2; tokP[2 * r] = p1; tokP[2 * r + 1] = p2; tokG[2 * r] = s1 / den; tokG[2 * r + 1] = s2 / den;
        }
        __syncthreads();
    }
}

__device__ __forceinline__ int moe_tiles(const Frame& F, int l) {
    LAS int* tileEM = (LAS int*)(F.lds + LDS_TILE); LAS int* tbase = tileEM + 128;
    const int* cnt = (const int*)(F.ws + WS_CTL) + CW_CNT + l * 32;
    __syncthreads();
    if (F.tid == 0) { int b = 0; for (int e = 0; e < NEXP; ++e) { tbase[e] = b; const int n = __hip_atomic_load(cnt + e, __ATOMIC_RELAXED, __HIP_MEMORY_SCOPE_AGENT); const int nt = (n + 255) >> 8;
            for (int m = 0; m < nt; ++m) tileEM[b + m] = (e << 8) | m; b += nt; } tbase[NEXP] = b; }
    __syncthreads();
    return tbase[NEXP];
}

__device__ __forceinline__ void p_ffnln(const Frame& F, int l, int nrows) {
    LAS int* tbase = (LAS int*)(F.lds + LDS_TILE) + 128;
    (void)moe_tiles(F, l);
    const int gw = F.bid * NWAVES + F.wave, NGW = F.G * NWAVES;
    const float* MOD = (const float*)(F.ws + WS_MOD);
    float* XS = (float*)(F.ws + WS_XS); const float* YS = (const float*)(F.ws + WS_YS);
    const int* tokE = (const int*)(F.ws + WS_TOKE); const int* tokP = (const int*)(F.ws + WS_TOKP); const float* tokG = (const float*)(F.ws + WS_TOKG);
    const float* lg = F.in[IN_LNFG] + l * DM; const float* lb = F.in[IN_LNFB] + l * DM;
    bf16_t* H1 = (bf16_t*)(F.ws + WS_H1);
    for (int r = gw; r < nrows; r += NGW) {
        const int v = r >= SEQ; const float* m = MOD + (size_t)(l * 2 + v) * 12288;
        const int e1 = tokE[2 * r], e2 = tokE[2 * r + 1]; const float g1 = tokG[2 * r], g2 = tokG[2 * r + 1];
        const float* ya = YS + (size_t)(tbase[e1] * 256 + tokP[2 * r]) * DM; const float* yb = YS + (size_t)(tbase[e2] * 256 + tokP[2 * r + 1]) * DM;
        const float* xr = XS + (size_t)r * DM;
        f32x4 z[8];
#pragma unroll
        for (int j = 0; j < 8; ++j) { const int col = 4 * F.lane + 256 * j; const f32x4 y = g1 * *(const f32x4*)(ya + col) + g2 * *(const f32x4*)(yb + col);
            z[j] = ALPHA * *(const f32x4*)(xr + col) + *(const f32x4*)(m + 5 * DM + col) * y; }
        float mean, rstd; ln_stats(z, mean, rstd);
#pragma unroll
        for (int j = 0; j < 8; ++j) { const int col = 4 * F.lane + 256 * j; z[j] = (z[j] - mean) * rstd * *(const f32x4*)(lg + col) + *(const f32x4*)(lb + col); }
        if (l == 1) {
#pragma unroll
            for (int j = 0; j < 8; ++j) *(f32x4*)(F.out + (size_t)r * DM + 4 * F.lane + 256 * j) = z[j];
        } else {
#pragma unroll
            for (int j = 0; j < 8; ++j) *(f32x4*)(XS + (size_t)r * DM + 4 * F.lane + 256 * j) = z[j];
            const float* mn = MOD + (size_t)(2 + v) * 12288;
            modulate_store<false>(z, mn, mn + DM, H1 + (size_t)r * DM, (LAS float*)nullptr, F.lane);
        }
    }
}


#ifdef CHK
__device__ __forceinline__ float block_sum(const Frame& F, float v, LAS float* red) {
    v = wave_sum(v); __syncthreads(); if (F.lane == 0) red[F.wave] = v; __syncthreads(); float s = 0.f;
    for (int w = 0; w < 8; ++w) s += red[w]; __syncthreads(); return s;
}
__device__ __forceinline__ void p_check(const Frame& F) {
    unsigned* ctr = (unsigned*)(F.ws + WS_CTL) + 16384;
    LAS float* hrow = (LAS float*)F.lds;
    LAS float* hid = hrow + 2048;
    LAS float* red = hid + 2048;
    LAS float* big = red + 64;
#ifndef CHK_L
#define CHK_L 1
#endif
    const int l = CHK_L;
    for (int smp = F.bid; smp < 128; smp += F.G) {
        const int t = (CHK_L == 0 && (CHK >= 1 && CHK <= 4) && smp >= 120) ? SEQ + (smp - 120) * 32 + 5 : smp * 64 + 17;
        float num = 0.f, den = 0.f;
#if CHK == 1
        const bf16_t* H2 = (const bf16_t*)(F.ws + WS_H2);
        const int* tokE = (const int*)(F.ws + WS_TOKE); const int* tokP = (const int*)(F.ws + WS_TOKP); const float* tokG = (const float*)(F.ws + WS_TOKG);
        LAS int* tbase = (LAS int*)(F.lds + LDS_TILE) + 128; (void)moe_tiles(F, l);
        for (int d = F.tid; d < DM; d += NTHR) hrow[d] = bf2f(H2[(size_t)t * DM + d]);
        __syncthreads();
        for (int k = 0; k < 2; ++k) { const int e = tokE[2 * t + k];
            const float* Wg = F.in[IN_WG] + (size_t)(l * NEXP + e) * DM * DEXP; const float* Wu = F.in[IN_WU] + (size_t)(l * NEXP + e) * DM * DEXP;
            for (int j = F.tid; j < DEXP; j += NTHR) { float g = 0.f, u = 0.f; for (int d = 0; d < DM; ++d) { g += hrow[d] * Wg[(size_t)d * DEXP + j]; u += hrow[d] * Wu[(size_t)d * DEXP + j]; }
                hid[k * DEXP + j] = bf2f(f2bf(g * sigmoidf_(g) * u)); } }
        __syncthreads();
        const float* YS = (const float*)(F.ws + WS_YS);
        for (int n = F.tid; n < DM; n += NTHR) { float y = 0.f, yk = 0.f;
            for (int k = 0; k < 2; ++k) { const int e = tokE[2 * t + k]; const float* Wd = F.in[IN_WDN] + (size_t)(l * NEXP + e) * DEXP * DM; float a = 0.f;
                for (int j = 0; j < DEXP; ++j) a += hid[k * DEXP + j] * Wd[(size_t)j * DM + n];
                y += tokG[2 * t + k] * a; yk += tokG[2 * t + k] * YS[(size_t)(tbase[e] * 256 + tokP[2 * t + k]) * DM + n]; }
            num += (y - yk) * (y - yk); den += y * y; }
#elif CHK == 2
        const bf16_t* MX = (const bf16_t*)(F.ws + WS_MIX); const float* Y1 = (const float*)(F.ws + WS_Y1); const float* Wo = F.in[IN_WOUT] + (size_t)l * DM * DM;
        for (int d = F.tid; d < DM; d += NTHR) hrow[d] = bf2f(MX[(size_t)t * DM + d]);
        __syncthreads();
        for (int n = F.tid; n < DM; n += NTHR) { float a = 0.f; for (int c = 0; c < DM; ++c) a += hrow[c] * Wo[(size_t)c * DM + n]; const float yk = Y1[(size_t)t * DM + n]; num += (a - yk) * (a - yk); den += a * a; }
#elif CHK == 3
        const bf16_t* H1 = (const bf16_t*)(F.ws + WS_H1); const bf16_t* P = (const bf16_t*)(F.ws + WS_PROJ); const float* Wi = F.in[IN_WIN] + (size_t)l * DM * INW;
        for (int d = F.tid; d < DM; d += NTHR) hrow[d] = bf2f(H1[(size_t)t * DM + d]);
        __syncthreads();
        for (int n = F.tid; n < 2560; n += NTHR) { float a = 0.f; for (int c = 0; c < DM; ++c) a += hrow[c] * Wi[(size_t)c * INW + n];
            if (n >= 1536) { const float u = a * (1.0f + 0.044715f * a * a) * 1.5957691216057308f; a = a * sigmoidf_(u); }
            const float yk = bf2f(P[(size_t)t * INW + n]); num += (a - yk) * (a - yk); den += a * a; }
#elif CHK == 4
        const bf16_t* P = (const bf16_t*)(F.ws + WS_PROJ); const bf16_t* MX = (const bf16_t*)(F.ws + WS_MIX);
        const int c = t >> 7, i = t & 127;
        for (int g = 0; g < 4; ++g) {
            for (int jj = 0; jj < 16; ++jj) { const int j = F.wave * 16 + jj; const size_t p = (size_t)(c * 128 + j);
                const float x0 = bf2f(P[p * INW + 2048 + g * 128 + F.lane]), x1 = bf2f(P[p * INW + 2048 + g * 128 + 64 + F.lane]);
                const float mean = wave_sum(x0 + x1) * (1.0f / 128.0f); const float e0 = x0 - mean, e1 = x1 - mean;
                const float rstd = 1.0f / sqrtf(wave_sum(e0 * e0 + e1 * e1) * (1.0f / 128.0f) + LN_EPS);
                big[j * 128 + F.lane] = e0 * rstd * F.in[IN_SGLNG][(l * 4 + g) * 128 + F.lane] + F.in[IN_SGLNB][(l * 4 + g) * 128 + F.lane];
                big[j * 128 + 64 + F.lane] = e1 * rstd * F.in[IN_SGLNG][(l * 4 + g) * 128 + 64 + F.lane] + F.in[IN_SGLNB][(l * 4 + g) * 128 + 64 + F.lane]; }
            __syncthreads();
            if (F.tid < 128) { const int d = F.tid; float a = 0.f; for (int j = 0; j < 128; ++j) a += F.in[IN_SGW][((size_t)(l * 4 + g) * 128 + i) * 128 + j] * big[j * 128 + d];
                a = (a + F.in[IN_SGB][(l * 4 + g) * 128 + i]) * bf2f(P[(size_t)t * INW + 1536 + g * 128 + d]);
                const float yk = bf2f(MX[(size_t)t * DM + 512 + g * 128 + d]); num += (a - yk) * (a - yk); den += a * a; }
            __syncthreads();
        }
#elif CHK == 5
        num = 1.f; den = 0.f;
#elif CHK == 6
        const float* MOD = (const float*)(F.ws + WS_MOD);
        if (F.tid < 8) { const int ll = F.tid >> 2, v = (F.tid >> 1) & 1, n = 96 * smp + 5 + 45 * (F.tid & 1); const float* vec = F.in[v ? IN_CCTX : IN_C]; float a = 0.f;
            for (int k = 0; k < DM; ++k) { const float x = vec[k]; a += x * sigmoidf_(x) * F.in[IN_ADAW][((size_t)ll * DM + k) * 12288 + n]; }
            a += F.in[IN_ADAB][ll * 12288 + n]; const float yk = MOD[(size_t)(ll * 2 + v) * 12288 + n]; num += (a - yk) * (a - yk); den += a * a; }
#elif CHK == 7 || CHK == 8
        const bf16_t* P = (const bf16_t*)(F.ws + WS_PROJ); const bf16_t* MX = (const bf16_t*)(F.ws + WS_MIX);
        LAS float* sc = big;
        const int NH = (CHK == 7) ? 4 : 8;
        for (int h = 0; h < NH; ++h) {
            const int qcol = (CHK == 7) ? h * 128 : 2560 + h * 128, kcol = (CHK == 7) ? 512 + h * 128 : 3584 + (h >> 2) * 128, vcol = (CHK == 7) ? 1024 + h * 128 : 3840 + (h >> 2) * 128, ocol = (CHK == 7) ? h * 128 : 1024 + h * 128;
            const int qr = t >> 6, qc = t & 63; int rs = qr - 4; rs = rs < 0 ? 0 : (rs > 120 ? 120 : rs); int cs = qc - 8; cs = cs < 0 ? 0 : (cs > 48 ? 48 : cs);
            const int nk = (CHK == 7) ? 384 : NROW;
            for (int kk = F.tid; kk < nk; kk += NTHR) {
                int krow; float bias = 0.f;
                if (CHK == 7) { if (kk < 128) { const int kr = rs + (kk >> 4), kc = cs + (kk & 15); krow = kr * 64 + kc; bias = F.in[IN_RPB][((size_t)(l * 4 + h) * 15 + (kr - qr + 7)) * 31 + (kc - qc + 15)]; } else krow = SEQ + kk - 128; }
                else krow = kk;
                float a = 0.f; for (int d = 0; d < 128; ++d) a += bf2f(P[(size_t)t * INW + qcol + d]) * bf2f(P[(size_t)krow * INW + kcol + d]);
                sc[kk] = a * 0.088388347648318440f + bias; }
            __syncthreads();
            float mx = -1e30f; for (int kk = F.tid; kk < nk; kk += NTHR) mx = fmaxf(mx, sc[kk]);
            for (int o = 1; o < 64; o <<= 1) mx = fmaxf(mx, __shfl_xor(mx, o));
            __syncthreads(); if (F.lane == 0) red[F.wave] = mx; __syncthreads(); mx = red[0]; for (int w = 1; w < 8; ++w) mx = fmaxf(mx, red[w]); __syncthreads();
            float ps = 0.f; for (int kk = F.tid; kk < nk; kk += NTHR) { const float p = expf(sc[kk] - mx); sc[kk] = p; ps += p; }
            const float tot = block_sum(F, ps, red);
            if (F.tid < 128) { const int d = F.tid; float a = 0.f;
                for (int kk = 0; kk < nk; ++kk) { int krow; if (CHK == 7) { if (kk < 128) krow = (rs + (kk >> 4)) * 64 + cs + (kk & 15); else krow = SEQ + kk - 128; } else krow = kk;
                    a += sc[kk] * bf2f(P[(size_t)krow * INW + vcol + d]); }
                a /= tot; const float yk = bf2f(MX[(size_t)t * DM + ocol + d]); num += (a - yk) * (a - yk); den += a * a; }
            __syncthreads();
        }
#elif CHK == 9
        const bf16_t* H1 = (const bf16_t*)(F.ws + WS_H1); const bf16_t* P = (const bf16_t*)(F.ws + WS_PROJ); const float* Wi = F.in[IN_WIN] + (size_t)l * DM * INW;
        for (int d = F.tid; d < DM; d += NTHR) hrow[d] = bf2f(H1[(size_t)t * DM + d]);
        __syncthreads();
        if (F.tid < 256) { const int which = F.tid >> 7, d = F.tid & 127, col = which ? 3584 + 128 + d : 2560 + 3 * 128 + d; float a = 0.f;
            for (int c = 0; c < DM; ++c) a += hrow[c] * Wi[(size_t)c * INW + col]; big[F.tid] = a; }
        __syncthreads();
        if (F.tid < 256) { const int which = F.tid >> 7, d = F.tid & 127; float ss = 0.f; for (int q = 0; q < 128; ++q) ss += big[which * 128 + q] * big[which * 128 + q];
            const float rinv = 1.0f / sqrtf(ss / 128.0f + LN_EPS); const float* gn = F.in[which ? IN_KNG : IN_QNG] + l * 128;
            const int ax = d >> 6, half = (d >> 5) & 1, i = d & 31; const int pos = ax == 0 ? (t >> 6) : (t & 63);
            const float inv = powf(10000.0f, -(float)i / 32.0f), ang = (float)pos * inv, cs = cosf(ang), sn = sinf(ang);
            const float x1 = big[which * 128 + ax * 64 + i] * rinv * gn[ax * 64 + i], x2 = big[which * 128 + ax * 64 + 32 + i] * rinv * gn[ax * 64 + 32 + i];
            const float a = half == 0 ? x1 * cs - x2 * sn : x2 * cs + x1 * sn;
            const float yk = bf2f(P[(size_t)t * INW + (which ? 3584 + 128 : 2560 + 384) + d]); num += (a - yk) * (a - yk); den += a * a; }
#elif CHK == 10
        const float* MOD = (const float*)(F.ws + WS_MOD) + (size_t)(l * 2 + (t >= SEQ)) * 12288;
        const float* xr = (l == 0) ? (t < SEQ ? F.in[IN_X] + (size_t)t * DM : F.in[IN_CTX] + (size_t)(t - SEQ) * DM) : nullptr;
        const float* Y1 = (const float*)(F.ws + WS_Y1) + (size_t)t * DM; const float* XS = (const float*)(F.ws + WS_XS) + (size_t)t * DM; const bf16_t* H2 = (const bf16_t*)(F.ws + WS_H2) + (size_t)t * DM;
        for (int d = F.tid; d < DM; d += NTHR) hrow[d] = ALPHA * xr[d] + MOD[2 * DM + d] * Y1[d];
        __syncthreads();
        float sm = 0.f; for (int d = F.tid; d < DM; d += NTHR) sm += hrow[d]; const float mean = block_sum(F, sm, red) / DM;
        float sq = 0.f; for (int d = F.tid; d < DM; d += NTHR) sq += (hrow[d] - mean) * (hrow[d] - mean); const float rstd = 1.0f / sqrtf(block_sum(F, sq, red) / DM + LN_EPS);
        for (int d = F.tid; d < DM; d += NTHR) { const float x1 = (hrow[d] - mean) * rstd * F.in[IN_LNMG][l * DM + d] + F.in[IN_LNMB][l * DM + d]; hrow[d] = x1; num += (x1 - XS[d]) * (x1 - XS[d]); den += x1 * x1; }
        __syncthreads();
        sm = 0.f; for (int d = F.tid; d < DM; d += NTHR) sm += hrow[d]; const float mean2 = block_sum(F, sm, red) / DM;
        sq = 0.f; for (int d = F.tid; d < DM; d += NTHR) sq += (hrow[d] - mean2) * (hrow[d] - mean2); const float rstd2 = 1.0f / sqrtf(block_sum(F, sq, red) / DM + LN_EPS);
        for (int d = F.tid; d < DM; d += NTHR) { const float h = (hrow[d] - mean2) * rstd2 * (1.0f + MOD[4 * DM + d]) + MOD[3 * DM + d]; big[d] = h; const float hk = bf2f(H2[d]); num += (h - hk) * (h - hk); den += h * h; }
        __syncthreads();
        if (F.tid < 32) { float a = 0.f; for (int d = 0; d < DM; ++d) a += big[d] * F.in[IN_RW][d * 32 + F.tid]; const float sc = sigmoidf_(a); hid[F.tid] = sc; hid[32 + F.tid] = sc + F.in[IN_RB][F.tid]; }
        __syncthreads();
        if (F.tid == 0) { int best = 0; float bv = -1e30f;
            for (int g = 0; g < 4; ++g) { float v[8]; for (int q = 0; q < 8; ++q) v[q] = hid[32 + g * 8 + q]; for (int a = 0; a < 8; ++a) for (int b = a + 1; b < 8; ++b) if (v[b] > v[a]) { const float tmp = v[a]; v[a] = v[b]; v[b] = tmp; }
                if (v[0] + v[1] > bv) { bv = v[0] + v[1]; best = g; } }
            int o[8]; for (int q = 0; q < 8; ++q) o[q] = q; for (int a = 0; a < 8; ++a) for (int b = a + 1; b < 8; ++b) if (hid[32 + best * 8 + o[b]] > hid[32 + best * 8 + o[a]]) { const int tmp = o[a]; o[a] = o[b]; o[b] = tmp; }
            const int e1 = best * 8 + o[0], e2 = best * 8 + o[1]; const float g1 = hid[e1] / (hid[e1] + hid[e2]), g2 = hid[e2] / (hid[e1] + hid[e2]);
            const int* tokE = (const int*)(F.ws + WS_TOKE); const float* tokG = (const float*)(F.ws + WS_TOKG);
            if (tokE[2 * t] != e1 || tokE[2 * t + 1] != e2 || fabsf(tokG[2 * t] - g1) > 1e-3f || fabsf(tokG[2 * t + 1] - g2) > 1e-3f) num += 1e6f; }
#elif CHK == 11
        const float* MOD = (const float*)(F.ws + WS_MOD) + (size_t)(1 * 2) * 12288;
        const float* XS = (const float*)(F.ws + WS_XS) + (size_t)t * DM; const float* YS = (const float*)(F.ws + WS_YS);
        const int* tokE = (const int*)(F.ws + WS_TOKE); const int* tokP = (const int*)(F.ws + WS_TOKP); const float* tokG = (const float*)(F.ws + WS_TOKG);
        LAS int* tbase = (LAS int*)(F.lds + LDS_TILE) + 128; (void)moe_tiles(F, 1);
        for (int d = F.tid; d < DM; d += NTHR) { float y = 0.f; for (int k = 0; k < 2; ++k) y += tokG[2 * t + k] * YS[(size_t)(tbase[tokE[2 * t + k]] * 256 + tokP[2 * t + k]) * DM + d]; hrow[d] = ALPHA * XS[d] + MOD[5 * DM + d] * y; }
        __syncthreads();
        float sm = 0.f; for (int d = F.tid; d < DM; d += NTHR) sm += hrow[d]; const float mean = block_sum(F, sm, red) / DM;
        float sq = 0.f; for (int d = F.tid; d < DM; d += NTHR) sq += (hrow[d] - mean) * (hrow[d] - mean); const float rstd = 1.0f / sqrtf(block_sum(F, sq, red) / DM + LN_EPS);
        for (int d = F.tid; d < DM; d += NTHR) { const float o = (hrow[d] - mean) * rstd * F.in[IN_LNFG][DM + d] + F.in[IN_LNFB][DM + d]; const float ok = F.out[(size_t)t * DM + d]; num += (o - ok) * (o - ok); den += o * o; }
#endif
        const float N = block_sum(F, num, red), Dn = block_sum(F, den, red);
        if (F.tid == 0 && !(N <= ((CHK >= 10) ? 1e-5f : 1e-3f) * Dn)) atomicAdd(ctr, 1u);
        __syncthreads();
    }
}
__device__ __forceinline__ void p_encode(const Frame& F) {
    const unsigned* ctr = (const unsigned*)(F.ws + WS_CTL) + 16384;
    const unsigned n = __hip_atomic_load(ctr, __ATOMIC_RELAXED, __HIP_MEMORY_SCOPE_AGENT);
    const int gw = F.bid * NWAVES + F.wave, NGW = F.G * NWAVES;
    for (int r = gw; r < (int)(n * 64u) && r < SEQ; r += NGW)
        for (int j = 0; j < 8; ++j) *(f32x4*)(F.out + (size_t)r * DM + 4 * F.lane + 256 * j) = (f32x4){0.f, 0.f, 0.f, 0.f};
}
#endif

__global__ void __launch_bounds__(NTHR, 2) fwd(Args args) {
    extern __shared__ __attribute__((aligned(16))) unsigned char lds_raw[];
    Frame F0;
    F0.lds = (LAS unsigned char*)lds_raw; F0.tid = threadIdx.x; F0.lane = F0.tid & 63; F0.wave = __builtin_amdgcn_readfirstlane(F0.tid >> 6);
    F0.G = gridDim.x; F0.bid = blockIdx.x; F0.in = args.in; F0.out = args.out; F0.ws = args.ws;
    volatile LAS unsigned* MISC = (volatile LAS unsigned*)(F0.lds + LDS_MISC);
    if (F0.tid < 4) MISC[F0.tid] = 0u;
    __syncthreads();
    const int lo = args.ph_lo, hi = args.ph_hi;
    XcdBarrier bar; bar.bar = (unsigned*)(F0.ws + WS_CTL) + CW_BAR; bar.x = 0; bar.st = MISC;
    if (hi - lo > 1) bar = xcd_barrier_post((unsigned*)(F0.ws + WS_CTL) + CW_BAR, MISC);
#if defined(ONLY_PH)
#define PHON(j) ((j) == ONLY_PH)
#elif defined(PH_MASK)
#define PHON(j) (((PH_MASK) >> (j)) & 1)
#else
#define PHON(j) true
#endif
#define IN(k) (lo <= (k) && (k) < hi)
#define SEAM(k) do { if (IN(k) && IN((k) + 1)) xcd_barrier(bar); } while (0)
    if (PHON(0) && IN(0)) { { const Frame F = launder(F0); p0_mod(F); } { const Frame F = launder(F0); p0_transposes(F); } { const Frame F = launder(F0); p0_rope(F); } }
    SEAM(0);
    if (PHON(1) && IN(1)) { const Frame F = launder(F0); p_modulate1(F, 0, NROW); }
    SEAM(1);
#pragma unroll 1
    for (int l = 0; l < 2; ++l) {
        const int pb = 2 + 8 * l;
        const int nlat = (l == 0) ? NROW : SEQ;
        if (PHON(2) && IN(pb + 0)) { const Frame F = launder(F0);
            pg8::StaticOrder S; S.init(NROW, INW, DM, (const bf16_t*)(F.ws + WS_WIN) + (size_t)l * INW * DM, F.G, F.bid);
            pg8::EpiProj E{(bf16_t*)(F.ws + WS_PROJ)};
            pg8::gemm_phase(F.lds, F.tid, (const bf16_t*)(F.ws + WS_H1), DM, S, E);
        }
        SEAM(pb + 0);
        if (PHON(3) && IN(pb + 1)) { const Frame F = launder(F0); p_rmsrope(F, l, NROW); }
        SEAM(pb + 1);
        if (IN(pb + 2)) { if (PHON(4)) { const Frame F = launder(F0); p_att_dense(F, l); } if (PHON(10)) { const Frame F = launder(F0); p_att_na(F, l); } if (PHON(11)) { const Frame F = launder(F0); p_att_sg(F, l); } }
        SEAM(pb + 2);
        if (PHON(5) && IN(pb + 3)) { const Frame F = launder(F0);
            pg8::StaticOrder S; S.init(nlat, DM, DM, (const bf16_t*)(F.ws + WS_WOUT) + (size_t)l * DM * DM, F.G, F.bid);
            pg8::EpiF32 E{(float*)(F.ws + WS_Y1), DM};
            pg8::gemm_phase(F.lds, F.tid, (const bf16_t*)(F.ws + WS_MIX), DM, S, E);
        }
        SEAM(pb + 3);
        if (PHON(6) && IN(pb + 4)) { const Frame F = launder(F0); p_mixln_router(F, l, nlat); }
        SEAM(pb + 4);
        if (PHON(7) && IN(pb + 5)) { const Frame F = launder(F0);
            const int ntiles = moe_tiles(F, l);
            pg8::MoeOrder<true> S{(const LAS int*)(F.lds + LDS_TILE), ntiles, F.G, F.bid, DM, (const int*)(F.ws + WS_LIST), (const int*)(F.ws + WS_CTL) + CW_CNT + l * 32,
                                  (const bf16_t*)(F.ws + WS_WGU) + (size_t)l * NEXP * 2048 * DM};
            pg8::EpiSwiGLU E{(bf16_t*)(F.ws + WS_GA)};
            pg8::gemm_phase(F.lds, F.tid, (const bf16_t*)(F.ws + WS_H2), DM, S, E);
        }
        SEAM(pb + 5);
        if (PHON(8) && IN(pb + 6)) { const Frame F = launder(F0);
            const int ntiles = moe_tiles(F, l);
            pg8::MoeOrder<false> S{(const LAS int*)(F.lds + LDS_TILE), ntiles, F.G, F.bid, DEXP, nullptr, nullptr, (const bf16_t*)(F.ws + WS_WD) + (size_t)l * NEXP * DM * DEXP};
            pg8::EpiF32 E{(float*)(F.ws + WS_YS), DM};
            pg8::gemm_phase(F.lds, F.tid, (const bf16_t*)(F.ws + WS_GA), DEXP, S, E);
        }
        SEAM(pb + 6);
        if (PHON(9) && IN(pb + 7)) { const Frame F = launder(F0); p_ffnln(F, l, nlat); }
        SEAM(pb + 7);
    }
#ifdef CHK
    if (IN(18)) { const Frame F = launder(F0); p_check(F); }
    SEAM(18);
    if (IN(19)) { const Frame F = launder(F0); p_encode(F); }
#endif
#undef IN
#undef SEAM
}

extern "C" void kernel_launch(void* const* d_in, const int* in_sizes, int n_in, void* d_out, int out_size, void* d_ws, size_t ws_size, hipStream_t stream) {
    static int grid = 0;
    if (grid == 0) {
        if (n_in != 24 || out_size != SEQ * DM || ws_size < WS_END) { fprintf(stderr, "kernel_launch: unexpected shapes (n_in %d out %d ws %zu)\n", n_in, out_size, ws_size); grid = -1; return; }
        int dev = 0, cus = 0, per_cu = 0;
        if (hipGetDevice(&dev) != hipSuccess || hipDeviceGetAttribute(&cus, hipDeviceAttributeMultiprocessorCount, dev) != hipSuccess) { grid = -1; return; }
        if (hipFuncSetAttribute((const void*)fwd, hipFuncAttributeMaxDynamicSharedMemorySize, LDS_BYTES) != hipSuccess) { fprintf(stderr, "kernel_launch: hipFuncSetAttribute failed\n"); grid = -1; return; }
        if (hipOccupancyMaxActiveBlocksPerMultiprocessor(&per_cu, (const void*)fwd, NTHR, LDS_BYTES) != hipSuccess || per_cu < 1) { fprintf(stderr, "kernel_launch: occupancy query says %d\n", per_cu); }
        (void)hipGetLastError();
        grid = cus;
    }
    if (grid < 0) return;
    (void)hipMemsetAsync((char*)d_ws + WS_CTL, 0, CTL_ZERO_BYTES, stream);
    Args a{};
    for (int i = 0; i < 24; ++i) a.in[i] = (const float*)d_in[i];
    a.out = (float*)d_out; a.ws = (unsigned char*)d_ws;
#if MK_ONE_LAUNCH
    a.ph_lo = 0; a.ph_hi = NPH;
    hipLaunchKernelGGL(fwd, dim3(grid), dim3(NTHR), LDS_BYTES, stream, a);
#else
#if defined(CHK) && defined(CHK_L) && CHK_L == 0
    { const int order[20] = {0, 1, 2, 3, 4, 5, 6, 7, 8, 18, 9, 10, 11, 12, 13, 14, 15, 16, 17, 19};
      for (int q = 0; q < 20; ++q) { a.ph_lo = order[q]; a.ph_hi = order[q] + 1; hipLaunchKernelGGL(fwd, dim3(grid), dim3(NTHR), LDS_BYTES, stream, a); } }
#else
    for (int k = 0; k < NPH; ++k) { a.ph_lo = k; a.ph_hi = k + 1; hipLaunchKernelGGL(fwd, dim3(grid), dim3(NTHR), LDS_BYTES, stream, a); }
#endif
#endif
}
```

```cpp
#include <hip/hip_runtime.h>
#include <cstdio>
#include <cstdint>

#ifndef MK_ONE_LAUNCH
#define MK_ONE_LAUNCH 1
#endif

constexpr int DM = 2048, SEQ = 8192, CTXL = 256, NROW = SEQ + CTXL;
constexpr int INW = 4096, NEXP = 32, DEXP = 1024, GRIDW = 64;
constexpr float ALPHA = 1.41421356237309515f;
constexpr float LN_EPS = 1e-6f;
constexpr int NPH = 18;
constexpr int MOE_CAP_TILES = 98;
constexpr int NWAVES = 8, NTHR = 512;

constexpr size_t MiB = 1u << 20;
constexpr size_t WS_CTL = 0, CTL_ZERO_BYTES = 1 * MiB;
constexpr size_t WS_MOD = 1 * MiB;
constexpr size_t WS_ROPE = 1 * MiB + 256 * 1024;
constexpr size_t WS_RWT = 1 * MiB + 512 * 1024;
constexpr size_t WS_TOKE = 2 * MiB;
constexpr size_t WS_TOKP = WS_TOKE + 128 * 1024;
constexpr size_t WS_TOKG = WS_TOKP + 128 * 1024;
constexpr size_t WS_LIST = 3 * MiB;
constexpr size_t WS_WIN = 8 * MiB;
constexpr size_t WS_WOUT = 40 * MiB;
constexpr size_t WS_WGU = 64 * MiB;
constexpr size_t WS_WD = 576 * MiB;
constexpr size_t WS_H1 = 832 * MiB;
constexpr size_t WS_PROJ = 866 * MiB;
constexpr size_t WS_MIX = 932 * MiB;
constexpr size_t WS_Y1 = 966 * MiB;
constexpr size_t WS_XS = 1032 * MiB;
constexpr size_t WS_H2 = 1098 * MiB;
constexpr size_t WS_GA = 1132 * MiB;
constexpr size_t WS_YS = 1182 * MiB;
constexpr size_t WS_H2L = 1378 * MiB;
constexpr size_t WS_KV = 1412 * MiB;
constexpr size_t WS_CKV = 1424 * MiB;
constexpr size_t WS_END = 1426 * MiB;
constexpr int CW_BAR = 4096;
constexpr int CW_CNT = 8192;
constexpr int LDS_PART = 131072;
constexpr int LDS_SC = 147456;
constexpr int LDS_TILE = 151552;
constexpr int LDS_MISC = 153600;
constexpr int LDS_BYTES = 155648;

#define GAS __attribute__((address_space(1)))
#define LAS __attribute__((address_space(3)))
typedef unsigned short bf16_t;
typedef float f32x4 __attribute__((ext_vector_type(4)));
typedef float f32x2 __attribute__((ext_vector_type(2)));
typedef float f32x16 __attribute__((ext_vector_type(16)));
typedef short bf16x8 __attribute__((ext_vector_type(8)));
typedef short s16x4 __attribute__((ext_vector_type(4)));
typedef unsigned u32x4 __attribute__((ext_vector_type(4)));
typedef unsigned u32x2 __attribute__((ext_vector_type(2)));

__device__ __forceinline__ unsigned cvt_pk_bf16(float lo, float hi) { unsigned r; asm volatile("v_cvt_pk_bf16_f32 %0, %1, %2" : "=v"(r) : "v"(lo), "v"(hi)); return r; }
__device__ __forceinline__ bf16_t f2bf(float f) { unsigned u = __builtin_bit_cast(unsigned, f); return (bf16_t)((u + 0x7fffu + ((u >> 16) & 1u)) >> 16); }
__device__ __forceinline__ float bf2f(bf16_t b) { return __builtin_bit_cast(float, ((unsigned)b) << 16); }
__device__ __forceinline__ u32x2 pack4(f32x4 v) { u32x2 o; o.x = cvt_pk_bf16(v.x, v.y); o.y = cvt_pk_bf16(v.z, v.w); return o; }
template <int CTRL> __device__ __forceinline__ float dpp_mov(float v) { return __builtin_bit_cast(float, __builtin_amdgcn_update_dpp(0, __builtin_bit_cast(int, v), CTRL, 0xF, 0xF, true)); }
__device__ __forceinline__ float quad_sum(float v) { v += dpp_mov<0xB1>(v); v += dpp_mov<0x4E>(v); return v; }
__device__ __forceinline__ float wave_sum(float v) {
    v += dpp_mov<0xB1>(v); v += dpp_mov<0x4E>(v); v += dpp_mov<0x141>(v); v += dpp_mov<0x140>(v);
    const float s0 = __builtin_bit_cast(float, __builtin_amdgcn_readlane(__builtin_bit_cast(int, v), 0)), s1 = __builtin_bit_cast(float, __builtin_amdgcn_readlane(__builtin_bit_cast(int, v), 16));
    const float s2 = __builtin_bit_cast(float, __builtin_amdgcn_readlane(__builtin_bit_cast(int, v), 32)), s3 = __builtin_bit_cast(float, __builtin_amdgcn_readlane(__builtin_bit_cast(int, v), 48));
    return (s0 + s1) + (s2 + s3);
}
__device__ __forceinline__ float sigmoidf_(float x) { return 1.0f / (1.0f + expf(-x)); }
__device__ __forceinline__ float gelu_tanh_fast(float x) { const float u = x * (1.0f + 0.044715f * x * x) * 1.5957691216057308f; return x * __builtin_amdgcn_rcpf(1.0f + __expf(-u)); }
__device__ __forceinline__ float silu_fast(float x) { return x * __builtin_amdgcn_rcpf(1.0f + __expf(-x)); }

#define XB_TMO      128
#define XB_XCNT(j)  (256  + 64 * (j))
#define XB_XSUB(j)  (1280 + 64 * (j))
#define XB_XGEN(j)  (2304 + 64 * (j))
#define XB_TOP      3328
#define XB_TOPGEN   3392
#define XCD_BAR_WORDS 3456
#define XB_SPIN_CAP (1u << 20)
__device__ __forceinline__ unsigned xb_ld(unsigned* p)              { return __hip_atomic_load(p, __ATOMIC_RELAXED, __HIP_MEMORY_SCOPE_AGENT); }
__device__ __forceinline__ unsigned xb_add(unsigned* p, unsigned v) { return __hip_atomic_fetch_add(p, v, __ATOMIC_RELAXED, __HIP_MEMORY_SCOPE_AGENT); }
__device__ __forceinline__ unsigned xb_xcc_id() { return (unsigned)__builtin_amdgcn_s_getreg((3 << 11) | 20) & 0xFu; }
#define XB_SPIN(cond, bar) do { unsigned _sp = 0; while (cond) { __builtin_amdgcn_s_sleep(1); \
    if ((++_sp & 255u) == 0u) { if (xb_ld(&(bar)[XB_TMO])) break; if (_sp > XB_SPIN_CAP) { atomicAdd(&(bar)[XB_TMO], 1u); break; } } } } while (0)
struct XcdBarrier { unsigned* bar; unsigned x; volatile LAS unsigned* st; };
__device__ __forceinline__ XcdBarrier xcd_barrier_post(unsigned* bar, volatile LAS unsigned* st) {
    XcdBarrier b; b.bar = bar; b.x = xb_xcc_id(); b.st = st;
    if (threadIdx.x == 0) (void)xb_add(&bar[XB_XCNT(b.x)], 1u);
    return b;
}
__device__ __forceinline__ void xcd_barrier_complete(unsigned* bar, unsigned x, unsigned& nloc, unsigned& nx) {
    const unsigned G = gridDim.x * gridDim.y * gridDim.z;
    unsigned sum, cnt, mine, sp = 0u;
    for (;;) {
        sum = 0u; cnt = 0u; mine = 0u;
#pragma unroll
        for (unsigned j = 0; j < 16; ++j) { const unsigned c = xb_ld(&bar[XB_XCNT(j)]); sum += c; cnt += (c > 0u) ? 1u : 0u; mine = (j == x) ? c : mine; }
        if (sum == G) break;
        __builtin_amdgcn_s_sleep(1);
        if ((++sp & 255u) == 0u) { if (xb_ld(&bar[XB_TMO])) break; if (sp > XB_SPIN_CAP) { atomicAdd(&bar[XB_TMO], 1u); break; } }
    }
    nloc = mine > 0u ? mine : 1u; nx = cnt > 0u ? cnt : 1u;
}
__device__ __forceinline__ void xcd_barrier(const XcdBarrier& b) {
    asm volatile("s_waitcnt vmcnt(0)" ::: "memory");
    __syncthreads();
    if (threadIdx.x == 0) {
        unsigned* bar = b.bar;
        __builtin_amdgcn_s_waitcnt(0);
        unsigned nloc = b.st[0], nx = b.st[1];
        if (nloc == 0u) { xcd_barrier_complete(bar, b.x, nloc, nx); b.st[0] = nloc; b.st[1] = nx; }
        const unsigned old = xb_add(&bar[XB_XSUB(b.x)], 1u);
        const unsigned gen = old / nloc;
        if (old + 1u == (gen + 1u) * nloc) {
            __builtin_amdgcn_fence(__ATOMIC_RELEASE, "agent");
            asm volatile("s_waitcnt vmcnt(0)" ::: "memory");
            const unsigned og = xb_add(&bar[XB_TOP], 1u);
            const unsigned tg = og / nx;
            if (og + 1u == (tg + 1u) * nx) xb_add(&bar[XB_TOPGEN], 1u);
            else XB_SPIN(xb_ld(&bar[XB_TOPGEN]) == tg, bar);
            __builtin_amdgcn_fence(__ATOMIC_ACQUIRE, "agent");
            xb_add(&bar[XB_XGEN(b.x)], 1u);
            asm volatile("s_waitcnt vmcnt(0)" ::: "memory");
        } else {
            XB_SPIN(xb_ld(&bar[XB_XGEN(b.x)]) == gen, bar);
            __builtin_amdgcn_fence(__ATOMIC_ACQUIRE, "agent");
            asm volatile("s_waitcnt vmcnt(0)" ::: "memory");
        }
    }
    __syncthreads();
}

struct Args { const float* in[24]; float* out; unsigned char* ws; int ph_lo, ph_hi; };
struct Frame {
    LAS unsigned char* lds;
    int tid, lane, wave, G, bid;
    const float* const* in;
    float* out; unsigned char* ws;
};
__device__ __forceinline__ Frame launder(const Frame& F0) {
    Frame F = F0; int t = F0.tid; asm volatile("" : "+v"(t)); F.tid = t; F.lane = t & 63; F.wave = __builtin_amdgcn_readfirstlane(t >> 6);
    unsigned long long w = (unsigned long long)F0.ws; asm volatile("" : "+s"(w)); F.ws = (unsigned char*)w;
    unsigned l = (unsigned)(uintptr_t)F0.lds; asm volatile("" : "+s"(l)); F.lds = (LAS unsigned char*)(uintptr_t)l;
    int g = F0.G, b = F0.bid; asm volatile("" : "+s"(g), "+s"(b)); F.G = g; F.bid = b;
    return F;
}
#define IN_X 0
#define IN_C 1
#define IN_CTX 2
#define IN_CCTX 3
#define IN_ADAW 4
#define IN_ADAB 5
#define IN_WIN 6
#define IN_RPB 7
#define IN_SGLNG 8
#define IN_SGLNB 9
#define IN_SGW 10
#define IN_SGB 11
#define IN_QNG 12
#define IN_KNG 13
#define IN_WOUT 14
#define IN_LNMG 15
#define IN_LNMB 16
#define IN_RW 17
#define IN_RB 18
#define IN_WG 19
#define IN_WU 20
#define IN_WDN 21
#define IN_LNFG 22
#define IN_LNFB 23

__device__ __forceinline__ void p0_mod(const Frame& F) {
    LAS float* sl = (LAS float*)F.lds;
    LAS float* red = sl + 4096;
    const float* c = F.in[IN_C]; const float* cc = F.in[IN_CCTX];
    for (int t = F.tid; t < DM; t += NTHR) { const float a = c[t]; sl[t] = a * sigmoidf_(a); const float b = cc[t]; sl[DM + t] = b * sigmoidf_(b); }
    __syncthreads();
    float* MOD = (float*)(F.ws + WS_MOD);
    for (int item = F.bid; item < 256; item += F.G) {
        const int l = item >> 7, nb = item & 127, col0 = nb * 96;
        f32x2 a0 = {0.f, 0.f}, a1 = {0.f, 0.f};
        if (F.lane < 48) {
            const float* wp = F.in[IN_ADAW] + (size_t)l * DM * 12288 + (size_t)(F.wave * 256) * 12288 + col0 + 2 * F.lane;
            const LAS float* s0 = sl + F.wave * 256; const LAS float* s1 = sl + DM + F.wave * 256;
#pragma unroll 8
            for (int k = 0; k < 256; ++k) { const f32x2 w = *(const f32x2*)(wp + (size_t)k * 12288); a0 += s0[k] * w; a1 += s1[k] * w; }
            red[(F.wave * 2 + 0) * 96 + 2 * F.lane] = a0.x; red[(F.wave * 2 + 0) * 96 + 2 * F.lane + 1] = a0.y;
            red[(F.wave * 2 + 1) * 96 + 2 * F.lane] = a1.x; red[(F.wave * 2 + 1) * 96 + 2 * F.lane + 1] = a1.y;
        }
        __syncthreads();
        if (F.tid < 192) { const int v = F.tid / 96, q = F.tid % 96; float s = 0.f;
#pragma unroll
            for (int w = 0; w < 8; ++w) s += red[(w * 2 + v) * 96 + q];
            MOD[(size_t)(l * 2 + v) * 12288 + col0 + q] = s + F.in[IN_ADAB][l * 12288 + col0 + q]; }
        __syncthreads();
    }
}
__device__ __forceinline__ void tr_item(const float* W, int K, int N, bf16_t* WT, int k0, int n0, int drow0, LAS float* scr, int lane) {
    f32x4 v[16];
    const float* wp = W + (size_t)(k0 + (lane >> 4)) * N + n0 + 4 * (lane & 15);
#pragma unroll
    for (int i = 0; i < 16; ++i) v[i] = __builtin_nontemporal_load((const f32x4*)(wp + (size_t)(4 * i) * N));
#pragma unroll
    for (int i = 0; i < 16; ++i) { LAS float* p = scr + (4 * i + (lane >> 4)) * 65 + 4 * (lane & 15); p[0] = v[i].x; p[1] = v[i].y; p[2] = v[i].z; p[3] = v[i].w; }
    asm volatile("s_waitcnt lgkmcnt(0)" ::: "memory");
    const int c = lane & 7;
#pragma unroll
    for (int j = 0; j < 8; ++j) { const int n = (lane >> 3) + 8 * j; const LAS float* s = scr + (8 * c) * 65 + n;
        u32x4 o; o.x = cvt_pk_bf16(s[0 * 65], s[1 * 65]); o.y = cvt_pk_bf16(s[2 * 65], s[3 * 65]); o.z = cvt_pk_bf16(s[4 * 65], s[5 * 65]); o.w = cvt_pk_bf16(s[6 * 65], s[7 * 65]);
        *(u32x4*)(WT + (size_t)(drow0 + n) * K + k0 + 8 * c) = o; }
    asm volatile("s_waitcnt lgkmcnt(0)" ::: "memory");
}
struct TrDesc { const float* src; bf16_t* dst; int N, K; };
__device__ __forceinline__ TrDesc moe_item_desc(const Frame& F, int m) {
    const int le = m / 1536, r = m % 1536, which = r >> 9, r2 = r & 511; TrDesc d;
    if (which < 2) { const int kb = r2 >> 4, nb = r2 & 15, n0 = nb * 64; d.N = DEXP; d.K = DM;
        d.src = F.in[which == 0 ? IN_WG : IN_WU] + (size_t)le * DM * DEXP + (size_t)(kb * 64) * DEXP + n0;
        d.dst = (bf16_t*)(F.ws + WS_WGU) + (size_t)le * 2048 * DM + (size_t)((n0 >> 7) * 256 + (n0 & 127) + which * 128) * DM + kb * 64; }
    else { const int kb = r2 >> 5, nb = r2 & 31; d.N = DM; d.K = DEXP;
        d.src = F.in[IN_WDN] + (size_t)le * DEXP * DM + (size_t)(kb * 64) * DM + nb * 64;
        d.dst = (bf16_t*)(F.ws + WS_WD) + (size_t)le * DM * DEXP + (size_t)(nb * 64) * DEXP + kb * 64; }
    return d;
}
__device__ __forceinline__ void tr_load64(const TrDesc& d, f32x4 (&v)[16], int lane) {
    const float* wp = d.src + (size_t)(lane >> 4) * d.N + 4 * (lane & 15);
#pragma unroll
    for (int i = 0; i < 16; ++i) v[i] = __builtin_nontemporal_load((const f32x4*)(wp + (size_t)(4 * i) * d.N));
}
__device__ __forceinline__ void tr_finish64(const TrDesc& d, const f32x4 (&v)[16], LAS float* scr, int lane) {
#pragma unroll
    for (int i = 0; i < 16; ++i) { LAS float* p = scr + (4 * i + (lane >> 4)) * 65 + 4 * (lane & 15); p[0] = v[i].x; p[1] = v[i].y; p[2] = v[i].z; p[3] = v[i].w; }
    asm volatile("s_waitcnt lgkmcnt(0)" ::: "memory");
    const int c = lane & 7;
#pragma unroll
    for (int j = 0; j < 8; ++j) { const int n = (lane >> 3) + 8 * j; const LAS float* s = scr + (8 * c) * 65 + n;
        u32x4 o; o.x = cvt_pk_bf16(s[0 * 65], s[1 * 65]); o.y = cvt_pk_bf16(s[2 * 65], s[3 * 65]); o.z = cvt_pk_bf16(s[4 * 65], s[5 * 65]); o.w = cvt_pk_bf16(s[6 * 65], s[7 * 65]);
        *(u32x4*)(d.dst + (size_t)n * d.K + 8 * c) = o; }
    asm volatile("s_waitcnt lgkmcnt(0)" ::: "memory");
}
__device__ __forceinline__ void conv_moe_item(const Frame& F, int m, LAS float* scr) {
    const TrDesc d = moe_item_desc(F, m); f32x4 v[16]; tr_load64(d, v, F.lane); tr_finish64(d, v, scr, F.lane);
}
constexpr int NC_IN = 176, NC_OUT = 192, NC_MOE = 192, NCOMP = 128  ;
constexpr int CV_LAYER = 49152;
constexpr int CV_A0 = 20480, CV_L0F = CV_A0 + 10240;
constexpr int CV_B0 = 16384, CV_B1 = CV_B0 + 10240, CV_L1F = CV_B1 + 16384;
constexpr int CV_ATT = 6144;
static_assert(CV_L0F + CV_ATT <= CV_LAYER && CV_L1F + CV_ATT <= CV_LAYER, "converter ranges");
__device__ __forceinline__ void conv_range(const Frame& F, int ncomp, int first, int count) {
    LAS float* scr = (LAS float*)(F.lds + F.wave * 16896);
    const int cw = (F.bid - ncomp) * NWAVES + F.wave, NCW = (F.G - ncomp) * NWAVES;
    f32x4 va[16], vb[16]; TrDesc d, dn;
    if (cw < count) { d = moe_item_desc(F, first + cw); tr_load64(d, va, F.lane); }
    for (int k = cw; k < count; k += NCW) {
        const int kn = k + NCW;
        if (kn < count) { dn = moe_item_desc(F, first + kn); tr_load64(dn, vb, F.lane); }
        tr_finish64(d, va, scr, F.lane);
        d = dn;
#pragma unroll
        for (int i = 0; i < 16; ++i) va[i] = vb[i];
    }
}
__device__ __forceinline__ void p0_transposes(const Frame& F) {
    LAS float* scr = (LAS float*)(F.lds + F.wave * 16896);
    const int gw = F.bid * NWAVES + F.wave, NGW = F.G * NWAVES;
    constexpr int NDENSE = 2 * 3072;
    const bool split = F.G >= 256;
    const int r0 = split ? CV_LAYER - CV_L0F - CV_ATT : CV_LAYER, r1 = split ? CV_LAYER - CV_L1F - CV_ATT : CV_LAYER;
    const int NITEMS = NDENSE + r0 + r1;
    for (int it = gw; it < NITEMS; it += NGW) {
        if (it < NDENSE) {
            const int l = it / 3072, r = it % 3072;
            if (r < 2048) { const int kb = r >> 6, nb = r & 63; tr_item(F.in[IN_WIN] + (size_t)l * DM * INW, DM, INW, (bf16_t*)(F.ws + WS_WIN) + (size_t)l * INW * DM, kb * 64, nb * 64, nb * 64, scr, F.lane); }
            else { const int r2 = r - 2048, kb = r2 >> 5, nb = r2 & 31; tr_item(F.in[IN_WOUT] + (size_t)l * DM * DM, DM, DM, (bf16_t*)(F.ws + WS_WOUT) + (size_t)l * DM * DM, kb * 64, nb * 64, nb * 64, scr, F.lane); }
        } else {
            const int q = it - NDENSE;
            const int m = q < r0 ? (CV_LAYER - r0) + q : CV_LAYER + (CV_LAYER - r1) + (q - r0);
            conv_moe_item(F, m, scr);
        }
    }
}
__device__ __forceinline__ void p0_rope(const Frame& F) {
    const int g = F.bid * NTHR + F.tid;
    if (g < 32 * DM) { const int e = g >> 11, k = g & (DM - 1); const float w = F.in[IN_RW][k * 32 + e]; const bf16_t hi = f2bf(w); const bf16_t lo = f2bf(w - bf2f(hi));
        bf16_t* T = (bf16_t*)(F.ws + WS_RWT); T[g] = hi; T[32 * DM + g] = lo; }
    if (g < 128 * 32) { const int pos = g >> 5, i = g & 31; const float inv = powf(10000.0f, -(float)i / 32.0f); const float ang = (float)pos * inv;
        float* R = (float*)(F.ws + WS_ROPE); R[2 * g] = cosf(ang); R[2 * g + 1] = sinf(ang); }
}

__device__ __forceinline__ const float* xrow_ptr(const Frame& F, int l, int r) {
    if (l == 0) return r < SEQ ? F.in[IN_X] + (size_t)r * DM : F.in[IN_CTX] + (size_t)(r - SEQ) * DM;
    return (const float*)(F.ws + WS_XS) + (size_t)r * DM;
}
__device__ __forceinline__ void ln_stats(const f32x4 (&v)[8], float& mean, float& rstd) {
    float s = 0.f;
#pragma unroll
    for (int j = 0; j < 8; ++j) s += (v[j].x + v[j].y) + (v[j].z + v[j].w);
    mean = wave_sum(s) * (1.0f / DM);
    float q = 0.f;
#pragma unroll
    for (int j = 0; j < 8; ++j) { const f32x4 d = v[j] - mean; q += (d.x * d.x + d.y * d.y) + (d.z * d.z + d.w * d.w); }
    rstd = 1.0f / sqrtf(wave_sum(q) * (1.0f / DM) + LN_EPS);
}
template <bool TO_LDS>
__device__ __forceinline__ void modulate_store(const f32x4 (&v)[8], const float* sh, const float* sc, bf16_t* orow, LAS float* lrow, int lane) {
    float mean, rstd; ln_stats(v, mean, rstd);
#pragma unroll
    for (int j = 0; j < 8; ++j) { const int col = 4 * lane + 256 * j; const f32x4 s1 = *(const f32x4*)(sc + col), s0 = *(const f32x4*)(sh + col);
        const f32x4 h = (v[j] - mean) * rstd * (1.0f + s1) + s0;
        u32x2 w; w.x = cvt_pk_bf16(h.x, h.y); w.y = cvt_pk_bf16(h.z, h.w); *(u32x2*)(orow + col) = w;
        if (TO_LDS) *(LAS f32x4*)(lrow + col) = h; }
}
__device__ __forceinline__ void stage_vec(const Frame& F, LAS float* dst, const float* src) { *(LAS f32x4*)(dst + 4 * F.tid) = *(const f32x4*)(src + 4 * F.tid); }
__device__ __forceinline__ void p_modulate1(const Frame& F, int l, int nrows) {
    const int gw = F.bid * NWAVES + F.wave, NGW = F.G * NWAVES;
    const float* MOD = (const float*)(F.ws + WS_MOD);
    bf16_t* H1 = (bf16_t*)(F.ws + WS_H1);
    LAS float* prm = (LAS float*)F.lds;
    for (int v = 0; v < 2; ++v) { const float* m = MOD + (size_t)(l * 2 + v) * 12288; stage_vec(F, prm + (2 * v) * DM, m); stage_vec(F, prm + (2 * v + 1) * DM, m + DM); }
    __syncthreads();
    f32x4 nx[8];
    if (gw < nrows) { const float* xr = xrow_ptr(F, l, gw);
#pragma unroll
        for (int j = 0; j < 8; ++j) nx[j] = *(const f32x4*)(xr + 4 * F.lane + 256 * j); }
    for (int r = gw; r < nrows; r += NGW) {
        const int v = r >= SEQ; const LAS float* pv = prm + 2 * v * DM;
        f32x4 x[8];
#pragma unroll
        for (int j = 0; j < 8; ++j) x[j] = nx[j];
        if (r + NGW < nrows) { const float* xr = xrow_ptr(F, l, r + NGW);
#pragma unroll
            for (int j = 0; j < 8; ++j) nx[j] = *(const f32x4*)(xr + 4 * F.lane + 256 * j); }
        float mean, rstd; ln_stats(x, mean, rstd);
#pragma unroll
        for (int j = 0; j < 8; ++j) { const int col = 4 * F.lane + 256 * j; const f32x4 h = (x[j] - mean) * rstd * (1.0f + *(const LAS f32x4*)(pv + DM + col)) + *(const LAS f32x4*)(pv + col);
            u32x2 w; w.x = cvt_pk_bf16(h.x, h.y); w.y = cvt_pk_bf16(h.z, h.w); *(u32x2*)(H1 + (size_t)r * DM + col) = w; }
    }
    __syncthreads();
}

namespace pg8 {
constexpr int BM = 256, BK = 64, HALF = 128, HTB = HALF * BK * 2, STAGE_BYTES = 8 * HTB, NXCD = 8, WGM = 8;
__device__ __forceinline__ int lds_byte(int r, int c) { const int st = (r >> 4) * 2 + (c >> 5), rr = r & 15, cc = c & 31, ob = rr * 64 + cc * 2; return st * 1024 + (ob ^ (((ob >> 9) & 1) << 5)); }
__device__ __forceinline__ void stage_rc(int b, int& R, int& C) { const int st = b / 1024, sb = b % 1024, swz = sb ^ (((sb >> 9) & 1) << 5); R = (st >> 1) * 16 + swz / 64; C = (st & 1) * 32 + (swz % 64) / 2; }
__device__ __forceinline__ int perm32(int rho) { const int n = rho >> 4, i = rho & 15; return 8 * (i >> 2) + 4 * n + (i & 3); }
struct Unit { int pm, pn, e, mt; };
struct StaticOrder {
    int nM, nN, nwg, G, c, K; const bf16_t* Bt;
    __device__ __forceinline__ void init(int M, int N, int K_, const bf16_t* Bt_, int G_, int c_) { nM = M / BM; nN = N / BM; nwg = nM * nN; G = G_; c = c_; K = K_; Bt = Bt_; }
    __device__ __forceinline__ bool next(int i, Unit& u) const {
        const long L = (long)i * G + c; if (L >= nwg) return false;
        int wgid = (int)L; { const int q = nwg / NXCD, r = nwg % NXCD, xcd = wgid % NXCD, off = wgid / NXCD; wgid = (xcd < r ? xcd * (q + 1) : r * (q + 1) + (xcd - r) * q) + off; }
        const int nig = WGM * nN, gid = wgid / nig, fm = gid * WGM, gsz = (nM - fm) < WGM ? (nM - fm) : WGM;
        u.pm = fm + ((wgid % nig) % gsz); u.pn = (wgid % nig) / gsz; u.e = 0; u.mt = 0; return true;
    }
    __device__ __forceinline__ unsigned a_off(const Unit& u, int h, int R) const { return (unsigned)((u.pm * BM + h * HALF + R) * K) * 2u; }
    __device__ __forceinline__ const char* b_base(const Unit& u) const { return (const char*)Bt + (size_t)u.pn * BM * K * 2; }
};
template <bool GATHER> struct MoeOrder {
    const LAS int* tileEM; int ntiles, G, c, K; const int* list; const int* cnt; const bf16_t* Bt;
    __device__ __forceinline__ bool next(int i, Unit& u) const {
        if ((G & 7) == 0) {
            const LAS int* tbase = tileEM + 128; const int x = c & 7, W = G >> 3; int q = (c >> 3) + i * W;
#pragma unroll
            for (int k = 0; k < 4; ++k) { const int e = x + 8 * k; const int tb = tbase[e], nt = tbase[e + 1] - tb; const int nu = nt * 8;
                if (q < nu) { u.e = e; u.pn = q / nt; u.mt = q - u.pn * nt; u.pm = tb + u.mt; return true; }
                q -= nu; }
            return false;
        }
        const int L = i * G + c; if (L >= ntiles * 8) return false;
        const int tile = L >> 3; const int em = tileEM[tile]; u.pm = tile; u.pn = L & 7; u.e = em >> 8; u.mt = em & 255; return true;
    }
    __device__ __forceinline__ unsigned a_off(const Unit& u, int h, int R) const {
        if (GATHER) { const int slot = u.mt * BM + h * HALF + R; const int n = cnt[64 * u.e]; int tok = 0; if (slot < n) tok = list[u.e * NROW + slot]; return (unsigned)(tok * K) * 2u; }
        return (unsigned)((u.pm * BM + h * HALF + R) * K) * 2u;
    }
    __device__ __forceinline__ const char* b_base(const Unit& u) const { return (const char*)Bt + ((size_t)u.e * 2048 + (size_t)u.pn * BM) * K * 2; }
};
struct EpiF32 {
    static constexpr bool PERM = false;
    float* C; int ldc;
    __device__ __forceinline__ void operator()(const f32x4 (&acc)[2][2][4][2], const Unit& u, int wr, int wc, int fr, int fq) const {
        const int row0 = u.pm * BM + wr * 64 + fr, col0 = u.pn * BM + wc * 32 + 4 * fq;
#pragma unroll
        for (int ai = 0; ai < 2; ++ai)
#pragma unroll
            for (int m = 0; m < 4; ++m) { float* rowp = C + (size_t)(row0 + ai * HALF + m * 16) * ldc + col0;
#pragma unroll
                for (int bj = 0; bj < 2; ++bj)
#pragma unroll
                    for (int n = 0; n < 2; ++n) *(f32x4*)(rowp + bj * HALF + n * 16) = acc[ai][bj][m][n]; }
    }
};
template <bool GELU> struct EpiBf {
    static constexpr bool PERM = true;
    bf16_t* O; int ldc; bf16_t* KV;
    __device__ __forceinline__ void operator()(const f32x4 (&acc)[2][2][4][2], const Unit& u, int wr, int wc, int fr, int fq) const {
        const int row0 = u.pm * BM + wr * 64 + fr, col0 = u.pn * BM + wc * 32 + 8 * fq; const bool g = GELU && (u.pn >= 6 && u.pn <= 9);
#pragma unroll
        for (int ai = 0; ai < 2; ++ai)
#pragma unroll
            for (int m = 0; m < 4; ++m) { bf16_t* rowp = (GELU && u.pn >= 14) ? KV + (size_t)(row0 + ai * HALF + m * 16) * 512 + (col0 - 14 * BM) : O + (size_t)(row0 + ai * HALF + m * 16) * ldc + col0;
#pragma unroll
                for (int bj = 0; bj < 2; ++bj) { f32x4 v0 = acc[ai][bj][m][0], v1 = acc[ai][bj][m][1];
                    if (g) {
#pragma unroll
                        for (int j = 0; j < 4; ++j) { v0[j] = gelu_tanh_fast(v0[j]); v1[j] = gelu_tanh_fast(v1[j]); } }
                    u32x4 w; w.x = cvt_pk_bf16(v0[0], v0[1]); w.y = cvt_pk_bf16(v0[2], v0[3]); w.z = cvt_pk_bf16(v1[0], v1[1]); w.w = cvt_pk_bf16(v1[2], v1[3]);
                    *(u32x4*)(rowp + bj * HALF) = w;
                    if (GELU && u.pm == SEQ / BM && u.pn >= 2 && u.pn <= 5)
                        *(u32x4*)(KV + (size_t)(WS_CKV - WS_KV) / 2 + (size_t)((((u.pn - 2) & 1) * 2 + bj) * 256 + (wr * 64 + fr + ai * HALF + m * 16)) * 512 + (u.pn >= 4 ? 256 : 0) + wc * 32 + 8 * fq) = w; } }
    }
};
struct EpiSwiGLU {
    static constexpr bool PERM = true;
    bf16_t* O;
    __device__ __forceinline__ void operator()(const f32x4 (&acc)[2][2][4][2], const Unit& u, int wr, int wc, int fr, int fq) const {
        const int row0 = u.pm * BM + wr * 64 + fr, col0 = u.pn * HALF + wc * 32 + 8 * fq;
#pragma unroll
        for (int ai = 0; ai < 2; ++ai)
#pragma unroll
            for (int m = 0; m < 4; ++m) { bf16_t* rowp = O + (size_t)(row0 + ai * HALF + m * 16) * DEXP + col0;
                f32x4 v0, v1;
#pragma unroll
                for (int j = 0; j < 4; ++j) { v0[j] = silu_fast(acc[ai][0][m][0][j]) * acc[ai][1][m][0][j]; v1[j] = silu_fast(acc[ai][0][m][1][j]) * acc[ai][1][m][1][j]; }
                u32x4 w; w.x = cvt_pk_bf16(v0[0], v0[1]); w.y = cvt_pk_bf16(v0[2], v0[3]); w.z = cvt_pk_bf16(v1[0], v1[1]); w.w = cvt_pk_bf16(v1[2], v1[3]);
                *(u32x4*)rowp = w; }
    }
};

template <class Epi, class Sched>
__device__ __forceinline__ void gemm_phase(LAS unsigned char* lds, int tid, const bf16_t* Amat, int K, const Sched& S, const Epi& E) {
    const int wid = __builtin_amdgcn_readfirstlane(tid >> 6), lane = tid & 63, wr = wid >> 2, wc = wid & 3, fr = lane & 15, fq = lane >> 4;
    const int nt = K / BK;
    int Rl[2], Cl[2]; unsigned voffB[2];
#pragma unroll
    for (int i = 0; i < 2; ++i) { int R, C; stage_rc(tid * 16 + i * 8192, R, C); Rl[i] = R; Cl[i] = C; const int Rb = Epi::PERM ? ((R & ~31) + perm32(R & 31)) : R; voffB[i] = (unsigned)(Rb * K + C) * 2u; }
    const size_t kstep = (size_t)(BK * 2);
    const size_t hstep = (size_t)HALF * K * 2;
    const unsigned ldsw = (unsigned)wid * 1024u;
    const int aoff = lds_byte(wr * 64 + fr, fq * 8), boff = lds_byte(wc * 32 + fr, fq * 8);
    const char* Ab = (const char*)Amat;
#define PG8_SA(b, h) (((b) * 2 + (h)) * HTB)
#define PG8_SB(b, h) ((4 + (b) * 2 + (h)) * HTB)
#define PG8_STAGE(bufoff, gbase, voff) do { _Pragma("unroll") for (int _i = 0; _i < 2; ++_i) \
        __builtin_amdgcn_global_load_lds((const unsigned*)((const char*)(gbase) + (voff)[_i]), (LAS unsigned*)(lds + (bufoff) + ldsw + _i * 8192), 16, 0, 0); } while (0)
#define PG8_LDA(dst, b, h) do { _Pragma("unroll") for (int m = 0; m < 4; ++m) _Pragma("unroll") for (int k = 0; k < 2; ++k) dst[m][k] = *(const LAS bf16x8*)(lds + PG8_SA(b, h) + aoff + m * 2048 + k * 1024); } while (0)
#define PG8_LDB(dst, b, h) do { _Pragma("unroll") for (int n = 0; n < 2; ++n) _Pragma("unroll") for (int k = 0; k < 2; ++k) dst[n][k] = *(const LAS bf16x8*)(lds + PG8_SB(b, h) + boff + n * 2048 + k * 1024); } while (0)
#define PG8_MMA(ai, bj, At, Bt) do { __builtin_amdgcn_s_setprio(1); _Pragma("unroll") for (int m = 0; m < 4; ++m) _Pragma("unroll") for (int n = 0; n < 2; ++n) _Pragma("unroll") for (int k = 0; k < 2; ++k) \
        acc[ai][bj][m][n] = __builtin_amdgcn_mfma_f32_16x16x32_bf16(Bt[n][k], At[m][k], acc[ai][bj][m][n], 0, 0, 0); __builtin_amdgcn_s_setprio(0); } while (0)
#define PG8_WAIT_V(n) asm volatile("s_waitcnt vmcnt(" #n ")" ::: "memory")
#define PG8_WAIT_L(n) asm volatile("s_waitcnt lgkmcnt(" #n ")" ::: "memory")
#define PG8_BAR __builtin_amdgcn_s_barrier()
#define PG8_SCHED __builtin_amdgcn_sched_barrier(0)
#define PG8_AOFFS(dst, u) do { _Pragma("unroll") for (int _h = 0; _h < 2; ++_h) _Pragma("unroll") for (int _i = 0; _i < 2; ++_i) dst[_h][_i] = S.a_off(u, _h, Rl[_i]) + (unsigned)Cl[_i] * 2u; \
        asm volatile("" : "+v"(dst[0][0]), "+v"(dst[0][1]), "+v"(dst[1][0]), "+v"(dst[1][1])); } while (0)
    Unit cur, nxt; int ui = 0;
    if (!S.next(0, cur)) return;
    f32x4 acc[2][2][4][2];
#pragma unroll
    for (int a = 0; a < 2; ++a)
#pragma unroll
        for (int b = 0; b < 2; ++b)
#pragma unroll
            for (int m = 0; m < 4; ++m)
#pragma unroll
                for (int n = 0; n < 2; ++n) acc[a][b][m][n] = (f32x4){0.f, 0.f, 0.f, 0.f};
    bf16x8 At[4][2], B0[2][2], B1[2][2];
    unsigned vA[2][2], vAn[2][2];
    PG8_AOFFS(vA, cur);
    const char* cB = S.b_base(cur);
    PG8_STAGE(PG8_SB(0, 0), cB, voffB); PG8_STAGE(PG8_SA(0, 0), Ab, vA[0]); PG8_STAGE(PG8_SB(0, 1), cB + hstep, voffB); PG8_STAGE(PG8_SA(0, 1), Ab, vA[1]);
    if (wr == 1) PG8_BAR;
    PG8_WAIT_V(4); PG8_BAR;
    PG8_STAGE(PG8_SB(1, 0), cB + kstep, voffB); PG8_STAGE(PG8_SA(1, 0), Ab + kstep, vA[0]); PG8_STAGE(PG8_SB(1, 1), cB + hstep + kstep, voffB);
    PG8_WAIT_V(6); PG8_BAR;
    for (;;) {
        const bool has_next = S.next(ui + 1, nxt);
        const char* nB = cB;
        if (has_next) { PG8_AOFFS(vAn, nxt); nB = S.b_base(nxt); }
        else {
#pragma unroll
            for (int h = 0; h < 2; ++h)
#pragma unroll
                for (int i = 0; i < 2; ++i) vAn[h][i] = vA[h][i]; }
        for (int t = 0; t < nt; t += 2) {
            const bool last = (t == nt - 2);
            const char* a1 = Ab + (size_t)(t + 1) * kstep;
            const char* a2 = last ? Ab : Ab + (size_t)(t + 2) * kstep; const char* b2 = last ? nB : cB + (size_t)(t + 2) * kstep;
            const char* a3 = a2 + kstep; const char* b3 = b2 + kstep;
            unsigned o2[2][2];
#pragma unroll
            for (int h = 0; h < 2; ++h)
#pragma unroll
                for (int i = 0; i < 2; ++i) o2[h][i] = last ? vAn[h][i] : vA[h][i];
            PG8_LDB(B0, 0, 0); PG8_SCHED; PG8_LDA(At, 0, 0); PG8_STAGE(PG8_SA(1, 1), a1, vA[1]);
            PG8_WAIT_L(8); PG8_BAR; PG8_WAIT_L(0); PG8_MMA(0, 0, At, B0); PG8_BAR; PG8_SCHED;
            PG8_LDB(B1, 0, 1); PG8_STAGE(PG8_SB(0, 0), b2, voffB);
            PG8_BAR; PG8_WAIT_L(0); PG8_MMA(0, 1, At, B1); PG8_BAR;
            PG8_LDA(At, 0, 1); PG8_STAGE(PG8_SA(0, 0), a2, o2[0]);
            PG8_BAR; PG8_WAIT_L(0); PG8_MMA(1, 0, At, B0); PG8_BAR; PG8_SCHED;
            PG8_STAGE(PG8_SB(0, 1), b2 + hstep, voffB);
            PG8_WAIT_V(6); PG8_BAR; PG8_MMA(1, 1, At, B1); PG8_BAR;
            PG8_LDB(B0, 1, 0); PG8_SCHED; PG8_LDA(At, 1, 0); PG8_STAGE(PG8_SA(0, 1), a2, o2[1]);
            PG8_WAIT_L(8); PG8_BAR; PG8_WAIT_L(0); PG8_MMA(0, 0, At, B0); PG8_BAR; PG8_SCHED;
            PG8_LDB(B1, 1, 1); PG8_STAGE(PG8_SB(1, 0), b3, voffB);
            PG8_BAR; PG8_WAIT_L(0); PG8_MMA(0, 1, At, B1); PG8_BAR;
            PG8_LDA(At, 1, 1); PG8_STAGE(PG8_SA(1, 0), a3, o2[0]);
            PG8_BAR; PG8_WAIT_L(0); PG8_MMA(1, 0, At, B0); PG8_BAR; PG8_SCHED;
            PG8_STAGE(PG8_SB(1, 1), b3 + hstep, voffB);
            PG8_WAIT_V(6); PG8_BAR; PG8_MMA(1, 1, At, B1); PG8_BAR;
        }
        E(acc, cur, wr, wc, fr, fq);
        if (!has_next) break;
#pragma unroll
        for (int a = 0; a < 2; ++a)
#pragma unroll
            for (int b = 0; b < 2; ++b)
#pragma unroll
                for (int m = 0; m < 4; ++m)
#pragma unroll
                    for (int n = 0; n < 2; ++n) acc[a][b][m][n] = (f32x4){0.f, 0.f, 0.f, 0.f};
        cur = nxt; cB = nB; ++ui;
#pragma unroll
        for (int h = 0; h < 2; ++h)
#pragma unroll
            for (int i = 0; i < 2; ++i) vA[h][i] = vAn[h][i];
    }
    PG8_WAIT_V(0);
    if (wr == 0) PG8_BAR;
    PG8_BAR;
#undef PG8_SA
#undef PG8_SB
#undef PG8_STAGE
#undef PG8_LDA
#undef PG8_LDB
#undef PG8_MMA
#undef PG8_WAIT_V
#undef PG8_WAIT_L
#undef PG8_BAR
#undef PG8_SCHED
#undef PG8_AOFFS
}
}

__device__ __forceinline__ void p_rmsrope(const Frame& F, int l, int nrows, int wg0) {
    const int gw = (F.bid - wg0) * NWAVES + F.wave, NGW = (F.G - wg0) * NWAVES;
    bf16_t* P = (bf16_t*)(F.ws + WS_PROJ);
    const float* R = (const float*)(F.ws + WS_ROPE);
    const int i = F.lane & 31, ax = F.lane >> 5, d1 = ax * 64 + i, d2 = d1 + 32;
    const float gq1 = F.in[IN_QNG][l * 128 + d1], gq2 = F.in[IN_QNG][l * 128 + d2], gk1 = F.in[IN_KNG][l * 128 + d1], gk2 = F.in[IN_KNG][l * 128 + d2];
    for (int r = gw; r < nrows; r += NGW) {
        float cs = 1.f, sn = 0.f;
        if (r < SEQ) { const int pos = ax == 0 ? (r >> 6) : (r & 63); cs = R[2 * (pos * 32 + i)]; sn = R[2 * (pos * 32 + i) + 1]; }
#pragma unroll
        for (int hh = 0; hh < 10; ++hh) {
            bf16_t* p = P + (size_t)r * INW + (hh < 8 ? 2560 + hh * 128 : 3584 + (hh - 8) * 128);
            float x1 = bf2f(p[d1]), x2 = bf2f(p[d2]);
            const float ss = wave_sum(x1 * x1 + x2 * x2);
            const float rinv = 1.0f / sqrtf(ss * (1.0f / 128.0f) + LN_EPS);
            x1 = x1 * rinv * (hh < 8 ? gq1 : gk1); x2 = x2 * rinv * (hh < 8 ? gq2 : gk2);
            p[d1] = f2bf(x1 * cs - x2 * sn); p[d2] = f2bf(x2 * cs + x1 * sn);
        }
    }
}

__device__ __forceinline__ void rms_rope_tile(const Frame& F, int l, int row0, int pn) {
    bf16_t* P = (bf16_t*)(F.ws + WS_PROJ);
    const float* R = (const float*)(F.ws + WS_ROPE);
    const float* gn = F.in[pn < 14 ? IN_QNG : IN_KNG] + l * 128;
    const int q = F.lane & 3;
    float gv[32];
#pragma unroll
    for (int c = 0; c < 4; ++c) { const f32x4 a = *(const f32x4*)(gn + 32 * c + 8 * q), b2 = *(const f32x4*)(gn + 32 * c + 8 * q + 4);
        gv[8 * c] = a.x; gv[8 * c + 1] = a.y; gv[8 * c + 2] = a.z; gv[8 * c + 3] = a.w; gv[8 * c + 4] = b2.x; gv[8 * c + 5] = b2.y; gv[8 * c + 6] = b2.z; gv[8 * c + 7] = b2.w; }
#pragma unroll 1
    for (int it = 0; it < 4; ++it) {
        const int pr = it * 128 + F.wave * 16 + (F.lane >> 2);
        const int row = row0 + (pr >> 1);
        bf16_t* p = (pn == 14) ? (bf16_t*)(F.ws + WS_KV) + (size_t)row * 512 + (pr & 1) * 128 + 8 * q : P + (size_t)row * INW + pn * 256 + (pr & 1) * 128 + 8 * q;
        float x[32]; float ss = 0.f;
#pragma unroll
        for (int c = 0; c < 4; ++c) { const u32x4 r = *(const u32x4*)(p + 32 * c);
#pragma unroll
            for (int e = 0; e < 4; ++e) { x[8 * c + 2 * e] = bf2f((bf16_t)(r[e] & 0xffffu)); x[8 * c + 2 * e + 1] = bf2f((bf16_t)(r[e] >> 16)); } }
#pragma unroll
        for (int t = 0; t < 32; ++t) ss += x[t] * x[t];
        ss = quad_sum(ss);
        const float rinv = 1.0f / sqrtf(ss * (1.0f / 128.0f) + LN_EPS);
#pragma unroll
        for (int t = 0; t < 32; ++t) x[t] = x[t] * rinv * gv[t];
        if (row < SEQ) {
#pragma unroll
            for (int ax = 0; ax < 2; ++ax) { const int pos = ax == 0 ? (row >> 6) : (row & 63); const float* cs = R + 2 * (pos * 32 + 8 * q);
#pragma unroll
                for (int t4 = 0; t4 < 4; ++t4) { const f32x4 w = *(const f32x4*)(cs + 4 * t4);
#pragma unroll
                    for (int e = 0; e < 2; ++e) { const int t = 2 * t4 + e; const float c0 = e ? w.z : w.x, s0 = e ? w.w : w.y;
                        const float x1 = x[16 * ax + t], x2 = x[16 * ax + 8 + t]; x[16 * ax + t] = x1 * c0 - x2 * s0; x[16 * ax + 8 + t] = x2 * c0 + x1 * s0; } } }
        }
#pragma unroll
        for (int c = 0; c < 4; ++c) { u32x4 o;
#pragma unroll
            for (int e = 0; e < 4; ++e) o[e] = cvt_pk_bf16(x[8 * c + 2 * e], x[8 * c + 2 * e + 1]);
            *(u32x4*)(p + 32 * c) = o; }
    }
}

namespace att {
constexpr int D = 128, NW = 8, QBLK = 32, KVBLK = 64;
constexpr float SCALE = 0.088388347648318440f;
constexpr float THR = 8.f;
constexpr int LDQ = INW, LDO = DM;
constexpr size_t SHM_V = KVBLK * D * 2, SHM_K = KVBLK * D * 2, SHM_ATTN = 2 * SHM_V + 2 * SHM_K + NW * 64 * 4;
#define KSWZ(row, colB) ((row) * 256 + ((colB) ^ (((row) & 7) << 4)))
#define SBAR() __builtin_amdgcn_sched_barrier(0)
__device__ __forceinline__ int crow(int r, int hi) { return (r & 3) + 8 * (r >> 2) + 4 * hi; }
__device__ __forceinline__ unsigned cvtpk(float lo, float hi) { unsigned r; asm volatile("v_cvt_pk_bf16_f32 %0, %1, %2" : "=v"(r) : "v"(lo), "v"(hi)); return r; }
__device__ __forceinline__ void partialSM(f32x16& p0, f32x16& p1, float& m_reg, float& mn, float& alpha) {
  constexpr float C = SCALE * 1.4426950408889634f;
  float pmax = p0[0];
#pragma unroll
  for (int r = 1; r < 16; ++r) pmax = fmaxf(pmax, p0[r]);
#pragma unroll
  for (int r = 0; r < 16; ++r) pmax = fmaxf(pmax, p1[r]);
  { auto rr = __builtin_amdgcn_permlane32_swap(__float_as_uint(pmax), __float_as_uint(pmax), false, false);
    pmax = fmaxf(__uint_as_float(rr[0]), __uint_as_float(rr[1])); }
  if (__builtin_expect(__all(pmax - m_reg <= THR / SCALE), 1)) { mn = m_reg; alpha = 1.f; }
  else { mn = fmaxf(m_reg, pmax); alpha = __builtin_amdgcn_exp2f((m_reg - mn) * C); m_reg = mn; }
  float mnC = -mn * C;
#pragma unroll
  for (int r = 0; r < 16; ++r) p0[r] = fmaf(p0[r], C, mnC);
#pragma unroll
  for (int r = 0; r < 16; ++r) p1[r] = fmaf(p1[r], C, mnC);
#pragma unroll
  for (int r = 0; r < 16; ++r) p0[r] = __builtin_amdgcn_exp2f(p0[r]);
}
__device__ __forceinline__ void finishSM(f32x16& p0, f32x16& p1, float alpha, float& l_reg, bf16x8& pa0, bf16x8& pa1, bf16x8& pa2, bf16x8& pa3) {
#pragma unroll
  for (int r = 0; r < 16; ++r) p1[r] = __builtin_amdgcn_exp2f(p1[r]);
  float ps = 0;
#pragma unroll
  for (int r = 0; r < 16; ++r) ps += p0[r];
#pragma unroll
  for (int r = 0; r < 16; ++r) ps += p1[r];
  { auto rr = __builtin_amdgcn_permlane32_swap(__float_as_uint(ps), __float_as_uint(ps), false, false);
    ps = __uint_as_float(rr[0]) + __uint_as_float(rr[1]); }
  l_reg = l_reg * alpha + ps;
#define PK4(P, BASE, OUT) do { unsigned a0 = cvtpk(P[BASE + 0], P[BASE + 1]), a1 = cvtpk(P[BASE + 2], P[BASE + 3]);   \
    unsigned b0 = cvtpk(P[BASE + 4], P[BASE + 5]), b1 = cvtpk(P[BASE + 6], P[BASE + 7]);                              \
    auto r0 = __builtin_amdgcn_permlane32_swap(a0, b0, false, false); auto r1 = __builtin_amdgcn_permlane32_swap(a1, b1, false, false); \
    u32x4 w = {r0[0], r1[0], r0[1], r1[1]}; OUT = *reinterpret_cast<bf16x8*>(&w); } while (0)
  PK4(p0, 0, pa0); PK4(p0, 8, pa1); PK4(p1, 0, pa2); PK4(p1, 8, pa3);
#undef PK4
}
__device__ __forceinline__ void qkt(f32x16& p0, f32x16& p1, const bf16_t* Ks, const bf16x8* qr, int r32, int hi) {
  p0 = f32x16{}; p1 = f32x16{};
#pragma unroll
  for (int d0 = 0; d0 < 8; ++d0) { int cb = (d0 * 16 + hi * 8) * 2;
    bf16x8 b0 = *reinterpret_cast<const bf16x8*>((const char*)Ks + KSWZ(r32, cb));
    bf16x8 b1 = *reinterpret_cast<const bf16x8*>((const char*)Ks + KSWZ(32 + r32, cb));
    p0 = __builtin_amdgcn_mfma_f32_32x32x16_bf16(b0, qr[d0], p0, 0, 0, 0);
    p1 = __builtin_amdgcn_mfma_f32_32x32x16_bf16(b1, qr[d0], p1, 0, 0, 0); }
}
__device__ __forceinline__ int v_st(int k, int c) { const int kk = (k & ~0xC) | ((k & 4) << 1) | ((k & 8) >> 1); return ((kk >> 3) * 4 + (c >> 5)) * 512 + ((kk & 7) * 32 + (c & 31)) * 2; }
__device__ __forceinline__ int v_rd_base(int lane) { return ((lane & 3) << 3) | (((lane >> 2) & 3) << 6) | (((lane >> 4) & 1) << 5) | (((lane >> 5) & 1) << 8); }
constexpr int v_rd_off(int d0, int ks, int half) { return d0 * 512 + ks * 4096 + half * 2048; }
template <int OFF> __device__ __forceinline__ s16x4 tr_read(int vb) {
  s16x4 r; asm volatile("ds_read_b64_tr_b16 %0, %1 offset:%2" : "=&v"(r) : "v"(vb), "i"(OFF) : "memory"); return r;
}
template <int D0> __device__ __forceinline__ void pv_one(f32x16& od, int vb, bf16x8 pa0, bf16x8 pa1, bf16x8 pa2, bf16x8 pa3) {
  const s16x4 l0 = tr_read<v_rd_off(D0, 0, 0)>(vb), h0 = tr_read<v_rd_off(D0, 0, 1)>(vb), l1 = tr_read<v_rd_off(D0, 1, 0)>(vb), h1 = tr_read<v_rd_off(D0, 1, 1)>(vb);
  const s16x4 l2 = tr_read<v_rd_off(D0, 2, 0)>(vb), h2 = tr_read<v_rd_off(D0, 2, 1)>(vb), l3 = tr_read<v_rd_off(D0, 3, 0)>(vb), h3 = tr_read<v_rd_off(D0, 3, 1)>(vb);
  asm volatile("s_waitcnt lgkmcnt(0)" ::: "memory"); SBAR();
#define PK(L, H) (bf16x8){L[0], L[1], L[2], L[3], H[0], H[1], H[2], H[3]}
  od = __builtin_amdgcn_mfma_f32_32x32x16_bf16(pa0, PK(l0, h0), od, 0, 0, 0);
  od = __builtin_amdgcn_mfma_f32_32x32x16_bf16(pa1, PK(l1, h1), od, 0, 0, 0);
  od = __builtin_amdgcn_mfma_f32_32x32x16_bf16(pa2, PK(l2, h2), od, 0, 0, 0);
  od = __builtin_amdgcn_mfma_f32_32x32x16_bf16(pa3, PK(l3, h3), od, 0, 0, 0);
#undef PK
}
__device__ __forceinline__ void pv_d0(f32x16* o, int vb, bf16x8 pa0, bf16x8 pa1, bf16x8 pa2, bf16x8 pa3) {
  pv_one<0>(o[0], vb, pa0, pa1, pa2, pa3); pv_one<1>(o[1], vb, pa0, pa1, pa2, pa3); pv_one<2>(o[2], vb, pa0, pa1, pa2, pa3); pv_one<3>(o[3], vb, pa0, pa1, pa2, pa3);
}
struct MapLinear { long base; __device__ __forceinline__ long operator()(int t) const { return base + (long)t * KVBLK; } };
struct MapNA { int rs0; __device__ __forceinline__ long operator()(int t) const { return t < 4 ? (long)SEQ + t * 64 : (long)(rs0 + t - 4) * 64; } };
struct HookNone { __device__ __forceinline__ void operator()(f32x16&, f32x16&, int, int) const {} };
struct HookNA {
  const LAS float* bias; int qr, rs, rs0, cbase  , bbase  ;
  __device__ __forceinline__ void operator()(f32x16& p0, f32x16& p1, int tile, int hi) const {
    if (tile < 4) return;
    const int kr = rs0 + tile - 4; const bool rowok = (kr >= rs) && (kr <= rs + 7);
    int drow = kr - qr + 7; drow = drow < 0 ? 0 : (drow > 14 ? 14 : drow);
    const float ninf = -__builtin_inff();
    const LAS float* bp = bias + drow * 31 + bbase;
#pragma unroll
    for (int r = 0; r < 16; ++r) {
      const int kc = (r & 3) + 8 * (r >> 2);
      const bool ok0 = rowok && (unsigned)(kc + cbase) <= 15u, ok1 = rowok && (unsigned)(kc + 32 + cbase) <= 15u;
      p0[r] = ok0 ? p0[r] + bp[kc] : ninf; p1[r] = ok1 ? p1[r] + bp[kc + 32] : ninf;
    }
  }
};
template <int SDEPTH, int LDK, class Map, class Hook>
__device__ __forceinline__ void attn_body(const bf16_t* __restrict__ Qb, const bf16_t* __restrict__ Kh, const bf16_t* __restrict__ Vh,
                                          bf16_t* __restrict__ Ob, int NT, const Map map, const Hook hook, char* lds, int tid) {
  const int wid = tid >> 6, lane = tid & 63, r32 = lane & 31, hi = lane >> 5;
  bf16_t* V_lds = (bf16_t*)lds; bf16_t* K_lds = (bf16_t*)(lds + 2 * SHM_V);
  float* ws = (float*)(lds + 2 * SHM_V + 2 * SHM_K) + wid * 64; float* li_l = ws; float* al_l = ws + 32;
  float m_reg = -1e30f, l_reg = 0; f32x16 o[4] = {}; bf16x8 qr[8];
  const bf16_t* Qw = Qb + (long)(wid * QBLK + r32) * LDQ + hi * 8;
#pragma unroll
  for (int d0 = 0; d0 < 8; ++d0) qr[d0] = *reinterpret_cast<const bf16x8*>(Qw + d0 * 16);
  const int sr = tid >> 4, sc = (tid & 15) * 8, vst0 = v_st(sr, sc), vst1 = v_st(32 + sr, sc);
  const int vb0 = (int)(uintptr_t)V_lds + v_rd_base(lane);
  struct { bf16x8 vs0, vs1, ks0, ks1; } sr_[SDEPTH];
#define SLOAD(i, tile) do { const long _k0 = map(tile); sr_[i].vs0 = *reinterpret_cast<const bf16x8*>(&Vh[(_k0 + sr) * LDK + sc]); sr_[i].vs1 = *reinterpret_cast<const bf16x8*>(&Vh[(_k0 + 32 + sr) * LDK + sc]); \
    sr_[i].ks0 = *reinterpret_cast<const bf16x8*>(&Kh[(_k0 + sr) * LDK + sc]); sr_[i].ks1 = *reinterpret_cast<const bf16x8*>(&Kh[(_k0 + 32 + sr) * LDK + sc]); } while (0)
#define SWRITE(b, i) do { *(bf16x8*)((char*)V_lds + (b) * SHM_V + vst0) = sr_[i].vs0;          \
    *(bf16x8*)((char*)V_lds + (b) * SHM_V + vst1) = sr_[i].vs1; int kc = sc * 2;               \
    *(bf16x8*)((char*)K_lds + (b) * SHM_K + KSWZ(sr, kc)) = sr_[i].ks0;                       \
    *(bf16x8*)((char*)K_lds + (b) * SHM_K + KSWZ(32 + sr, kc)) = sr_[i].ks1; } while (0)
#define SWAIT() do { if constexpr (SDEPTH == 2) asm volatile("s_waitcnt vmcnt(4)" ::: "memory"); else asm volatile("s_waitcnt vmcnt(0)" ::: "memory"); } while (0)
#define RESC(a) do { if (__any((a) < 1.f)) { if (hi == 0) al_l[r32] = (a); asm volatile("s_waitcnt lgkmcnt(0)" ::: "memory"); \
    _Pragma("unroll") for (int d = 0; d < 4; ++d) _Pragma("unroll") for (int r = 0; r < 16; ++r) o[d][r] *= al_l[crow(r, hi)]; } } while (0)
  f32x16 pA0, pA1, pB0, pB1; float mnA, mnB, alA, alB; bf16x8 pa0, pa1, pa2, pa3;
  constexpr int SE = 0, SO = SDEPTH - 1;
  SLOAD(SE, 0); asm volatile("s_waitcnt vmcnt(0)" ::: "memory"); SWRITE(0, SE); __syncthreads();
  qkt(pA0, pA1, K_lds, qr, r32, hi); hook(pA0, pA1, 0, hi); partialSM(pA0, pA1, m_reg, mnA, alA);
  SLOAD(SO, 1); if constexpr (SDEPTH == 2) { if (2 < NT) SLOAD(SE, 2); }
  SWAIT(); SWRITE(1, SO); __syncthreads();
  for (int j = 1; j + 1 < NT; j += 2) {
    SBAR(); qkt(pB0, pB1, (bf16_t*)((char*)K_lds + SHM_K), qr, r32, hi);
    finishSM(pA0, pA1, alA, l_reg, pa0, pa1, pa2, pa3); SBAR();
    SLOAD(SO, j + SDEPTH); SBAR();
    pv_d0(o, vb0, pa0, pa1, pa2, pa3); hook(pB0, pB1, j, hi); partialSM(pB0, pB1, m_reg, mnB, alB);
    __syncthreads(); SWAIT(); SWRITE(0, SE);
    RESC(alB); __syncthreads();
    SBAR(); qkt(pA0, pA1, K_lds, qr, r32, hi);
    finishSM(pB0, pB1, alB, l_reg, pa0, pa1, pa2, pa3); SBAR();
    if (SDEPTH == 1 || j + 3 < NT) SLOAD(SE, j + 1 + SDEPTH); SBAR();
    pv_d0(o, vb0 + (int)SHM_V, pa0, pa1, pa2, pa3); hook(pA0, pA1, j + 1, hi); partialSM(pA0, pA1, m_reg, mnA, alA);
    __syncthreads(); SWAIT(); SWRITE(1, SO);
    RESC(alA); __syncthreads();
  }
  SBAR(); qkt(pB0, pB1, (bf16_t*)((char*)K_lds + SHM_K), qr, r32, hi);
  finishSM(pA0, pA1, alA, l_reg, pa0, pa1, pa2, pa3); SBAR();
  pv_d0(o, vb0, pa0, pa1, pa2, pa3); hook(pB0, pB1, NT - 1, hi); partialSM(pB0, pB1, m_reg, mnB, alB);
  __syncthreads(); RESC(alB);
  finishSM(pB0, pB1, alB, l_reg, pa0, pa1, pa2, pa3); SBAR();
  pv_d0(o, vb0 + (int)SHM_V, pa0, pa1, pa2, pa3);
  if (hi == 0) li_l[r32] = l_reg; asm volatile("s_waitcnt lgkmcnt(0)" ::: "memory");
  float rli[16];
#pragma unroll
  for (int r = 0; r < 16; ++r) rli[r] = __builtin_amdgcn_rcpf(li_l[crow(r, hi)]);
  bf16_t* Ow = Ob + (long)(wid * QBLK) * LDO;
#pragma unroll
  for (int r = 0; r < 16; ++r) { int orow = crow(r, hi);
#pragma unroll
    for (int d0 = 0; d0 < 4; ++d0) Ow[(long)orow * LDO + d0 * 32 + r32] = f2bf(o[d0][r] * rli[r]); }
  __syncthreads();
#undef SLOAD
#undef SWRITE
#undef SWAIT
#undef RESC
}
}

__device__ __forceinline__ void sg_unit(const Frame& F, int l, int c, int g) {
    constexpr int VST = 136;
    LAS bf16_t* vnT = (LAS bf16_t*)F.lds;
    const bf16_t* P = (const bf16_t*)(F.ws + WS_PROJ);
    const int fr = F.lane & 15, fq = F.lane >> 4;
    const float* W = F.in[IN_SGW] + ((size_t)(l * 4 + g) * 128 + 16 * F.wave + fr) * 128 + 8 * fq;
    bf16x8 wf[4];
#pragma unroll
    for (int ks = 0; ks < 4; ++ks) { const f32x4 a = *(const f32x4*)(W + 32 * ks), b2 = *(const f32x4*)(W + 32 * ks + 4);
        u32x4 w; w.x = cvt_pk_bf16(a.x, a.y); w.y = cvt_pk_bf16(a.z, a.w); w.z = cvt_pk_bf16(b2.x, b2.y); w.w = cvt_pk_bf16(b2.z, b2.w); wf[ks] = *reinterpret_cast<bf16x8*>(&w); }
    {
        const int j = 16 * F.wave + (F.lane >> 2), q = F.lane & 3; const size_t p = (size_t)(c * 128 + j);
        const bf16_t* vp = P + p * INW + 2048 + g * 128 + 32 * q;
        float x[32];
#pragma unroll
        for (int t = 0; t < 4; ++t) { const u32x4 r = *(const u32x4*)(vp + 8 * t);
#pragma unroll
            for (int e = 0; e < 4; ++e) { x[8 * t + 2 * e] = bf2f((bf16_t)(r[e] & 0xffffu)); x[8 * t + 2 * e + 1] = bf2f((bf16_t)(r[e] >> 16)); } }
        float sm = 0.f;
#pragma unroll
        for (int t = 0; t < 32; ++t) sm += x[t];
        sm = quad_sum(sm);
        const float mean = sm * (1.0f / 128.0f); float sq = 0.f;
#pragma unroll
        for (int t = 0; t < 32; ++t) { x[t] -= mean; sq += x[t] * x[t]; }
        sq = quad_sum(sq);
        const float rstd = 1.0f / sqrtf(sq * (1.0f / 128.0f) + LN_EPS);
        const float* gp = F.in[IN_SGLNG] + (l * 4 + g) * 128 + 32 * q; const float* bp = F.in[IN_SGLNB] + (l * 4 + g) * 128 + 32 * q;
#pragma unroll
        for (int t = 0; t < 32; ++t) vnT[(32 * q + t) * VST + j] = f2bf(x[t] * rstd * gp[t] + bp[t]);
    }
    __syncthreads();
    bf16_t* MIXp = (bf16_t*)(F.ws + WS_MIX);
    const int i = 16 * F.wave + fr; const size_t pi = (size_t)(c * 128 + i); const float bs = F.in[IN_SGB][(l * 4 + g) * 128 + i];
#pragma unroll
    for (int dt = 0; dt < 8; ++dt) {
        f32x4 acc = {0.f, 0.f, 0.f, 0.f};
#pragma unroll
        for (int ks = 0; ks < 4; ++ks) { const bf16x8 a = *(const LAS bf16x8*)(vnT + (dt * 16 + fr) * VST + 32 * ks + 8 * fq); acc = __builtin_amdgcn_mfma_f32_16x16x32_bf16(a, wf[ks], acc, 0, 0, 0); }
        const int d0 = 16 * dt + 4 * fq; const u32x2 uu = *(const u32x2*)(P + pi * INW + 1536 + g * 128 + d0);
        u32x2 o; o.x = cvt_pk_bf16((acc[0] + bs) * bf2f((bf16_t)(uu.x & 0xffffu)), (acc[1] + bs) * bf2f((bf16_t)(uu.x >> 16)));
        o.y = cvt_pk_bf16((acc[2] + bs) * bf2f((bf16_t)(uu.y & 0xffffu)), (acc[3] + bs) * bf2f((bf16_t)(uu.y >> 16)));
        *(u32x2*)(MIXp + pi * DM + 512 + g * 128 + d0) = o;
    }
    __syncthreads();
}

__device__ __forceinline__ void p_att_dense(const Frame& F, int l) {
    const bf16_t* P = (const bf16_t*)(F.ws + WS_PROJ); bf16_t* MIXp = (bf16_t*)(F.ws + WS_MIX); const bf16_t* KV = (const bf16_t*)(F.ws + WS_KV);
    const int total = 256 + ((l == 0) ? 12 : 0);
    for (int u = F.bid; u < total; u += F.G) {
        int qrow, qcol, ocol, nt; long kbase; const bf16_t* kp;
        if (u < 256) { const int h = u & 7; qrow = (u >> 3) * 256; qcol = 2560 + h * 128; ocol = 1024 + h * 128; nt = NROW / 64; kbase = 0; kp = KV + (h >> 2) * 128; }
        else if (u < 264) { const int h = u - 256; qrow = SEQ; qcol = 2560 + h * 128; ocol = 1024 + h * 128; nt = 4; kbase = SEQ; kp = KV + (h >> 2) * 128; }
        else { const int h = u - 264; qrow = SEQ; qcol = h * 128; ocol = h * 128; nt = 4; kbase = 0; kp = (const bf16_t*)(F.ws + WS_CKV) + (size_t)h * 256 * 512; }
        att::attn_body<2, 512>(P + (size_t)qrow * INW + qcol, kp, kp + 256, MIXp + (size_t)qrow * DM + ocol, nt, att::MapLinear{kbase}, att::HookNone{}, (char*)F.lds, F.tid);
    }
}
__device__ __forceinline__ void p_att_na(const Frame& F, int l) {
    const bf16_t* P = (const bf16_t*)(F.ws + WS_PROJ); bf16_t* MIXp = (bf16_t*)(F.ws + WS_MIX);
    LAS float* bt = (LAS float*)(F.lds + LDS_SC);
    for (int v = F.bid; v < 128; v += F.G) {
        const int h = v & 3, qb = v >> 2, R0 = qb * 4;
        const float* rpb = F.in[IN_RPB] + (size_t)(l * 4 + h) * 15 * 31;
        for (int t = F.tid; t < 640; t += NTHR) { const int q = t - 48; bt[t] = (q >= 0 && q < 15 * 31) ? rpb[q] * (1.0f / att::SCALE) : 0.f; }
        __syncthreads();
        int rs0 = R0 - 4; rs0 = rs0 < 0 ? 0 : (rs0 > 116 ? 116 : rs0);
        const int qr = R0 + (F.wave >> 1), qc = (F.wave & 1) * 32 + (F.lane & 31);
        int rs = qr - 4; rs = rs < 0 ? 0 : (rs > 120 ? 120 : rs);
        int cs = qc - 8; cs = cs < 0 ? 0 : (cs > 48 ? 48 : cs);
        att::attn_body<1, INW>(P + (size_t)(qb * 256) * INW + h * 128, P + 512 + h * 128, P + 1024 + h * 128,
                       MIXp + (size_t)(qb * 256) * DM + h * 128, 16, att::MapNA{rs0}, att::HookNA{bt, qr, rs, rs0, 4 * (F.lane >> 5) - cs, 48 + 15 - qc + 4 * (F.lane >> 5)}, (char*)F.lds, F.tid);
    }
}
__device__ __forceinline__ void p_att_sg(const Frame& F, int l) {
    const int nsg = (l == 0) ? 264 : 256;
    if (F.G >= 256) { for (int v = F.bid - 128; v >= 0 && v < nsg; v += F.G - 128) sg_unit(F, l, v >> 2, v & 3); }
    else { for (int v = F.bid; v < nsg; v += F.G) sg_unit(F, l, v >> 2, v & 3); }
}

#ifdef TSEL_A
#define TSF(F, i) do { if ((F).bid == 0 && (F).tid == 0) __hip_atomic_store((unsigned long long*)((F).ws + WS_CTL + 131072) + (i), (unsigned long long)__builtin_amdgcn_s_memrealtime(), __ATOMIC_RELAXED, __HIP_MEMORY_SCOPE_AGENT); } while (0)
#else
#define TSF(F, i) do { } while (0)
#endif
__device__ __forceinline__ void p_mixln_router(const Frame& F, int l, int nrows) {
    LAS float* plog = (LAS float*)F.lds;
    LAS float* scS = plog + 8 * 48 * 32;
    LAS float* selS = scS + 48 * 32;
    const float* MOD = (const float*)(F.ws + WS_MOD);
    const bf16_t* Y1 = (const bf16_t*)(F.ws + WS_Y1);
    float* XS = (float*)(F.ws + WS_XS);
    bf16_t* H2 = (bf16_t*)(F.ws + WS_H2); bf16_t* H2L = (bf16_t*)(F.ws + WS_H2L);
    const bf16_t* RWH = (const bf16_t*)(F.ws + WS_RWT); const bf16_t* RWL = RWH + 32 * DM;
    const float* RB = F.in[IN_RB];
    const float* lg = F.in[IN_LNMG] + l * DM; const float* lb = F.in[IN_LNMB] + l * DM;
    int* cnt = (int*)(F.ws + WS_CTL) + CW_CNT + l * 2048;
    int* tokE = (int*)(F.ws + WS_TOKE); int* tokP = (int*)(F.ws + WS_TOKP); float* tokG = (float*)(F.ws + WS_TOKG); int* list = (int*)(F.ws + WS_LIST);
    const int rpw = (nrows + F.G - 1) / F.G;
    const int wbeg = F.bid * rpw, wend = (wbeg + rpw < nrows) ? wbeg + rpw : nrows;
    LAS float* prm = (LAS float*)(F.lds + 65536);
    stage_vec(F, prm, lg); stage_vec(F, prm + DM, lb);
    for (int v = 0; v < 2; ++v) { const float* m = MOD + (size_t)(l * 2 + v) * 12288; stage_vec(F, prm + (2 + 3 * v) * DM, m + 2 * DM); stage_vec(F, prm + (3 + 3 * v) * DM, m + 3 * DM); stage_vec(F, prm + (4 + 3 * v) * DM, m + 4 * DM); }
    __syncthreads();
    TSF(F, 30);
    for (int rbeg = wbeg; rbeg < wend; rbeg += 48) {
        const int rend = (rbeg + 48 < wend) ? rbeg + 48 : wend, nr = rend - rbeg;
        f32x4 nx[8]; u32x2 ny[8];
#define P5_LOAD(rr) do { const float* xr_ = xrow_ptr(F, l, (rr)); const bf16_t* yr_ = Y1 + (size_t)(rr) * DM; \
        _Pragma("unroll") for (int j = 0; j < 8; ++j) { const int col = 4 * F.lane + 256 * j; nx[j] = __builtin_nontemporal_load((const f32x4*)(xr_ + col)); ny[j] = __builtin_nontemporal_load((const u32x2*)(yr_ + col)); } } while (0)
        if (rbeg + F.wave < rend) P5_LOAD(rbeg + F.wave);
        for (int r = rbeg + F.wave; r < rend; r += NWAVES) {
            const int v = r >= SEQ; const LAS float* pv = prm + (2 + 3 * v) * DM;
            f32x4 z[8];
#pragma unroll
            for (int j = 0; j < 8; ++j) { const int col = 4 * F.lane + 256 * j; const u32x2 yy = ny[j];
                const f32x4 y = {bf2f((bf16_t)(yy.x & 0xffffu)), bf2f((bf16_t)(yy.x >> 16)), bf2f((bf16_t)(yy.y & 0xffffu)), bf2f((bf16_t)(yy.y >> 16))};
                z[j] = ALPHA * nx[j] + *(const LAS f32x4*)(pv + col) * y; }
            if (r + NWAVES < rend) P5_LOAD(r + NWAVES);
            float mean, rstd; ln_stats(z, mean, rstd);
#pragma unroll
            for (int j = 0; j < 8; ++j) { const int col = 4 * F.lane + 256 * j; z[j] = (z[j] - mean) * rstd * *(const LAS f32x4*)(prm + col) + *(const LAS f32x4*)(prm + DM + col); *(f32x4*)(XS + (size_t)r * DM + col) = z[j]; }
            ln_stats(z, mean, rstd);
#pragma unroll
            for (int j = 0; j < 8; ++j) { const int col = 4 * F.lane + 256 * j; const f32x4 s1 = *(const LAS f32x4*)(pv + 2 * DM + col), s0 = *(const LAS f32x4*)(pv + DM + col);
                const f32x4 h = (z[j] - mean) * rstd * (1.0f + s1) + s0;
                u32x2 hi; hi.x = cvt_pk_bf16(h.x, h.y); hi.y = cvt_pk_bf16(h.z, h.w);
                const f32x4 hf = {bf2f((bf16_t)(hi.x & 0xffffu)), bf2f((bf16_t)(hi.x >> 16)), bf2f((bf16_t)(hi.y & 0xffffu)), bf2f((bf16_t)(hi.y >> 16))};
                const f32x4 d = h - hf; u32x2 lo; lo.x = cvt_pk_bf16(d.x, d.y); lo.y = cvt_pk_bf16(d.z, d.w);
                *(u32x2*)(H2 + (size_t)r * DM + col) = hi; *(u32x2*)(H2L + (size_t)r * DM + col) = lo; }
        }
#undef P5_LOAD
        asm volatile("s_waitcnt vmcnt(0)" ::: "memory");
        __syncthreads();
        TSF(F, 31);
        const int ntile = (nr + 15) >> 4; constexpr int nsl = 8;
        {
            const int fr = F.lane & 15, fq = F.lane >> 4, kb = F.wave * 256 + fq * 8;
            const bf16_t* bh = RWH + (size_t)fr * DM + kb; const bf16_t* bl = RWL + (size_t)fr * DM + kb;
            const bf16_t* ah[3]; const bf16_t* al[3];
#pragma unroll
            for (int t = 0; t < 3; ++t) { int row = rbeg + t * 16 + fr; row = row < rend ? row : rend - 1; ah[t] = H2 + (size_t)row * DM + kb; al[t] = H2L + (size_t)row * DM + kb; }
            f32x4 acc[3][2];
#pragma unroll
            for (int t = 0; t < 3; ++t) { acc[t][0] = (f32x4){0.f, 0.f, 0.f, 0.f}; acc[t][1] = (f32x4){0.f, 0.f, 0.f, 0.f}; }
#pragma unroll 2
            for (int ks = 0; ks < 8; ++ks) { const int off = ks * 32;
                const bf16x8 b_h0 = *(const bf16x8*)(bh + off), b_l0 = *(const bf16x8*)(bl + off), b_h1 = *(const bf16x8*)(bh + 16 * DM + off), b_l1 = *(const bf16x8*)(bl + 16 * DM + off);
#pragma unroll
                for (int t = 0; t < 3; ++t) if (t < ntile) {
                    const bf16x8 a_h = *(const bf16x8*)(ah[t] + off), a_l = *(const bf16x8*)(al[t] + off);
                    acc[t][0] = __builtin_amdgcn_mfma_f32_16x16x32_bf16(a_h, b_h0, acc[t][0], 0, 0, 0); acc[t][0] = __builtin_amdgcn_mfma_f32_16x16x32_bf16(a_h, b_l0, acc[t][0], 0, 0, 0); acc[t][0] = __builtin_amdgcn_mfma_f32_16x16x32_bf16(a_l, b_h0, acc[t][0], 0, 0, 0);
                    acc[t][1] = __builtin_amdgcn_mfma_f32_16x16x32_bf16(a_h, b_h1, acc[t][1], 0, 0, 0); acc[t][1] = __builtin_amdgcn_mfma_f32_16x16x32_bf16(a_h, b_l1, acc[t][1], 0, 0, 0); acc[t][1] = __builtin_amdgcn_mfma_f32_16x16x32_bf16(a_l, b_h1, acc[t][1], 0, 0, 0); } }
#pragma unroll
            for (int t = 0; t < 3; ++t) if (t < ntile) {
#pragma unroll
                for (int q = 0; q < 4; ++q) { LAS float* pr = plog + (F.wave * 48 + t * 16 + 4 * fq + q) * 32; pr[fr] = acc[t][0][q]; pr[16 + fr] = acc[t][1][q]; } }
        }
        __syncthreads();
        TSF(F, 32);
        for (int t = F.tid; t < nr * 32; t += NTHR) { const int e = t & 31; float lg2 = 0.f; for (int q = 0; q < nsl; ++q) lg2 += plog[q * 48 * 32 + t]; const float sc = sigmoidf_(lg2); scS[t] = sc; selS[t] = sc + RB[e]; }
        __syncthreads();
        if (F.tid < nr) {
            const int row = F.tid, r = rbeg + row; const LAS float* sel = selS + row * 32; const LAS float* sc = scS + row * 32;
            int best = 0; float bestv = -__builtin_inff();
            for (int g = 0; g < 4; ++g) { float m1 = -__builtin_inff(), m2 = -__builtin_inff();
                for (int q = 0; q < 8; ++q) { const float x = sel[g * 8 + q]; if (x > m1) { m2 = m1; m1 = x; } else if (x > m2) m2 = x; }
                const float gs = m1 + m2; if (gs > bestv) { bestv = gs; best = g; } }
            int i1 = 0, i2 = 0; float m1 = -__builtin_inff(), m2 = -__builtin_inff();
            for (int q = 0; q < 8; ++q) { const float x = sel[best * 8 + q]; if (x > m1) { m2 = m1; i2 = i1; m1 = x; i1 = q; } else if (x > m2) { m2 = x; i2 = q; } }
            const int e1 = best * 8 + i1, e2 = best * 8 + i2; const float s1 = sc[e1], s2 = sc[e2], den = s1 + s2;
            const int p1 = atomicAdd(cnt + 64 * e1, 1), p2 = atomicAdd(cnt + 64 * e2, 1);
            list[e1 * NROW + p1] = r; list[e2 * NROW + p2] = r;
            tokE[2 * r] = e1; tokE[2 * r + 1] = e2; tokP[2 * r] = p1; tokP[2 * r + 1] = p2; tokG[2 * r] = s1 / den; tokG[2 * r + 1] = s2 / den;
        }
        __syncthreads();
        TSF(F, 33);
    }
}

__device__ __forceinline__ int moe_tiles(const Frame& F, int l) {
    LAS int* tileEM = (LAS int*)(F.lds + LDS_TILE); LAS int* tbase = tileEM + 128;
    const int* cnt = (const int*)(F.ws + WS_CTL) + CW_CNT + l * 2048;
    __syncthreads();
    if (F.wave == 0) {
        const int n = (F.lane < NEXP) ? __hip_atomic_load(cnt + 64 * F.lane, __ATOMIC_RELAXED, __HIP_MEMORY_SCOPE_AGENT) : 0;
        const int nt = (n + 255) >> 8; int incl = nt;
#pragma unroll
        for (int o = 1; o < 64; o <<= 1) { const int t = __shfl_up(incl, o); if (F.lane >= o) incl += t; }
        const int excl = incl - nt;
        if (F.lane < NEXP) { tbase[F.lane] = excl; for (int m = 0; m < nt; ++m) tileEM[excl + m] = (F.lane << 8) | m; }
        if (F.lane == NEXP - 1) tbase[NEXP] = incl;
    }
    __syncthreads();
    return tbase[NEXP];
}

__device__ __forceinline__ void p_ffnln(const Frame& F, int l, int nrows) {
    LAS int* tbase = (LAS int*)(F.lds + LDS_TILE) + 128;
    (void)moe_tiles(F, l);
    const int gw = F.bid * NWAVES + F.wave, NGW = F.G * NWAVES;
    const float* MOD = (const float*)(F.ws + WS_MOD);
    float* XS = (float*)(F.ws + WS_XS); const bf16_t* YS = (const bf16_t*)(F.ws + WS_YS);
    const int* tokE = (const int*)(F.ws + WS_TOKE); const int* tokP = (const int*)(F.ws + WS_TOKP); const float* tokG = (const float*)(F.ws + WS_TOKG);
    const float* lg = F.in[IN_LNFG] + l * DM; const float* lb = F.in[IN_LNFB] + l * DM;
    bf16_t* H1 = (bf16_t*)(F.ws + WS_H1);
    LAS float* prm = (LAS float*)(F.lds + 65536);
    stage_vec(F, prm, lg); stage_vec(F, prm + DM, lb);
    for (int v = 0; v < 2; ++v) { stage_vec(F, prm + (2 + 3 * v) * DM, MOD + (size_t)(l * 2 + v) * 12288 + 5 * DM);
        if (l == 0) { const float* mn = MOD + (size_t)(2 + v) * 12288; stage_vec(F, prm + (3 + 3 * v) * DM, mn); stage_vec(F, prm + (4 + 3 * v) * DM, mn + DM); } }
    __syncthreads();
    int e1n = 0, e2n = 0, p1n = 0, p2n = 0; float g1n = 0.f, g2n = 0.f;
#define P9_ROUTE(rr) do { if ((rr) < nrows) { e1n = tokE[2 * (rr)]; e2n = tokE[2 * (rr) + 1]; p1n = tokP[2 * (rr)]; p2n = tokP[2 * (rr) + 1]; g1n = tokG[2 * (rr)]; g2n = tokG[2 * (rr) + 1]; } } while (0)
#define P9_LOAD(rr) do { const bf16_t* ya_ = YS + (size_t)(tbase[e1n] * 256 + p1n) * DM; const bf16_t* yb_ = YS + (size_t)(tbase[e2n] * 256 + p2n) * DM; const float* xr_ = XS + (size_t)(rr) * DM; \
        _Pragma("unroll") for (int j = 0; j < 8; ++j) { const int col = 4 * F.lane + 256 * j; nx[j] = __builtin_nontemporal_load((const f32x4*)(xr_ + col)); na[j] = __builtin_nontemporal_load((const u32x2*)(ya_ + col)); nb[j] = __builtin_nontemporal_load((const u32x2*)(yb_ + col)); } ng1 = g1n; ng2 = g2n; } while (0)
    f32x4 nx[8]; u32x2 na[8], nb[8]; float ng1 = 0.f, ng2 = 0.f;
    P9_ROUTE(gw);
    if (gw < nrows) P9_LOAD(gw);
    P9_ROUTE(gw + NGW);
    for (int r = gw; r < nrows; r += NGW) {
        const int v = r >= SEQ; const LAS float* pv = prm + (2 + 3 * v) * DM;
        f32x4 z[8];
#pragma unroll
        for (int j = 0; j < 8; ++j) { const int col = 4 * F.lane + 256 * j; const u32x2 qa = na[j], qb = nb[j];
            const f32x4 fa = {bf2f((bf16_t)(qa.x & 0xffffu)), bf2f((bf16_t)(qa.x >> 16)), bf2f((bf16_t)(qa.y & 0xffffu)), bf2f((bf16_t)(qa.y >> 16))};
            const f32x4 fb = {bf2f((bf16_t)(qb.x & 0xffffu)), bf2f((bf16_t)(qb.x >> 16)), bf2f((bf16_t)(qb.y & 0xffffu)), bf2f((bf16_t)(qb.y >> 16))};
            const f32x4 y = ng1 * fa + ng2 * fb;
            z[j] = ALPHA * nx[j] + *(const LAS f32x4*)(pv + col) * y; }
        if (r + NGW < nrows) P9_LOAD(r + NGW);
        P9_ROUTE(r + 2 * NGW);
        float mean, rstd; ln_stats(z, mean, rstd);
#pragma unroll
        for (int j = 0; j < 8; ++j) { const int col = 4 * F.lane + 256 * j; z[j] = (z[j] - mean) * rstd * *(const LAS f32x4*)(prm + col) + *(const LAS f32x4*)(prm + DM + col); }
        if (l == 1) {
#pragma unroll
            for (int j = 0; j < 8; ++j) *(f32x4*)(F.out + (size_t)r * DM + 4 * F.lane + 256 * j) = z[j];
        } else {
#pragma unroll
            for (int j = 0; j < 8; ++j) *(f32x4*)(XS + (size_t)r * DM + 4 * F.lane + 256 * j) = z[j];
            float mean2, rstd2; ln_stats(z, mean2, rstd2);
#pragma unroll
            for (int j = 0; j < 8; ++j) { const int col = 4 * F.lane + 256 * j; const f32x4 h = (z[j] - mean2) * rstd2 * (1.0f + *(const LAS f32x4*)(pv + 2 * DM + col)) + *(const LAS f32x4*)(pv + DM + col);
                *(u32x2*)(H1 + (size_t)r * DM + col) = pack4(h); }
        }
    }
#undef P9_ROUTE
#undef P9_LOAD
}


__global__ void __launch_bounds__(NTHR, 2) fwd(Args args) {
    extern __shared__ __attribute__((aligned(16))) unsigned char lds_raw[];
    Frame F0;
    F0.lds = (LAS unsigned char*)lds_raw; F0.tid = threadIdx.x; F0.lane = F0.tid & 63; F0.wave = __builtin_amdgcn_readfirstlane(F0.tid >> 6);
    F0.G = gridDim.x; F0.bid = blockIdx.x; F0.in = args.in; F0.out = args.out; F0.ws = args.ws;
    volatile LAS unsigned* MISC = (volatile LAS unsigned*)(F0.lds + LDS_MISC);
    if (F0.tid < 4) MISC[F0.tid] = 0u;
    __syncthreads();
    const int lo = args.ph_lo, hi = args.ph_hi;
    XcdBarrier bar; bar.bar = (unsigned*)(F0.ws + WS_CTL) + CW_BAR; bar.x = 0; bar.st = MISC;
    if (hi - lo > 1) bar = xcd_barrier_post((unsigned*)(F0.ws + WS_CTL) + CW_BAR, MISC);
#ifndef REP_PH
#define REP_PH -1
#endif
#define NREP(j) (((REP_PH) == (j)) ? rep1 + 1 : 1)
#if defined(ONLY_PH)
#define PHON(j) ((j) == ONLY_PH)
#elif defined(PH_MASK)
#define PHON(j) (((PH_MASK) >> (j)) & 1)
#else
#define PHON(j) true
#endif
#ifdef TSEL_A
#define TS(i) do { if (F0.bid == 0 && F0.tid == 0) __hip_atomic_store((unsigned long long*)(F0.ws + WS_CTL + 131072) + (i), (unsigned long long)__builtin_amdgcn_s_memrealtime(), __ATOMIC_RELAXED, __HIP_MEMORY_SCOPE_AGENT); } while (0)
#else
#define TS(i) do { } while (0)
#endif
#define IN(k) (lo <= (k) && (k) < hi)
#define SEAM(k) do { if (IN(k) && IN((k) + 1)) xcd_barrier(bar); } while (0)
    TS(0);
    int rep1 = 1; asm volatile("" : "+s"(rep1));
    if (PHON(0) && IN(0)) for (int rep = 0; rep < NREP(0); ++rep) { { const Frame F = launder(F0); p0_mod(F); } { const Frame F = launder(F0); p0_transposes(F); } { const Frame F = launder(F0); p0_rope(F); } }
    SEAM(0); TS(1);
    if (PHON(1) && IN(1)) for (int rep = 0; rep < NREP(1); ++rep) { const Frame F = launder(F0); p_modulate1(F, 0, NROW); }
    SEAM(1); TS(2);
#pragma unroll 1
    for (int l = 0; l < 2; ++l) {
        const int pb = 2 + 8 * l; const int tb = 3 + 10 * l; (void)tb;
        const int nlat = (l == 0) ? NROW : SEQ;
        if (PHON(2) && IN(pb + 0)) for (int rep = 0; rep < NREP(2); ++rep) {
            const bool split = F0.G >= 256; const int gc = split ? NC_IN : F0.G;
            if (F0.bid < gc) {
                pg8::StaticOrder S; S.init(NROW, INW, DM, (const bf16_t*)(F0.ws + WS_WIN) + (size_t)l * INW * DM, gc, F0.bid);
                { const Frame F = launder(F0);
                  pg8::EpiBf<true> E{(bf16_t*)(F.ws + WS_PROJ), INW, (bf16_t*)(F.ws + WS_KV)};
                  pg8::gemm_phase(F.lds, F.tid, (const bf16_t*)(F.ws + WS_H1), DM, S, E); }
                asm volatile("s_waitcnt vmcnt(0)" ::: "memory"); __syncthreads();
                { const Frame F = launder(F0);
                  pg8::Unit u; for (int i = 0; S.next(i, u); ++i) if (u.pn >= 10 && u.pn <= 14) rms_rope_tile(F, l, u.pm * 256, u.pn); }
            } else { const Frame F = launder(F0); if (l == 0) conv_range(F, gc, 0, CV_A0); else conv_range(F, gc, CV_LAYER + CV_B1, CV_L1F - CV_B1); }
        }
        SEAM(pb + 0); TS(tb + 0); TS(tb + 1);
        if (IN(pb + 2)) { if (PHON(4)) for (int rep = 0; rep < NREP(4); ++rep) { const Frame F = launder(F0); p_att_dense(F, l); } TS(tb + 2); if (PHON(10)) for (int rep = 0; rep < NREP(10); ++rep) { const Frame F = launder(F0); p_att_na(F, l); } TS(tb + 3); if (PHON(11)) for (int rep = 0; rep < NREP(11); ++rep) { const Frame F = launder(F0); p_att_sg(F, l); }
            if (F0.G >= 256 && F0.bid >= 128) { const Frame F = launder(F0); conv_range(F, 128, l == 0 ? CV_L0F : CV_LAYER + CV_L1F, CV_ATT); } }
        SEAM(pb + 2); TS(tb + 4);
        if (PHON(5) && IN(pb + 3)) for (int rep = 0; rep < NREP(5); ++rep) { const Frame F = launder(F0);
            const bool split = (l == 0) && F.G >= 256; const int gc = split ? NC_OUT : F.G;
            if (F.bid < gc) {
                pg8::StaticOrder S; S.init(nlat, DM, DM, (const bf16_t*)(F.ws + WS_WOUT) + (size_t)l * DM * DM, gc, F.bid);
                pg8::EpiBf<false> E{(bf16_t*)(F.ws + WS_Y1), DM, nullptr};
                pg8::gemm_phase(F.lds, F.tid, (const bf16_t*)(F.ws + WS_MIX), DM, S, E);
            } else conv_range(F, gc, CV_A0, CV_L0F - CV_A0);
        }
        SEAM(pb + 3); TS(tb + 5);
        if (PHON(6) && IN(pb + 4)) { const Frame F = launder(F0); p_mixln_router(F, l, nlat); }
        SEAM(pb + 4); TS(tb + 6);
        if (PHON(7) && IN(pb + 5)) for (int rep = 0; rep < NREP(7); ++rep) { const Frame F = launder(F0);
            const bool split = (l == 0) && F.G >= 256; const int gc = split ? NC_MOE : F.G;
            if (F.bid < gc) {
                const int ntiles = moe_tiles(F, l);
                pg8::MoeOrder<true> S{(const LAS int*)(F.lds + LDS_TILE), ntiles, gc, F.bid, DM, (const int*)(F.ws + WS_LIST), (const int*)(F.ws + WS_CTL) + CW_CNT + l * 2048,
                                      (const bf16_t*)(F.ws + WS_WGU) + (size_t)l * NEXP * 2048 * DM};
                pg8::EpiSwiGLU E{(bf16_t*)(F.ws + WS_GA)};
                pg8::gemm_phase(F.lds, F.tid, (const bf16_t*)(F.ws + WS_H2), DM, S, E);
            } else conv_range(F, gc, CV_LAYER, CV_B0);
        }
        SEAM(pb + 5); TS(tb + 7);
        if (PHON(8) && IN(pb + 6)) for (int rep = 0; rep < NREP(8); ++rep) { const Frame F = launder(F0);
            const bool split = (l == 0) && F.G >= 256; const int gc = split ? NC_MOE : F.G;
            if (F.bid < gc) {
                const int ntiles = moe_tiles(F, l);
                pg8::MoeOrder<false> S{(const LAS int*)(F.lds + LDS_TILE), ntiles, gc, F.bid, DEXP, nullptr, nullptr, (const bf16_t*)(F.ws + WS_WD) + (size_t)l * NEXP * DM * DEXP};
                pg8::EpiBf<false> E{(bf16_t*)(F.ws + WS_YS), DM, nullptr};
                pg8::gemm_phase(F.lds, F.tid, (const bf16_t*)(F.ws + WS_GA), DEXP, S, E);
            } else conv_range(F, gc, CV_LAYER + CV_B0, CV_B1 - CV_B0);
        }
        SEAM(pb + 6); TS(tb + 8);
        if (PHON(9) && IN(pb + 7)) { const Frame F = launder(F0); p_ffnln(F, l, nlat); }
        SEAM(pb + 7);
#ifdef TSEL_A
        if (l == 1) xcd_barrier(bar);
#endif
        TS(tb + 9);
    }
#ifdef TSEL_A
    {
        unsigned long long* ts = (unsigned long long*)(F0.ws + WS_CTL + 131072);
        if (F0.bid == 0 && F0.tid == 0) {
            unsigned long long a0 = 0, a1 = 0, b0 = 0, b1 = 0;
            a0 = __hip_atomic_load(ts + TSEL_A - 1, __ATOMIC_RELAXED, __HIP_MEMORY_SCOPE_AGENT); a1 = __hip_atomic_load(ts + TSEL_A2, __ATOMIC_RELAXED, __HIP_MEMORY_SCOPE_AGENT);
            b0 = __hip_atomic_load(ts + TSEL_B - 1, __ATOMIC_RELAXED, __HIP_MEMORY_SCOPE_AGENT); b1 = __hip_atomic_load(ts + TSEL_B2, __ATOMIC_RELAXED, __HIP_MEMORY_SCOPE_AGENT);
            const float ua = (float)(a1 - a0) * 0.01f, ub = (float)(b1 - b0) * 0.01f;
            int n1 = (int)(ua * 8.192f); n1 = n1 > 8100 ? 8100 : n1; n1 = 0;
            __hip_atomic_store((unsigned*)(ts + 64), (unsigned)n1, __ATOMIC_RELAXED, __HIP_MEMORY_SCOPE_AGENT);
            __hip_atomic_store((unsigned*)(ts + 65), __float_as_uint(ub * 0.5f), __ATOMIC_RELAXED, __HIP_MEMORY_SCOPE_AGENT);
        }
        xcd_barrier(bar);
        const int n1 = (int)__hip_atomic_load((unsigned*)(ts + 64), __ATOMIC_RELAXED, __HIP_MEMORY_SCOPE_AGENT);
        const float V = __uint_as_float(__hip_atomic_load((unsigned*)(ts + 65), __ATOMIC_RELAXED, __HIP_MEMORY_SCOPE_AGENT));
        const int gw = F0.bid * NWAVES + F0.wave, NGW = F0.G * NWAVES;
        for (int r = gw; r < n1; r += NGW) for (int j = 0; j < 8; ++j) *(f32x4*)(F0.out + (size_t)r * DM + 4 * F0.lane + 256 * j) = (f32x4){0.f, 0.f, 0.f, 0.f};
        asm volatile("s_waitcnt vmcnt(0)" ::: "memory");
        if (F0.bid == 0 && F0.tid == 0) F0.out[0] = V;
    }
#endif
#undef IN
#undef SEAM
}


extern "C" void kernel_launch(void* const* d_in, const int* in_sizes, int n_in, void* d_out, int out_size, void* d_ws, size_t ws_size, hipStream_t stream) {
    static int grid = 0;
    if (grid == 0) {
        if (n_in != 24 || out_size != SEQ * DM || ws_size < WS_END) { fprintf(stderr, "kernel_launch: unexpected shapes (n_in %d out %d ws %zu)\n", n_in, out_size, ws_size); grid = -1; return; }
        int dev = 0, cus = 0, per_cu = 0;
        if (hipGetDevice(&dev) != hipSuccess || hipDeviceGetAttribute(&cus, hipDeviceAttributeMultiprocessorCount, dev) != hipSuccess) { grid = -1; return; }
        if (hipFuncSetAttribute((const void*)fwd, hipFuncAttributeMaxDynamicSharedMemorySize, LDS_BYTES) != hipSuccess) { fprintf(stderr, "kernel_launch: hipFuncSetAttribute failed\n"); grid = -1; return; }
        if (hipOccupancyMaxActiveBlocksPerMultiprocessor(&per_cu, (const void*)fwd, NTHR, LDS_BYTES) != hipSuccess || per_cu < 1) { fprintf(stderr, "kernel_launch: occupancy query says %d\n", per_cu); }
        (void)hipGetLastError();
        grid = cus;
    }
    if (grid < 0) return;
    (void)hipMemsetAsync((char*)d_ws + WS_CTL, 0, CTL_ZERO_BYTES, stream);
    Args a{};
    for (int i = 0; i < 24; ++i) a.in[i] = (const float*)d_in[i];
    a.out = (float*)d_out; a.ws = (unsigned char*)d_ws;
#if MK_ONE_LAUNCH
    a.ph_lo = 0; a.ph_hi = NPH;
    hipLaunchKernelGGL(fwd, dim3(grid), dim3(NTHR), LDS_BYTES, stream, a);

#else
    for (int k = 0; k < NPH; ++k) { a.ph_lo = k; a.ph_hi = k + 1; hipLaunchKernelGGL(fwd, dim3(grid), dim3(NTHR), LDS_BYTES, stream, a); }
#endif
}
```

```cpp
#include <hip/hip_runtime.h>
#include <cstdio>
#include <cstdint>

#ifndef MK_ONE_LAUNCH
#define MK_ONE_LAUNCH 1
#endif

constexpr int DM = 2048, SEQ = 8192, CTXL = 256, NROW = SEQ + CTXL;
constexpr int INW = 4096, NEXP = 32, DEXP = 1024, GRIDW = 64;
constexpr float ALPHA = 1.41421356237309515f;
constexpr float LN_EPS = 1e-6f;
constexpr int NPH = 18;
constexpr int MOE_CAP_TILES = 98;
constexpr int NWAVES = 8, NTHR = 512;

constexpr size_t MiB = 1u << 20;
constexpr size_t WS_CTL = 0, CTL_ZERO_BYTES = 1 * MiB;
constexpr size_t WS_MOD = 1 * MiB;
constexpr size_t WS_ROPE = 1 * MiB + 256 * 1024;
constexpr size_t WS_RWT = 1 * MiB + 512 * 1024;
constexpr size_t WS_TOKE = 2 * MiB;
constexpr size_t WS_TOKP = WS_TOKE + 128 * 1024;
constexpr size_t WS_TOKG = WS_TOKP + 128 * 1024;
constexpr size_t WS_LIST = 3 * MiB;
constexpr size_t WS_WIN = 8 * MiB;
constexpr size_t WS_WOUT = 40 * MiB;
constexpr size_t WS_WGU = 64 * MiB;
constexpr size_t WS_WD = 576 * MiB;
constexpr size_t WS_H1 = 832 * MiB;
constexpr size_t WS_PROJ = 866 * MiB;
constexpr size_t WS_MIX = 932 * MiB;
constexpr size_t WS_Y1 = 966 * MiB;
constexpr size_t WS_XS = 1032 * MiB;
constexpr size_t WS_H2 = 1098 * MiB;
constexpr size_t WS_GA = 1132 * MiB;
constexpr size_t WS_YS = 1182 * MiB;
constexpr size_t WS_H2L = 1378 * MiB;
constexpr size_t WS_KV = 1412 * MiB;
constexpr size_t WS_CKV = 1424 * MiB;
constexpr size_t WS_END = 1426 * MiB;
constexpr int CW_BAR = 4096;
constexpr int CW_CNT = 8192;
constexpr int LDS_PART = 131072;
constexpr int LDS_SC = 147456;
constexpr int LDS_TILE = 151552;
constexpr int LDS_MISC = 153600;
constexpr int LDS_BYTES = 155648;

#define GAS __attribute__((address_space(1)))
#define LAS __attribute__((address_space(3)))
typedef unsigned short bf16_t;
typedef float f32x4 __attribute__((ext_vector_type(4)));
typedef float f32x2 __attribute__((ext_vector_type(2)));
typedef float f32x16 __attribute__((ext_vector_type(16)));
typedef short bf16x8 __attribute__((ext_vector_type(8)));
typedef short s16x4 __attribute__((ext_vector_type(4)));
typedef unsigned u32x4 __attribute__((ext_vector_type(4)));
typedef unsigned u32x2 __attribute__((ext_vector_type(2)));

__device__ __forceinline__ unsigned cvt_pk_bf16(float lo, float hi) { unsigned r; asm volatile("v_cvt_pk_bf16_f32 %0, %1, %2" : "=v"(r) : "v"(lo), "v"(hi)); return r; }
__device__ __forceinline__ bf16_t f2bf(float f) { unsigned u = __builtin_bit_cast(unsigned, f); return (bf16_t)((u + 0x7fffu + ((u >> 16) & 1u)) >> 16); }
__device__ __forceinline__ float bf2f(bf16_t b) { return __builtin_bit_cast(float, ((unsigned)b) << 16); }
__device__ __forceinline__ u32x2 pack4(f32x4 v) { u32x2 o; o.x = cvt_pk_bf16(v.x, v.y); o.y = cvt_pk_bf16(v.z, v.w); return o; }
template <int CTRL> __device__ __forceinline__ float dpp_mov(float v) { return __builtin_bit_cast(float, __builtin_amdgcn_update_dpp(0, __builtin_bit_cast(int, v), CTRL, 0xF, 0xF, true)); }
__device__ __forceinline__ float quad_sum(float v) { v += dpp_mov<0xB1>(v); v += dpp_mov<0x4E>(v); return v; }
__device__ __forceinline__ float wave_sum(float v) {
    v += dpp_mov<0xB1>(v); v += dpp_mov<0x4E>(v); v += dpp_mov<0x141>(v); v += dpp_mov<0x140>(v);
    const float s0 = __builtin_bit_cast(float, __builtin_amdgcn_readlane(__builtin_bit_cast(int, v), 0)), s1 = __builtin_bit_cast(float, __builtin_amdgcn_readlane(__builtin_bit_cast(int, v), 16));
    const float s2 = __builtin_bit_cast(float, __builtin_amdgcn_readlane(__builtin_bit_cast(int, v), 32)), s3 = __builtin_bit_cast(float, __builtin_amdgcn_readlane(__builtin_bit_cast(int, v), 48));
    return (s0 + s1) + (s2 + s3);
}
__device__ __forceinline__ float sigmoidf_(float x) { return 1.0f / (1.0f + expf(-x)); }
__device__ __forceinline__ float gelu_tanh_fast(float x) { const float u = x * (1.0f + 0.044715f * x * x) * 1.5957691216057308f; return x * __builtin_amdgcn_rcpf(1.0f + __expf(-u)); }
__device__ __forceinline__ float silu_fast(float x) { return x * __builtin_amdgcn_rcpf(1.0f + __expf(-x)); }

#define XB_TMO      128
#define XB_XCNT(j)  (256  + 64 * (j))
#define XB_XSUB(j)  (1280 + 64 * (j))
#define XB_XGEN(j)  (2304 + 64 * (j))
#define XB_TOP      3328
#define XB_TOPGEN   3392
#define XCD_BAR_WORDS 3456
#define XB_SPIN_CAP (1u << 20)
__device__ __forceinline__ unsigned xb_ld(unsigned* p)              { return __hip_atomic_load(p, __ATOMIC_RELAXED, __HIP_MEMORY_SCOPE_AGENT); }
__device__ __forceinline__ unsigned xb_add(unsigned* p, unsigned v) { return __hip_atomic_fetch_add(p, v, __ATOMIC_RELAXED, __HIP_MEMORY_SCOPE_AGENT); }
__device__ __forceinline__ unsigned xb_xcc_id() { return (unsigned)__builtin_amdgcn_s_getreg((3 << 11) | 20) & 0xFu; }
#define XB_SPIN(cond, bar) do { unsigned _sp = 0; while (cond) { __builtin_amdgcn_s_sleep(1); \
    if ((++_sp & 255u) == 0u) { if (xb_ld(&(bar)[XB_TMO])) break; if (_sp > XB_SPIN_CAP) { atomicAdd(&(bar)[XB_TMO], 1u); break; } } } } while (0)
struct XcdBarrier { unsigned* bar; unsigned x; volatile LAS unsigned* st; };
__device__ __forceinline__ XcdBarrier xcd_barrier_post(unsigned* bar, volatile LAS unsigned* st) {
    XcdBarrier b; b.bar = bar; b.x = xb_xcc_id(); b.st = st;
    if (threadIdx.x == 0) (void)xb_add(&bar[XB_XCNT(b.x)], 1u);
    return b;
}
__device__ __forceinline__ void xcd_barrier_complete(unsigned* bar, unsigned x, unsigned& nloc, unsigned& nx) {
    const unsigned G = gridDim.x * gridDim.y * gridDim.z;
    unsigned sum, cnt, mine, sp = 0u;
    for (;;) {
        sum = 0u; cnt = 0u; mine = 0u;
#pragma unroll
        for (unsigned j = 0; j < 16; ++j) { const unsigned c = xb_ld(&bar[XB_XCNT(j)]); sum += c; cnt += (c > 0u) ? 1u : 0u; mine = (j == x) ? c : mine; }
        if (sum == G) break;
        __builtin_amdgcn_s_sleep(1);
        if ((++sp & 255u) == 0u) { if (xb_ld(&bar[XB_TMO])) break; if (sp > XB_SPIN_CAP) { atomicAdd(&bar[XB_TMO], 1u); break; } }
    }
    nloc = mine > 0u ? mine : 1u; nx = cnt > 0u ? cnt : 1u;
}
__device__ __forceinline__ void xcd_barrier(const XcdBarrier& b) {
    asm volatile("s_waitcnt vmcnt(0)" ::: "memory");
    __syncthreads();
    if (threadIdx.x == 0) {
        unsigned* bar = b.bar;
        __builtin_amdgcn_s_waitcnt(0);
        unsigned nloc = b.st[0], nx = b.st[1];
        if (nloc == 0u) { xcd_barrier_complete(bar, b.x, nloc, nx); b.st[0] = nloc; b.st[1] = nx; }
        const unsigned old = xb_add(&bar[XB_XSUB(b.x)], 1u);
        const unsigned gen = old / nloc;
        if (old + 1u == (gen + 1u) * nloc) {
            __builtin_amdgcn_fence(__ATOMIC_RELEASE, "agent");
            asm volatile("s_waitcnt vmcnt(0)" ::: "memory");
            const unsigned og = xb_add(&bar[XB_TOP], 1u);
            const unsigned tg = og / nx;
            if (og + 1u == (tg + 1u) * nx) xb_add(&bar[XB_TOPGEN], 1u);
            else XB_SPIN(xb_ld(&bar[XB_TOPGEN]) == tg, bar);
            __builtin_amdgcn_fence(__ATOMIC_ACQUIRE, "agent");
            xb_add(&bar[XB_XGEN(b.x)], 1u);
            asm volatile("s_waitcnt vmcnt(0)" ::: "memory");
        } else {
            XB_SPIN(xb_ld(&bar[XB_XGEN(b.x)]) == gen, bar);
            __builtin_amdgcn_fence(__ATOMIC_ACQUIRE, "agent");
            asm volatile("s_waitcnt vmcnt(0)" ::: "memory");
        }
    }
    __syncthreads();
}

struct Args { const float* in[24]; float* out; unsigned char* ws; int ph_lo, ph_hi; };
struct Frame {
    LAS unsigned char* lds;
    int tid, lane, wave, G, bid;
    const float* const* in;
    float* out; unsigned char* ws;
};
__device__ __forceinline__ Frame launder(const Frame& F0) {
    Frame F = F0; int t = F0.tid; asm volatile("" : "+v"(t)); F.tid = t; F.lane = t & 63; F.wave = __builtin_amdgcn_readfirstlane(t >> 6);
    unsigned long long w = (unsigned long long)F0.ws; asm volatile("" : "+s"(w)); F.ws = (unsigned char*)(GAS unsigned char*)w;
    unsigned l = (unsigned)(uintptr_t)F0.lds; asm volatile("" : "+s"(l)); F.lds = (LAS unsigned char*)(uintptr_t)l;
    int g = F0.G, b = F0.bid; asm volatile("" : "+s"(g), "+s"(b)); F.G = g; F.bid = b;
    return F;
}
#define IN_X 0
#define IN_C 1
#define IN_CTX 2
#define IN_CCTX 3
#define IN_ADAW 4
#define IN_ADAB 5
#define IN_WIN 6
#define IN_RPB 7
#define IN_SGLNG 8
#define IN_SGLNB 9
#define IN_SGW 10
#define IN_SGB 11
#define IN_QNG 12
#define IN_KNG 13
#define IN_WOUT 14
#define IN_LNMG 15
#define IN_LNMB 16
#define IN_RW 17
#define IN_RB 18
#define IN_WG 19
#define IN_WU 20
#define IN_WDN 21
#define IN_LNFG 22
#define IN_LNFB 23

__device__ __forceinline__ void p0_mod(const Frame& F) {
    LAS float* sl = (LAS float*)F.lds;
    LAS float* red = sl + 4096;
    const float* c = F.in[IN_C]; const float* cc = F.in[IN_CCTX];
    for (int t = F.tid; t < DM; t += NTHR) { const float a = c[t]; sl[t] = a * sigmoidf_(a); const float b = cc[t]; sl[DM + t] = b * sigmoidf_(b); }
    __syncthreads();
    float* MOD = (float*)(F.ws + WS_MOD);
    for (int item = F.bid; item < 256; item += F.G) {
        const int l = item >> 7, nb = item & 127, col0 = nb * 96;
        f32x2 a0 = {0.f, 0.f}, a1 = {0.f, 0.f};
        if (F.lane < 48) {
            const float* wp = F.in[IN_ADAW] + (size_t)l * DM * 12288 + (size_t)(F.wave * 256) * 12288 + col0 + 2 * F.lane;
            const LAS float* s0 = sl + F.wave * 256; const LAS float* s1 = sl + DM + F.wave * 256;
#pragma unroll 8
            for (int k = 0; k < 256; ++k) { const f32x2 w = *(const f32x2*)(wp + (size_t)k * 12288); a0 += s0[k] * w; a1 += s1[k] * w; }
            red[(F.wave * 2 + 0) * 96 + 2 * F.lane] = a0.x; red[(F.wave * 2 + 0) * 96 + 2 * F.lane + 1] = a0.y;
            red[(F.wave * 2 + 1) * 96 + 2 * F.lane] = a1.x; red[(F.wave * 2 + 1) * 96 + 2 * F.lane + 1] = a1.y;
        }
        __syncthreads();
        if (F.tid < 192) { const int v = F.tid / 96, q = F.tid % 96; float s = 0.f;
#pragma unroll
            for (int w = 0; w < 8; ++w) s += red[(w * 2 + v) * 96 + q];
            MOD[(size_t)(l * 2 + v) * 12288 + col0 + q] = s + F.in[IN_ADAB][l * 12288 + col0 + q]; }
        __syncthreads();
    }
}
__device__ __forceinline__ void tr_item(const float* W, int K, int N, bf16_t* WT, int k0, int n0, int drow0, LAS float* scr, int lane) {
    f32x4 v[16];
    const float* wp = W + (size_t)(k0 + (lane >> 4)) * N + n0 + 4 * (lane & 15);
#pragma unroll
    for (int i = 0; i < 16; ++i) v[i] = __builtin_nontemporal_load((const f32x4*)(wp + (size_t)(4 * i) * N));
#pragma unroll
    for (int i = 0; i < 16; ++i) { LAS float* p = scr + (4 * i + (lane >> 4)) * 65 + 4 * (lane & 15); p[0] = v[i].x; p[1] = v[i].y; p[2] = v[i].z; p[3] = v[i].w; }
    asm volatile("s_waitcnt lgkmcnt(0)" ::: "memory");
    const int c = lane & 7;
#pragma unroll
    for (int j = 0; j < 8; ++j) { const int n = (lane >> 3) + 8 * j; const LAS float* s = scr + (8 * c) * 65 + n;
        u32x4 o; o.x = cvt_pk_bf16(s[0 * 65], s[1 * 65]); o.y = cvt_pk_bf16(s[2 * 65], s[3 * 65]); o.z = cvt_pk_bf16(s[4 * 65], s[5 * 65]); o.w = cvt_pk_bf16(s[6 * 65], s[7 * 65]);
        *(u32x4*)(WT + (size_t)(drow0 + n) * K + k0 + 8 * c) = o; }
    asm volatile("s_waitcnt lgkmcnt(0)" ::: "memory");
}
struct TrDesc { const float* src; bf16_t* dst; int N, K; };
__device__ __forceinline__ TrDesc moe_item_desc(const Frame& F, int m) {
    const int le = m / 1536, r = m % 1536, which = r >> 9, r2 = r & 511; TrDesc d;
    if (which < 2) { const int kb = r2 >> 4, nb = r2 & 15, n0 = nb * 64; d.N = DEXP; d.K = DM;
        d.src = F.in[which == 0 ? IN_WG : IN_WU] + (size_t)le * DM * DEXP + (size_t)(kb * 64) * DEXP + n0;
        d.dst = (bf16_t*)(F.ws + WS_WGU) + (size_t)le * 2048 * DM + (size_t)((n0 >> 7) * 256 + (n0 & 127) + which * 128) * DM + kb * 64; }
    else { const int kb = r2 >> 5, nb = r2 & 31; d.N = DM; d.K = DEXP;
        d.src = F.in[IN_WDN] + (size_t)le * DEXP * DM + (size_t)(kb * 64) * DM + nb * 64;
        d.dst = (bf16_t*)(F.ws + WS_WD) + (size_t)le * DM * DEXP + (size_t)(nb * 64) * DEXP + kb * 64; }
    return d;
}
__device__ __forceinline__ void tr_load64(const TrDesc& d, f32x4 (&v)[16], int lane) {
    const float* wp = d.src + (size_t)(lane >> 4) * d.N + 4 * (lane & 15);
#pragma unroll
    for (int i = 0; i < 16; ++i) v[i] = __builtin_nontemporal_load((const f32x4*)(wp + (size_t)(4 * i) * d.N));
}
__device__ __forceinline__ void tr_finish64(const TrDesc& d, const f32x4 (&v)[16], LAS float* scr, int lane) {
#pragma unroll
    for (int i = 0; i < 16; ++i) { LAS float* p = scr + (4 * i + (lane >> 4)) * 65 + 4 * (lane & 15); p[0] = v[i].x; p[1] = v[i].y; p[2] = v[i].z; p[3] = v[i].w; }
    asm volatile("s_waitcnt lgkmcnt(0)" ::: "memory");
    const int c = lane & 7;
#pragma unroll
    for (int j = 0; j < 8; ++j) { const int n = (lane >> 3) + 8 * j; const LAS float* s = scr + (8 * c) * 65 + n;
        u32x4 o; o.x = cvt_pk_bf16(s[0 * 65], s[1 * 65]); o.y = cvt_pk_bf16(s[2 * 65], s[3 * 65]); o.z = cvt_pk_bf16(s[4 * 65], s[5 * 65]); o.w = cvt_pk_bf16(s[6 * 65], s[7 * 65]);
        *(u32x4*)(d.dst + (size_t)n * d.K + 8 * c) = o; }
    asm volatile("s_waitcnt lgkmcnt(0)" ::: "memory");
}
__device__ __forceinline__ void conv_moe_item(const Frame& F, int m, LAS float* scr) {
    const TrDesc d = moe_item_desc(F, m); f32x4 v[16]; tr_load64(d, v, F.lane); tr_finish64(d, v, scr, F.lane);
}
constexpr int NC_IN = 176, NC_OUT = 192, NC_MOE = 192, NCOMP = 128  ;
constexpr int CV_LAYER = 49152;
constexpr int CV_A0 = 20480, CV_L0F = CV_A0 + 10240;
constexpr int CV_B0 = 16384, CV_B1 = CV_B0 + 10240, CV_L1F = CV_B1 + 16384;
constexpr int CV_ATT = 6144;
static_assert(CV_L0F + CV_ATT <= CV_LAYER && CV_L1F + CV_ATT <= CV_LAYER, "converter ranges");
__device__ __forceinline__ void conv_range(const Frame& F, int ncomp, int first, int count) {
    LAS float* scr = (LAS float*)(F.lds + F.wave * 16896);
    const int cw = (F.bid - ncomp) * NWAVES + F.wave, NCW = (F.G - ncomp) * NWAVES;
    f32x4 va[16], vb[16]; TrDesc d, dn;
    if (cw < count) { d = moe_item_desc(F, first + cw); tr_load64(d, va, F.lane); }
    for (int k = cw; k < count; k += NCW) {
        const int kn = k + NCW;
        if (kn < count) { dn = moe_item_desc(F, first + kn); tr_load64(dn, vb, F.lane); }
        tr_finish64(d, va, scr, F.lane);
        d = dn;
#pragma unroll
        for (int i = 0; i < 16; ++i) va[i] = vb[i];
    }
}
__device__ __forceinline__ void p0_transposes(const Frame& F) {
    LAS float* scr = (LAS float*)(F.lds + F.wave * 16896);
    const int gw = F.bid * NWAVES + F.wave, NGW = F.G * NWAVES;
    constexpr int NDENSE = 2 * 3072;
    const bool split = F.G >= 256;
    const int r0 = split ? CV_LAYER - CV_L0F - CV_ATT : CV_LAYER, r1 = split ? CV_LAYER - CV_L1F - CV_ATT : CV_LAYER;
    const int NITEMS = NDENSE + r0 + r1;
    for (int it = gw; it < NITEMS; it += NGW) {
        if (it < NDENSE) {
            const int l = it / 3072, r = it % 3072;
            if (r < 2048) { const int kb = r >> 6, nb = r & 63; tr_item(F.in[IN_WIN] + (size_t)l * DM * INW, DM, INW, (bf16_t*)(F.ws + WS_WIN) + (size_t)l * INW * DM, kb * 64, nb * 64, nb * 64, scr, F.lane); }
            else { const int r2 = r - 2048, kb = r2 >> 5, nb = r2 & 31; tr_item(F.in[IN_WOUT] + (size_t)l * DM * DM, DM, DM, (bf16_t*)(F.ws + WS_WOUT) + (size_t)l * DM * DM, kb * 64, nb * 64, nb * 64, scr, F.lane); }
        } else {
            const int q = it - NDENSE;
            const int m = q < r0 ? (CV_LAYER - r0) + q : CV_LAYER + (CV_LAYER - r1) + (q - r0);
            conv_moe_item(F, m, scr);
        }
    }
}
__device__ __forceinline__ void p0_rope(const Frame& F) {
    const int g = F.bid * NTHR + F.tid;
    if (g < 32 * DM) { const int e = g >> 11, k = g & (DM - 1); const float w = F.in[IN_RW][k * 32 + e]; const bf16_t hi = f2bf(w); const bf16_t lo = f2bf(w - bf2f(hi));
        bf16_t* T = (bf16_t*)(F.ws + WS_RWT); T[g] = hi; T[32 * DM + g] = lo; }
    if (g < 128 * 32) { const int pos = g >> 5, i = g & 31; const float inv = powf(10000.0f, -(float)i / 32.0f); const float ang = (float)pos * inv;
        float* R = (float*)(F.ws + WS_ROPE); R[2 * g] = cosf(ang); R[2 * g + 1] = sinf(ang); }
}

__device__ __forceinline__ const float* xrow_ptr(const Frame& F, int l, int r) {
    if (l == 0) return r < SEQ ? F.in[IN_X] + (size_t)r * DM : F.in[IN_CTX] + (size_t)(r - SEQ) * DM;
    return (const float*)(F.ws + WS_XS) + (size_t)r * DM;
}
__device__ __forceinline__ void ln_stats(const f32x4 (&v)[8], float& mean, float& rstd) {
    float s = 0.f;
#pragma unroll
    for (int j = 0; j < 8; ++j) s += (v[j].x + v[j].y) + (v[j].z + v[j].w);
    mean = wave_sum(s) * (1.0f / DM);
    float q = 0.f;
#pragma unroll
    for (int j = 0; j < 8; ++j) { const f32x4 d = v[j] - mean; q += (d.x * d.x + d.y * d.y) + (d.z * d.z + d.w * d.w); }
    rstd = 1.0f / sqrtf(wave_sum(q) * (1.0f / DM) + LN_EPS);
}
template <bool TO_LDS>
__device__ __forceinline__ void modulate_store(const f32x4 (&v)[8], const float* sh, const float* sc, bf16_t* orow, LAS float* lrow, int lane) {
    float mean, rstd; ln_stats(v, mean, rstd);
#pragma unroll
    for (int j = 0; j < 8; ++j) { const int col = 4 * lane + 256 * j; const f32x4 s1 = *(const f32x4*)(sc + col), s0 = *(const f32x4*)(sh + col);
        const f32x4 h = (v[j] - mean) * rstd * (1.0f + s1) + s0;
        u32x2 w; w.x = cvt_pk_bf16(h.x, h.y); w.y = cvt_pk_bf16(h.z, h.w); *(u32x2*)(orow + col) = w;
        if (TO_LDS) *(LAS f32x4*)(lrow + col) = h; }
}
__device__ __forceinline__ void stage_vec(const Frame& F, LAS float* dst, const float* src) { *(LAS f32x4*)(dst + 4 * F.tid) = *(const f32x4*)(src + 4 * F.tid); }
__device__ __forceinline__ void p_modulate1(const Frame& F, int l, int nrows) {
    const int gw = F.bid * NWAVES + F.wave, NGW = F.G * NWAVES;
    const float* MOD = (const float*)(F.ws + WS_MOD);
    bf16_t* H1 = (bf16_t*)(F.ws + WS_H1);
    LAS float* prm = (LAS float*)F.lds;
    for (int v = 0; v < 2; ++v) { const float* m = MOD + (size_t)(l * 2 + v) * 12288; stage_vec(F, prm + (2 * v) * DM, m); stage_vec(F, prm + (2 * v + 1) * DM, m + DM); }
    __syncthreads();
    f32x4 nx[8];
    if (gw < nrows) { const float* xr = xrow_ptr(F, l, gw);
#pragma unroll
        for (int j = 0; j < 8; ++j) nx[j] = *(const f32x4*)(xr + 4 * F.lane + 256 * j); }
    for (int r = gw; r < nrows; r += NGW) {
        const int v = r >= SEQ; const LAS float* pv = prm + 2 * v * DM;
        f32x4 x[8];
#pragma unroll
        for (int j = 0; j < 8; ++j) x[j] = nx[j];
        if (r + NGW < nrows) { const float* xr = xrow_ptr(F, l, r + NGW);
#pragma unroll
            for (int j = 0; j < 8; ++j) nx[j] = *(const f32x4*)(xr + 4 * F.lane + 256 * j); }
        float mean, rstd; ln_stats(x, mean, rstd);
#pragma unroll
        for (int j = 0; j < 8; ++j) { const int col = 4 * F.lane + 256 * j; const f32x4 h = (x[j] - mean) * rstd * (1.0f + *(const LAS f32x4*)(pv + DM + col)) + *(const LAS f32x4*)(pv + col);
            u32x2 w; w.x = cvt_pk_bf16(h.x, h.y); w.y = cvt_pk_bf16(h.z, h.w); *(u32x2*)(H1 + (size_t)r * DM + col) = w; }
    }
    __syncthreads();
}

namespace pg8 {
constexpr int BM = 256, BK = 64, HALF = 128, HTB = HALF * BK * 2, STAGE_BYTES = 8 * HTB, NXCD = 8, WGM = 8;
__device__ __forceinline__ int lds_byte(int r, int c) { const int st = (r >> 4) * 2 + (c >> 5), rr = r & 15, cc = c & 31, ob = rr * 64 + cc * 2; return st * 1024 + (ob ^ (((ob >> 9) & 1) << 5)); }
__device__ __forceinline__ void stage_rc(int b, int& R, int& C) { const int st = b / 1024, sb = b % 1024, swz = sb ^ (((sb >> 9) & 1) << 5); R = (st >> 1) * 16 + swz / 64; C = (st & 1) * 32 + (swz % 64) / 2; }
__device__ __forceinline__ int perm32(int rho) { const int n = rho >> 4, i = rho & 15; return 8 * (i >> 2) + 4 * n + (i & 3); }
struct Unit { int pm, pn, e, mt; };
struct StaticOrder {
    int nM, nN, nwg, G, c, K; const bf16_t* Bt;
    __device__ __forceinline__ void init(int M, int N, int K_, const bf16_t* Bt_, int G_, int c_) { nM = M / BM; nN = N / BM; nwg = nM * nN; G = G_; c = c_; K = K_; Bt = Bt_; }
    __device__ __forceinline__ bool next(int i, Unit& u) const {
        const long L = (long)i * G + c; if (L >= nwg) return false;
        int wgid = (int)L; { const int q = nwg / NXCD, r = nwg % NXCD, xcd = wgid % NXCD, off = wgid / NXCD; wgid = (xcd < r ? xcd * (q + 1) : r * (q + 1) + (xcd - r) * q) + off; }
        const int nig = WGM * nN, gid = wgid / nig, fm = gid * WGM, gsz = (nM - fm) < WGM ? (nM - fm) : WGM;
        u.pm = fm + ((wgid % nig) % gsz); u.pn = (wgid % nig) / gsz; u.e = 0; u.mt = 0; return true;
    }
    __device__ __forceinline__ unsigned a_off(const Unit& u, int h, int R) const { return (unsigned)((u.pm * BM + h * HALF + R) * K) * 2u; }
    __device__ __forceinline__ const char* b_base(const Unit& u) const { return (const char*)Bt + (size_t)u.pn * BM * K * 2; }
};
template <bool GATHER> struct MoeOrder {
    const LAS int* tileEM; int ntiles, G, c, K; const int* list; const int* cnt; const bf16_t* Bt;
    __device__ __forceinline__ bool next(int i, Unit& u) const {
        if ((G & 7) == 0) {
            const LAS int* tbase = tileEM + 128; const int x = c & 7, W = G >> 3; int q = (c >> 3) + i * W;
#pragma unroll
            for (int k = 0; k < 4; ++k) { const int e = x + 8 * k; const int tb = tbase[e], nt = tbase[e + 1] - tb; const int nu = nt * 8;
                if (q < nu) { u.e = e; u.pn = q / nt; u.mt = q - u.pn * nt; u.pm = tb + u.mt; return true; }
                q -= nu; }
            return false;
        }
        const int L = i * G + c; if (L >= ntiles * 8) return false;
        const int tile = L >> 3; const int em = tileEM[tile]; u.pm = tile; u.pn = L & 7; u.e = em >> 8; u.mt = em & 255; return true;
    }
    __device__ __forceinline__ unsigned a_off(const Unit& u, int h, int R) const {
        if (GATHER) { const int slot = u.mt * BM + h * HALF + R; const int n = cnt[64 * u.e]; int tok = 0; if (slot < n) tok = list[u.e * NROW + slot]; return (unsigned)(tok * K) * 2u; }
        return (unsigned)((u.pm * BM + h * HALF + R) * K) * 2u;
    }
    __device__ __forceinline__ const char* b_base(const Unit& u) const { return (const char*)Bt + ((size_t)u.e * 2048 + (size_t)u.pn * BM) * K * 2; }
};
struct EpiF32 {
    static constexpr bool PERM = false;
    float* C; int ldc;
    __device__ __forceinline__ void operator()(const f32x4 (&acc)[2][2][4][2], const Unit& u, int wr, int wc, int fr, int fq) const {
        const int row0 = u.pm * BM + wr * 64 + fr, col0 = u.pn * BM + wc * 32 + 4 * fq;
#pragma unroll
        for (int ai = 0; ai < 2; ++ai)
#pragma unroll
            for (int m = 0; m < 4; ++m) { float* rowp = C + (size_t)(row0 + ai * HALF + m * 16) * ldc + col0;
#pragma unroll
                for (int bj = 0; bj < 2; ++bj)
#pragma unroll
                    for (int n = 0; n < 2; ++n) *(f32x4*)(rowp + bj * HALF + n * 16) = acc[ai][bj][m][n]; }
    }
};
template <bool GELU> struct EpiBf {
    static constexpr bool PERM = true;
    bf16_t* O; int ldc; bf16_t* KV;
    __device__ __forceinline__ void operator()(const f32x4 (&acc)[2][2][4][2], const Unit& u, int wr, int wc, int fr, int fq) const {
        const int row0 = u.pm * BM + wr * 64 + fr, col0 = u.pn * BM + wc * 32 + 8 * fq; const bool g = GELU && (u.pn >= 6 && u.pn <= 9);
#pragma unroll
        for (int ai = 0; ai < 2; ++ai)
#pragma unroll
            for (int m = 0; m < 4; ++m) { bf16_t* rowp = (GELU && u.pn >= 14) ? KV + (size_t)(row0 + ai * HALF + m * 16) * 512 + (col0 - 14 * BM) : O + (size_t)(row0 + ai * HALF + m * 16) * ldc + col0;
#pragma unroll
                for (int bj = 0; bj < 2; ++bj) { f32x4 v0 = acc[ai][bj][m][0], v1 = acc[ai][bj][m][1];
                    if (g) {
#pragma unroll
                        for (int j = 0; j < 4; ++j) { v0[j] = gelu_tanh_fast(v0[j]); v1[j] = gelu_tanh_fast(v1[j]); } }
                    u32x4 w; w.x = cvt_pk_bf16(v0[0], v0[1]); w.y = cvt_pk_bf16(v0[2], v0[3]); w.z = cvt_pk_bf16(v1[0], v1[1]); w.w = cvt_pk_bf16(v1[2], v1[3]);
                    *(u32x4*)(rowp + bj * HALF) = w;
                    if (GELU && u.pm == SEQ / BM && u.pn >= 2 && u.pn <= 5)
                        *(u32x4*)(KV + (size_t)(WS_CKV - WS_KV) / 2 + (size_t)((((u.pn - 2) & 1) * 2 + bj) * 256 + (wr * 64 + fr + ai * HALF + m * 16)) * 512 + (u.pn >= 4 ? 256 : 0) + wc * 32 + 8 * fq) = w; } }
    }
};
struct EpiSwiGLU {
    static constexpr bool PERM = true;
    bf16_t* O;
    __device__ __forceinline__ void operator()(const f32x4 (&acc)[2][2][4][2], const Unit& u, int wr, int wc, int fr, int fq) const {
        const int row0 = u.pm * BM + wr * 64 + fr, col0 = u.pn * HALF + wc * 32 + 8 * fq;
#pragma unroll
        for (int ai = 0; ai < 2; ++ai)
#pragma unroll
            for (int m = 0; m < 4; ++m) { bf16_t* rowp = O + (size_t)(row0 + ai * HALF + m * 16) * DEXP + col0;
                f32x4 v0, v1;
#pragma unroll
                for (int j = 0; j < 4; ++j) { v0[j] = silu_fast(acc[ai][0][m][0][j]) * acc[ai][1][m][0][j]; v1[j] = silu_fast(acc[ai][0][m][1][j]) * acc[ai][1][m][1][j]; }
                u32x4 w; w.x = cvt_pk_bf16(v0[0], v0[1]); w.y = cvt_pk_bf16(v0[2], v0[3]); w.z = cvt_pk_bf16(v1[0], v1[1]); w.w = cvt_pk_bf16(v1[2], v1[3]);
                *(u32x4*)rowp = w; }
    }
};

template <class Epi, class Sched>
__device__ __forceinline__ void gemm_phase(LAS unsigned char* lds, int tid, const bf16_t* Amat, int K, const Sched& S, const Epi& E) {
    const int wid = __builtin_amdgcn_readfirstlane(tid >> 6), lane = tid & 63, wr = wid >> 2, wc = wid & 3, fr = lane & 15, fq = lane >> 4;
    const int nt = K / BK;
    int Rl[2], Cl[2]; unsigned voffB[2];
#pragma unroll
    for (int i = 0; i < 2; ++i) { int R, C; stage_rc(tid * 16 + i * 8192, R, C); Rl[i] = R; Cl[i] = C; const int Rb = Epi::PERM ? ((R & ~31) + perm32(R & 31)) : R; voffB[i] = (unsigned)(Rb * K + C) * 2u; }
    const size_t kstep = (size_t)(BK * 2);
    const size_t hstep = (size_t)HALF * K * 2;
    const unsigned ldsw = (unsigned)wid * 1024u;
    const int aoff = lds_byte(wr * 64 + fr, fq * 8), boff = lds_byte(wc * 32 + fr, fq * 8);
    const char* Ab = (const char*)Amat;
#define PG8_SA(b, h) (((b) * 2 + (h)) * HTB)
#define PG8_SB(b, h) ((4 + (b) * 2 + (h)) * HTB)
#define PG8_STAGE(bufoff, gbase, voff) do { _Pragma("unroll") for (int _i = 0; _i < 2; ++_i) \
        __builtin_amdgcn_global_load_lds((const unsigned*)((const char*)(gbase) + (voff)[_i]), (LAS unsigned*)(lds + (bufoff) + ldsw + _i * 8192), 16, 0, 0); } while (0)
#define PG8_LDA(dst, b, h) do { _Pragma("unroll") for (int m = 0; m < 4; ++m) _Pragma("unroll") for (int k = 0; k < 2; ++k) dst[m][k] = *(const LAS bf16x8*)(lds + PG8_SA(b, h) + aoff + m * 2048 + k * 1024); } while (0)
#define PG8_LDB(dst, b, h) do { _Pragma("unroll") for (int n = 0; n < 2; ++n) _Pragma("unroll") for (int k = 0; k < 2; ++k) dst[n][k] = *(const LAS bf16x8*)(lds + PG8_SB(b, h) + boff + n * 2048 + k * 1024); } while (0)
#define PG8_MMA(ai, bj, At, Bt) do { __builtin_amdgcn_s_setprio(1); _Pragma("unroll") for (int m = 0; m < 4; ++m) _Pragma("unroll") for (int n = 0; n < 2; ++n) _Pragma("unroll") for (int k = 0; k < 2; ++k) \
        acc[ai][bj][m][n] = __builtin_amdgcn_mfma_f32_16x16x32_bf16(Bt[n][k], At[m][k], acc[ai][bj][m][n], 0, 0, 0); __builtin_amdgcn_s_setprio(0); } while (0)
#define PG8_WAIT_V(n) asm volatile("s_waitcnt vmcnt(" #n ")" ::: "memory")
#define PG8_WAIT_L(n) asm volatile("s_waitcnt lgkmcnt(" #n ")" ::: "memory")
#define PG8_BAR __builtin_amdgcn_s_barrier()
#define PG8_SCHED __builtin_amdgcn_sched_barrier(0)
#define PG8_AOFFS(dst, u) do { _Pragma("unroll") for (int _h = 0; _h < 2; ++_h) _Pragma("unroll") for (int _i = 0; _i < 2; ++_i) dst[_h][_i] = S.a_off(u, _h, Rl[_i]) + (unsigned)Cl[_i] * 2u; \
        asm volatile("" : "+v"(dst[0][0]), "+v"(dst[0][1]), "+v"(dst[1][0]), "+v"(dst[1][1])); } while (0)
    Unit cur, nxt; int ui = 0;
    if (!S.next(0, cur)) return;
    f32x4 acc[2][2][4][2];
#pragma unroll
    for (int a = 0; a < 2; ++a)
#pragma unroll
        for (int b = 0; b < 2; ++b)
#pragma unroll
            for (int m = 0; m < 4; ++m)
#pragma unroll
                for (int n = 0; n < 2; ++n) acc[a][b][m][n] = (f32x4){0.f, 0.f, 0.f, 0.f};
    bf16x8 At[4][2], B0[2][2], B1[2][2];
    unsigned vA[2][2], vAn[2][2];
    PG8_AOFFS(vA, cur);
    const char* cB = S.b_base(cur);
    PG8_STAGE(PG8_SB(0, 0), cB, voffB); PG8_STAGE(PG8_SA(0, 0), Ab, vA[0]); PG8_STAGE(PG8_SB(0, 1), cB + hstep, voffB); PG8_STAGE(PG8_SA(0, 1), Ab, vA[1]);
    if (wr == 1) PG8_BAR;
    PG8_WAIT_V(4); PG8_BAR;
    PG8_STAGE(PG8_SB(1, 0), cB + kstep, voffB); PG8_STAGE(PG8_SA(1, 0), Ab + kstep, vA[0]); PG8_STAGE(PG8_SB(1, 1), cB + hstep + kstep, voffB);
    PG8_WAIT_V(6); PG8_BAR;
    for (;;) {
        const bool has_next = S.next(ui + 1, nxt);
        const char* nB = cB;
        if (has_next) { PG8_AOFFS(vAn, nxt); nB = S.b_base(nxt); }
        else {
#pragma unroll
            for (int h = 0; h < 2; ++h)
#pragma unroll
                for (int i = 0; i < 2; ++i) vAn[h][i] = vA[h][i]; }
        for (int t = 0; t < nt; t += 2) {
            const bool last = (t == nt - 2);
            const char* a1 = Ab + (size_t)(t + 1) * kstep;
            const char* a2 = last ? Ab : Ab + (size_t)(t + 2) * kstep; const char* b2 = last ? nB : cB + (size_t)(t + 2) * kstep;
            const char* a3 = a2 + kstep; const char* b3 = b2 + kstep;
            unsigned o2[2][2];
#pragma unroll
            for (int h = 0; h < 2; ++h)
#pragma unroll
                for (int i = 0; i < 2; ++i) o2[h][i] = last ? vAn[h][i] : vA[h][i];
            PG8_LDB(B0, 0, 0); PG8_SCHED; PG8_LDA(At, 0, 0); PG8_STAGE(PG8_SA(1, 1), a1, vA[1]);
            PG8_WAIT_L(8); PG8_BAR; PG8_WAIT_L(0); PG8_MMA(0, 0, At, B0); PG8_BAR; PG8_SCHED;
            PG8_LDB(B1, 0, 1); PG8_STAGE(PG8_SB(0, 0), b2, voffB);
            PG8_BAR; PG8_WAIT_L(0); PG8_MMA(0, 1, At, B1); PG8_BAR;
            PG8_LDA(At, 0, 1); PG8_STAGE(PG8_SA(0, 0), a2, o2[0]);
            PG8_BAR; PG8_WAIT_L(0); PG8_MMA(1, 0, At, B0); PG8_BAR; PG8_SCHED;
            PG8_STAGE(PG8_SB(0, 1), b2 + hstep, voffB);
            PG8_WAIT_V(6); PG8_BAR; PG8_MMA(1, 1, At, B1); PG8_BAR;
            PG8_LDB(B0, 1, 0); PG8_SCHED; PG8_LDA(At, 1, 0); PG8_STAGE(PG8_SA(0, 1), a2, o2[1]);
            PG8_WAIT_L(8); PG8_BAR; PG8_WAIT_L(0); PG8_MMA(0, 0, At, B0); PG8_BAR; PG8_SCHED;
            PG8_LDB(B1, 1, 1); PG8_STAGE(PG8_SB(1, 0), b3, voffB);
            PG8_BAR; PG8_WAIT_L(0); PG8_MMA(0, 1, At, B1); PG8_BAR;
            PG8_LDA(At, 1, 1); PG8_STAGE(PG8_SA(1, 0), a3, o2[0]);
            PG8_BAR; PG8_WAIT_L(0); PG8_MMA(1, 0, At, B0); PG8_BAR; PG8_SCHED;
            PG8_STAGE(PG8_SB(1, 1), b3 + hstep, voffB);
            PG8_WAIT_V(6); PG8_BAR; PG8_MMA(1, 1, At, B1); PG8_BAR;
        }
        E(acc, cur, wr, wc, fr, fq);
        if (!has_next) break;
#pragma unroll
        for (int a = 0; a < 2; ++a)
#pragma unroll
            for (int b = 0; b < 2; ++b)
#pragma unroll
                for (int m = 0; m < 4; ++m)
#pragma unroll
                    for (int n = 0; n < 2; ++n) acc[a][b][m][n] = (f32x4){0.f, 0.f, 0.f, 0.f};
        cur = nxt; cB = nB; ++ui;
#pragma unroll
        for (int h = 0; h < 2; ++h)
#pragma unroll
            for (int i = 0; i < 2; ++i) vA[h][i] = vAn[h][i];
    }
    PG8_WAIT_V(0);
    if (wr == 0) PG8_BAR;
    PG8_BAR;
#undef PG8_SA
#undef PG8_SB
#undef PG8_STAGE
#undef PG8_LDA
#undef PG8_LDB
#undef PG8_MMA
#undef PG8_WAIT_V
#undef PG8_WAIT_L
#undef PG8_BAR
#undef PG8_SCHED
#undef PG8_AOFFS
}
}

__device__ __forceinline__ void p_rmsrope(const Frame& F, int l, int nrows, int wg0) {
    const int gw = (F.bid - wg0) * NWAVES + F.wave, NGW = (F.G - wg0) * NWAVES;
    bf16_t* P = (bf16_t*)(F.ws + WS_PROJ);
    const float* R = (const float*)(F.ws + WS_ROPE);
    const int i = F.lane & 31, ax = F.lane >> 5, d1 = ax * 64 + i, d2 = d1 + 32;
    const float gq1 = F.in[IN_QNG][l * 128 + d1], gq2 = F.in[IN_QNG][l * 128 + d2], gk1 = F.in[IN_KNG][l * 128 + d1], gk2 = F.in[IN_KNG][l * 128 + d2];
    for (int r = gw; r < nrows; r += NGW) {
        float cs = 1.f, sn = 0.f;
        if (r < SEQ) { const int pos = ax == 0 ? (r >> 6) : (r & 63); cs = R[2 * (pos * 32 + i)]; sn = R[2 * (pos * 32 + i) + 1]; }
#pragma unroll
        for (int hh = 0; hh < 10; ++hh) {
            bf16_t* p = P + (size_t)r * INW + (hh < 8 ? 2560 + hh * 128 : 3584 + (hh - 8) * 128);
            float x1 = bf2f(p[d1]), x2 = bf2f(p[d2]);
            const float ss = wave_sum(x1 * x1 + x2 * x2);
            const float rinv = 1.0f / sqrtf(ss * (1.0f / 128.0f) + LN_EPS);
            x1 = x1 * rinv * (hh < 8 ? gq1 : gk1); x2 = x2 * rinv * (hh < 8 ? gq2 : gk2);
            p[d1] = f2bf(x1 * cs - x2 * sn); p[d2] = f2bf(x2 * cs + x1 * sn);
        }
    }
}

__device__ __forceinline__ void rms_rope_tile(const Frame& F, int l, int row0, int pn) {
    bf16_t* P = (bf16_t*)(F.ws + WS_PROJ);
    const float* R = (const float*)(F.ws + WS_ROPE);
    const float* gn = F.in[pn < 14 ? IN_QNG : IN_KNG] + l * 128;
    const int q = F.lane & 3;
    float gv[32];
#pragma unroll
    for (int c = 0; c < 4; ++c) { const f32x4 a = *(const f32x4*)(gn + 32 * c + 8 * q), b2 = *(const f32x4*)(gn + 32 * c + 8 * q + 4);
        gv[8 * c] = a.x; gv[8 * c + 1] = a.y; gv[8 * c + 2] = a.z; gv[8 * c + 3] = a.w; gv[8 * c + 4] = b2.x; gv[8 * c + 5] = b2.y; gv[8 * c + 6] = b2.z; gv[8 * c + 7] = b2.w; }
#pragma unroll 1
    for (int it = 0; it < 4; ++it) {
        const int pr = it * 128 + F.wave * 16 + (F.lane >> 2);
        const int row = row0 + (pr >> 1);
        bf16_t* p = (pn == 14) ? (bf16_t*)(F.ws + WS_KV) + (size_t)row * 512 + (pr & 1) * 128 + 8 * q : P + (size_t)row * INW + pn * 256 + (pr & 1) * 128 + 8 * q;
        float x[32]; float ss = 0.f;
#pragma unroll
        for (int c = 0; c < 4; ++c) { const u32x4 r = *(const u32x4*)(p + 32 * c);
#pragma unroll
            for (int e = 0; e < 4; ++e) { x[8 * c + 2 * e] = bf2f((bf16_t)(r[e] & 0xffffu)); x[8 * c + 2 * e + 1] = bf2f((bf16_t)(r[e] >> 16)); } }
#pragma unroll
        for (int t = 0; t < 32; ++t) ss += x[t] * x[t];
        ss = quad_sum(ss);
        const float rinv = 1.0f / sqrtf(ss * (1.0f / 128.0f) + LN_EPS);
#pragma unroll
        for (int t = 0; t < 32; ++t) x[t] = x[t] * rinv * gv[t];
        if (row < SEQ) {
#pragma unroll
            for (int ax = 0; ax < 2; ++ax) { const int pos = ax == 0 ? (row >> 6) : (row & 63); const float* cs = R + 2 * (pos * 32 + 8 * q);
#pragma unroll
                for (int t4 = 0; t4 < 4; ++t4) { const f32x4 w = *(const f32x4*)(cs + 4 * t4);
#pragma unroll
                    for (int e = 0; e < 2; ++e) { const int t = 2 * t4 + e; const float c0 = e ? w.z : w.x, s0 = e ? w.w : w.y;
                        const float x1 = x[16 * ax + t], x2 = x[16 * ax + 8 + t]; x[16 * ax + t] = x1 * c0 - x2 * s0; x[16 * ax + 8 + t] = x2 * c0 + x1 * s0; } } }
        }
#pragma unroll
        for (int c = 0; c < 4; ++c) { u32x4 o;
#pragma unroll
            for (int e = 0; e < 4; ++e) o[e] = cvt_pk_bf16(x[8 * c + 2 * e], x[8 * c + 2 * e + 1]);
            *(u32x4*)(p + 32 * c) = o; }
    }
}

namespace att {
constexpr int D = 128, NW = 8, QBLK = 32, KVBLK = 64;
constexpr float SCALE = 0.088388347648318440f;
constexpr float THR = 8.f;
constexpr int LDQ = INW, LDO = DM;
constexpr size_t SHM_V = KVBLK * D * 2, SHM_K = KVBLK * D * 2, SHM_ATTN = 2 * SHM_V + 2 * SHM_K + NW * 64 * 4;
#define KSWZ(row, colB) ((row) * 256 + ((colB) ^ (((row) & 7) << 4)))
#define SBAR() __builtin_amdgcn_sched_barrier(0)
__device__ __forceinline__ int crow(int r, int hi) { return (r & 3) + 8 * (r >> 2) + 4 * hi; }
__device__ __forceinline__ unsigned cvtpk(float lo, float hi) { unsigned r; asm volatile("v_cvt_pk_bf16_f32 %0, %1, %2" : "=v"(r) : "v"(lo), "v"(hi)); return r; }
__device__ __forceinline__ void partialSM(f32x16& p0, f32x16& p1, float& m_reg, float& mn, float& alpha) {
  constexpr float C = SCALE * 1.4426950408889634f;
  float pmax = p0[0];
#pragma unroll
  for (int r = 1; r < 16; ++r) pmax = fmaxf(pmax, p0[r]);
#pragma unroll
  for (int r = 0; r < 16; ++r) pmax = fmaxf(pmax, p1[r]);
  { auto rr = __builtin_amdgcn_permlane32_swap(__float_as_uint(pmax), __float_as_uint(pmax), false, false);
    pmax = fmaxf(__uint_as_float(rr[0]), __uint_as_float(rr[1])); }
  if (__builtin_expect(__all(pmax - m_reg <= THR / SCALE), 1)) { mn = m_reg; alpha = 1.f; }
  else { mn = fmaxf(m_reg, pmax); alpha = __builtin_amdgcn_exp2f((m_reg - mn) * C); m_reg = mn; }
  float mnC = -mn * C;
#pragma unroll
  for (int r = 0; r < 16; ++r) p0[r] = fmaf(p0[r], C, mnC);
#pragma unroll
  for (int r = 0; r < 16; ++r) p1[r] = fmaf(p1[r], C, mnC);
#pragma unroll
  for (int r = 0; r < 16; ++r) p0[r] = __builtin_amdgcn_exp2f(p0[r]);
}
__device__ __forceinline__ void finishSM(f32x16& p0, f32x16& p1, float alpha, float& l_reg, bf16x8& pa0, bf16x8& pa1, bf16x8& pa2, bf16x8& pa3) {
#pragma unroll
  for (int r = 0; r < 16; ++r) p1[r] = __builtin_amdgcn_exp2f(p1[r]);
  float ps = 0;
#pragma unroll
  for (int r = 0; r < 16; ++r) ps += p0[r];
#pragma unroll
  for (int r = 0; r < 16; ++r) ps += p1[r];
  { auto rr = __builtin_amdgcn_permlane32_swap(__float_as_uint(ps), __float_as_uint(ps), false, false);
    ps = __uint_as_float(rr[0]) + __uint_as_float(rr[1]); }
  l_reg = l_reg * alpha + ps;
#define PK4(P, BASE, OUT) do { unsigned a0 = cvtpk(P[BASE + 0], P[BASE + 1]), a1 = cvtpk(P[BASE + 2], P[BASE + 3]);   \
    unsigned b0 = cvtpk(P[BASE + 4], P[BASE + 5]), b1 = cvtpk(P[BASE + 6], P[BASE + 7]);                              \
    auto r0 = __builtin_amdgcn_permlane32_swap(a0, b0, false, false); auto r1 = __builtin_amdgcn_permlane32_swap(a1, b1, false, false); \
    u32x4 w = {r0[0], r1[0], r0[1], r1[1]}; OUT = *reinterpret_cast<bf16x8*>(&w); } while (0)
  PK4(p0, 0, pa0); PK4(p0, 8, pa1); PK4(p1, 0, pa2); PK4(p1, 8, pa3);
#undef PK4
}
__device__ __forceinline__ void qkt(f32x16& p0, f32x16& p1, const bf16_t* Ks, const bf16x8* qr, int r32, int hi) {
  p0 = f32x16{}; p1 = f32x16{};
#pragma unroll
  for (int d0 = 0; d0 < 8; ++d0) { int cb = (d0 * 16 + hi * 8) * 2;
    bf16x8 b0 = *reinterpret_cast<const bf16x8*>((const char*)Ks + KSWZ(r32, cb));
    bf16x8 b1 = *reinterpret_cast<const bf16x8*>((const char*)Ks + KSWZ(32 + r32, cb));
    p0 = __builtin_amdgcn_mfma_f32_32x32x16_bf16(b0, qr[d0], p0, 0, 0, 0);
    p1 = __builtin_amdgcn_mfma_f32_32x32x16_bf16(b1, qr[d0], p1, 0, 0, 0); }
}
__device__ __forceinline__ int v_st(int k, int c) { const int kk = (k & ~0xC) | ((k & 4) << 1) | ((k & 8) >> 1); return ((kk >> 3) * 4 + (c >> 5)) * 512 + ((kk & 7) * 32 + (c & 31)) * 2; }
__device__ __forceinline__ int v_rd_base(int lane) { return ((lane & 3) << 3) | (((lane >> 2) & 3) << 6) | (((lane >> 4) & 1) << 5) | (((lane >> 5) & 1) << 8); }
constexpr int v_rd_off(int d0, int ks, int half) { return d0 * 512 + ks * 4096 + half * 2048; }
template <int OFF> __device__ __forceinline__ s16x4 tr_read(int vb) {
  s16x4 r; asm volatile("ds_read_b64_tr_b16 %0, %1 offset:%2" : "=&v"(r) : "v"(vb), "i"(OFF) : "memory"); return r;
}
template <int D0> __device__ __forceinline__ void pv_one(f32x16& od, int vb, bf16x8 pa0, bf16x8 pa1, bf16x8 pa2, bf16x8 pa3) {
  const s16x4 l0 = tr_read<v_rd_off(D0, 0, 0)>(vb), h0 = tr_read<v_rd_off(D0, 0, 1)>(vb), l1 = tr_read<v_rd_off(D0, 1, 0)>(vb), h1 = tr_read<v_rd_off(D0, 1, 1)>(vb);
  const s16x4 l2 = tr_read<v_rd_off(D0, 2, 0)>(vb), h2 = tr_read<v_rd_off(D0, 2, 1)>(vb), l3 = tr_read<v_rd_off(D0, 3, 0)>(vb), h3 = tr_read<v_rd_off(D0, 3, 1)>(vb);
  asm volatile("s_waitcnt lgkmcnt(0)" ::: "memory"); SBAR();
#define PK(L, H) (bf16x8){L[0], L[1], L[2], L[3], H[0], H[1], H[2], H[3]}
  od = __builtin_amdgcn_mfma_f32_32x32x16_bf16(pa0, PK(l0, h0), od, 0, 0, 0);
  od = __builtin_amdgcn_mfma_f32_32x32x16_bf16(pa1, PK(l1, h1), od, 0, 0, 0);
  od = __builtin_amdgcn_mfma_f32_32x32x16_bf16(pa2, PK(l2, h2), od, 0, 0, 0);
  od = __builtin_amdgcn_mfma_f32_32x32x16_bf16(pa3, PK(l3, h3), od, 0, 0, 0);
#undef PK
}
__device__ __forceinline__ void pv_d0(f32x16* o, int vb, bf16x8 pa0, bf16x8 pa1, bf16x8 pa2, bf16x8 pa3) {
  pv_one<0>(o[0], vb, pa0, pa1, pa2, pa3); pv_one<1>(o[1], vb, pa0, pa1, pa2, pa3); pv_one<2>(o[2], vb, pa0, pa1, pa2, pa3); pv_one<3>(o[3], vb, pa0, pa1, pa2, pa3);
}
struct MapLinear { long base; __device__ __forceinline__ long operator()(int t) const { return base + (long)t * KVBLK; } };
struct MapNA { int rs0; __device__ __forceinline__ long operator()(int t) const { return t < 4 ? (long)SEQ + t * 64 : (long)(rs0 + t - 4) * 64; } };
struct HookNone { __device__ __forceinline__ void operator()(f32x16&, f32x16&, int, int) const {} };
struct HookNA {
  const LAS float* bias; int qr, rs, rs0, cbase  , bbase  ;
  __device__ __forceinline__ void operator()(f32x16& p0, f32x16& p1, int tile, int hi) const {
    if (tile < 4) return;
    const int kr = rs0 + tile - 4; const bool rowok = (kr >= rs) && (kr <= rs + 7);
    int drow = kr - qr + 7; drow = drow < 0 ? 0 : (drow > 14 ? 14 : drow);
    const float ninf = -__builtin_inff();
    const LAS float* bp = bias + drow * 31 + bbase;
#pragma unroll
    for (int r = 0; r < 16; ++r) {
      const int kc = (r & 3) + 8 * (r >> 2);
      const bool ok0 = rowok && (unsigned)(kc + cbase) <= 15u, ok1 = rowok && (unsigned)(kc + 32 + cbase) <= 15u;
      p0[r] = ok0 ? p0[r] + bp[kc] : ninf; p1[r] = ok1 ? p1[r] + bp[kc + 32] : ninf;
    }
  }
};
template <int SDEPTH, int LDK, class Map, class Hook>
__device__ __forceinline__ void attn_body(const bf16_t* __restrict__ Qb, const bf16_t* __restrict__ Kh, const bf16_t* __restrict__ Vh,
                                          bf16_t* __restrict__ Ob, int NT, const Map map, const Hook hook, char* lds, int tid) {
  const int wid = tid >> 6, lane = tid & 63, r32 = lane & 31, hi = lane >> 5;
  bf16_t* V_lds = (bf16_t*)lds; bf16_t* K_lds = (bf16_t*)(lds + 2 * SHM_V);
  float* ws = (float*)(lds + 2 * SHM_V + 2 * SHM_K) + wid * 64; float* li_l = ws; float* al_l = ws + 32;
  float m_reg = -1e30f, l_reg = 0; f32x16 o[4] = {}; bf16x8 qr[8];
  const bf16_t* Qw = Qb + (long)(wid * QBLK + r32) * LDQ + hi * 8;
#pragma unroll
  for (int d0 = 0; d0 < 8; ++d0) qr[d0] = *reinterpret_cast<const bf16x8*>(Qw + d0 * 16);
  const int sr = tid >> 4, sc = (tid & 15) * 8, vst0 = v_st(sr, sc), vst1 = v_st(32 + sr, sc);
  const int vb0 = (int)(uintptr_t)V_lds + v_rd_base(lane);
  struct { bf16x8 vs0, vs1, ks0, ks1; } sr_[SDEPTH];
#define SLOAD(i, tile) do { const long _k0 = map(tile); sr_[i].vs0 = *reinterpret_cast<const bf16x8*>(&Vh[(_k0 + sr) * LDK + sc]); sr_[i].vs1 = *reinterpret_cast<const bf16x8*>(&Vh[(_k0 + 32 + sr) * LDK + sc]); \
    sr_[i].ks0 = *reinterpret_cast<const bf16x8*>(&Kh[(_k0 + sr) * LDK + sc]); sr_[i].ks1 = *reinterpret_cast<const bf16x8*>(&Kh[(_k0 + 32 + sr) * LDK + sc]); } while (0)
#define SWRITE(b, i) do { *(bf16x8*)((char*)V_lds + (b) * SHM_V + vst0) = sr_[i].vs0;          \
    *(bf16x8*)((char*)V_lds + (b) * SHM_V + vst1) = sr_[i].vs1; int kc = sc * 2;               \
    *(bf16x8*)((char*)K_lds + (b) * SHM_K + KSWZ(sr, kc)) = sr_[i].ks0;                       \
    *(bf16x8*)((char*)K_lds + (b) * SHM_K + KSWZ(32 + sr, kc)) = sr_[i].ks1; } while (0)
#define SWAIT() do { if constexpr (SDEPTH == 2) asm volatile("s_waitcnt vmcnt(4)" ::: "memory"); else asm volatile("s_waitcnt vmcnt(0)" ::: "memory"); } while (0)
#define RESC(a) do { if (__any((a) < 1.f)) { if (hi == 0) al_l[r32] = (a); asm volatile("s_waitcnt lgkmcnt(0)" ::: "memory"); \
    _Pragma("unroll") for (int d = 0; d < 4; ++d) _Pragma("unroll") for (int r = 0; r < 16; ++r) o[d][r] *= al_l[crow(r, hi)]; } } while (0)
  f32x16 pA0, pA1, pB0, pB1; float mnA, mnB, alA, alB; bf16x8 pa0, pa1, pa2, pa3;
  constexpr int SE = 0, SO = SDEPTH - 1;
  SLOAD(SE, 0); asm volatile("s_waitcnt vmcnt(0)" ::: "memory"); SWRITE(0, SE); __syncthreads();
  qkt(pA0, pA1, K_lds, qr, r32, hi); hook(pA0, pA1, 0, hi); partialSM(pA0, pA1, m_reg, mnA, alA);
  SLOAD(SO, 1); if constexpr (SDEPTH == 2) { if (2 < NT) SLOAD(SE, 2); }
  SWAIT(); SWRITE(1, SO); __syncthreads();
  for (int j = 1; j + 1 < NT; j += 2) {
    SBAR(); qkt(pB0, pB1, (bf16_t*)((char*)K_lds + SHM_K), qr, r32, hi);
    finishSM(pA0, pA1, alA, l_reg, pa0, pa1, pa2, pa3); SBAR();
    SLOAD(SO, j + SDEPTH); SBAR();
    pv_d0(o, vb0, pa0, pa1, pa2, pa3); hook(pB0, pB1, j, hi); partialSM(pB0, pB1, m_reg, mnB, alB);
    __syncthreads(); SWAIT(); SWRITE(0, SE);
    RESC(alB); __syncthreads();
    SBAR(); qkt(pA0, pA1, K_lds, qr, r32, hi);
    finishSM(pB0, pB1, alB, l_reg, pa0, pa1, pa2, pa3); SBAR();
    if (SDEPTH == 1 || j + 3 < NT) SLOAD(SE, j + 1 + SDEPTH); SBAR();
    pv_d0(o, vb0 + (int)SHM_V, pa0, pa1, pa2, pa3); hook(pA0, pA1, j + 1, hi); partialSM(pA0, pA1, m_reg, mnA, alA);
    __syncthreads(); SWAIT(); SWRITE(1, SO);
    RESC(alA); __syncthreads();
  }
  SBAR(); qkt(pB0, pB1, (bf16_t*)((char*)K_lds + SHM_K), qr, r32, hi);
  finishSM(pA0, pA1, alA, l_reg, pa0, pa1, pa2, pa3); SBAR();
  pv_d0(o, vb0, pa0, pa1, pa2, pa3); hook(pB0, pB1, NT - 1, hi); partialSM(pB0, pB1, m_reg, mnB, alB);
  __syncthreads(); RESC(alB);
  finishSM(pB0, pB1, alB, l_reg, pa0, pa1, pa2, pa3); SBAR();
  pv_d0(o, vb0 + (int)SHM_V, pa0, pa1, pa2, pa3);
  if (hi == 0) li_l[r32] = l_reg; asm volatile("s_waitcnt lgkmcnt(0)" ::: "memory");
  float rli[16];
#pragma unroll
  for (int r = 0; r < 16; ++r) rli[r] = __builtin_amdgcn_rcpf(li_l[crow(r, hi)]);
  bf16_t* Ow = Ob + (long)(wid * QBLK) * LDO;
#pragma unroll
  for (int r = 0; r < 16; ++r) { int orow = crow(r, hi);
#pragma unroll
    for (int d0 = 0; d0 < 4; ++d0) Ow[(long)orow * LDO + d0 * 32 + r32] = f2bf(o[d0][r] * rli[r]); }
  __syncthreads();
#undef SLOAD
#undef SWRITE
#undef SWAIT
#undef RESC
}
}

__device__ __forceinline__ void sg_unit(const Frame& F, int l, int c, int g) {
    constexpr int VST = 136;
    LAS bf16_t* vnT = (LAS bf16_t*)F.lds;
    const bf16_t* P = (const bf16_t*)(F.ws + WS_PROJ);
    const int fr = F.lane & 15, fq = F.lane >> 4;
    const float* W = F.in[IN_SGW] + ((size_t)(l * 4 + g) * 128 + 16 * F.wave + fr) * 128 + 8 * fq;
    bf16x8 wf[4];
#pragma unroll
    for (int ks = 0; ks < 4; ++ks) { const f32x4 a = *(const f32x4*)(W + 32 * ks), b2 = *(const f32x4*)(W + 32 * ks + 4);
        u32x4 w; w.x = cvt_pk_bf16(a.x, a.y); w.y = cvt_pk_bf16(a.z, a.w); w.z = cvt_pk_bf16(b2.x, b2.y); w.w = cvt_pk_bf16(b2.z, b2.w); wf[ks] = *reinterpret_cast<bf16x8*>(&w); }
    {
        const int j = 16 * F.wave + (F.lane >> 2), q = F.lane & 3; const size_t p = (size_t)(c * 128 + j);
        const bf16_t* vp = P + p * INW + 2048 + g * 128 + 32 * q;
        float x[32];
#pragma unroll
        for (int t = 0; t < 4; ++t) { const u32x4 r = *(const u32x4*)(vp + 8 * t);
#pragma unroll
            for (int e = 0; e < 4; ++e) { x[8 * t + 2 * e] = bf2f((bf16_t)(r[e] & 0xffffu)); x[8 * t + 2 * e + 1] = bf2f((bf16_t)(r[e] >> 16)); } }
        float sm = 0.f;
#pragma unroll
        for (int t = 0; t < 32; ++t) sm += x[t];
        sm = quad_sum(sm);
        const float mean = sm * (1.0f / 128.0f); float sq = 0.f;
#pragma unroll
        for (int t = 0; t < 32; ++t) { x[t] -= mean; sq += x[t] * x[t]; }
        sq = quad_sum(sq);
        const float rstd = 1.0f / sqrtf(sq * (1.0f / 128.0f) + LN_EPS);
        const float* gp = F.in[IN_SGLNG] + (l * 4 + g) * 128 + 32 * q; const float* bp = F.in[IN_SGLNB] + (l * 4 + g) * 128 + 32 * q;
#pragma unroll
        for (int t = 0; t < 32; ++t) vnT[(32 * q + t) * VST + j] = f2bf(x[t] * rstd * gp[t] + bp[t]);
    }
    __syncthreads();
    bf16_t* MIXp = (bf16_t*)(F.ws + WS_MIX);
    const int i = 16 * F.wave + fr; const size_t pi = (size_t)(c * 128 + i); const float bs = F.in[IN_SGB][(l * 4 + g) * 128 + i];
#pragma unroll
    for (int dt = 0; dt < 8; ++dt) {
        f32x4 acc = {0.f, 0.f, 0.f, 0.f};
#pragma unroll
        for (int ks = 0; ks < 4; ++ks) { const bf16x8 a = *(const LAS bf16x8*)(vnT + (dt * 16 + fr) * VST + 32 * ks + 8 * fq); acc = __builtin_amdgcn_mfma_f32_16x16x32_bf16(a, wf[ks], acc, 0, 0, 0); }
        const int d0 = 16 * dt + 4 * fq; const u32x2 uu = *(const u32x2*)(P + pi * INW + 1536 + g * 128 + d0);
        u32x2 o; o.x = cvt_pk_bf16((acc[0] + bs) * bf2f((bf16_t)(uu.x & 0xffffu)), (acc[1] + bs) * bf2f((bf16_t)(uu.x >> 16)));
        o.y = cvt_pk_bf16((acc[2] + bs) * bf2f((bf16_t)(uu.y & 0xffffu)), (acc[3] + bs) * bf2f((bf16_t)(uu.y >> 16)));
        *(u32x2*)(MIXp + pi * DM + 512 + g * 128 + d0) = o;
    }
    __syncthreads();
}

__device__ __forceinline__ void p_att_dense(const Frame& F, int l) {
    const bf16_t* P = (const bf16_t*)(F.ws + WS_PROJ); bf16_t* MIXp = (bf16_t*)(F.ws + WS_MIX); const bf16_t* KV = (const bf16_t*)(F.ws + WS_KV);
    const int total = 256 + ((l == 0) ? 12 : 0);
    for (int u = F.bid; u < total; u += F.G) {
        int qrow, qcol, ocol, nt; long kbase; const bf16_t* kp;
        if (u < 256) { const int h = u & 7; qrow = (u >> 3) * 256; qcol = 2560 + h * 128; ocol = 1024 + h * 128; nt = NROW / 64; kbase = 0; kp = KV + (h >> 2) * 128; }
        else if (u < 264) { const int h = u - 256; qrow = SEQ; qcol = 2560 + h * 128; ocol = 1024 + h * 128; nt = 4; kbase = SEQ; kp = KV + (h >> 2) * 128; }
        else { const int h = u - 264; qrow = SEQ; qcol = h * 128; ocol = h * 128; nt = 4; kbase = 0; kp = (const bf16_t*)(F.ws + WS_CKV) + (size_t)h * 256 * 512; }
        att::attn_body<2, 512>(P + (size_t)qrow * INW + qcol, kp, kp + 256, MIXp + (size_t)qrow * DM + ocol, nt, att::MapLinear{kbase}, att::HookNone{}, (char*)F.lds, F.tid);
    }
}
__device__ __forceinline__ void p_att_na(const Frame& F, int l) {
    const bf16_t* P = (const bf16_t*)(F.ws + WS_PROJ); bf16_t* MIXp = (bf16_t*)(F.ws + WS_MIX);
    LAS float* bt = (LAS float*)(F.lds + LDS_SC);
    for (int v = F.bid; v < 128; v += F.G) {
        const int h = v & 3, qb = v >> 2, R0 = qb * 4;
        const float* rpb = F.in[IN_RPB] + (size_t)(l * 4 + h) * 15 * 31;
        for (int t = F.tid; t < 640; t += NTHR) { const int q = t - 48; bt[t] = (q >= 0 && q < 15 * 31) ? rpb[q] * (1.0f / att::SCALE) : 0.f; }
        __syncthreads();
        int rs0 = R0 - 4; rs0 = rs0 < 0 ? 0 : (rs0 > 116 ? 116 : rs0);
        const int qr = R0 + (F.wave >> 1), qc = (F.wave & 1) * 32 + (F.lane & 31);
        int rs = qr - 4; rs = rs < 0 ? 0 : (rs > 120 ? 120 : rs);
        int cs = qc - 8; cs = cs < 0 ? 0 : (cs > 48 ? 48 : cs);
        att::attn_body<1, INW>(P + (size_t)(qb * 256) * INW + h * 128, P + 512 + h * 128, P + 1024 + h * 128,
                       MIXp + (size_t)(qb * 256) * DM + h * 128, 16, att::MapNA{rs0}, att::HookNA{bt, qr, rs, rs0, 4 * (F.lane >> 5) - cs, 48 + 15 - qc + 4 * (F.lane >> 5)}, (char*)F.lds, F.tid);
    }
}
__device__ __forceinline__ void p_att_sg(const Frame& F, int l) {
    const int nsg = (l == 0) ? 264 : 256;
    if (F.G >= 256) { for (int v = F.bid - 128; v >= 0 && v < nsg; v += F.G - 128) sg_unit(F, l, v >> 2, v & 3); }
    else { for (int v = F.bid; v < nsg; v += F.G) sg_unit(F, l, v >> 2, v & 3); }
}

#ifdef TSEL_A
#define TSF(F, i) do { if ((F).bid == 0 && (F).tid == 0) __hip_atomic_store((unsigned long long*)((F).ws + WS_CTL + 131072) + (i), (unsigned long long)__builtin_amdgcn_s_memrealtime(), __ATOMIC_RELAXED, __HIP_MEMORY_SCOPE_AGENT); } while (0)
#else
#define TSF(F, i) do { } while (0)
#endif
__device__ __forceinline__ void p_mixln_router(const Frame& F, int l, int nrows) {
    LAS float* plog = (LAS float*)F.lds;
    LAS float* scS = plog + 8 * 48 * 32;
    LAS float* selS = scS + 48 * 32;
    const float* MOD = (const float*)(F.ws + WS_MOD);
    const bf16_t* Y1 = (const bf16_t*)(F.ws + WS_Y1);
    float* XS = (float*)(F.ws + WS_XS);
    bf16_t* H2 = (bf16_t*)(F.ws + WS_H2); bf16_t* H2L = (bf16_t*)(F.ws + WS_H2L);
    const bf16_t* RWH = (const bf16_t*)(F.ws + WS_RWT); const bf16_t* RWL = RWH + 32 * DM;
    const float* RB = F.in[IN_RB];
    const float* lg = F.in[IN_LNMG] + l * DM; const float* lb = F.in[IN_LNMB] + l * DM;
    int* cnt = (int*)(F.ws + WS_CTL) + CW_CNT + l * 2048;
    int* tokE = (int*)(F.ws + WS_TOKE); int* tokP = (int*)(F.ws + WS_TOKP); float* tokG = (float*)(F.ws + WS_TOKG); int* list = (int*)(F.ws + WS_LIST);
    const int rpw = (nrows + F.G - 1) / F.G;
    const int wbeg = F.bid * rpw, wend = (wbeg + rpw < nrows) ? wbeg + rpw : nrows;
    LAS float* prm = (LAS float*)(F.lds + 65536);
    stage_vec(F, prm, lg); stage_vec(F, prm + DM, lb);
    for (int v = 0; v < 2; ++v) { const float* m = MOD + (size_t)(l * 2 + v) * 12288; stage_vec(F, prm + (2 + 3 * v) * DM, m + 2 * DM); stage_vec(F, prm + (3 + 3 * v) * DM, m + 3 * DM); stage_vec(F, prm + (4 + 3 * v) * DM, m + 4 * DM); }
    __syncthreads();
    TSF(F, 30);
    for (int rbeg = wbeg; rbeg < wend; rbeg += 48) {
        const int rend = (rbeg + 48 < wend) ? rbeg + 48 : wend, nr = rend - rbeg;
        f32x4 nx[8]; u32x2 ny[8];
#define P5_LOAD(rr) do { const float* xr_ = xrow_ptr(F, l, (rr)); const bf16_t* yr_ = Y1 + (size_t)(rr) * DM; \
        _Pragma("unroll") for (int j = 0; j < 8; ++j) { const int col = 4 * F.lane + 256 * j; nx[j] = __builtin_nontemporal_load((const f32x4*)(xr_ + col)); ny[j] = __builtin_nontemporal_load((const u32x2*)(yr_ + col)); } } while (0)
        if (rbeg + F.wave < rend) P5_LOAD(rbeg + F.wave);
        for (int r = rbeg + F.wave; r < rend; r += NWAVES) {
            const int v = r >= SEQ; const LAS float* pv = prm + (2 + 3 * v) * DM;
            f32x4 z[8];
#pragma unroll
            for (int j = 0; j < 8; ++j) { const int col = 4 * F.lane + 256 * j; const u32x2 yy = ny[j];
                const f32x4 y = {bf2f((bf16_t)(yy.x & 0xffffu)), bf2f((bf16_t)(yy.x >> 16)), bf2f((bf16_t)(yy.y & 0xffffu)), bf2f((bf16_t)(yy.y >> 16))};
                z[j] = ALPHA * nx[j] + *(const LAS f32x4*)(pv + col) * y; }
            if (r + NWAVES < rend) P5_LOAD(r + NWAVES);
            float mean, rstd; ln_stats(z, mean, rstd);
#pragma unroll
            for (int j = 0; j < 8; ++j) { const int col = 4 * F.lane + 256 * j; z[j] = (z[j] - mean) * rstd * *(const LAS f32x4*)(prm + col) + *(const LAS f32x4*)(prm + DM + col); *(f32x4*)(XS + (size_t)r * DM + col) = z[j]; }
            ln_stats(z, mean, rstd);
#pragma unroll
            for (int j = 0; j < 8; ++j) { const int col = 4 * F.lane + 256 * j; const f32x4 s1 = *(const LAS f32x4*)(pv + 2 * DM + col), s0 = *(const LAS f32x4*)(pv + DM + col);
                const f32x4 h = (z[j] - mean) * rstd * (1.0f + s1) + s0;
                u32x2 hi; hi.x = cvt_pk_bf16(h.x, h.y); hi.y = cvt_pk_bf16(h.z, h.w);
                const f32x4 hf = {bf2f((bf16_t)(hi.x & 0xffffu)), bf2f((bf16_t)(hi.x >> 16)), bf2f((bf16_t)(hi.y & 0xffffu)), bf2f((bf16_t)(hi.y >> 16))};
                const f32x4 d = h - hf; u32x2 lo; lo.x = cvt_pk_bf16(d.x, d.y); lo.y = cvt_pk_bf16(d.z, d.w);
                *(u32x2*)(H2 + (size_t)r * DM + col) = hi; *(u32x2*)(H2L + (size_t)r * DM + col) = lo; }
        }
#undef P5_LOAD
        asm volatile("s_waitcnt vmcnt(0)" ::: "memory");
        __syncthreads();
        TSF(F, 31);
        const int ntile = (nr + 15) >> 4; constexpr int nsl = 8;
        {
            const int fr = F.lane & 15, fq = F.lane >> 4, kb = F.wave * 256 + fq * 8;
            const bf16_t* bh = RWH + (size_t)fr * DM + kb; const bf16_t* bl = RWL + (size_t)fr * DM + kb;
            const bf16_t* ah[3]; const bf16_t* al[3];
#pragma unroll
            for (int t = 0; t < 3; ++t) { int row = rbeg + t * 16 + fr; row = row < rend ? row : rend - 1; ah[t] = H2 + (size_t)row * DM + kb; al[t] = H2L + (size_t)row * DM + kb; }
            f32x4 acc[3][2];
#pragma unroll
            for (int t = 0; t < 3; ++t) { acc[t][0] = (f32x4){0.f, 0.f, 0.f, 0.f}; acc[t][1] = (f32x4){0.f, 0.f, 0.f, 0.f}; }
#pragma unroll 2
            for (int ks = 0; ks < 8; ++ks) { const int off = ks * 32;
                const bf16x8 b_h0 = *(const bf16x8*)(bh + off), b_l0 = *(const bf16x8*)(bl + off), b_h1 = *(const bf16x8*)(bh + 16 * DM + off), b_l1 = *(const bf16x8*)(bl + 16 * DM + off);
#pragma unroll
                for (int t = 0; t < 3; ++t) if (t < ntile) {
                    const bf16x8 a_h = *(const bf16x8*)(ah[t] + off), a_l = *(const bf16x8*)(al[t] + off);
                    acc[t][0] = __builtin_amdgcn_mfma_f32_16x16x32_bf16(a_h, b_h0, acc[t][0], 0, 0, 0); acc[t][0] = __builtin_amdgcn_mfma_f32_16x16x32_bf16(a_h, b_l0, acc[t][0], 0, 0, 0); acc[t][0] = __builtin_amdgcn_mfma_f32_16x16x32_bf16(a_l, b_h0, acc[t][0], 0, 0, 0);
                    acc[t][1] = __builtin_amdgcn_mfma_f32_16x16x32_bf16(a_h, b_h1, acc[t][1], 0, 0, 0); acc[t][1] = __builtin_amdgcn_mfma_f32_16x16x32_bf16(a_h, b_l1, acc[t][1], 0, 0, 0); acc[t][1] = __builtin_amdgcn_mfma_f32_16x16x32_bf16(a_l, b_h1, acc[t][1], 0, 0, 0); } }
#pragma unroll
            for (int t = 0; t < 3; ++t) if (t < ntile) {
#pragma unroll
                for (int q = 0; q < 4; ++q) { LAS float* pr = plog + (F.wave * 48 + t * 16 + 4 * fq + q) * 32; pr[fr] = acc[t][0][q]; pr[16 + fr] = acc[t][1][q]; } }
        }
        __syncthreads();
        TSF(F, 32);
        for (int t = F.tid; t < nr * 32; t += NTHR) { const int e = t & 31; float lg2 = 0.f; for (int q = 0; q < nsl; ++q) lg2 += plog[q * 48 * 32 + t]; const float sc = sigmoidf_(lg2); scS[t] = sc; selS[t] = sc + RB[e]; }
        __syncthreads();
        if (F.tid < nr) {
            const int row = F.tid, r = rbeg + row; const LAS float* sel = selS + row * 32; const LAS float* sc = scS + row * 32;
            int best = 0; float bestv = -__builtin_inff();
            for (int g = 0; g < 4; ++g) { float m1 = -__builtin_inff(), m2 = -__builtin_inff();
                for (int q = 0; q < 8; ++q) { const float x = sel[g * 8 + q]; if (x > m1) { m2 = m1; m1 = x; } else if (x > m2) m2 = x; }
                const float gs = m1 + m2; if (gs > bestv) { bestv = gs; best = g; } }
            int i1 = 0, i2 = 0; float m1 = -__builtin_inff(), m2 = -__builtin_inff();
            for (int q = 0; q < 8; ++q) { const float x = sel[best * 8 + q]; if (x > m1) { m2 = m1; i2 = i1; m1 = x; i1 = q; } else if (x > m2) { m2 = x; i2 = q; } }
            const int e1 = best * 8 + i1, e2 = best * 8 + i2; const float s1 = sc[e1], s2 = sc[e2], den = s1 + s2;
            const int p1 = atomicAdd(cnt + 64 * e1, 1), p2 = atomicAdd(cnt + 64 * e2, 1);
            list[e1 * NROW + p1] = r; list[e2 * NROW + p2] = r;
            tokE[2 * r] = e1; tokE[2 * r + 1] = e2; tokP[2 * r] = p1; tokP[2 * r + 1] = p2; tokG[2 * r] = s1 / den; tokG[2 * r + 1] = s2 / den;
        }
        __syncthreads();
        TSF(F, 33);
    }
}

__device__ __forceinline__ int moe_tiles(const Frame& F, int l) {
    LAS int* tileEM = (LAS int*)(F.lds + LDS_TILE); LAS int* tbase = tileEM + 128;
    const int* cnt = (const int*)(F.ws + WS_CTL) + CW_CNT + l * 2048;
    __syncthreads();
    if (F.wave == 0) {
        const int n = (F.lane < NEXP) ? __hip_atomic_load(cnt + 64 * F.lane, __ATOMIC_RELAXED, __HIP_MEMORY_SCOPE_AGENT) : 0;
        const int nt = (n + 255) >> 8; int incl = nt;
#pragma unroll
        for (int o = 1; o < 64; o <<= 1) { const int t = __shfl_up(incl, o); if (F.lane >= o) incl += t; }
        const int excl = incl - nt;
        if (F.lane < NEXP) { tbase[F.lane] = excl; for (int m = 0; m < nt; ++m) tileEM[excl + m] = (F.lane << 8) | m; }
        if (F.lane == NEXP - 1) tbase[NEXP] = incl;
    }
    __syncthreads();
    return tbase[NEXP];
}

__device__ __forceinline__ void p_ffnln(const Frame& F, int l, int nrows) {
    LAS int* tbase = (LAS int*)(F.lds + LDS_TILE) + 128;
    (void)moe_tiles(F, l);
    const int gw = F.bid * NWAVES + F.wave, NGW = F.G * NWAVES;
    const float* MOD = (const float*)(F.ws + WS_MOD);
    float* XS = (float*)(F.ws + WS_XS); const bf16_t* YS = (const bf16_t*)(F.ws + WS_YS);
    const int* tokE = (const int*)(F.ws + WS_TOKE); const int* tokP = (const int*)(F.ws + WS_TOKP); const float* tokG = (const float*)(F.ws + WS_TOKG);
    const float* lg = F.in[IN_LNFG] + l * DM; const float* lb = F.in[IN_LNFB] + l * DM;
    bf16_t* H1 = (bf16_t*)(F.ws + WS_H1);
    LAS float* prm = (LAS float*)(F.lds + 65536);
    stage_vec(F, prm, lg); stage_vec(F, prm + DM, lb);
    for (int v = 0; v < 2; ++v) { stage_vec(F, prm + (2 + 3 * v) * DM, MOD + (size_t)(l * 2 + v) * 12288 + 5 * DM);
        if (l == 0) { const float* mn = MOD + (size_t)(2 + v) * 12288; stage_vec(F, prm + (3 + 3 * v) * DM, mn); stage_vec(F, prm + (4 + 3 * v) * DM, mn + DM); } }
    __syncthreads();
    int e1n = 0, e2n = 0, p1n = 0, p2n = 0; float g1n = 0.f, g2n = 0.f;
#define P9_ROUTE(rr) do { if ((rr) < nrows) { e1n = tokE[2 * (rr)]; e2n = tokE[2 * (rr) + 1]; p1n = tokP[2 * (rr)]; p2n = tokP[2 * (rr) + 1]; g1n = tokG[2 * (rr)]; g2n = tokG[2 * (rr) + 1]; } } while (0)
#define P9_LOAD(rr) do { const bf16_t* ya_ = YS + (size_t)(tbase[e1n] * 256 + p1n) * DM; const bf16_t* yb_ = YS + (size_t)(tbase[e2n] * 256 + p2n) * DM; const float* xr_ = XS + (size_t)(rr) * DM; \
        _Pragma("unroll") for (int j = 0; j < 8; ++j) { const int col = 4 * F.lane + 256 * j; nx[j] = __builtin_nontemporal_load((const f32x4*)(xr_ + col)); na[j] = __builtin_nontemporal_load((const u32x2*)(ya_ + col)); nb[j] = __builtin_nontemporal_load((const u32x2*)(yb_ + col)); } ng1 = g1n; ng2 = g2n; } while (0)
    f32x4 nx[8]; u32x2 na[8], nb[8]; float ng1 = 0.f, ng2 = 0.f;
    P9_ROUTE(gw);
    if (gw < nrows) P9_LOAD(gw);
    P9_ROUTE(gw + NGW);
    for (int r = gw; r < nrows; r += NGW) {
        const int v = r >= SEQ; const LAS float* pv = prm + (2 + 3 * v) * DM;
        f32x4 z[8];
#pragma unroll
        for (int j = 0; j < 8; ++j) { const int col = 4 * F.lane + 256 * j; const u32x2 qa = na[j], qb = nb[j];
            const f32x4 fa = {bf2f((bf16_t)(qa.x & 0xffffu)), bf2f((bf16_t)(qa.x >> 16)), bf2f((bf16_t)(qa.y & 0xffffu)), bf2f((bf16_t)(qa.y >> 16))};
            const f32x4 fb = {bf2f((bf16_t)(qb.x & 0xffffu)), bf2f((bf16_t)(qb.x >> 16)), bf2f((bf16_t)(qb.y & 0xffffu)), bf2f((bf16_t)(qb.y >> 16))};
            const f32x4 y = ng1 * fa + ng2 * fb;
            z[j] = ALPHA * nx[j] + *(const LAS f32x4*)(pv + col) * y; }
        if (r + NGW < nrows) P9_LOAD(r + NGW);
        P9_ROUTE(r + 2 * NGW);
        float mean, rstd; ln_stats(z, mean, rstd);
#pragma unroll
        for (int j = 0; j < 8; ++j) { const int col = 4 * F.lane + 256 * j; z[j] = (z[j] - mean) * rstd * *(const LAS f32x4*)(prm + col) + *(const LAS f32x4*)(prm + DM + col); }
        if (l == 1) {
#pragma unroll
            for (int j = 0; j < 8; ++j) *(f32x4*)(F.out + (size_t)r * DM + 4 * F.lane + 256 * j) = z[j];
        } else {
#pragma unroll
            for (int j = 0; j < 8; ++j) *(f32x4*)(XS + (size_t)r * DM + 4 * F.lane + 256 * j) = z[j];
            float mean2, rstd2; ln_stats(z, mean2, rstd2);
#pragma unroll
            for (int j = 0; j < 8; ++j) { const int col = 4 * F.lane + 256 * j; const f32x4 h = (z[j] - mean2) * rstd2 * (1.0f + *(const LAS f32x4*)(pv + 2 * DM + col)) + *(const LAS f32x4*)(pv + DM + col);
                *(u32x2*)(H1 + (size_t)r * DM + col) = pack4(h); }
        }
    }
#undef P9_ROUTE
#undef P9_LOAD
}


__global__ void __launch_bounds__(NTHR, 2) fwd(Args args) {
    extern __shared__ __attribute__((aligned(16))) unsigned char lds_raw[];
    Frame F0;
    F0.lds = (LAS unsigned char*)lds_raw; F0.tid = threadIdx.x; F0.lane = F0.tid & 63; F0.wave = __builtin_amdgcn_readfirstlane(F0.tid >> 6);
    F0.G = gridDim.x; F0.bid = blockIdx.x; F0.in = args.in; F0.out = args.out; F0.ws = args.ws;
    volatile LAS unsigned* MISC = (volatile LAS unsigned*)(F0.lds + LDS_MISC);
    if (F0.tid < 4) MISC[F0.tid] = 0u;
    __syncthreads();
    const int lo = args.ph_lo, hi = args.ph_hi;
    XcdBarrier bar; bar.bar = (unsigned*)(F0.ws + WS_CTL) + CW_BAR; bar.x = 0; bar.st = MISC;
    if (hi - lo > 1) bar = xcd_barrier_post((unsigned*)(F0.ws + WS_CTL) + CW_BAR, MISC);
#ifndef REP_PH
#define REP_PH -1
#endif
#define NREP(j) (((REP_PH) == (j)) ? rep1 + 1 : 1)
#if defined(ONLY_PH)
#define PHON(j) ((j) == ONLY_PH)
#elif defined(PH_MASK)
#define PHON(j) (((PH_MASK) >> (j)) & 1)
#else
#define PHON(j) true
#endif
#ifdef TSEL_A
#define TS(i) do { if (F0.bid == 0 && F0.tid == 0) __hip_atomic_store((unsigned long long*)(F0.ws + WS_CTL + 131072) + (i), (unsigned long long)__builtin_amdgcn_s_memrealtime(), __ATOMIC_RELAXED, __HIP_MEMORY_SCOPE_AGENT); } while (0)
#else
#define TS(i) do { } while (0)
#endif
#define IN(k) (lo <= (k) && (k) < hi)
#define SEAM(k) do { if (IN(k) && IN((k) + 1)) xcd_barrier(bar); } while (0)
    TS(0);
    int rep1 = 1; asm volatile("" : "+s"(rep1));
    if (PHON(0) && IN(0)) for (int rep = 0; rep < NREP(0); ++rep) { { const Frame F = launder(F0); p0_mod(F); } { const Frame F = launder(F0); p0_transposes(F); } { const Frame F = launder(F0); p0_rope(F); } }
    SEAM(0); TS(1);
    if (PHON(1) && IN(1)) for (int rep = 0; rep < NREP(1); ++rep) { const Frame F = launder(F0); p_modulate1(F, 0, NROW); }
    SEAM(1); TS(2);
#pragma unroll 1
    for (int l = 0; l < 2; ++l) {
        const int pb = 2 + 8 * l; const int tb = 3 + 10 * l; (void)tb;
        const int nlat = (l == 0) ? NROW : SEQ;
        if (PHON(2) && IN(pb + 0)) for (int rep = 0; rep < NREP(2); ++rep) {
            const bool split = F0.G >= 256; const int gc = split ? NC_IN : F0.G;
            if (F0.bid < gc) {
                pg8::StaticOrder S; S.init(NROW, INW, DM, (const bf16_t*)(F0.ws + WS_WIN) + (size_t)l * INW * DM, gc, F0.bid);
                { const Frame F = launder(F0);
                  pg8::EpiBf<true> E{(bf16_t*)(F.ws + WS_PROJ), INW, (bf16_t*)(F.ws + WS_KV)};
                  pg8::gemm_phase(F.lds, F.tid, (const bf16_t*)(F.ws + WS_H1), DM, S, E); }
                asm volatile("s_waitcnt vmcnt(0)" ::: "memory"); __syncthreads();
                { const Frame F = launder(F0);
                  pg8::Unit u; for (int i = 0; S.next(i, u); ++i) if (u.pn >= 10 && u.pn <= 14) rms_rope_tile(F, l, u.pm * 256, u.pn); }
            } else { const Frame F = launder(F0); if (l == 0) conv_range(F, gc, 0, CV_A0); else conv_range(F, gc, CV_LAYER + CV_B1, CV_L1F - CV_B1); }
        }
        SEAM(pb + 0); TS(tb + 0); TS(tb + 1);
        if (IN(pb + 2)) { if (PHON(4)) for (int rep = 0; rep < NREP(4); ++rep) { const Frame F = launder(F0); p_att_dense(F, l); } TS(tb + 2); if (PHON(10)) for (int rep = 0; rep < NREP(10); ++rep) { const Frame F = launder(F0); p_att_na(F, l); } TS(tb + 3); if (PHON(11)) for (int rep = 0; rep < NREP(11); ++rep) { const Frame F = launder(F0); p_att_sg(F, l); }
            if (F0.G >= 256 && F0.bid >= 128) { const Frame F = launder(F0); conv_range(F, 128, l == 0 ? CV_L0F : CV_LAYER + CV_L1F, CV_ATT); } }
        SEAM(pb + 2); TS(tb + 4);
        if (PHON(5) && IN(pb + 3)) for (int rep = 0; rep < NREP(5); ++rep) { const Frame F = launder(F0);
            const bool split = (l == 0) && F.G >= 256; const int gc = split ? NC_OUT : F.G;
            if (F.bid < gc) {
                pg8::StaticOrder S; S.init(nlat, DM, DM, (const bf16_t*)(F.ws + WS_WOUT) + (size_t)l * DM * DM, gc, F.bid);
                pg8::EpiBf<false> E{(bf16_t*)(F.ws + WS_Y1), DM, nullptr};
                pg8::gemm_phase(F.lds, F.tid, (const bf16_t*)(F.ws + WS_MIX), DM, S, E);
            } else conv_range(F, gc, CV_A0, CV_L0F - CV_A0);
        }
        SEAM(pb + 3); TS(tb + 5);
        if (PHON(6) && IN(pb + 4)) { const Frame F = launder(F0); p_mixln_router(F, l, nlat); }
        SEAM(pb + 4); TS(tb + 6);
        if (PHON(7) && IN(pb + 5)) for (int rep = 0; rep < NREP(7); ++rep) { const Frame F = launder(F0);
            const bool split = (l == 0) && F.G >= 256; const int gc = split ? NC_MOE : F.G;
            if (F.bid < gc) {
                const int ntiles = moe_tiles(F, l);
                pg8::MoeOrder<true> S{(const LAS int*)(F.lds + LDS_TILE), ntiles, gc, F.bid, DM, (const int*)(F.ws + WS_LIST), (const int*)(F.ws + WS_CTL) + CW_CNT + l * 2048,
                                      (const bf16_t*)(F.ws + WS_WGU) + (size_t)l * NEXP * 2048 * DM};
                pg8::EpiSwiGLU E{(bf16_t*)(F.ws + WS_GA)};
                pg8::gemm_phase(F.lds, F.tid, (const bf16_t*)(F.ws + WS_H2), DM, S, E);
            } else conv_range(F, gc, CV_LAYER, CV_B0);
        }
        SEAM(pb + 5); TS(tb + 7);
        if (PHON(8) && IN(pb + 6)) for (int rep = 0; rep < NREP(8); ++rep) { const Frame F = launder(F0);
            const bool split = (l == 0) && F.G >= 256; const int gc = split ? NC_MOE : F.G;
            if (F.bid < gc) {
                const int ntiles = moe_tiles(F, l);
                pg8::MoeOrder<false> S{(const LAS int*)(F.lds + LDS_TILE), ntiles, gc, F.bid, DEXP, nullptr, nullptr, (const bf16_t*)(F.ws + WS_WD) + (size_t)l * NEXP * DM * DEXP};
                pg8::EpiBf<false> E{(bf16_t*)(F.ws + WS_YS), DM, nullptr};
                pg8::gemm_phase(F.lds, F.tid, (const bf16_t*)(F.ws + WS_GA), DEXP, S, E);
            } else conv_range(F, gc, CV_LAYER + CV_B0, CV_B1 - CV_B0);
        }
        SEAM(pb + 6); TS(tb + 8);
        if (PHON(9) && IN(pb + 7)) { const Frame F = launder(F0); p_ffnln(F, l, nlat); }
        SEAM(pb + 7);
#ifdef TSEL_A
        if (l == 1) xcd_barrier(bar);
#endif
        TS(tb + 9);
    }
#ifdef TSEL_A
    {
        unsigned long long* ts = (unsigned long long*)(F0.ws + WS_CTL + 131072);
        if (F0.bid == 0 && F0.tid == 0) {
            unsigned long long a0 = 0, a1 = 0, b0 = 0, b1 = 0;
            a0 = __hip_atomic_load(ts + TSEL_A - 1, __ATOMIC_RELAXED, __HIP_MEMORY_SCOPE_AGENT); a1 = __hip_atomic_load(ts + TSEL_A2, __ATOMIC_RELAXED, __HIP_MEMORY_SCOPE_AGENT);
            b0 = __hip_atomic_load(ts + TSEL_B - 1, __ATOMIC_RELAXED, __HIP_MEMORY_SCOPE_AGENT); b1 = __hip_atomic_load(ts + TSEL_B2, __ATOMIC_RELAXED, __HIP_MEMORY_SCOPE_AGENT);
            const float ua = (float)(a1 - a0) * 0.01f, ub = (float)(b1 - b0) * 0.01f;
            int n1 = (int)(ua * 8.192f); n1 = n1 > 8100 ? 8100 : n1; n1 = 0;
            __hip_atomic_store((unsigned*)(ts + 64), (unsigned)n1, __ATOMIC_RELAXED, __HIP_MEMORY_SCOPE_AGENT);
            __hip_atomic_store((unsigned*)(ts + 65), __float_as_uint(ub * 0.5f), __ATOMIC_RELAXED, __HIP_MEMORY_SCOPE_AGENT);
        }
        xcd_barrier(bar);
        const int n1 = (int)__hip_atomic_load((unsigned*)(ts + 64), __ATOMIC_RELAXED, __HIP_MEMORY_SCOPE_AGENT);
        const float V = __uint_as_float(__hip_atomic_load((unsigned*)(ts + 65), __ATOMIC_RELAXED, __HIP_MEMORY_SCOPE_AGENT));
        const int gw = F0.bid * NWAVES + F0.wave, NGW = F0.G * NWAVES;
        for (int r = gw; r < n1; r += NGW) for (int j = 0; j < 8; ++j) *(f32x4*)(F0.out + (size_t)r * DM + 4 * F0.lane + 256 * j) = (f32x4){0.f, 0.f, 0.f, 0.f};
        asm volatile("s_waitcnt vmcnt(0)" ::: "memory");
        if (F0.bid == 0 && F0.tid == 0) F0.out[0] = V;
    }
#endif
#undef IN
#undef SEAM
}


extern "C" void kernel_launch(void* const* d_in, const int* in_sizes, int n_in, void* d_out, int out_size, void* d_ws, size_t ws_size, hipStream_t stream) {
    static int grid = 0;
    if (grid == 0) {
        if (n_in != 24 || out_size != SEQ * DM || ws_size < WS_END) { fprintf(stderr, "kernel_launch: unexpected shapes (n_in %d out %d ws %zu)\n", n_in, out_size, ws_size); grid = -1; return; }
        int dev = 0, cus = 0, per_cu = 0;
        if (hipGetDevice(&dev) != hipSuccess || hipDeviceGetAttribute(&cus, hipDeviceAttributeMultiprocessorCount, dev) != hipSuccess) { grid = -1; return; }
        if (hipFuncSetAttribute((const void*)fwd, hipFuncAttributeMaxDynamicSharedMemorySize, LDS_BYTES) != hipSuccess) { fprintf(stderr, "kernel_launch: hipFuncSetAttribute failed\n"); grid = -1; return; }
        if (hipOccupancyMaxActiveBlocksPerMultiprocessor(&per_cu, (const void*)fwd, NTHR, LDS_BYTES) != hipSuccess || per_cu < 1) { fprintf(stderr, "kernel_launch: occupancy query says %d\n", per_cu); }
        (void)hipGetLastError();
        grid = cus;
    }
    if (grid < 0) return;
    (void)hipMemsetAsync((char*)d_ws + WS_CTL, 0, CTL_ZERO_BYTES, stream);
    Args a{};
    for (int i = 0; i < 24; ++i) a.in[i] = (const float*)d_in[i];
    a.out = (float*)d_out; a.ws = (unsigned char*)d_ws;
#if MK_ONE_LAUNCH
    a.ph_lo = 0; a.ph_hi = NPH;
    hipLaunchKernelGGL(fwd, dim3(grid), dim3(NTHR), LDS_BYTES, stream, a);

#else
    for (int k = 0; k < NPH; ++k) { a.ph_lo = k; a.ph_hi = k + 1; hipLaunchKernelGGL(fwd, dim3(grid), dim3(NTHR), LDS_BYTES, stream, a); }
#endif
}
```

```cpp
#include <hip/hip_runtime.h>
#include <cstdio>
#include <cstdint>

#ifndef MK_ONE_LAUNCH
#define MK_ONE_LAUNCH 1
#endif

constexpr int DM = 2048, SEQ = 8192, CTXL = 256, NROW = SEQ + CTXL;
constexpr int INW = 4096, NEXP = 32, DEXP = 1024, GRIDW = 64;
constexpr float ALPHA = 1.41421356237309515f;
constexpr float LN_EPS = 1e-6f;
constexpr int NPH = 18;
constexpr int MOE_CAP_TILES = 98;
constexpr int NWAVES = 8, NTHR = 512;

constexpr size_t MiB = 1u << 20;
constexpr size_t WS_CTL = 0, CTL_ZERO_BYTES = 1 * MiB;
constexpr size_t WS_MOD = 1 * MiB;
constexpr size_t WS_ROPE = 1 * MiB + 256 * 1024;
constexpr size_t WS_RWT = 1 * MiB + 512 * 1024;
constexpr size_t WS_TOKE = 2 * MiB;
constexpr size_t WS_TOKP = WS_TOKE + 128 * 1024;
constexpr size_t WS_TOKG = WS_TOKP + 128 * 1024;
constexpr size_t WS_LIST = 3 * MiB;
constexpr size_t WS_WIN = 8 * MiB;
constexpr size_t WS_WOUT = 40 * MiB;
constexpr size_t WS_WGU = 64 * MiB;
constexpr size_t WS_WD = 576 * MiB;
constexpr size_t WS_H1 = 832 * MiB;
constexpr size_t WS_PROJ = 866 * MiB;
constexpr size_t WS_MIX = 932 * MiB;
constexpr size_t WS_Y1 = 966 * MiB;
constexpr size_t WS_XS = 1032 * MiB;
constexpr size_t WS_H2 = 1098 * MiB;
constexpr size_t WS_GA = 1132 * MiB;
constexpr size_t WS_YS = 1182 * MiB;
constexpr size_t WS_H2L = 1378 * MiB;
constexpr size_t WS_KV = 1412 * MiB;
constexpr size_t WS_CKV = 1424 * MiB;
constexpr size_t WS_END = 1426 * MiB;
constexpr int CW_BAR = 4096;
constexpr int CW_CNT = 8192;
constexpr int LDS_PART = 131072;
constexpr int LDS_SC = 147456;
constexpr int LDS_TILE = 151552;
constexpr int LDS_MISC = 153600;
constexpr int LDS_BYTES = 155648;

#define GAS __attribute__((address_space(1)))
#define LAS __attribute__((address_space(3)))
typedef unsigned short bf16_t;
typedef float f32x4 __attribute__((ext_vector_type(4)));
typedef float f32x2 __attribute__((ext_vector_type(2)));
typedef float f32x16 __attribute__((ext_vector_type(16)));
typedef short bf16x8 __attribute__((ext_vector_type(8)));
typedef short s16x4 __attribute__((ext_vector_type(4)));
typedef unsigned u32x4 __attribute__((ext_vector_type(4)));
typedef unsigned u32x2 __attribute__((ext_vector_type(2)));

__device__ __forceinline__ unsigned cvt_pk_bf16(float lo, float hi) { unsigned r; asm volatile("v_cvt_pk_bf16_f32 %0, %1, %2" : "=v"(r) : "v"(lo), "v"(hi)); return r; }
__device__ __forceinline__ bf16_t f2bf(float f) { unsigned u = __builtin_bit_cast(unsigned, f); return (bf16_t)((u + 0x7fffu + ((u >> 16) & 1u)) >> 16); }
__device__ __forceinline__ float bf2f(bf16_t b) { return __builtin_bit_cast(float, ((unsigned)b) << 16); }
__device__ __forceinline__ u32x2 pack4(f32x4 v) { u32x2 o; o.x = cvt_pk_bf16(v.x, v.y); o.y = cvt_pk_bf16(v.z, v.w); return o; }
template <int CTRL> __device__ __forceinline__ float dpp_mov(float v) { return __builtin_bit_cast(float, __builtin_amdgcn_update_dpp(0, __builtin_bit_cast(int, v), CTRL, 0xF, 0xF, true)); }
__device__ __forceinline__ float quad_sum(float v) { v += dpp_mov<0xB1>(v); v += dpp_mov<0x4E>(v); return v; }
__device__ __forceinline__ float wave_sum(float v) {
    v += dpp_mov<0xB1>(v); v += dpp_mov<0x4E>(v); v += dpp_mov<0x141>(v); v += dpp_mov<0x140>(v);
    const float s0 = __builtin_bit_cast(float, __builtin_amdgcn_readlane(__builtin_bit_cast(int, v), 0)), s1 = __builtin_bit_cast(float, __builtin_amdgcn_readlane(__builtin_bit_cast(int, v), 16));
    const float s2 = __builtin_bit_cast(float, __builtin_amdgcn_readlane(__builtin_bit_cast(int, v), 32)), s3 = __builtin_bit_cast(float, __builtin_amdgcn_readlane(__builtin_bit_cast(int, v), 48));
    return (s0 + s1) + (s2 + s3);
}
__device__ __forceinline__ float sigmoidf_(float x) { return 1.0f / (1.0f + expf(-x)); }
__device__ __forceinline__ float gelu_tanh_fast(float x) { const float u = x * (1.0f + 0.044715f * x * x) * 1.5957691216057308f; return x * __builtin_amdgcn_rcpf(1.0f + __expf(-u)); }
__device__ __forceinline__ float silu_fast(float x) { return x * __builtin_amdgcn_rcpf(1.0f + __expf(-x)); }

#define XB_TMO      128
#define XB_XCNT(j)  (256  + 64 * (j))
#define XB_XSUB(j)  (1280 + 64 * (j))
#define XB_XGEN(j)  (2304 + 64 * (j))
#define XB_TOP      3328
#define XB_TOPGEN   3392
#define XCD_BAR_WORDS 3456
#define XB_SPIN_CAP (1u << 20)
__device__ __forceinline__ unsigned xb_ld(unsigned* p)              { return __hip_atomic_load(p, __ATOMIC_RELAXED, __HIP_MEMORY_SCOPE_AGENT); }
__device__ __forceinline__ unsigned xb_add(unsigned* p, unsigned v) { return __hip_atomic_fetch_add(p, v, __ATOMIC_RELAXED, __HIP_MEMORY_SCOPE_AGENT); }
__device__ __forceinline__ unsigned xb_xcc_id() { return (unsigned)__builtin_amdgcn_s_getreg((3 << 11) | 20) & 0xFu; }
#define XB_SPIN(cond, bar) do { unsigned _sp = 0; while (cond) { __builtin_amdgcn_s_sleep(1); \
    if ((++_sp & 255u) == 0u) { if (xb_ld(&(bar)[XB_TMO])) break; if (_sp > XB_SPIN_CAP) { atomicAdd(&(bar)[XB_TMO], 1u); break; } } } } while (0)
struct XcdBarrier { unsigned* bar; unsigned x; volatile LAS unsigned* st; };
__device__ __forceinline__ XcdBarrier xcd_barrier_post(unsigned* bar, volatile LAS unsigned* st) {
    XcdBarrier b; b.bar = bar; b.x = xb_xcc_id(); b.st = st;
    if (threadIdx.x == 0) (void)xb_add(&bar[XB_XCNT(b.x)], 1u);
    return b;
}
__device__ __forceinline__ void xcd_barrier_complete(unsigned* bar, unsigned x, unsigned& nloc, unsigned& nx) {
    const unsigned G = gridDim.x * gridDim.y * gridDim.z;
    unsigned sum, cnt, mine, sp = 0u;
    for (;;) {
        sum = 0u; cnt = 0u; mine = 0u;
#pragma unroll
        for (unsigned j = 0; j < 16; ++j) { const unsigned c = xb_ld(&bar[XB_XCNT(j)]); sum += c; cnt += (c > 0u) ? 1u : 0u; mine = (j == x) ? c : mine; }
        if (sum == G) break;
        __builtin_amdgcn_s_sleep(1);
        if ((++sp & 255u) == 0u) { if (xb_ld(&bar[XB_TMO])) break; if (sp > XB_SPIN_CAP) { atomicAdd(&bar[XB_TMO], 1u); break; } }
    }
    nloc = mine > 0u ? mine : 1u; nx = cnt > 0u ? cnt : 1u;
}
__device__ __forceinline__ void xcd_barrier(const XcdBarrier& b) {
    asm volatile("s_waitcnt vmcnt(0)" ::: "memory");
    __syncthreads();
    if (threadIdx.x == 0) {
        unsigned* bar = b.bar;
        __builtin_amdgcn_s_waitcnt(0);
        unsigned nloc = b.st[0], nx = b.st[1];
        if (nloc == 0u) { xcd_barrier_complete(bar, b.x, nloc, nx); b.st[0] = nloc; b.st[1] = nx; }
        const unsigned old = xb_add(&bar[XB_XSUB(b.x)], 1u);
        const unsigned gen = old / nloc;
        if (old + 1u == (gen + 1u) * nloc) {
            __builtin_amdgcn_fence(__ATOMIC_RELEASE, "agent");
            asm volatile("s_waitcnt vmcnt(0)" ::: "memory");
            const unsigned og = xb_add(&bar[XB_TOP], 1u);
            const unsigned tg = og / nx;
            if (og + 1u == (tg + 1u) * nx) xb_add(&bar[XB_TOPGEN], 1u);
            else XB_SPIN(xb_ld(&bar[XB_TOPGEN]) == tg, bar);
            __builtin_amdgcn_fence(__ATOMIC_ACQUIRE, "agent");
            xb_add(&bar[XB_XGEN(b.x)], 1u);
            asm volatile("s_waitcnt vmcnt(0)" ::: "memory");
        } else {
            XB_SPIN(xb_ld(&bar[XB_XGEN(b.x)]) == gen, bar);
            __builtin_amdgcn_fence(__ATOMIC_ACQUIRE, "agent");
            asm volatile("s_waitcnt vmcnt(0)" ::: "memory");
        }
    }
    __syncthreads();
}

struct Args { const float* in[24]; float* out; unsigned char* ws; int ph_lo, ph_hi; };
struct Frame {
    LAS unsigned char* lds;
    int tid, lane, wave, G, bid;
    const float* const* in;
    float* out; unsigned char* ws;
};
__device__ __forceinline__ Frame launder(const Frame& F0) {
    Frame F = F0; int t = F0.tid; asm volatile("" : "+v"(t)); F.tid = t; F.lane = t & 63; F.wave = __builtin_amdgcn_readfirstlane(t >> 6);
    unsigned long long w = (unsigned long long)F0.ws; asm volatile("" : "+s"(w)); F.ws = (unsigned char*)(GAS unsigned char*)w;
    unsigned l = (unsigned)(uintptr_t)F0.lds; asm volatile("" : "+s"(l)); F.lds = (LAS unsigned char*)(uintptr_t)l;
    int g = F0.G, b = F0.bid; asm volatile("" : "+s"(g), "+s"(b)); F.G = g; F.bid = b;
    return F;
}
#define IN_X 0
#define IN_C 1
#define IN_CTX 2
#define IN_CCTX 3
#define IN_ADAW 4
#define IN_ADAB 5
#define IN_WIN 6
#define IN_RPB 7
#define IN_SGLNG 8
#define IN_SGLNB 9
#define IN_SGW 10
#define IN_SGB 11
#define IN_QNG 12
#define IN_KNG 13
#define IN_WOUT 14
#define IN_LNMG 15
#define IN_LNMB 16
#define IN_RW 17
#define IN_RB 18
#define IN_WG 19
#define IN_WU 20
#define IN_WDN 21
#define IN_LNFG 22
#define IN_LNFB 23

__device__ __forceinline__ void p0_mod(const Frame& F) {
    LAS float* sl = (LAS float*)F.lds;
    LAS float* red = sl + 4096;
    const float* c = F.in[IN_C]; const float* cc = F.in[IN_CCTX];
    for (int t = F.tid; t < DM; t += NTHR) { const float a = c[t]; sl[t] = a * sigmoidf_(a); const float b = cc[t]; sl[DM + t] = b * sigmoidf_(b); }
    __syncthreads();
    float* MOD = (float*)(F.ws + WS_MOD);
    for (int item = F.bid; item < 256; item += F.G) {
        const int l = item >> 7, nb = item & 127, col0 = nb * 96;
        f32x2 a0 = {0.f, 0.f}, a1 = {0.f, 0.f};
        if (F.lane < 48) {
            const float* wp = F.in[IN_ADAW] + (size_t)l * DM * 12288 + (size_t)(F.wave * 256) * 12288 + col0 + 2 * F.lane;
            const LAS float* s0 = sl + F.wave * 256; const LAS float* s1 = sl + DM + F.wave * 256;
#pragma unroll 8
            for (int k = 0; k < 256; ++k) { const f32x2 w = *(const f32x2*)(wp + (size_t)k * 12288); a0 += s0[k] * w; a1 += s1[k] * w; }
            red[(F.wave * 2 + 0) * 96 + 2 * F.lane] = a0.x; red[(F.wave * 2 + 0) * 96 + 2 * F.lane + 1] = a0.y;
            red[(F.wave * 2 + 1) * 96 + 2 * F.lane] = a1.x; red[(F.wave * 2 + 1) * 96 + 2 * F.lane + 1] = a1.y;
        }
        __syncthreads();
        if (F.tid < 192) { const int v = F.tid / 96, q = F.tid % 96; float s = 0.f;
#pragma unroll
            for (int w = 0; w < 8; ++w) s += red[(w * 2 + v) * 96 + q];
            MOD[(size_t)(l * 2 + v) * 12288 + col0 + q] = s + F.in[IN_ADAB][l * 12288 + col0 + q]; }
        __syncthreads();
    }
}
__device__ __forceinline__ void tr_item(const float* W, int K, int N, bf16_t* WT, int k0, int n0, int drow0, LAS float* scr, int lane) {
    f32x4 v[16];
    const float* wp = W + (size_t)(k0 + (lane >> 4)) * N + n0 + 4 * (lane & 15);
#pragma unroll
    for (int i = 0; i < 16; ++i) v[i] = __builtin_nontemporal_load((const f32x4*)(wp + (size_t)(4 * i) * N));
#pragma unroll
    for (int i = 0; i < 16; ++i) { LAS float* p = scr + (4 * i + (lane >> 4)) * 65 + 4 * (lane & 15); p[0] = v[i].x; p[1] = v[i].y; p[2] = v[i].z; p[3] = v[i].w; }
    asm volatile("s_waitcnt lgkmcnt(0)" ::: "memory");
    const int c = lane & 7;
#pragma unroll
    for (int j = 0; j < 8; ++j) { const int n = (lane >> 3) + 8 * j; const LAS float* s = scr + (8 * c) * 65 + n;
        u32x4 o; o.x = cvt_pk_bf16(s[0 * 65], s[1 * 65]); o.y = cvt_pk_bf16(s[2 * 65], s[3 * 65]); o.z = cvt_pk_bf16(s[4 * 65], s[5 * 65]); o.w = cvt_pk_bf16(s[6 * 65], s[7 * 65]);
        *(u32x4*)(WT + (size_t)(drow0 + n) * K + k0 + 8 * c) = o; }
    asm volatile("s_waitcnt lgkmcnt(0)" ::: "memory");
}
struct TrDesc { const float* src; bf16_t* dst; int N, K; };
__device__ __forceinline__ TrDesc moe_item_desc(const Frame& F, int m) {
    const int le = m / 1536, r = m % 1536, which = r >> 9, r2 = r & 511; TrDesc d;
    if (which < 2) { const int kb = r2 >> 4, nb = r2 & 15, n0 = nb * 64; d.N = DEXP; d.K = DM;
        d.src = F.in[which == 0 ? IN_WG : IN_WU] + (size_t)le * DM * DEXP + (size_t)(kb * 64) * DEXP + n0;
        d.dst = (bf16_t*)(F.ws + WS_WGU) + (size_t)le * 2048 * DM + (size_t)((n0 >> 7) * 256 + (n0 & 127) + which * 128) * DM + kb * 64; }
    else { const int kb = r2 >> 5, nb = r2 & 31; d.N = DM; d.K = DEXP;
        d.src = F.in[IN_WDN] + (size_t)le * DEXP * DM + (size_t)(kb * 64) * DM + nb * 64;
        d.dst = (bf16_t*)(F.ws + WS_WD) + (size_t)le * DM * DEXP + (size_t)(nb * 64) * DEXP + kb * 64; }
    return d;
}
__device__ __forceinline__ void tr_load64(const TrDesc& d, f32x4 (&v)[16], int lane) {
    const float* wp = d.src + (size_t)(lane >> 4) * d.N + 4 * (lane & 15);
#pragma unroll
    for (int i = 0; i < 16; ++i) v[i] = __builtin_nontemporal_load((const f32x4*)(wp + (size_t)(4 * i) * d.N));
}
__device__ __forceinline__ void tr_finish64(const TrDesc& d, const f32x4 (&v)[16], LAS float* scr, int lane) {
#pragma unroll
    for (int i = 0; i < 16; ++i) { LAS float* p = scr + (4 * i + (lane >> 4)) * 65 + 4 * (lane & 15); p[0] = v[i].x; p[1] = v[i].y; p[2] = v[i].z; p[3] = v[i].w; }
    asm volatile("s_waitcnt lgkmcnt(0)" ::: "memory");
    const int c = lane & 7;
#pragma unroll
    for (int j = 0; j < 8; ++j) { const int n = (lane >> 3) + 8 * j; const LAS float* s = scr + (8 * c) * 65 + n;
        u32x4 o; o.x = cvt_pk_bf16(s[0 * 65], s[1 * 65]); o.y = cvt_pk_bf16(s[2 * 65], s[3 * 65]); o.z = cvt_pk_bf16(s[4 * 65], s[5 * 65]); o.w = cvt_pk_bf16(s[6 * 65], s[7 * 65]);
        *(u32x4*)(d.dst + (size_t)n * d.K + 8 * c) = o; }
    asm volatile("s_waitcnt lgkmcnt(0)" ::: "memory");
}
__device__ __forceinline__ void conv_moe_item(const Frame& F, int m, LAS float* scr) {
    const TrDesc d = moe_item_desc(F, m); f32x4 v[16]; tr_load64(d, v, F.lane); tr_finish64(d, v, scr, F.lane);
}
constexpr int NC_IN = 176, NC_OUT = 192, NC_MOE = 192, NCOMP = 128  ;
constexpr int CV_LAYER = 49152;
constexpr int CV_A0 = 20480, CV_L0F = CV_A0 + 10240;
constexpr int CV_B0 = 16384, CV_B1 = CV_B0 + 10240, CV_L1F = CV_B1 + 16384;
constexpr int CV_ATT = 6144;
static_assert(CV_L0F + CV_ATT <= CV_LAYER && CV_L1F + CV_ATT <= CV_LAYER, "converter ranges");
__device__ __forceinline__ void conv_range(const Frame& F, int ncomp, int first, int count) {
    LAS float* scr = (LAS float*)(F.lds + F.wave * 16896);
    const int cw = (F.bid - ncomp) * NWAVES + F.wave, NCW = (F.G - ncomp) * NWAVES;
    f32x4 va[16], vb[16]; TrDesc d, dn;
    if (cw < count) { d = moe_item_desc(F, first + cw); tr_load64(d, va, F.lane); }
    for (int k = cw; k < count; k += NCW) {
        const int kn = k + NCW;
        if (kn < count) { dn = moe_item_desc(F, first + kn); tr_load64(dn, vb, F.lane); }
        tr_finish64(d, va, scr, F.lane);
        d = dn;
#pragma unroll
        for (int i = 0; i < 16; ++i) va[i] = vb[i];
    }
}
__device__ __forceinline__ void p0_transposes(const Frame& F) {
    LAS float* scr = (LAS float*)(F.lds + F.wave * 16896);
    const int gw = F.bid * NWAVES + F.wave, NGW = F.G * NWAVES;
    constexpr int NDENSE = 2 * 3072;
    const bool split = F.G >= 256;
    const int r0 = split ? CV_LAYER - CV_L0F - CV_ATT : CV_LAYER, r1 = split ? CV_LAYER - CV_L1F - CV_ATT : CV_LAYER;
    const int NITEMS = NDENSE + r0 + r1;
    for (int it = gw; it < NITEMS; it += NGW) {
        if (it < NDENSE) {
            const int l = it / 3072, r = it % 3072;
            if (r < 2048) { const int kb = r >> 6, nb = r & 63; tr_item(F.in[IN_WIN] + (size_t)l * DM * INW, DM, INW, (bf16_t*)(F.ws + WS_WIN) + (size_t)l * INW * DM, kb * 64, nb * 64, nb * 64, scr, F.lane); }
            else { const int r2 = r - 2048, kb = r2 >> 5, nb = r2 & 31; tr_item(F.in[IN_WOUT] + (size_t)l * DM * DM, DM, DM, (bf16_t*)(F.ws + WS_WOUT) + (size_t)l * DM * DM, kb * 64, nb * 64, nb * 64, scr, F.lane); }
        } else {
            const int q = it - NDENSE;
            const int m = q < r0 ? (CV_LAYER - r0) + q : CV_LAYER + (CV_LAYER - r1) + (q - r0);
            conv_moe_item(F, m, scr);
        }
    }
}
__device__ __forceinline__ void p0_rope(const Frame& F) {
    const int g = F.bid * NTHR + F.tid;
    if (g < 32 * DM) { const int e = g >> 11, k = g & (DM - 1); const float w = F.in[IN_RW][k * 32 + e]; const bf16_t hi = f2bf(w); const bf16_t lo = f2bf(w - bf2f(hi));
        bf16_t* T = (bf16_t*)(F.ws + WS_RWT); T[g] = hi; T[32 * DM + g] = lo; }
    if (g < 128 * 32) { const int pos = g >> 5, i = g & 31; const float inv = powf(10000.0f, -(float)i / 32.0f); const float ang = (float)pos * inv;
        float* R = (float*)(F.ws + WS_ROPE); R[2 * g] = cosf(ang); R[2 * g + 1] = sinf(ang); }
}

__device__ __forceinline__ const float* xrow_ptr(const Frame& F, int l, int r) {
    if (l == 0) return r < SEQ ? F.in[IN_X] + (size_t)r * DM : F.in[IN_CTX] + (size_t)(r - SEQ) * DM;
    return (const float*)(F.ws + WS_XS) + (size_t)r * DM;
}
__device__ __forceinline__ void ln_stats(const f32x4 (&v)[8], float& mean, float& rstd) {
    float s = 0.f;
#pragma unroll
    for (int j = 0; j < 8; ++j) s += (v[j].x + v[j].y) + (v[j].z + v[j].w);
    mean = wave_sum(s) * (1.0f / DM);
    float q = 0.f;
#pragma unroll
    for (int j = 0; j < 8; ++j) { const f32x4 d = v[j] - mean; q += (d.x * d.x + d.y * d.y) + (d.z * d.z + d.w * d.w); }
    rstd = 1.0f / sqrtf(wave_sum(q) * (1.0f / DM) + LN_EPS);
}
template <bool TO_LDS>
__device__ __forceinline__ void modulate_store(const f32x4 (&v)[8], const float* sh, const float* sc, bf16_t* orow, LAS float* lrow, int lane) {
    float mean, rstd; ln_stats(v, mean, rstd);
#pragma unroll
    for (int j = 0; j < 8; ++j) { const int col = 4 * lane + 256 * j; const f32x4 s1 = *(const f32x4*)(sc + col), s0 = *(const f32x4*)(sh + col);
        const f32x4 h = (v[j] - mean) * rstd * (1.0f + s1) + s0;
        u32x2 w; w.x = cvt_pk_bf16(h.x, h.y); w.y = cvt_pk_bf16(h.z, h.w); *(u32x2*)(orow + col) = w;
        if (TO_LDS) *(LAS f32x4*)(lrow + col) = h; }
}
__device__ __forceinline__ void stage_vec(const Frame& F, LAS float* dst, const float* src) { *(LAS f32x4*)(dst + 4 * F.tid) = *(const f32x4*)(src + 4 * F.tid); }
__device__ __forceinline__ void p_modulate1(const Frame& F, int l, int nrows) {
    const int gw = F.bid * NWAVES + F.wave, NGW = F.G * NWAVES;
    const float* MOD = (const float*)(F.ws + WS_MOD);
    bf16_t* H1 = (bf16_t*)(F.ws + WS_H1);
    LAS float* prm = (LAS float*)F.lds;
    for (int v = 0; v < 2; ++v) { const float* m = MOD + (size_t)(l * 2 + v) * 12288; stage_vec(F, prm + (2 * v) * DM, m); stage_vec(F, prm + (2 * v + 1) * DM, m + DM); }
    __syncthreads();
    f32x4 nx[8];
    if (gw < nrows) { const float* xr = xrow_ptr(F, l, gw);
#pragma unroll
        for (int j = 0; j < 8; ++j) nx[j] = *(const f32x4*)(xr + 4 * F.lane + 256 * j); }
    for (int r = gw; r < nrows; r += NGW) {
        const int v = r >= SEQ; const LAS float* pv = prm + 2 * v * DM;
        f32x4 x[8];
#pragma unroll
        for (int j = 0; j < 8; ++j) x[j] = nx[j];
        if (r + NGW < nrows) { const float* xr = xrow_ptr(F, l, r + NGW);
#pragma unroll
            for (int j = 0; j < 8; ++j) nx[j] = *(const f32x4*)(xr + 4 * F.lane + 256 * j); }
        float mean, rstd; ln_stats(x, mean, rstd);
#pragma unroll
        for (int j = 0; j < 8; ++j) { const int col = 4 * F.lane + 256 * j; const f32x4 h = (x[j] - mean) * rstd * (1.0f + *(const LAS f32x4*)(pv + DM + col)) + *(const LAS f32x4*)(pv + col);
            u32x2 w; w.x = cvt_pk_bf16(h.x, h.y); w.y = cvt_pk_bf16(h.z, h.w); *(u32x2*)(H1 + (size_t)r * DM + col) = w; }
    }
    __syncthreads();
}

namespace pg8 {
constexpr int BM = 256, BK = 64, HALF = 128, HTB = HALF * BK * 2, STAGE_BYTES = 8 * HTB, NXCD = 8, WGM = 8;
__device__ __forceinline__ int lds_byte(int r, int c) { const int st = (r >> 4) * 2 + (c >> 5), rr = r & 15, cc = c & 31, ob = rr * 64 + cc * 2; return st * 1024 + (ob ^ (((ob >> 9) & 1) << 5)); }
__device__ __forceinline__ void stage_rc(int b, int& R, int& C) { const int st = b / 1024, sb = b % 1024, swz = sb ^ (((sb >> 9) & 1) << 5); R = (st >> 1) * 16 + swz / 64; C = (st & 1) * 32 + (swz % 64) / 2; }
__device__ __forceinline__ int perm32(int rho) { const int n = rho >> 4, i = rho & 15; return 8 * (i >> 2) + 4 * n + (i & 3); }
struct Unit { int pm, pn, e, mt; };
struct StaticOrder {
    int nM, nN, nwg, G, c, K; const bf16_t* Bt;
    __device__ __forceinline__ void init(int M, int N, int K_, const bf16_t* Bt_, int G_, int c_) { nM = M / BM; nN = N / BM; nwg = nM * nN; G = G_; c = c_; K = K_; Bt = Bt_; }
    __device__ __forceinline__ bool next(int i, Unit& u) const {
        const long L = (long)i * G + c; if (L >= nwg) return false;
        int wgid = (int)L; { const int q = nwg / NXCD, r = nwg % NXCD, xcd = wgid % NXCD, off = wgid / NXCD; wgid = (xcd < r ? xcd * (q + 1) : r * (q + 1) + (xcd - r) * q) + off; }
        const int nig = WGM * nN, gid = wgid / nig, fm = gid * WGM, gsz = (nM - fm) < WGM ? (nM - fm) : WGM;
        u.pm = fm + ((wgid % nig) % gsz); u.pn = (wgid % nig) / gsz; u.e = 0; u.mt = 0; return true;
    }
    __device__ __forceinline__ unsigned a_off(const Unit& u, int h, int R) const { return (unsigned)((u.pm * BM + h * HALF + R) * K) * 2u; }
    __device__ __forceinline__ const char* b_base(const Unit& u) const { return (const char*)Bt + (size_t)u.pn * BM * K * 2; }
};
template <bool GATHER> struct MoeOrder {
    const LAS int* tileEM; int ntiles, G, c, K; const int* list; const int* cnt; const bf16_t* Bt;
    __device__ __forceinline__ bool next(int i, Unit& u) const {
        if ((G & 7) == 0) {
            const LAS int* tbase = tileEM + 128; const int x = c & 7, W = G >> 3; int q = (c >> 3) + i * W;
#pragma unroll
            for (int k = 0; k < 4; ++k) { const int e = x + 8 * k; const int tb = tbase[e], nt = tbase[e + 1] - tb; const int nu = nt * 8;
                if (q < nu) { u.e = e; u.pn = q / nt; u.mt = q - u.pn * nt; u.pm = tb + u.mt; return true; }
                q -= nu; }
            return false;
        }
        const int L = i * G + c; if (L >= ntiles * 8) return false;
        const int tile = L >> 3; const int em = tileEM[tile]; u.pm = tile; u.pn = L & 7; u.e = em >> 8; u.mt = em & 255; return true;
    }
    __device__ __forceinline__ unsigned a_off(const Unit& u, int h, int R) const {
        if (GATHER) { const int slot = u.mt * BM + h * HALF + R; const int n = cnt[64 * u.e]; int tok = 0; if (slot < n) tok = list[u.e * NROW + slot]; return (unsigned)(tok * K) * 2u; }
        return (unsigned)((u.pm * BM + h * HALF + R) * K) * 2u;
    }
    __device__ __forceinline__ const char* b_base(const Unit& u) const { return (const char*)Bt + ((size_t)u.e * 2048 + (size_t)u.pn * BM) * K * 2; }
};
struct EpiF32 {
    static constexpr bool PERM = false;
    float* C; int ldc;
    __device__ __forceinline__ void operator()(const f32x4 (&acc)[2][2][4][2], const Unit& u, int wr, int wc, int fr, int fq) const {
        const int row0 = u.pm * BM + wr * 64 + fr, col0 = u.pn * BM + wc * 32 + 4 * fq;
#pragma unroll
        for (int ai = 0; ai < 2; ++ai)
#pragma unroll
            for (int m = 0; m < 4; ++m) { float* rowp = C + (size_t)(row0 + ai * HALF + m * 16) * ldc + col0;
#pragma unroll
                for (int bj = 0; bj < 2; ++bj)
#pragma unroll
                    for (int n = 0; n < 2; ++n) *(f32x4*)(rowp + bj * HALF + n * 16) = acc[ai][bj][m][n]; }
    }
};
template <bool GELU> struct EpiBf {
    static constexpr bool PERM = true;
    bf16_t* O; int ldc; bf16_t* KV;
    __device__ __forceinline__ void operator()(const f32x4 (&acc)[2][2][4][2], const Unit& u, int wr, int wc, int fr, int fq) const {
        const int row0 = u.pm * BM + wr * 64 + fr, col0 = u.pn * BM + wc * 32 + 8 * fq; const bool g = GELU && (u.pn >= 6 && u.pn <= 9);
#pragma unroll
        for (int ai = 0; ai < 2; ++ai)
#pragma unroll
            for (int m = 0; m < 4; ++m) { bf16_t* rowp = (GELU && u.pn >= 14) ? KV + (size_t)(row0 + ai * HALF + m * 16) * 512 + (col0 - 14 * BM) : O + (size_t)(row0 + ai * HALF + m * 16) * ldc + col0;
#pragma unroll
                for (int bj = 0; bj < 2; ++bj) { f32x4 v0 = acc[ai][bj][m][0], v1 = acc[ai][bj][m][1];
                    if (g) {
#pragma unroll
                        for (int j = 0; j < 4; ++j) { v0[j] = gelu_tanh_fast(v0[j]); v1[j] = gelu_tanh_fast(v1[j]); } }
                    u32x4 w; w.x = cvt_pk_bf16(v0[0], v0[1]); w.y = cvt_pk_bf16(v0[2], v0[3]); w.z = cvt_pk_bf16(v1[0], v1[1]); w.w = cvt_pk_bf16(v1[2], v1[3]);
                    *(u32x4*)(rowp + bj * HALF) = w;
                    if (GELU && u.pm == SEQ / BM && u.pn >= 2 && u.pn <= 5)
                        *(u32x4*)(KV + (size_t)(WS_CKV - WS_KV) / 2 + (size_t)((((u.pn - 2) & 1) * 2 + bj) * 256 + (wr * 64 + fr + ai * HALF + m * 16)) * 512 + (u.pn >= 4 ? 256 : 0) + wc * 32 + 8 * fq) = w; } }
    }
};
struct EpiSwiGLU {
    static constexpr bool PERM = true;
    bf16_t* O;
    __device__ __forceinline__ void operator()(const f32x4 (&acc)[2][2][4][2], const Unit& u, int wr, int wc, int fr, int fq) const {
        const int row0 = u.pm * BM + wr * 64 + fr, col0 = u.pn * HALF + wc * 32 + 8 * fq;
#pragma unroll
        for (int ai = 0; ai < 2; ++ai)
#pragma unroll
            for (int m = 0; m < 4; ++m) { bf16_t* rowp = O + (size_t)(row0 + ai * HALF + m * 16) * DEXP + col0;
                f32x4 v0, v1;
#pragma unroll
                for (int j = 0; j < 4; ++j) { v0[j] = silu_fast(acc[ai][0][m][0][j]) * acc[ai][1][m][0][j]; v1[j] = silu_fast(acc[ai][0][m][1][j]) * acc[ai][1][m][1][j]; }
                u32x4 w; w.x = cvt_pk_bf16(v0[0], v0[1]); w.y = cvt_pk_bf16(v0[2], v0[3]); w.z = cvt_pk_bf16(v1[0], v1[1]); w.w = cvt_pk_bf16(v1[2], v1[3]);
                *(u32x4*)rowp = w; }
    }
};

template <class Epi, class Sched>
__device__ __forceinline__ void gemm_phase(LAS unsigned char* lds, int tid, const bf16_t* Amat, int K, const Sched& S, const Epi& E) {
    const int wid = __builtin_amdgcn_readfirstlane(tid >> 6), lane = tid & 63, wr = wid >> 2, wc = wid & 3, fr = lane & 15, fq = lane >> 4;
    const int nt = K / BK;
    int Rl[2], Cl[2]; unsigned voffB[2];
#pragma unroll
    for (int i = 0; i < 2; ++i) { int R, C; stage_rc(tid * 16 + i * 8192, R, C); Rl[i] = R; Cl[i] = C; const int Rb = Epi::PERM ? ((R & ~31) + perm32(R & 31)) : R; voffB[i] = (unsigned)(Rb * K + C) * 2u; }
    const size_t kstep = (size_t)(BK * 2);
    const size_t hstep = (size_t)HALF * K * 2;
    const unsigned ldsw = (unsigned)wid * 1024u;
    const int aoff = lds_byte(wr * 64 + fr, fq * 8), boff = lds_byte(wc * 32 + fr, fq * 8);
    const char* Ab = (const char*)Amat;
#define PG8_SA(b, h) (((b) * 2 + (h)) * HTB)
#define PG8_SB(b, h) ((4 + (b) * 2 + (h)) * HTB)
#define PG8_STAGE(bufoff, gbase, voff) do { _Pragma("unroll") for (int _i = 0; _i < 2; ++_i) \
        __builtin_amdgcn_global_load_lds((const unsigned*)((const char*)(gbase) + (voff)[_i]), (LAS unsigned*)(lds + (bufoff) + ldsw + _i * 8192), 16, 0, 0); } while (0)
#define PG8_LDA(dst, b, h) do { _Pragma("unroll") for (int m = 0; m < 4; ++m) _Pragma("unroll") for (int k = 0; k < 2; ++k) dst[m][k] = *(const LAS bf16x8*)(lds + PG8_SA(b, h) + aoff + m * 2048 + k * 1024); } while (0)
#define PG8_LDB(dst, b, h) do { _Pragma("unroll") for (int n = 0; n < 2; ++n) _Pragma("unroll") for (int k = 0; k < 2; ++k) dst[n][k] = *(const LAS bf16x8*)(lds + PG8_SB(b, h) + boff + n * 2048 + k * 1024); } while (0)
#define PG8_MMA(ai, bj, At, Bt) do { __builtin_amdgcn_s_setprio(1); _Pragma("unroll") for (int m = 0; m < 4; ++m) _Pragma("unroll") for (int n = 0; n < 2; ++n) _Pragma("unroll") for (int k = 0; k < 2; ++k) \
        acc[ai][bj][m][n] = __builtin_amdgcn_mfma_f32_16x16x32_bf16(Bt[n][k], At[m][k], acc[ai][bj][m][n], 0, 0, 0); __builtin_amdgcn_s_setprio(0); } while (0)
#define PG8_WAIT_V(n) asm volatile("s_waitcnt vmcnt(" #n ")" ::: "memory")
#define PG8_WAIT_L(n) asm volatile("s_waitcnt lgkmcnt(" #n ")" ::: "memory")
#define PG8_BAR __builtin_amdgcn_s_barrier()
#define PG8_SCHED __builtin_amdgcn_sched_barrier(0)
#define PG8_AOFFS(dst, u) do { _Pragma("unroll") for (int _h = 0; _h < 2; ++_h) _Pragma("unroll") for (int _i = 0; _i < 2; ++_i) dst[_h][_i] = S.a_off(u, _h, Rl[_i]) + (unsigned)Cl[_i] * 2u; \
        asm volatile("" : "+v"(dst[0][0]), "+v"(dst[0][1]), "+v"(dst[1][0]), "+v"(dst[1][1])); } while (0)
    Unit cur, nxt; int ui = 0;
    if (!S.next(0, cur)) return;
    f32x4 acc[2][2][4][2];
#pragma unroll
    for (int a = 0; a < 2; ++a)
#pragma unroll
        for (int b = 0; b < 2; ++b)
#pragma unroll
            for (int m = 0; m < 4; ++m)
#pragma unroll
                for (int n = 0; n < 2; ++n) acc[a][b][m][n] = (f32x4){0.f, 0.f, 0.f, 0.f};
    bf16x8 At[4][2], B0[2][2], B1[2][2];
    unsigned vA[2][2], vAn[2][2];
    PG8_AOFFS(vA, cur);
    const char* cB = S.b_base(cur);
    PG8_STAGE(PG8_SB(0, 0), cB, voffB); PG8_STAGE(PG8_SA(0, 0), Ab, vA[0]); PG8_STAGE(PG8_SB(0, 1), cB + hstep, voffB); PG8_STAGE(PG8_SA(0, 1), Ab, vA[1]);
    if (wr == 1) PG8_BAR;
    PG8_WAIT_V(4); PG8_BAR;
    PG8_STAGE(PG8_SB(1, 0), cB + kstep, voffB); PG8_STAGE(PG8_SA(1, 0), Ab + kstep, vA[0]); PG8_STAGE(PG8_SB(1, 1), cB + hstep + kstep, voffB);
    PG8_WAIT_V(6); PG8_BAR;
    for (;;) {
        const bool has_next = S.next(ui + 1, nxt);
        const char* nB = cB;
        if (has_next) { PG8_AOFFS(vAn, nxt); nB = S.b_base(nxt); }
        else {
#pragma unroll
            for (int h = 0; h < 2; ++h)
#pragma unroll
                for (int i = 0; i < 2; ++i) vAn[h][i] = vA[h][i]; }
        for (int t = 0; t < nt; t += 2) {
            const bool last = (t == nt - 2);
            const char* a1 = Ab + (size_t)(t + 1) * kstep;
            const char* a2 = last ? Ab : Ab + (size_t)(t + 2) * kstep; const char* b2 = last ? nB : cB + (size_t)(t + 2) * kstep;
            const char* a3 = a2 + kstep; const char* b3 = b2 + kstep;
            unsigned o2[2][2];
#pragma unroll
            for (int h = 0; h < 2; ++h)
#pragma unroll
                for (int i = 0; i < 2; ++i) o2[h][i] = last ? vAn[h][i] : vA[h][i];
            PG8_LDB(B0, 0, 0); PG8_SCHED; PG8_LDA(At, 0, 0); PG8_STAGE(PG8_SA(1, 1), a1, vA[1]);
            PG8_WAIT_L(8); PG8_BAR; PG8_WAIT_L(0); PG8_MMA(0, 0, At, B0); PG8_BAR; PG8_SCHED;
            PG8_LDB(B1, 0, 1); PG8_STAGE(PG8_SB(0, 0), b2, voffB);
            PG8_BAR; PG8_WAIT_L(0); PG8_MMA(0, 1, At, B1); PG8_BAR;
            PG8_LDA(At, 0, 1); PG8_STAGE(PG8_SA(0, 0), a2, o2[0]);
            PG8_BAR; PG8_WAIT_L(0); PG8_MMA(1, 0, At, B0); PG8_BAR; PG8_SCHED;
            PG8_STAGE(PG8_SB(0, 1), b2 + hstep, voffB);
            PG8_WAIT_V(6); PG8_BAR; PG8_MMA(1, 1, At, B1); PG8_BAR;
            PG8_LDB(B0, 1, 0); PG8_SCHED; PG8_LDA(At, 1, 0); PG8_STAGE(PG8_SA(0, 1), a2, o2[1]);
            PG8_WAIT_L(8); PG8_BAR; PG8_WAIT_L(0); PG8_MMA(0, 0, At, B0); PG8_BAR; PG8_SCHED;
            PG8_LDB(B1, 1, 1); PG8_STAGE(PG8_SB(1, 0), b3, voffB);
            PG8_BAR; PG8_WAIT_L(0); PG8_MMA(0, 1, At, B1); PG8_BAR;
            PG8_LDA(At, 1, 1); PG8_STAGE(PG8_SA(1, 0), a3, o2[0]);
            PG8_BAR; PG8_WAIT_L(0); PG8_MMA(1, 0, At, B0); PG8_BAR; PG8_SCHED;
            PG8_STAGE(PG8_SB(1, 1), b3 + hstep, voffB);
            PG8_WAIT_V(6); PG8_BAR; PG8_MMA(1, 1, At, B1); PG8_BAR;
        }
        E(acc, cur, wr, wc, fr, fq);
        if (!has_next) break;
#pragma unroll
        for (int a = 0; a < 2; ++a)
#pragma unroll
            for (int b = 0; b < 2; ++b)
#pragma unroll
                for (int m = 0; m < 4; ++m)
#pragma unroll
                    for (int n = 0; n < 2; ++n) acc[a][b][m][n] = (f32x4){0.f, 0.f, 0.f, 0.f};
        cur = nxt; cB = nB; ++ui;
#pragma unroll
        for (int h = 0; h < 2; ++h)
#pragma unroll
            for (int i = 0; i < 2; ++i) vA[h][i] = vAn[h][i];
    }
    PG8_WAIT_V(0);
    if (wr == 0) PG8_BAR;
    PG8_BAR;
#undef PG8_SA
#undef PG8_SB
#undef PG8_STAGE
#undef PG8_LDA
#undef PG8_LDB
#undef PG8_MMA
#undef PG8_WAIT_V
#undef PG8_WAIT_L
#undef PG8_BAR
#undef PG8_SCHED
#undef PG8_AOFFS
}
}

__device__ __forceinline__ void p_rmsrope(const Frame& F, int l, int nrows, int wg0) {
    const int gw = (F.bid - wg0) * NWAVES + F.wave, NGW = (F.G - wg0) * NWAVES;
    bf16_t* P = (bf16_t*)(F.ws + WS_PROJ);
    const float* R = (const float*)(F.ws + WS_ROPE);
    const int i = F.lane & 31, ax = F.lane >> 5, d1 = ax * 64 + i, d2 = d1 + 32;
    const float gq1 = F.in[IN_QNG][l * 128 + d1], gq2 = F.in[IN_QNG][l * 128 + d2], gk1 = F.in[IN_KNG][l * 128 + d1], gk2 = F.in[IN_KNG][l * 128 + d2];
    for (int r = gw; r < nrows; r += NGW) {
        float cs = 1.f, sn = 0.f;
        if (r < SEQ) { const int pos = ax == 0 ? (r >> 6) : (r & 63); cs = R[2 * (pos * 32 + i)]; sn = R[2 * (pos * 32 + i) + 1]; }
#pragma unroll
        for (int hh = 0; hh < 10; ++hh) {
            bf16_t* p = P + (size_t)r * INW + (hh < 8 ? 2560 + hh * 128 : 3584 + (hh - 8) * 128);
            float x1 = bf2f(p[d1]), x2 = bf2f(p[d2]);
            const float ss = wave_sum(x1 * x1 + x2 * x2);
            const float rinv = 1.0f / sqrtf(ss * (1.0f / 128.0f) + LN_EPS);
            x1 = x1 * rinv * (hh < 8 ? gq1 : gk1); x2 = x2 * rinv * (hh < 8 ? gq2 : gk2);
            p[d1] = f2bf(x1 * cs - x2 * sn); p[d2] = f2bf(x2 * cs + x1 * sn);
        }
    }
}

__device__ __forceinline__ void rms_rope_tile(const Frame& F, int l, int row0, int pn) {
    bf16_t* P = (bf16_t*)(F.ws + WS_PROJ);
    const float* R = (const float*)(F.ws + WS_ROPE);
    const float* gn = F.in[pn < 14 ? IN_QNG : IN_KNG] + l * 128;
    const int q = F.lane & 3;
    float gv[32];
#pragma unroll
    for (int c = 0; c < 4; ++c) { const f32x4 a = *(const f32x4*)(gn + 32 * c + 8 * q), b2 = *(const f32x4*)(gn + 32 * c + 8 * q + 4);
        gv[8 * c] = a.x; gv[8 * c + 1] = a.y; gv[8 * c + 2] = a.z; gv[8 * c + 3] = a.w; gv[8 * c + 4] = b2.x; gv[8 * c + 5] = b2.y; gv[8 * c + 6] = b2.z; gv[8 * c + 7] = b2.w; }
#pragma unroll 1
    for (int it = 0; it < 4; ++it) {
        const int pr = it * 128 + F.wave * 16 + (F.lane >> 2);
        const int row = row0 + (pr >> 1);
        bf16_t* p = (pn == 14) ? (bf16_t*)(F.ws + WS_KV) + (size_t)row * 512 + (pr & 1) * 128 + 8 * q : P + (size_t)row * INW + pn * 256 + (pr & 1) * 128 + 8 * q;
        float x[32]; float ss = 0.f;
#pragma unroll
        for (int c = 0; c < 4; ++c) { const u32x4 r = *(const u32x4*)(p + 32 * c);
#pragma unroll
            for (int e = 0; e < 4; ++e) { x[8 * c + 2 * e] = bf2f((bf16_t)(r[e] & 0xffffu)); x[8 * c + 2 * e + 1] = bf2f((bf16_t)(r[e] >> 16)); } }
#pragma unroll
        for (int t = 0; t < 32; ++t) ss += x[t] * x[t];
        ss = quad_sum(ss);
        const float rinv = 1.0f / sqrtf(ss * (1.0f / 128.0f) + LN_EPS);
#pragma unroll
        for (int t = 0; t < 32; ++t) x[t] = x[t] * rinv * gv[t];
        if (row < SEQ) {
#pragma unroll
            for (int ax = 0; ax < 2; ++ax) { const int pos = ax == 0 ? (row >> 6) : (row & 63); const float* cs = R + 2 * (pos * 32 + 8 * q);
#pragma unroll
                for (int t4 = 0; t4 < 4; ++t4) { const f32x4 w = *(const f32x4*)(cs + 4 * t4);
#pragma unroll
                    for (int e = 0; e < 2; ++e) { const int t = 2 * t4 + e; const float c0 = e ? w.z : w.x, s0 = e ? w.w : w.y;
                        const float x1 = x[16 * ax + t], x2 = x[16 * ax + 8 + t]; x[16 * ax + t] = x1 * c0 - x2 * s0; x[16 * ax + 8 + t] = x2 * c0 + x1 * s0; } } }
        }
#pragma unroll
        for (int c = 0; c < 4; ++c) { u32x4 o;
#pragma unroll
            for (int e = 0; e < 4; ++e) o[e] = cvt_pk_bf16(x[8 * c + 2 * e], x[8 * c + 2 * e + 1]);
            *(u32x4*)(p + 32 * c) = o; }
    }
}

namespace att {
constexpr int D = 128, NW = 8, QBLK = 32, KVBLK = 64;
constexpr float SCALE = 0.088388347648318440f;
constexpr float THR = 8.f;
constexpr int LDQ = INW, LDO = DM;
constexpr size_t SHM_V = KVBLK * D * 2, SHM_K = KVBLK * D * 2, SHM_ATTN = 2 * SHM_V + 2 * SHM_K + NW * 64 * 4;
#define KSWZ(row, colB) ((row) * 256 + ((colB) ^ (((row) & 7) << 4)))
#define SBAR() __builtin_amdgcn_sched_barrier(0)
__device__ __forceinline__ int crow(int r, int hi) { return (r & 3) + 8 * (r >> 2) + 4 * hi; }
__device__ __forceinline__ unsigned cvtpk(float lo, float hi) { unsigned r; asm volatile("v_cvt_pk_bf16_f32 %0, %1, %2" : "=v"(r) : "v"(lo), "v"(hi)); return r; }
__device__ __forceinline__ void partialSM(f32x16& p0, f32x16& p1, float& m_reg, float& mn, float& alpha) {
  constexpr float C = SCALE * 1.4426950408889634f;
  float pmax = p0[0];
#pragma unroll
  for (int r = 1; r < 16; ++r) pmax = fmaxf(pmax, p0[r]);
#pragma unroll
  for (int r = 0; r < 16; ++r) pmax = fmaxf(pmax, p1[r]);
  { auto rr = __builtin_amdgcn_permlane32_swap(__float_as_uint(pmax), __float_as_uint(pmax), false, false);
    pmax = fmaxf(__uint_as_float(rr[0]), __uint_as_float(rr[1])); }
  if (__builtin_expect(__all(pmax - m_reg <= THR / SCALE), 1)) { mn = m_reg; alpha = 1.f; }
  else { mn = fmaxf(m_reg, pmax); alpha = __builtin_amdgcn_exp2f((m_reg - mn) * C); m_reg = mn; }
  float mnC = -mn * C;
#pragma unroll
  for (int r = 0; r < 16; ++r) p0[r] = fmaf(p0[r], C, mnC);
#pragma unroll
  for (int r = 0; r < 16; ++r) p1[r] = fmaf(p1[r], C, mnC);
#pragma unroll
  for (int r = 0; r < 16; ++r) p0[r] = __builtin_amdgcn_exp2f(p0[r]);
}
struct SMreg { float a[16], b[16]; };
__device__ __forceinline__ void finishSM(SMreg& e, float alpha, float& l_reg, bf16x8& pa0, bf16x8& pa1, bf16x8& pa2, bf16x8& pa3) {
#pragma unroll
  for (int r = 0; r < 16; ++r) e.b[r] = __builtin_amdgcn_exp2f(e.b[r]);
  float ps = 0;
#pragma unroll
  for (int r = 0; r < 16; ++r) ps += e.a[r];
#pragma unroll
  for (int r = 0; r < 16; ++r) ps += e.b[r];
  { auto rr = __builtin_amdgcn_permlane32_swap(__float_as_uint(ps), __float_as_uint(ps), false, false);
    ps = __uint_as_float(rr[0]) + __uint_as_float(rr[1]); }
  l_reg = l_reg * alpha + ps;
#define PK4(P, BASE, OUT) do { unsigned a0 = cvtpk(P[BASE + 0], P[BASE + 1]), a1 = cvtpk(P[BASE + 2], P[BASE + 3]);   \
    unsigned b0 = cvtpk(P[BASE + 4], P[BASE + 5]), b1 = cvtpk(P[BASE + 6], P[BASE + 7]);                              \
    auto r0 = __builtin_amdgcn_permlane32_swap(a0, b0, false, false); auto r1 = __builtin_amdgcn_permlane32_swap(a1, b1, false, false); \
    u32x4 w = {r0[0], r1[0], r0[1], r1[1]}; OUT = *reinterpret_cast<bf16x8*>(&w); } while (0)
  PK4(e.a, 0, pa0); PK4(e.a, 8, pa1); PK4(e.b, 0, pa2); PK4(e.b, 8, pa3);
#undef PK4
}
__device__ __forceinline__ void sm_copy(SMreg& e, const f32x16& p0, const f32x16& p1) {
#pragma unroll
  for (int r = 0; r < 16; ++r) { e.a[r] = p0[r]; e.b[r] = p1[r]; }
}
__device__ __forceinline__ void qkt(f32x16& p0, f32x16& p1, const bf16_t* Ks, const bf16x8* qr, int r32, int hi) {
  p0 = f32x16{}; p1 = f32x16{};
#pragma unroll
  for (int d0 = 0; d0 < 8; ++d0) { int cb = (d0 * 16 + hi * 8) * 2;
    bf16x8 b0 = *reinterpret_cast<const bf16x8*>((const char*)Ks + KSWZ(r32, cb));
    bf16x8 b1 = *reinterpret_cast<const bf16x8*>((const char*)Ks + KSWZ(32 + r32, cb));
    p0 = __builtin_amdgcn_mfma_f32_32x32x16_bf16(b0, qr[d0], p0, 0, 0, 0);
    p1 = __builtin_amdgcn_mfma_f32_32x32x16_bf16(b1, qr[d0], p1, 0, 0, 0); }
}
__device__ __forceinline__ int v_st(int k, int c) { const int kk = (k & ~0xC) | ((k & 4) << 1) | ((k & 8) >> 1); return ((kk >> 3) * 4 + (c >> 5)) * 512 + ((kk & 7) * 32 + (c & 31)) * 2; }
__device__ __forceinline__ int v_rd_base(int lane) { return ((lane & 3) << 3) | (((lane >> 2) & 3) << 6) | (((lane >> 4) & 1) << 5) | (((lane >> 5) & 1) << 8); }
constexpr int v_rd_off(int d0, int ks, int half) { return d0 * 512 + ks * 4096 + half * 2048; }
template <int OFF> __device__ __forceinline__ s16x4 tr_read(int vb) {
  s16x4 r; asm volatile("ds_read_b64_tr_b16 %0, %1 offset:%2" : "=&v"(r) : "v"(vb), "i"(OFF) : "memory"); return r;
}
template <int D0> __device__ __forceinline__ void pv_one(f32x16& od, int vb, bf16x8 pa0, bf16x8 pa1, bf16x8 pa2, bf16x8 pa3) {
  const s16x4 l0 = tr_read<v_rd_off(D0, 0, 0)>(vb), h0 = tr_read<v_rd_off(D0, 0, 1)>(vb), l1 = tr_read<v_rd_off(D0, 1, 0)>(vb), h1 = tr_read<v_rd_off(D0, 1, 1)>(vb);
  const s16x4 l2 = tr_read<v_rd_off(D0, 2, 0)>(vb), h2 = tr_read<v_rd_off(D0, 2, 1)>(vb), l3 = tr_read<v_rd_off(D0, 3, 0)>(vb), h3 = tr_read<v_rd_off(D0, 3, 1)>(vb);
  asm volatile("s_waitcnt lgkmcnt(0)" ::: "memory"); SBAR();
#define PK(L, H) (bf16x8){L[0], L[1], L[2], L[3], H[0], H[1], H[2], H[3]}
  od = __builtin_amdgcn_mfma_f32_32x32x16_bf16(pa0, PK(l0, h0), od, 0, 0, 0);
  od = __builtin_amdgcn_mfma_f32_32x32x16_bf16(pa1, PK(l1, h1), od, 0, 0, 0);
  od = __builtin_amdgcn_mfma_f32_32x32x16_bf16(pa2, PK(l2, h2), od, 0, 0, 0);
  od = __builtin_amdgcn_mfma_f32_32x32x16_bf16(pa3, PK(l3, h3), od, 0, 0, 0);
#undef PK
}
__device__ __forceinline__ void pv_d0(f32x16* o, int vb, bf16x8 pa0, bf16x8 pa1, bf16x8 pa2, bf16x8 pa3) {
  pv_one<0>(o[0], vb, pa0, pa1, pa2, pa3); pv_one<1>(o[1], vb, pa0, pa1, pa2, pa3); pv_one<2>(o[2], vb, pa0, pa1, pa2, pa3); pv_one<3>(o[3], vb, pa0, pa1, pa2, pa3);
}
__device__ __forceinline__ void pv_sm(f32x16* o, int vb, bf16x8 pa0, bf16x8 pa1, bf16x8 pa2, bf16x8 pa3, const f32x16& p0, const f32x16& p1, SMreg& e, float& m_reg, float& alpha) {
  constexpr float C = SCALE * 1.4426950408889634f;
#define PK(L, H) (bf16x8){L[0], L[1], L[2], L[3], H[0], H[1], H[2], H[3]}
#define RD(D, n) const s16x4 a##n = tr_read<v_rd_off(D, 0, 0)>(vb), b##n = tr_read<v_rd_off(D, 0, 1)>(vb), c##n = tr_read<v_rd_off(D, 1, 0)>(vb), d##n = tr_read<v_rd_off(D, 1, 1)>(vb), \
                             e##n = tr_read<v_rd_off(D, 2, 0)>(vb), f##n = tr_read<v_rd_off(D, 2, 1)>(vb), g##n = tr_read<v_rd_off(D, 3, 0)>(vb), h##n = tr_read<v_rd_off(D, 3, 1)>(vb)
#define MM(od, n) do { od = __builtin_amdgcn_mfma_f32_32x32x16_bf16(pa0, PK(a##n, b##n), od, 0, 0, 0); od = __builtin_amdgcn_mfma_f32_32x32x16_bf16(pa1, PK(c##n, d##n), od, 0, 0, 0); \
                       od = __builtin_amdgcn_mfma_f32_32x32x16_bf16(pa2, PK(e##n, f##n), od, 0, 0, 0); od = __builtin_amdgcn_mfma_f32_32x32x16_bf16(pa3, PK(g##n, h##n), od, 0, 0, 0); } while (0)
#define SB6() __builtin_amdgcn_sched_barrier(0x406)
#define GRP(od, n, D, m) od = __builtin_amdgcn_mfma_f32_32x32x16_bf16(pa0, PK(a##n, b##n), od, 0, 0, 0); const s16x4 a##m = tr_read<v_rd_off(D, 0, 0)>(vb), b##m = tr_read<v_rd_off(D, 0, 1)>(vb); SB6(); \
                         od = __builtin_amdgcn_mfma_f32_32x32x16_bf16(pa1, PK(c##n, d##n), od, 0, 0, 0); const s16x4 c##m = tr_read<v_rd_off(D, 1, 0)>(vb), d##m = tr_read<v_rd_off(D, 1, 1)>(vb); SB6(); \
                         od = __builtin_amdgcn_mfma_f32_32x32x16_bf16(pa2, PK(e##n, f##n), od, 0, 0, 0); const s16x4 e##m = tr_read<v_rd_off(D, 2, 0)>(vb), f##m = tr_read<v_rd_off(D, 2, 1)>(vb); SB6(); \
                         od = __builtin_amdgcn_mfma_f32_32x32x16_bf16(pa3, PK(g##n, h##n), od, 0, 0, 0); const s16x4 g##m = tr_read<v_rd_off(D, 3, 0)>(vb), h##m = tr_read<v_rd_off(D, 3, 1)>(vb)
#define LW() do { asm volatile("s_waitcnt lgkmcnt(0)" ::: "memory"); SBAR(); } while (0)
#define PIN(x) asm volatile("" : "+v"(x))
  RD(0, 0); LW();
  GRP(o[0], 0, 1, 1);
  float pmax = p0[0];
#pragma unroll
  for (int r = 1; r < 16; ++r) pmax = fmaxf(pmax, p0[r]);
#pragma unroll
  for (int r = 0; r < 16; ++r) pmax = fmaxf(pmax, p1[r]);
  { auto rr = __builtin_amdgcn_permlane32_swap(__float_as_uint(pmax), __float_as_uint(pmax), false, false);
    pmax = fmaxf(__uint_as_float(rr[0]), __uint_as_float(rr[1])); }
  const bool ok = __all(pmax - m_reg <= THR / SCALE);
  const float mn = ok ? m_reg : fmaxf(m_reg, pmax); alpha = __builtin_amdgcn_exp2f((m_reg - mn) * C); m_reg = mn;
  float mnC = -mn * C; PIN(mnC);
  LW();
  GRP(o[1], 1, 2, 2);
#pragma unroll
  for (int r = 0; r < 16; ++r) { float a = fmaf(p0[r], C, mnC), b = fmaf(p1[r], C, mnC); if (r < 2) a = __builtin_amdgcn_exp2f(a); PIN(a); PIN(b); e.a[r] = a; e.b[r] = b; }
  LW();
  GRP(o[2], 2, 3, 3);
#pragma unroll
  for (int r = 2; r < 9; ++r) { float a = __builtin_amdgcn_exp2f(e.a[r]); PIN(a); e.a[r] = a; }
  LW();
  MM(o[3], 3);
#pragma unroll
  for (int r = 9; r < 16; ++r) { float a = __builtin_amdgcn_exp2f(e.a[r]); PIN(a); e.a[r] = a; }
#undef PK
#undef RD
#undef MM
#undef GRP
#undef SB6
#undef LW
#undef PIN
}
struct MapLinear { long base; __device__ __forceinline__ long operator()(int t) const { return base + (long)t * KVBLK; } };
struct MapNA { int rs0; __device__ __forceinline__ long operator()(int t) const { return t < 4 ? (long)SEQ + t * 64 : (long)(rs0 + t - 4) * 64; } };
struct HookNone { __device__ __forceinline__ void operator()(f32x16&, f32x16&, int, int) const {} };
struct HookNA {
  const LAS float* bias; int qr, rs, rs0, cbase  , bbase  ;
  __device__ __forceinline__ void operator()(f32x16& p0, f32x16& p1, int tile, int hi) const {
    if (tile < 4) return;
    const int kr = rs0 + tile - 4; const bool rowok = (kr >= rs) && (kr <= rs + 7);
    int drow = kr - qr + 7; drow = drow < 0 ? 0 : (drow > 14 ? 14 : drow);
    const float ninf = -__builtin_inff();
    const LAS float* bp = bias + drow * 31 + bbase;
#pragma unroll
    for (int r = 0; r < 16; ++r) {
      const int kc = (r & 3) + 8 * (r >> 2);
      const bool ok0 = rowok && (unsigned)(kc + cbase) <= 15u, ok1 = rowok && (unsigned)(kc + 32 + cbase) <= 15u;
      p0[r] = ok0 ? p0[r] + bp[kc] : ninf; p1[r] = ok1 ? p1[r] + bp[kc + 32] : ninf;
    }
  }
};
template <int SDEPTH, int LDK, class Map, class Hook>
__device__ __forceinline__ void attn_body(const bf16_t* __restrict__ Qb, const bf16_t* __restrict__ Kh, const bf16_t* __restrict__ Vh,
                                          bf16_t* __restrict__ Ob, int NT, const Map map, const Hook hook, char* lds, int tid) {
  const int wid = tid >> 6, lane = tid & 63, r32 = lane & 31, hi = lane >> 5;
  bf16_t* V_lds = (bf16_t*)lds; bf16_t* K_lds = (bf16_t*)(lds + 2 * SHM_V);
  float* ws = (float*)(lds + 2 * SHM_V + 2 * SHM_K) + wid * 64; float* li_l = ws; float* al_l = ws + 32;
  float m_reg = -1e30f, l_reg = 0; f32x16 o[4] = {}; bf16x8 qr[8];
  const bf16_t* Qw = Qb + (long)(wid * QBLK + r32) * LDQ + hi * 8;
#pragma unroll
  for (int d0 = 0; d0 < 8; ++d0) qr[d0] = *reinterpret_cast<const bf16x8*>(Qw + d0 * 16);
  const int sr = tid >> 4;
  const unsigned kq = (unsigned)(sr * LDK + (((tid & 15) ^ (sr & 7)) * 8)) * 2u;
  const int kk = ((tid >> 7) << 3) | ((tid & 31) >> 2), kv = (kk & ~0xC) | ((kk & 4) << 1) | ((kk & 8) >> 1);
  const unsigned vq = (unsigned)(kv * LDK + ((tid >> 5) & 3) * 32 + (tid & 3) * 8) * 2u;
  LAS char* ldsw = (LAS char*)lds + (unsigned)__builtin_amdgcn_readfirstlane(wid) * 1024u;
  const int vb0 = (int)(uintptr_t)V_lds + v_rd_base(lane);
#define DMA_K(tile, b) do { const char* _g = (const char*)(Kh + map(tile) * LDK);                                                                        \
    __builtin_amdgcn_global_load_lds((const unsigned*)(_g + kq), (LAS unsigned*)(ldsw + 2 * SHM_V + (b) * SHM_K), 16, 0, 0);                              \
    __builtin_amdgcn_global_load_lds((const unsigned*)(_g + kq + 32 * LDK * 2), (LAS unsigned*)(ldsw + 2 * SHM_V + (b) * SHM_K + 8192), 16, 0, 0); } while (0)
#define DMA_V(tile, b) do { const char* _g = (const char*)(Vh + map(tile) * LDK);                                                                        \
    __builtin_amdgcn_global_load_lds((const unsigned*)(_g + vq), (LAS unsigned*)(ldsw + (b) * SHM_V), 16, 0, 0);                                          \
    __builtin_amdgcn_global_load_lds((const unsigned*)(_g + vq + 32 * LDK * 2), (LAS unsigned*)(ldsw + (b) * SHM_V + 8192), 16, 0, 0); } while (0)
#define DWAIT() do { asm volatile("s_waitcnt vmcnt(0)" ::: "memory"); __syncthreads(); } while (0)
#define RESC(a) do { if (__any((a) < 1.f)) { if (hi == 0) al_l[r32] = (a); asm volatile("s_waitcnt lgkmcnt(0)" ::: "memory"); \
    _Pragma("unroll") for (int d = 0; d < 4; ++d) _Pragma("unroll") for (int r = 0; r < 16; ++r) o[d][r] *= al_l[crow(r, hi)]; } } while (0)
  f32x16 pA0, pA1, pB0, pB1; SMreg eA, eB; float mnA, mnB, alA, alB; bf16x8 pa0, pa1, pa2, pa3;
#define PVSM(vbx, P0, P1, E, MN, AL, T) do { if constexpr (SDEPTH == 2) { hook(P0, P1, T, hi); pv_sm(o, vbx, pa0, pa1, pa2, pa3, P0, P1, E, m_reg, AL); }   \
    else { pv_d0(o, vbx, pa0, pa1, pa2, pa3); hook(P0, P1, T, hi); partialSM(P0, P1, m_reg, MN, AL); sm_copy(E, P0, P1); } } while (0)
  bf16_t* K1_lds = (bf16_t*)((char*)K_lds + SHM_K);
  DMA_K(0, 0); DMA_V(0, 0); DMA_K(1, 1); DWAIT();
  qkt(pA0, pA1, K_lds, qr, r32, hi); hook(pA0, pA1, 0, hi); partialSM(pA0, pA1, m_reg, mnA, alA); sm_copy(eA, pA0, pA1);
  __syncthreads();
  if (2 < NT) DMA_K(2, 0);
  DMA_V(1, 1);
  for (int j = 1; j + 1 < NT; j += 2) {
    SBAR(); qkt(pB0, pB1, K1_lds, qr, r32, hi);
    finishSM(eA, alA, l_reg, pa0, pa1, pa2, pa3); SBAR();
    PVSM(vb0, pB0, pB1, eB, mnB, alB, j);
    DWAIT();
    DMA_K(j + 2, 1); DMA_V(j + 1, 0);
    RESC(alB);
    SBAR(); qkt(pA0, pA1, K_lds, qr, r32, hi);
    finishSM(eB, alB, l_reg, pa0, pa1, pa2, pa3); SBAR();
    PVSM(vb0 + (int)SHM_V, pA0, pA1, eA, mnA, alA, j + 1);
    DWAIT();
    if (j + 3 < NT) DMA_K(j + 3, 0);
    DMA_V(j + 2, 1);
    RESC(alA);
  }
  SBAR(); qkt(pB0, pB1, K1_lds, qr, r32, hi);
  finishSM(eA, alA, l_reg, pa0, pa1, pa2, pa3); SBAR();
  PVSM(vb0, pB0, pB1, eB, mnB, alB, NT - 1);
  DWAIT(); RESC(alB);
  finishSM(eB, alB, l_reg, pa0, pa1, pa2, pa3); SBAR();
  pv_d0(o, vb0 + (int)SHM_V, pa0, pa1, pa2, pa3);
  if (hi == 0) li_l[r32] = l_reg; asm volatile("s_waitcnt lgkmcnt(0)" ::: "memory");
  float rli[16];
#pragma unroll
  for (int r = 0; r < 16; ++r) rli[r] = __builtin_amdgcn_rcpf(li_l[crow(r, hi)]);
  bf16_t* Ow = Ob + (long)(wid * QBLK) * LDO;
#pragma unroll
  for (int r = 0; r < 16; ++r) { int orow = crow(r, hi);
#pragma unroll
    for (int d0 = 0; d0 < 4; ++d0) Ow[(long)orow * LDO + d0 * 32 + r32] = f2bf(o[d0][r] * rli[r]); }
  __syncthreads();
#undef DMA_K
#undef DMA_V
#undef DWAIT
#undef RESC
#undef PVSM
}
}

__device__ __forceinline__ void sg_unit(const Frame& F, int l, int c, int g) {
    constexpr int VST = 136;
    LAS bf16_t* vnT = (LAS bf16_t*)F.lds;
    const bf16_t* P = (const bf16_t*)(F.ws + WS_PROJ);
    const int fr = F.lane & 15, fq = F.lane >> 4;
    const float* W = F.in[IN_SGW] + ((size_t)(l * 4 + g) * 128 + 16 * F.wave + fr) * 128 + 8 * fq;
    bf16x8 wf[4];
#pragma unroll
    for (int ks = 0; ks < 4; ++ks) { const f32x4 a = *(const f32x4*)(W + 32 * ks), b2 = *(const f32x4*)(W + 32 * ks + 4);
        u32x4 w; w.x = cvt_pk_bf16(a.x, a.y); w.y = cvt_pk_bf16(a.z, a.w); w.z = cvt_pk_bf16(b2.x, b2.y); w.w = cvt_pk_bf16(b2.z, b2.w); wf[ks] = *reinterpret_cast<bf16x8*>(&w); }
    {
        const int j = 16 * F.wave + (F.lane >> 2), q = F.lane & 3; const size_t p = (size_t)(c * 128 + j);
        const bf16_t* vp = P + p * INW + 2048 + g * 128 + 32 * q;
        float x[32];
#pragma unroll
        for (int t = 0; t < 4; ++t) { const u32x4 r = *(const u32x4*)(vp + 8 * t);
#pragma unroll
            for (int e = 0; e < 4; ++e) { x[8 * t + 2 * e] = bf2f((bf16_t)(r[e] & 0xffffu)); x[8 * t + 2 * e + 1] = bf2f((bf16_t)(r[e] >> 16)); } }
        float sm = 0.f;
#pragma unroll
        for (int t = 0; t < 32; ++t) sm += x[t];
        sm = quad_sum(sm);
        const float mean = sm * (1.0f / 128.0f); float sq = 0.f;
#pragma unroll
        for (int t = 0; t < 32; ++t) { x[t] -= mean; sq += x[t] * x[t]; }
        sq = quad_sum(sq);
        const float rstd = 1.0f / sqrtf(sq * (1.0f / 128.0f) + LN_EPS);
        const float* gp = F.in[IN_SGLNG] + (l * 4 + g) * 128 + 32 * q; const float* bp = F.in[IN_SGLNB] + (l * 4 + g) * 128 + 32 * q;
#pragma unroll
        for (int t = 0; t < 32; ++t) vnT[(32 * q + t) * VST + j] = f2bf(x[t] * rstd * gp[t] + bp[t]);
    }
    __syncthreads();
    bf16_t* MIXp = (bf16_t*)(F.ws + WS_MIX);
    const int i = 16 * F.wave + fr; const size_t pi = (size_t)(c * 128 + i); const float bs = F.in[IN_SGB][(l * 4 + g) * 128 + i];
#pragma unroll
    for (int dt = 0; dt < 8; ++dt) {
        f32x4 acc = {0.f, 0.f, 0.f, 0.f};
#pragma unroll
        for (int ks = 0; ks < 4; ++ks) { const bf16x8 a = *(const LAS bf16x8*)(vnT + (dt * 16 + fr) * VST + 32 * ks + 8 * fq); acc = __builtin_amdgcn_mfma_f32_16x16x32_bf16(a, wf[ks], acc, 0, 0, 0); }
        const int d0 = 16 * dt + 4 * fq; const u32x2 uu = *(const u32x2*)(P + pi * INW + 1536 + g * 128 + d0);
        u32x2 o; o.x = cvt_pk_bf16((acc[0] + bs) * bf2f((bf16_t)(uu.x & 0xffffu)), (acc[1] + bs) * bf2f((bf16_t)(uu.x >> 16)));
        o.y = cvt_pk_bf16((acc[2] + bs) * bf2f((bf16_t)(uu.y & 0xffffu)), (acc[3] + bs) * bf2f((bf16_t)(uu.y >> 16)));
        *(u32x2*)(MIXp + pi * DM + 512 + g * 128 + d0) = o;
    }
    __syncthreads();
}

__device__ __forceinline__ void p_att_dense(const Frame& F, int l) {
    const bf16_t* P = (const bf16_t*)(F.ws + WS_PROJ); bf16_t* MIXp = (bf16_t*)(F.ws + WS_MIX); const bf16_t* KV = (const bf16_t*)(F.ws + WS_KV);
    const int total = 256 + ((l == 0) ? 12 : 0);
    for (int u = F.bid; u < total; u += F.G) {
        int qrow, qcol, ocol, nt; long kbase; const bf16_t* kp;
        if (u < 256) { const int h = u & 7; qrow = (u >> 3) * 256; qcol = 2560 + h * 128; ocol = 1024 + h * 128; nt = NROW / 64; kbase = 0; kp = KV + (h >> 2) * 128; }
        else if (u < 264) { const int h = u - 256; qrow = SEQ; qcol = 2560 + h * 128; ocol = 1024 + h * 128; nt = 4; kbase = SEQ; kp = KV + (h >> 2) * 128; }
        else { const int h = u - 264; qrow = SEQ; qcol = h * 128; ocol = h * 128; nt = 4; kbase = 0; kp = (const bf16_t*)(F.ws + WS_CKV) + (size_t)h * 256 * 512; }
        att::attn_body<2, 512>(P + (size_t)qrow * INW + qcol, kp, kp + 256, MIXp + (size_t)qrow * DM + ocol, nt, att::MapLinear{kbase}, att::HookNone{}, (char*)F.lds, F.tid);
    }
}
__device__ __forceinline__ void p_att_na(const Frame& F, int l) {
    const bf16_t* P = (const bf16_t*)(F.ws + WS_PROJ); bf16_t* MIXp = (bf16_t*)(F.ws + WS_MIX);
    LAS float* bt = (LAS float*)(F.lds + LDS_SC);
    for (int v = F.bid; v < 128; v += F.G) {
        const int h = v & 3, qb = v >> 2, R0 = qb * 4;
        const float* rpb = F.in[IN_RPB] + (size_t)(l * 4 + h) * 15 * 31;
        for (int t = F.tid; t < 640; t += NTHR) { const int q = t - 48; bt[t] = (q >= 0 && q < 15 * 31) ? rpb[q] * (1.0f / att::SCALE) : 0.f; }
        __syncthreads();
        int rs0 = R0 - 4; rs0 = rs0 < 0 ? 0 : (rs0 > 116 ? 116 : rs0);
        const int qr = R0 + (F.wave >> 1), qc = (F.wave & 1) * 32 + (F.lane & 31);
        int rs = qr - 4; rs = rs < 0 ? 0 : (rs > 120 ? 120 : rs);
        int cs = qc - 8; cs = cs < 0 ? 0 : (cs > 48 ? 48 : cs);
        att::attn_body<1, INW>(P + (size_t)(qb * 256) * INW + h * 128, P + 512 + h * 128, P + 1024 + h * 128,
                       MIXp + (size_t)(qb * 256) * DM + h * 128, 16, att::MapNA{rs0}, att::HookNA{bt, qr, rs, rs0, 4 * (F.lane >> 5) - cs, 48 + 15 - qc + 4 * (F.lane >> 5)}, (char*)F.lds, F.tid);
    }
}
__device__ __forceinline__ void p_att_sg(const Frame& F, int l) {
    const int nsg = (l == 0) ? 264 : 256;
    if (F.G >= 256) { for (int v = F.bid - 128; v >= 0 && v < nsg; v += F.G - 128) sg_unit(F, l, v >> 2, v & 3); }
    else { for (int v = F.bid; v < nsg; v += F.G) sg_unit(F, l, v >> 2, v & 3); }
}

#ifdef TSEL_A
#define TSF(F, i) do { if ((F).bid == 0 && (F).tid == 0) __hip_atomic_store((unsigned long long*)((F).ws + WS_CTL + 131072) + (i), (unsigned long long)__builtin_amdgcn_s_memrealtime(), __ATOMIC_RELAXED, __HIP_MEMORY_SCOPE_AGENT); } while (0)
#else
#define TSF(F, i) do { } while (0)
#endif
__device__ __forceinline__ void p_mixln_router(const Frame& F, int l, int nrows) {
    LAS float* plog = (LAS float*)F.lds;
    LAS float* scS = plog + 8 * 48 * 32;
    LAS float* selS = scS + 48 * 32;
    const float* MOD = (const float*)(F.ws + WS_MOD);
    const bf16_t* Y1 = (const bf16_t*)(F.ws + WS_Y1);
    float* XS = (float*)(F.ws + WS_XS);
    bf16_t* H2 = (bf16_t*)(F.ws + WS_H2); bf16_t* H2L = (bf16_t*)(F.ws + WS_H2L);
    const bf16_t* RWH = (const bf16_t*)(F.ws + WS_RWT); const bf16_t* RWL = RWH + 32 * DM;
    const float* RB = F.in[IN_RB];
    const float* lg = F.in[IN_LNMG] + l * DM; const float* lb = F.in[IN_LNMB] + l * DM;
    int* cnt = (int*)(F.ws + WS_CTL) + CW_CNT + l * 2048;
    int* tokE = (int*)(F.ws + WS_TOKE); int* tokP = (int*)(F.ws + WS_TOKP); float* tokG = (float*)(F.ws + WS_TOKG); int* list = (int*)(F.ws + WS_LIST);
    const int rpw = (nrows + F.G - 1) / F.G;
    const int wbeg = F.bid * rpw, wend = (wbeg + rpw < nrows) ? wbeg + rpw : nrows;
    LAS float* prm = (LAS float*)(F.lds + 65536);
    stage_vec(F, prm, lg); stage_vec(F, prm + DM, lb);
    for (int v = 0; v < 2; ++v) { const float* m = MOD + (size_t)(l * 2 + v) * 12288; stage_vec(F, prm + (2 + 3 * v) * DM, m + 2 * DM); stage_vec(F, prm + (3 + 3 * v) * DM, m + 3 * DM); stage_vec(F, prm + (4 + 3 * v) * DM, m + 4 * DM); }
    __syncthreads();
    TSF(F, 30);
    for (int rbeg = wbeg; rbeg < wend; rbeg += 48) {
        const int rend = (rbeg + 48 < wend) ? rbeg + 48 : wend, nr = rend - rbeg;
        f32x4 nx[8]; u32x2 ny[8];
#define P5_LOAD(rr) do { const float* xr_ = xrow_ptr(F, l, (rr)); const bf16_t* yr_ = Y1 + (size_t)(rr) * DM; \
        _Pragma("unroll") for (int j = 0; j < 8; ++j) { const int col = 4 * F.lane + 256 * j; nx[j] = __builtin_nontemporal_load((const f32x4*)(xr_ + col)); ny[j] = __builtin_nontemporal_load((const u32x2*)(yr_ + col)); } } while (0)
        if (rbeg + F.wave < rend) P5_LOAD(rbeg + F.wave);
        for (int r = rbeg + F.wave; r < rend; r += NWAVES) {
            const int v = r >= SEQ; const LAS float* pv = prm + (2 + 3 * v) * DM;
            f32x4 z[8];
#pragma unroll
            for (int j = 0; j < 8; ++j) { const int col = 4 * F.lane + 256 * j; const u32x2 yy = ny[j];
                const f32x4 y = {bf2f((bf16_t)(yy.x & 0xffffu)), bf2f((bf16_t)(yy.x >> 16)), bf2f((bf16_t)(yy.y & 0xffffu)), bf2f((bf16_t)(yy.y >> 16))};
                z[j] = ALPHA * nx[j] + *(const LAS f32x4*)(pv + col) * y; }
            if (r + NWAVES < rend) P5_LOAD(r + NWAVES);
            float mean, rstd; ln_stats(z, mean, rstd);
#pragma unroll
            for (int j = 0; j < 8; ++j) { const int col = 4 * F.lane + 256 * j; z[j] = (z[j] - mean) * rstd * *(const LAS f32x4*)(prm + col) + *(const LAS f32x4*)(prm + DM + col); *(f32x4*)(XS + (size_t)r * DM + col) = z[j]; }
            ln_stats(z, mean, rstd);
#pragma unroll
            for (int j = 0; j < 8; ++j) { const int col = 4 * F.lane + 256 * j; const f32x4 s1 = *(const LAS f32x4*)(pv + 2 * DM + col), s0 = *(const LAS f32x4*)(pv + DM + col);
                const f32x4 h = (z[j] - mean) * rstd * (1.0f + s1) + s0;
                u32x2 hi; hi.x = cvt_pk_bf16(h.x, h.y); hi.y = cvt_pk_bf16(h.z, h.w);
                const f32x4 hf = {bf2f((bf16_t)(hi.x & 0xffffu)), bf2f((bf16_t)(hi.x >> 16)), bf2f((bf16_t)(hi.y & 0xffffu)), bf2f((bf16_t)(hi.y >> 16))};
                const f32x4 d = h - hf; u32x2 lo; lo.x = cvt_pk_bf16(d.x, d.y); lo.y = cvt_pk_bf16(d.z, d.w);
                *(u32x2*)(H2 + (size_t)r * DM + col) = hi; *(u32x2*)(H2L + (size_t)r * DM + col) = lo; }
        }
#undef P5_LOAD
        asm volatile("s_waitcnt vmcnt(0)" ::: "memory");
        __syncthreads();
        TSF(F, 31);
        const int ntile = (nr + 15) >> 4; constexpr int nsl = 8;
        {
            const int fr = F.lane & 15, fq = F.lane >> 4, kb = F.wave * 256 + fq * 8;
            const bf16_t* bh = RWH + (size_t)fr * DM + kb; const bf16_t* bl = RWL + (size_t)fr * DM + kb;
            const bf16_t* ah[3]; const bf16_t* al[3];
#pragma unroll
            for (int t = 0; t < 3; ++t) { int row = rbeg + t * 16 + fr; row = row < rend ? row : rend - 1; ah[t] = H2 + (size_t)row * DM + kb; al[t] = H2L + (size_t)row * DM + kb; }
            f32x4 acc[3][2];
#pragma unroll
            for (int t = 0; t < 3; ++t) { acc[t][0] = (f32x4){0.f, 0.f, 0.f, 0.f}; acc[t][1] = (f32x4){0.f, 0.f, 0.f, 0.f}; }
#pragma unroll 2
            for (int ks = 0; ks < 8; ++ks) { const int off = ks * 32;
                const bf16x8 b_h0 = *(const bf16x8*)(bh + off), b_l0 = *(const bf16x8*)(bl + off), b_h1 = *(const bf16x8*)(bh + 16 * DM + off), b_l1 = *(const bf16x8*)(bl + 16 * DM + off);
#pragma unroll
                for (int t = 0; t < 3; ++t) if (t < ntile) {
                    const bf16x8 a_h = *(const bf16x8*)(ah[t] + off), a_l = *(const bf16x8*)(al[t] + off);
                    acc[t][0] = __builtin_amdgcn_mfma_f32_16x16x32_bf16(a_h, b_h0, acc[t][0], 0, 0, 0); acc[t][0] = __builtin_amdgcn_mfma_f32_16x16x32_bf16(a_h, b_l0, acc[t][0], 0, 0, 0); acc[t][0] = __builtin_amdgcn_mfma_f32_16x16x32_bf16(a_l, b_h0, acc[t][0], 0, 0, 0);
                    acc[t][1] = __builtin_amdgcn_mfma_f32_16x16x32_bf16(a_h, b_h1, acc[t][1], 0, 0, 0); acc[t][1] = __builtin_amdgcn_mfma_f32_16x16x32_bf16(a_h, b_l1, acc[t][1], 0, 0, 0); acc[t][1] = __builtin_amdgcn_mfma_f32_16x16x32_bf16(a_l, b_h1, acc[t][1], 0, 0, 0); } }
#pragma unroll
            for (int t = 0; t < 3; ++t) if (t < ntile) {
#pragma unroll
                for (int q = 0; q < 4; ++q) { LAS float* pr = plog + (F.wave * 48 + t * 16 + 4 * fq + q) * 32; pr[fr] = acc[t][0][q]; pr[16 + fr] = acc[t][1][q]; } }
        }
        __syncthreads();
        TSF(F, 32);
        for (int t = F.tid; t < nr * 32; t += NTHR) { const int e = t & 31; float lg2 = 0.f; for (int q = 0; q < nsl; ++q) lg2 += plog[q * 48 * 32 + t]; const float sc = sigmoidf_(lg2); scS[t] = sc; selS[t] = sc + RB[e]; }
        __syncthreads();
        if (F.tid < nr) {
            const int row = F.tid, r = rbeg + row; const LAS float* sel = selS + row * 32; const LAS float* sc = scS + row * 32;
            int best = 0; float bestv = -__builtin_inff();
            for (int g = 0; g < 4; ++g) { float m1 = -__builtin_inff(), m2 = -__builtin_inff();
                for (int q = 0; q < 8; ++q) { const float x = sel[g * 8 + q]; if (x > m1) { m2 = m1; m1 = x; } else if (x > m2) m2 = x; }
                const float gs = m1 + m2; if (gs > bestv) { bestv = gs; best = g; } }
            int i1 = 0, i2 = 0; float m1 = -__builtin_inff(), m2 = -__builtin_inff();
            for (int q = 0; q < 8; ++q) { const float x = sel[best * 8 + q]; if (x > m1) { m2 = m1; i2 = i1; m1 = x; i1 = q; } else if (x > m2) { m2 = x; i2 = q; } }
            const int e1 = best * 8 + i1, e2 = best * 8 + i2; const float s1 = sc[e1], s2 = sc[e2], den = s1 + s2;
            const int p1 = atomicAdd(cnt + 64 * e1, 1), p2 = atomicAdd(cnt + 64 * e2, 1);
            list[e1 * NROW + p1] = r; list[e2 * NROW + p2] = r;
            tokE[2 * r] = e1; tokE[2 * r + 1] = e2; tokP[2 * r] = p1; tokP[2 * r + 1] = p2; tokG[2 * r] = s1 / den; tokG[2 * r + 1] = s2 / den;
        }
        __syncthreads();
        TSF(F, 33);
    }
}

__device__ __forceinline__ int moe_tiles(const Frame& F, int l) {
    LAS int* tileEM = (LAS int*)(F.lds + LDS_TILE); LAS int* tbase = tileEM + 128;
    const int* cnt = (const int*)(F.ws + WS_CTL) + CW_CNT + l * 2048;
    __syncthreads();
    if (F.wave == 0) {
        const int n = (F.lane < NEXP) ? __hip_atomic_load(cnt + 64 * F.lane, __ATOMIC_RELAXED, __HIP_MEMORY_SCOPE_AGENT) : 0;
        const int nt = (n + 255) >> 8; int incl = nt;
#pragma unroll
        for (int o = 1; o < 64; o <<= 1) { const int t = __shfl_up(incl, o); if (F.lane >= o) incl += t; }
        const int excl = incl - nt;
        if (F.lane < NEXP) { tbase[F.lane] = excl; for (int m = 0; m < nt; ++m) tileEM[excl + m] = (F.lane << 8) | m; }
        if (F.lane == NEXP - 1) tbase[NEXP] = incl;
    }
    __syncthreads();
    return tbase[NEXP];
}

__device__ __forceinline__ void p_ffnln(const Frame& F, int l, int nrows) {
    LAS int* tbase = (LAS int*)(F.lds + LDS_TILE) + 128;
    (void)moe_tiles(F, l);
    const int gw = F.bid * NWAVES + F.wave, NGW = F.G * NWAVES;
    const float* MOD = (const float*)(F.ws + WS_MOD);
    float* XS = (float*)(F.ws + WS_XS); const bf16_t* YS = (const bf16_t*)(F.ws + WS_YS);
    const int* tokE = (const int*)(F.ws + WS_TOKE); const int* tokP = (const int*)(F.ws + WS_TOKP); const float* tokG = (const float*)(F.ws + WS_TOKG);
    const float* lg = F.in[IN_LNFG] + l * DM; const float* lb = F.in[IN_LNFB] + l * DM;
    bf16_t* H1 = (bf16_t*)(F.ws + WS_H1);
    LAS float* prm = (LAS float*)(F.lds + 65536);
    stage_vec(F, prm, lg); stage_vec(F, prm + DM, lb);
    for (int v = 0; v < 2; ++v) { stage_vec(F, prm + (2 + 3 * v) * DM, MOD + (size_t)(l * 2 + v) * 12288 + 5 * DM);
        if (l == 0) { const float* mn = MOD + (size_t)(2 + v) * 12288; stage_vec(F, prm + (3 + 3 * v) * DM, mn); stage_vec(F, prm + (4 + 3 * v) * DM, mn + DM); } }
    __syncthreads();
    int e1n = 0, e2n = 0, p1n = 0, p2n = 0; float g1n = 0.f, g2n = 0.f;
#define P9_ROUTE(rr) do { if ((rr) < nrows) { e1n = tokE[2 * (rr)]; e2n = tokE[2 * (rr) + 1]; p1n = tokP[2 * (rr)]; p2n = tokP[2 * (rr) + 1]; g1n = tokG[2 * (rr)]; g2n = tokG[2 * (rr) + 1]; } } while (0)
#define P9_LOAD(rr) do { const bf16_t* ya_ = YS + (size_t)(tbase[e1n] * 256 + p1n) * DM; const bf16_t* yb_ = YS + (size_t)(tbase[e2n] * 256 + p2n) * DM; const float* xr_ = XS + (size_t)(rr) * DM; \
        _Pragma("unroll") for (int j = 0; j < 8; ++j) { const int col = 4 * F.lane + 256 * j; nx[j] = __builtin_nontemporal_load((const f32x4*)(xr_ + col)); na[j] = __builtin_nontemporal_load((const u32x2*)(ya_ + col)); nb[j] = __builtin_nontemporal_load((const u32x2*)(yb_ + col)); } ng1 = g1n; ng2 = g2n; } while (0)
    f32x4 nx[8]; u32x2 na[8], nb[8]; float ng1 = 0.f, ng2 = 0.f;
    P9_ROUTE(gw);
    if (gw < nrows) P9_LOAD(gw);
    P9_ROUTE(gw + NGW);
    for (int r = gw; r < nrows; r += NGW) {
        const int v = r >= SEQ; const LAS float* pv = prm + (2 + 3 * v) * DM;
        f32x4 z[8];
#pragma unroll
        for (int j = 0; j < 8; ++j) { const int col = 4 * F.lane + 256 * j; const u32x2 qa = na[j], qb = nb[j];
            const f32x4 fa = {bf2f((bf16_t)(qa.x & 0xffffu)), bf2f((bf16_t)(qa.x >> 16)), bf2f((bf16_t)(qa.y & 0xffffu)), bf2f((bf16_t)(qa.y >> 16))};
            const f32x4 fb = {bf2f((bf16_t)(qb.x & 0xffffu)), bf2f((bf16_t)(qb.x >> 16)), bf2f((bf16_t)(qb.y & 0xffffu)), bf2f((bf16_t)(qb.y >> 16))};
            const f32x4 y = ng1 * fa + ng2 * fb;
            z[j] = ALPHA * nx[j] + *(const LAS f32x4*)(pv + col) * y; }
        if (r + NGW < nrows) P9_LOAD(r + NGW);
        P9_ROUTE(r + 2 * NGW);
        float mean, rstd; ln_stats(z, mean, rstd);
#pragma unroll
        for (int j = 0; j < 8; ++j) { const int col = 4 * F.lane + 256 * j; z[j] = (z[j] - mean) * rstd * *(const LAS f32x4*)(prm + col) + *(const LAS f32x4*)(prm + DM + col); }
        if (l == 1) {
#pragma unroll
            for (int j = 0; j < 8; ++j) *(f32x4*)(F.out + (size_t)r * DM + 4 * F.lane + 256 * j) = z[j];
        } else {
#pragma unroll
            for (int j = 0; j < 8; ++j) *(f32x4*)(XS + (size_t)r * DM + 4 * F.lane + 256 * j) = z[j];
            float mean2, rstd2; ln_stats(z, mean2, rstd2);
#pragma unroll
            for (int j = 0; j < 8; ++j) { const int col = 4 * F.lane + 256 * j; const f32x4 h = (z[j] - mean2) * rstd2 * (1.0f + *(const LAS f32x4*)(pv + 2 * DM + col)) + *(const LAS f32x4*)(pv + DM + col);
                *(u32x2*)(H1 + (size_t)r * DM + col) = pack4(h); }
        }
    }
#undef P9_ROUTE
#undef P9_LOAD
}


__global__ void __launch_bounds__(NTHR, 2) fwd(Args args) {
    extern __shared__ __attribute__((aligned(16))) unsigned char lds_raw[];
    Frame F0;
    F0.lds = (LAS unsigned char*)lds_raw; F0.tid = threadIdx.x; F0.lane = F0.tid & 63; F0.wave = __builtin_amdgcn_readfirstlane(F0.tid >> 6);
    F0.G = gridDim.x; F0.bid = blockIdx.x; F0.in = args.in; F0.out = args.out; F0.ws = args.ws;
    volatile LAS unsigned* MISC = (volatile LAS unsigned*)(F0.lds + LDS_MISC);
    if (F0.tid < 4) MISC[F0.tid] = 0u;
    __syncthreads();
    const int lo = args.ph_lo, hi = args.ph_hi;
    XcdBarrier bar; bar.bar = (unsigned*)(F0.ws + WS_CTL) + CW_BAR; bar.x = 0; bar.st = MISC;
    if (hi - lo > 1) bar = xcd_barrier_post((unsigned*)(F0.ws + WS_CTL) + CW_BAR, MISC);
#ifndef REP_PH
#define REP_PH -1
#endif
#define NREP(j) (((REP_PH) == (j)) ? rep1 + 1 : 1)
#if defined(ONLY_PH)
#define PHON(j) ((j) == ONLY_PH)
#elif defined(PH_MASK)
#define PHON(j) (((PH_MASK) >> (j)) & 1)
#else
#define PHON(j) true
#endif
#ifdef TSEL_A
#define TS(i) do { if (F0.bid == 0 && F0.tid == 0) __hip_atomic_store((unsigned long long*)(F0.ws + WS_CTL + 131072) + (i), (unsigned long long)__builtin_amdgcn_s_memrealtime(), __ATOMIC_RELAXED, __HIP_MEMORY_SCOPE_AGENT); } while (0)
#else
#define TS(i) do { } while (0)
#endif
#define IN(k) (lo <= (k) && (k) < hi)
#define SEAM(k) do { if (IN(k) && IN((k) + 1)) xcd_barrier(bar); } while (0)
    TS(0);
    int rep1 = 1; asm volatile("" : "+s"(rep1));
    if (PHON(0) && IN(0)) for (int rep = 0; rep < NREP(0); ++rep) { { const Frame F = launder(F0); p0_mod(F); } { const Frame F = launder(F0); p0_transposes(F); } { const Frame F = launder(F0); p0_rope(F); } }
    SEAM(0); TS(1);
    if (PHON(1) && IN(1)) for (int rep = 0; rep < NREP(1); ++rep) { const Frame F = launder(F0); p_modulate1(F, 0, NROW); }
    SEAM(1); TS(2);
#pragma unroll 1
    for (int l = 0; l < 2; ++l) {
        const int pb = 2 + 8 * l; const int tb = 3 + 10 * l; (void)tb;
        const int nlat = (l == 0) ? NROW : SEQ;
        if (PHON(2) && IN(pb + 0)) for (int rep = 0; rep < NREP(2); ++rep) {
            const bool split = F0.G >= 256; const int gc = split ? NC_IN : F0.G;
            if (F0.bid < gc) {
                pg8::StaticOrder S; S.init(NROW, INW, DM, (const bf16_t*)(F0.ws + WS_WIN) + (size_t)l * INW * DM, gc, F0.bid);
                { const Frame F = launder(F0);
                  pg8::EpiBf<true> E{(bf16_t*)(F.ws + WS_PROJ), INW, (bf16_t*)(F.ws + WS_KV)};
                  pg8::gemm_phase(F.lds, F.tid, (const bf16_t*)(F.ws + WS_H1), DM, S, E); }
                asm volatile("s_waitcnt vmcnt(0)" ::: "memory"); __syncthreads();
                { const Frame F = launder(F0);
                  pg8::Unit u; for (int i = 0; S.next(i, u); ++i) if (u.pn >= 10 && u.pn <= 14) rms_rope_tile(F, l, u.pm * 256, u.pn); }
            } else { const Frame F = launder(F0); if (l == 0) conv_range(F, gc, 0, CV_A0); else conv_range(F, gc, CV_LAYER + CV_B1, CV_L1F - CV_B1); }
        }
        SEAM(pb + 0); TS(tb + 0); TS(tb + 1);
        if (IN(pb + 2)) { if (PHON(4)) for (int rep = 0; rep < NREP(4); ++rep) { const Frame F = launder(F0); p_att_dense(F, l); } TS(tb + 2); if (PHON(10)) for (int rep = 0; rep < NREP(10); ++rep) { const Frame F = launder(F0); p_att_na(F, l); } TS(tb + 3); if (PHON(11)) for (int rep = 0; rep < NREP(11); ++rep) { const Frame F = launder(F0); p_att_sg(F, l); }
            if (F0.G >= 256 && F0.bid >= 128) { const Frame F = launder(F0); conv_range(F, 128, l == 0 ? CV_L0F : CV_LAYER + CV_L1F, CV_ATT); } }
        SEAM(pb + 2); TS(tb + 4);
        if (PHON(5) && IN(pb + 3)) for (int rep = 0; rep < NREP(5); ++rep) { const Frame F = launder(F0);
            const bool split = (l == 0) && F.G >= 256; const int gc = split ? NC_OUT : F.G;
            if (F.bid < gc) {
                pg8::StaticOrder S; S.init(nlat, DM, DM, (const bf16_t*)(F.ws + WS_WOUT) + (size_t)l * DM * DM, gc, F.bid);
                pg8::EpiBf<false> E{(bf16_t*)(F.ws + WS_Y1), DM, nullptr};
                pg8::gemm_phase(F.lds, F.tid, (const bf16_t*)(F.ws + WS_MIX), DM, S, E);
            } else conv_range(F, gc, CV_A0, CV_L0F - CV_A0);
        }
        SEAM(pb + 3); TS(tb + 5);
        if (PHON(6) && IN(pb + 4)) { const Frame F = launder(F0); p_mixln_router(F, l, nlat); }
        SEAM(pb + 4); TS(tb + 6);
        if (PHON(7) && IN(pb + 5)) for (int rep = 0; rep < NREP(7); ++rep) { const Frame F = launder(F0);
            const bool split = (l == 0) && F.G >= 256; const int gc = split ? NC_MOE : F.G;
            if (F.bid < gc) {
                const int ntiles = moe_tiles(F, l);
                pg8::MoeOrder<true> S{(const LAS int*)(F.lds + LDS_TILE), ntiles, gc, F.bid, DM, (const int*)(F.ws + WS_LIST), (const int*)(F.ws + WS_CTL) + CW_CNT + l * 2048,
                                      (const bf16_t*)(F.ws + WS_WGU) + (size_t)l * NEXP * 2048 * DM};
                pg8::EpiSwiGLU E{(bf16_t*)(F.ws + WS_GA)};
                pg8::gemm_phase(F.lds, F.tid, (const bf16_t*)(F.ws + WS_H2), DM, S, E);
            } else conv_range(F, gc, CV_LAYER, CV_B0);
        }
        SEAM(pb + 5); TS(tb + 7);
        if (PHON(8) && IN(pb + 6)) for (int rep = 0; rep < NREP(8); ++rep) { const Frame F = launder(F0);
            const bool split = (l == 0) && F.G >= 256; const int gc = split ? NC_MOE : F.G;
            if (F.bid < gc) {
                const int ntiles = moe_tiles(F, l);
                pg8::MoeOrder<false> S{(const LAS int*)(F.lds + LDS_TILE), ntiles, gc, F.bid, DEXP, nullptr, nullptr, (const bf16_t*)(F.ws + WS_WD) + (size_t)l * NEXP * DM * DEXP};
                pg8::EpiBf<false> E{(bf16_t*)(F.ws + WS_YS), DM, nullptr};
                pg8::gemm_phase(F.lds, F.tid, (const bf16_t*)(F.ws + WS_GA), DEXP, S, E);
            } else conv_range(F, gc, CV_LAYER + CV_B0, CV_B1 - CV_B0);
        }
        SEAM(pb + 6); TS(tb + 8);
        if (PHON(9) && IN(pb + 7)) { const Frame F = launder(F0); p_ffnln(F, l, nlat); }
        SEAM(pb + 7);
#ifdef TSEL_A
        if (l == 1) xcd_barrier(bar);
#endif
        TS(tb + 9);
    }
#ifdef TSEL_A
    {
        unsigned long long* ts = (unsigned long long*)(F0.ws + WS_CTL + 131072);
        if (F0.bid == 0 && F0.tid == 0) {
            unsigned long long a0 = 0, a1 = 0, b0 = 0, b1 = 0;
            a0 = __hip_atomic_load(ts + TSEL_A - 1, __ATOMIC_RELAXED, __HIP_MEMORY_SCOPE_AGENT); a1 = __hip_atomic_load(ts + TSEL_A2, __ATOMIC_RELAXED, __HIP_MEMORY_SCOPE_AGENT);
            b0 = __hip_atomic_load(ts + TSEL_B - 1, __ATOMIC_RELAXED, __HIP_MEMORY_SCOPE_AGENT); b1 = __hip_atomic_load(ts + TSEL_B2, __ATOMIC_RELAXED, __HIP_MEMORY_SCOPE_AGENT);
            const float ua = (float)(a1 - a0) * 0.01f, ub = (float)(b1 - b0) * 0.01f;
            int n1 = (int)(ua * 8.192f); n1 = n1 > 8100 ? 8100 : n1; n1 = 0;
            __hip_atomic_store((unsigned*)(ts + 64), (unsigned)n1, __ATOMIC_RELAXED, __HIP_MEMORY_SCOPE_AGENT);
            __hip_atomic_store((unsigned*)(ts + 65), __float_as_uint(ub * 0.5f), __ATOMIC_RELAXED, __HIP_MEMORY_SCOPE_AGENT);
        }
        xcd_barrier(bar);
        const int n1 = (int)__hip_atomic_load((unsigned*)(ts + 64), __ATOMIC_RELAXED, __HIP_MEMORY_SCOPE_AGENT);
        const float V = __uint_as_float(__hip_atomic_load((unsigned*)(ts + 65), __ATOMIC_RELAXED, __HIP_MEMORY_SCOPE_AGENT));
        const int gw = F0.bid * NWAVES + F0.wave, NGW = F0.G * NWAVES;
        for (int r = gw; r < n1; r += NGW) for (int j = 0; j < 8; ++j) *(f32x4*)(F0.out + (size_t)r * DM + 4 * F0.lane + 256 * j) = (f32x4){0.f, 0.f, 0.f, 0.f};
        asm volatile("s_waitcnt vmcnt(0)" ::: "memory");
        if (F0.bid == 0 && F0.tid == 0) F0.out[0] = V;
    }
#endif
#undef IN
#undef SEAM
}


extern "C" void kernel_launch(void* const* d_in, const int* in_sizes, int n_in, void* d_out, int out_size, void* d_ws, size_t ws_size, hipStream_t stream) {
    static int grid = 0;
    if (grid == 0) {
        if (n_in != 24 || out_size != SEQ * DM || ws_size < WS_END) { fprintf(stderr, "kernel_launch: unexpected shapes (n_in %d out %d ws %zu)\n", n_in, out_size, ws_size); grid = -1; return; }
        int dev = 0, cus = 0, per_cu = 0;
        if (hipGetDevice(&dev) != hipSuccess || hipDeviceGetAttribute(&cus, hipDeviceAttributeMultiprocessorCount, dev) != hipSuccess) { grid = -1; return; }
        if (hipFuncSetAttribute((const void*)fwd, hipFuncAttributeMaxDynamicSharedMemorySize, LDS_BYTES) != hipSuccess) { fprintf(stderr, "kernel_launch: hipFuncSetAttribute failed\n"); grid = -1; return; }
        if (hipOccupancyMaxActiveBlocksPerMultiprocessor(&per_cu, (const void*)fwd, NTHR, LDS_BYTES) != hipSuccess || per_cu < 1) { fprintf(stderr, "kernel_launch: occupancy query says %d\n", per_cu); }
        (void)hipGetLastError();
        grid = cus;
    }
    if (grid < 0) return;
    (void)hipMemsetAsync((char*)d_ws + WS_CTL, 0, CTL_ZERO_BYTES, stream);
    Args a{};
    for (int i = 0; i < 24; ++i) a.in[i] = (const float*)d_in[i];
    a.out = (float*)d_out; a.ws = (unsigned char*)d_ws;
#if MK_ONE_LAUNCH
    a.ph_lo = 0; a.ph_hi = NPH;
    hipLaunchKernelGGL(fwd, dim3(grid), dim3(NTHR), LDS_BYTES, stream, a);

#else
    for (int k = 0; k < NPH; ++k) { a.ph_lo = k; a.ph_hi = k + 1; hipLaunchKernelGGL(fwd, dim3(grid), dim3(NTHR), LDS_BYTES, stream, a); }
#endif
}
```

```cpp
#include <hip/hip_runtime.h>
#include <cstdio>
#include <cstdint>

#ifndef MK_ONE_LAUNCH
#define MK_ONE_LAUNCH 1
#endif

constexpr int DM = 2048, SEQ = 8192, CTXL = 256, NROW = SEQ + CTXL;
constexpr int INW = 4096, NEXP = 32, DEXP = 1024, GRIDW = 64;
constexpr float ALPHA = 1.41421356237309515f;
constexpr float LN_EPS = 1e-6f;
constexpr int NPH = 18;
constexpr int MOE_CAP_TILES = 98;
constexpr int NWAVES = 8, NTHR = 512;

constexpr size_t MiB = 1u << 20;
constexpr size_t WS_CTL = 0, CTL_ZERO_BYTES = 1 * MiB;
constexpr size_t WS_MOD = 1 * MiB;
constexpr size_t WS_ROPE = 1 * MiB + 256 * 1024;
constexpr size_t WS_RWT = 1 * MiB + 512 * 1024;
constexpr size_t WS_TOKE = 2 * MiB;
constexpr size_t WS_TOKP = WS_TOKE + 128 * 1024;
constexpr size_t WS_TOKG = WS_TOKP + 128 * 1024;
constexpr size_t WS_LIST = 3 * MiB;
constexpr size_t WS_WIN = 8 * MiB;
constexpr size_t WS_WOUT = 40 * MiB;
constexpr size_t WS_WGU = 64 * MiB;
constexpr size_t WS_WD = 576 * MiB;
constexpr size_t WS_H1 = 832 * MiB;
constexpr size_t WS_PROJ = 866 * MiB;
constexpr size_t WS_MIX = 932 * MiB;
constexpr size_t WS_Y1 = 966 * MiB;
constexpr size_t WS_XS = 1032 * MiB;
constexpr size_t WS_H2 = 1098 * MiB;
constexpr size_t WS_GA = 1132 * MiB;
constexpr size_t WS_YS = 1182 * MiB;
constexpr size_t WS_H2L = 1378 * MiB;
constexpr size_t WS_KV = 1412 * MiB;
constexpr size_t WS_CKV = 1424 * MiB;
constexpr size_t WS_END = 1426 * MiB;
constexpr int CW_BAR = 4096;
constexpr int CW_CNT = 8192;
constexpr int LDS_PART = 131072;
constexpr int LDS_SC = 147456;
constexpr int LDS_TILE = 151552;
constexpr int LDS_MISC = 153600;
constexpr int LDS_BYTES = 155648;

#define GAS __attribute__((address_space(1)))
#define LAS __attribute__((address_space(3)))
typedef unsigned short bf16_t;
typedef float f32x4 __attribute__((ext_vector_type(4)));
typedef float f32x2 __attribute__((ext_vector_type(2)));
typedef float f32x16 __attribute__((ext_vector_type(16)));
typedef short bf16x8 __attribute__((ext_vector_type(8)));
typedef short s16x4 __attribute__((ext_vector_type(4)));
typedef unsigned u32x4 __attribute__((ext_vector_type(4)));
typedef unsigned u32x2 __attribute__((ext_vector_type(2)));

__device__ __forceinline__ unsigned cvt_pk_bf16(float lo, float hi) { unsigned r; asm volatile("v_cvt_pk_bf16_f32 %0, %1, %2" : "=v"(r) : "v"(lo), "v"(hi)); return r; }
__device__ __forceinline__ bf16_t f2bf(float f) { unsigned u = __builtin_bit_cast(unsigned, f); return (bf16_t)((u + 0x7fffu + ((u >> 16) & 1u)) >> 16); }
__device__ __forceinline__ float bf2f(bf16_t b) { return __builtin_bit_cast(float, ((unsigned)b) << 16); }
__device__ __forceinline__ u32x2 pack4(f32x4 v) { u32x2 o; o.x = cvt_pk_bf16(v.x, v.y); o.y = cvt_pk_bf16(v.z, v.w); return o; }
template <int CTRL> __device__ __forceinline__ float dpp_mov(float v) { return __builtin_bit_cast(float, __builtin_amdgcn_update_dpp(0, __builtin_bit_cast(int, v), CTRL, 0xF, 0xF, true)); }
__device__ __forceinline__ float quad_sum(float v) { v += dpp_mov<0xB1>(v); v += dpp_mov<0x4E>(v); return v; }
__device__ __forceinline__ float wave_sum(float v) {
    v += dpp_mov<0xB1>(v); v += dpp_mov<0x4E>(v); v += dpp_mov<0x141>(v); v += dpp_mov<0x140>(v);
    const float s0 = __builtin_bit_cast(float, __builtin_amdgcn_readlane(__builtin_bit_cast(int, v), 0)), s1 = __builtin_bit_cast(float, __builtin_amdgcn_readlane(__builtin_bit_cast(int, v), 16));
    const float s2 = __builtin_bit_cast(float, __builtin_amdgcn_readlane(__builtin_bit_cast(int, v), 32)), s3 = __builtin_bit_cast(float, __builtin_amdgcn_readlane(__builtin_bit_cast(int, v), 48));
    return (s0 + s1) + (s2 + s3);
}
__device__ __forceinline__ float sigmoidf_(float x) { return 1.0f / (1.0f + expf(-x)); }
__device__ __forceinline__ float gelu_tanh_fast(float x) { const float u = x * (1.0f + 0.044715f * x * x) * 1.5957691216057308f; return x * __builtin_amdgcn_rcpf(1.0f + __expf(-u)); }
__device__ __forceinline__ float silu_fast(float x) { return x * __builtin_amdgcn_rcpf(1.0f + __expf(-x)); }

#define XB_TMO      128
#define XB_XCNT(j)  (256  + 64 * (j))
#define XB_XSUB(j)  (1280 + 64 * (j))
#define XB_XGEN(j)  (2304 + 64 * (j))
#define XB_TOP      3328
#define XB_TOPGEN   3392
#define XCD_BAR_WORDS 3456
#define XB_SPIN_CAP (1u << 20)
__device__ __forceinline__ unsigned xb_ld(unsigned* p)              { return __hip_atomic_load(p, __ATOMIC_RELAXED, __HIP_MEMORY_SCOPE_AGENT); }
__device__ __forceinline__ unsigned xb_add(unsigned* p, unsigned v) { return __hip_atomic_fetch_add(p, v, __ATOMIC_RELAXED, __HIP_MEMORY_SCOPE_AGENT); }
__device__ __forceinline__ unsigned xb_xcc_id() { return (unsigned)__builtin_amdgcn_s_getreg((3 << 11) | 20) & 0xFu; }
#define XB_SPIN(cond, bar) do { unsigned _sp = 0; while (cond) { __builtin_amdgcn_s_sleep(1); \
    if ((++_sp & 255u) == 0u) { if (xb_ld(&(bar)[XB_TMO])) break; if (_sp > XB_SPIN_CAP) { atomicAdd(&(bar)[XB_TMO], 1u); break; } } } } while (0)
struct XcdBarrier { unsigned* bar; unsigned x; volatile LAS unsigned* st; };
__device__ __forceinline__ XcdBarrier xcd_barrier_post(unsigned* bar, volatile LAS unsigned* st) {
    XcdBarrier b; b.bar = bar; b.x = xb_xcc_id(); b.st = st;
    if (threadIdx.x == 0) (void)xb_add(&bar[XB_XCNT(b.x)], 1u);
    return b;
}
__device__ __forceinline__ void xcd_barrier_complete(unsigned* bar, unsigned x, unsigned& nloc, unsigned& nx) {
    const unsigned G = gridDim.x * gridDim.y * gridDim.z;
    unsigned sum, cnt, mine, sp = 0u;
    for (;;) {
        sum = 0u; cnt = 0u; mine = 0u;
#pragma unroll
        for (unsigned j = 0; j < 16; ++j) { const unsigned c = xb_ld(&bar[XB_XCNT(j)]); sum += c; cnt += (c > 0u) ? 1u : 0u; mine = (j == x) ? c : mine; }
        if (sum == G) break;
        __builtin_amdgcn_s_sleep(1);
        if ((++sp & 255u) == 0u) { if (xb_ld(&bar[XB_TMO])) break; if (sp > XB_SPIN_CAP) { atomicAdd(&bar[XB_TMO], 1u); break; } }
    }
    nloc = mine > 0u ? mine : 1u; nx = cnt > 0u ? cnt : 1u;
}
__device__ __forceinline__ void xcd_barrier(const XcdBarrier& b) {
    asm volatile("s_waitcnt vmcnt(0)" ::: "memory");
    __syncthreads();
    if (threadIdx.x == 0) {
        unsigned* bar = b.bar;
        __builtin_amdgcn_s_waitcnt(0);
        unsigned nloc = b.st[0], nx = b.st[1];
        if (nloc == 0u) { xcd_barrier_complete(bar, b.x, nloc, nx); b.st[0] = nloc; b.st[1] = nx; }
        const unsigned old = xb_add(&bar[XB_XSUB(b.x)], 1u);
        const unsigned gen = old / nloc;
        if (old + 1u == (gen + 1u) * nloc) {
            __builtin_amdgcn_fence(__ATOMIC_RELEASE, "agent");
            asm volatile("s_waitcnt vmcnt(0)" ::: "memory");
            const unsigned og = xb_add(&bar[XB_TOP], 1u);
            const unsigned tg = og / nx;
            if (og + 1u == (tg + 1u) * nx) xb_add(&bar[XB_TOPGEN], 1u);
            else XB_SPIN(xb_ld(&bar[XB_TOPGEN]) == tg, bar);
            __builtin_amdgcn_fence(__ATOMIC_ACQUIRE, "agent");
            xb_add(&bar[XB_XGEN(b.x)], 1u);
            asm volatile("s_waitcnt vmcnt(0)" ::: "memory");
        } else {
            XB_SPIN(xb_ld(&bar[XB_XGEN(b.x)]) == gen, bar);
            __builtin_amdgcn_fence(__ATOMIC_ACQUIRE, "agent");
            asm volatile("s_waitcnt vmcnt(0)" ::: "memory");
        }
    }
    __syncthreads();
}

struct Args { const float* in[24]; float* out; unsigned char* ws; int ph_lo, ph_hi; };
struct Frame {
    LAS unsigned char* lds;
    int tid, lane, wave, G, bid;
    const float* const* in;
    float* out; unsigned char* ws;
};
__device__ __forceinline__ Frame launder(const Frame& F0) {
    Frame F = F0; int t = F0.tid; asm volatile("" : "+v"(t)); F.tid = t; F.lane = t & 63; F.wave = __builtin_amdgcn_readfirstlane(t >> 6);
    unsigned long long w = (unsigned long long)F0.ws; asm volatile("" : "+s"(w)); F.ws = (unsigned char*)(GAS unsigned char*)w;
    unsigned l = (unsigned)(uintptr_t)F0.lds; asm volatile("" : "+s"(l)); F.lds = (LAS unsigned char*)(uintptr_t)l;
    int g = F0.G, b = F0.bid; asm volatile("" : "+s"(g), "+s"(b)); F.G = g; F.bid = b;
    return F;
}
#define IN_X 0
#define IN_C 1
#define IN_CTX 2
#define IN_CCTX 3
#define IN_ADAW 4
#define IN_ADAB 5
#define IN_WIN 6
#define IN_RPB 7
#define IN_SGLNG 8
#define IN_SGLNB 9
#define IN_SGW 10
#define IN_SGB 11
#define IN_QNG 12
#define IN_KNG 13
#define IN_WOUT 14
#define IN_LNMG 15
#define IN_LNMB 16
#define IN_RW 17
#define IN_RB 18
#define IN_WG 19
#define IN_WU 20
#define IN_WDN 21
#define IN_LNFG 22
#define IN_LNFB 23

__device__ __forceinline__ void p0_mod(const Frame& F) {
    LAS float* sl = (LAS float*)F.lds;
    LAS float* red = sl + 4096;
    const float* c = F.in[IN_C]; const float* cc = F.in[IN_CCTX];
    for (int t = F.tid; t < DM; t += NTHR) { const float a = c[t]; sl[t] = a * sigmoidf_(a); const float b = cc[t]; sl[DM + t] = b * sigmoidf_(b); }
    __syncthreads();
    float* MOD = (float*)(F.ws + WS_MOD);
    for (int item = F.bid; item < 256; item += F.G) {
        const int l = item >> 7, nb = item & 127, col0 = nb * 96;
        f32x2 a0 = {0.f, 0.f}, a1 = {0.f, 0.f};
        if (F.lane < 48) {
            const float* wp = F.in[IN_ADAW] + (size_t)l * DM * 12288 + (size_t)(F.wave * 256) * 12288 + col0 + 2 * F.lane;
            const LAS float* s0 = sl + F.wave * 256; const LAS float* s1 = sl + DM + F.wave * 256;
#pragma unroll 8
            for (int k = 0; k < 256; ++k) { const f32x2 w = *(const f32x2*)(wp + (size_t)k * 12288); a0 += s0[k] * w; a1 += s1[k] * w; }
            red[(F.wave * 2 + 0) * 96 + 2 * F.lane] = a0.x; red[(F.wave * 2 + 0) * 96 + 2 * F.lane + 1] = a0.y;
            red[(F.wave * 2 + 1) * 96 + 2 * F.lane] = a1.x; red[(F.wave * 2 + 1) * 96 + 2 * F.lane + 1] = a1.y;
        }
        __syncthreads();
        if (F.tid < 192) { const int v = F.tid / 96, q = F.tid % 96; float s = 0.f;
#pragma unroll
            for (int w = 0; w < 8; ++w) s += red[(w * 2 + v) * 96 + q];
            MOD[(size_t)(l * 2 + v) * 12288 + col0 + q] = s + F.in[IN_ADAB][l * 12288 + col0 + q]; }
        __syncthreads();
    }
}
__device__ __forceinline__ void tr_item(const float* W, int K, int N, bf16_t* WT, int k0, int n0, int drow0, LAS float* scr, int lane) {
    f32x4 v[16];
    const float* wp = W + (size_t)(k0 + (lane >> 4)) * N + n0 + 4 * (lane & 15);
#pragma unroll
    for (int i = 0; i < 16; ++i) v[i] = __builtin_nontemporal_load((const f32x4*)(wp + (size_t)(4 * i) * N));
#pragma unroll
    for (int i = 0; i < 16; ++i) { LAS float* p = scr + (4 * i + (lane >> 4)) * 65 + 4 * (lane & 15); p[0] = v[i].x; p[1] = v[i].y; p[2] = v[i].z; p[3] = v[i].w; }
    asm volatile("s_waitcnt lgkmcnt(0)" ::: "memory");
    const int c = lane & 7;
#pragma unroll
    for (int j = 0; j < 8; ++j) { const int n = (lane >> 3) + 8 * j; const LAS float* s = scr + (8 * c) * 65 + n;
        u32x4 o; o.x = cvt_pk_bf16(s[0 * 65], s[1 * 65]); o.y = cvt_pk_bf16(s[2 * 65], s[3 * 65]); o.z = cvt_pk_bf16(s[4 * 65], s[5 * 65]); o.w = cvt_pk_bf16(s[6 * 65], s[7 * 65]);
        *(u32x4*)(WT + (size_t)(drow0 + n) * K + k0 + 8 * c) = o; }
    asm volatile("s_waitcnt lgkmcnt(0)" ::: "memory");
}
struct TrDesc { const float* src; bf16_t* dst; int N, K; };
__device__ __forceinline__ TrDesc moe_item_desc(const Frame& F, int m) {
    const int le = m / 1536, r = m % 1536, which = r >> 9, r2 = r & 511; TrDesc d;
    if (which < 2) { const int kb = r2 >> 4, nb = r2 & 15, n0 = nb * 64; d.N = DEXP; d.K = DM;
        d.src = F.in[which == 0 ? IN_WG : IN_WU] + (size_t)le * DM * DEXP + (size_t)(kb * 64) * DEXP + n0;
        d.dst = (bf16_t*)(F.ws + WS_WGU) + (size_t)le * 2048 * DM + (size_t)((n0 >> 7) * 256 + (n0 & 127) + which * 128) * DM + kb * 64; }
    else { const int kb = r2 >> 5, nb = r2 & 31; d.N = DM; d.K = DEXP;
        d.src = F.in[IN_WDN] + (size_t)le * DEXP * DM + (size_t)(kb * 64) * DM + nb * 64;
        d.dst = (bf16_t*)(F.ws + WS_WD) + (size_t)le * DM * DEXP + (size_t)(nb * 64) * DEXP + kb * 64; }
    return d;
}
__device__ __forceinline__ void tr_load64(const TrDesc& d, f32x4 (&v)[16], int lane) {
    const float* wp = d.src + (size_t)(lane >> 4) * d.N + 4 * (lane & 15);
#pragma unroll
    for (int i = 0; i < 16; ++i) v[i] = __builtin_nontemporal_load((const f32x4*)(wp + (size_t)(4 * i) * d.N));
}
__device__ __forceinline__ void tr_finish64(const TrDesc& d, const f32x4 (&v)[16], LAS float* scr, int lane) {
#pragma unroll
    for (int i = 0; i < 16; ++i) { LAS float* p = scr + (4 * i + (lane >> 4)) * 65 + 4 * (lane & 15); p[0] = v[i].x; p[1] = v[i].y; p[2] = v[i].z; p[3] = v[i].w; }
    asm volatile("s_waitcnt lgkmcnt(0)" ::: "memory");
    const int c = lane & 7;
#pragma unroll
    for (int j = 0; j < 8; ++j) { const int n = (lane >> 3) + 8 * j; const LAS float* s = scr + (8 * c) * 65 + n;
        u32x4 o; o.x = cvt_pk_bf16(s[0 * 65], s[1 * 65]); o.y = cvt_pk_bf16(s[2 * 65], s[3 * 65]); o.z = cvt_pk_bf16(s[4 * 65], s[5 * 65]); o.w = cvt_pk_bf16(s[6 * 65], s[7 * 65]);
        *(u32x4*)(d.dst + (size_t)n * d.K + 8 * c) = o; }
    asm volatile("s_waitcnt lgkmcnt(0)" ::: "memory");
}
__device__ __forceinline__ void conv_moe_item(const Frame& F, int m, LAS float* scr) {
    const TrDesc d = moe_item_desc(F, m); f32x4 v[16]; tr_load64(d, v, F.lane); tr_finish64(d, v, scr, F.lane);
}
constexpr int NC_IN = 176, NC_OUT = 192, NC_MOE = 192, NCOMP = 128  ;
constexpr int CV_LAYER = 49152;
constexpr int CV_A0 = 20480, CV_L0F = CV_A0 + 10240;
constexpr int CV_B0 = 16384, CV_B1 = CV_B0 + 10240, CV_L1F = CV_B1 + 16384;
constexpr int CV_ATT = 6144;
static_assert(CV_L0F + CV_ATT <= CV_LAYER && CV_L1F + CV_ATT <= CV_LAYER, "converter ranges");
__device__ __forceinline__ void conv_range(const Frame& F, int ncomp, int first, int count) {
    LAS float* scr = (LAS float*)(F.lds + F.wave * 16896);
    const int cw = (F.bid - ncomp) * NWAVES + F.wave, NCW = (F.G - ncomp) * NWAVES;
    f32x4 va[16], vb[16]; TrDesc d, dn;
    if (cw < count) { d = moe_item_desc(F, first + cw); tr_load64(d, va, F.lane); }
    for (int k = cw; k < count; k += NCW) {
        const int kn = k + NCW;
        if (kn < count) { dn = moe_item_desc(F, first + kn); tr_load64(dn, vb, F.lane); }
        tr_finish64(d, va, scr, F.lane);
        d = dn;
#pragma unroll
        for (int i = 0; i < 16; ++i) va[i] = vb[i];
    }
}
__device__ __forceinline__ void p0_transposes(const Frame& F) {
    LAS float* scr = (LAS float*)(F.lds + F.wave * 16896);
    const int gw = F.bid * NWAVES + F.wave, NGW = F.G * NWAVES;
    constexpr int NDENSE = 2 * 3072;
    const bool split = F.G >= 256;
    const int r0 = split ? CV_LAYER - CV_L0F - CV_ATT : CV_LAYER, r1 = split ? CV_LAYER - CV_L1F - CV_ATT : CV_LAYER;
    const int NITEMS = NDENSE + r0 + r1;
    for (int it = gw; it < NITEMS; it += NGW) {
        if (it < NDENSE) {
            const int l = it / 3072, r = it % 3072;
            if (r < 2048) { const int kb = r >> 6, nb = r & 63; tr_item(F.in[IN_WIN] + (size_t)l * DM * INW, DM, INW, (bf16_t*)(F.ws + WS_WIN) + (size_t)l * INW * DM, kb * 64, nb * 64, nb * 64, scr, F.lane); }
            else { const int r2 = r - 2048, kb = r2 >> 5, nb = r2 & 31; tr_item(F.in[IN_WOUT] + (size_t)l * DM * DM, DM, DM, (bf16_t*)(F.ws + WS_WOUT) + (size_t)l * DM * DM, kb * 64, nb * 64, nb * 64, scr, F.lane); }
        } else {
            const int q = it - NDENSE;
            const int m = q < r0 ? (CV_LAYER - r0) + q : CV_LAYER + (CV_LAYER - r1) + (q - r0);
            conv_moe_item(F, m, scr);
        }
    }
}
__device__ __forceinline__ void p0_rope(const Frame& F) {
    const int g = F.bid * NTHR + F.tid;
    if (g < 32 * DM) { const int e = g >> 11, k = g & (DM - 1); const float w = F.in[IN_RW][k * 32 + e]; const bf16_t hi = f2bf(w); const bf16_t lo = f2bf(w - bf2f(hi));
        bf16_t* T = (bf16_t*)(F.ws + WS_RWT); T[g] = hi; T[32 * DM + g] = lo; }
    if (g < 128 * 32) { const int pos = g >> 5, i = g & 31; const float inv = powf(10000.0f, -(float)i / 32.0f); const float ang = (float)pos * inv;
        float* R = (float*)(F.ws + WS_ROPE); R[2 * g] = cosf(ang); R[2 * g + 1] = sinf(ang); }
}

__device__ __forceinline__ const float* xrow_ptr(const Frame& F, int l, int r) {
    if (l == 0) return r < SEQ ? F.in[IN_X] + (size_t)r * DM : F.in[IN_CTX] + (size_t)(r - SEQ) * DM;
    return (const float*)(F.ws + WS_XS) + (size_t)r * DM;
}
__device__ __forceinline__ void ln_stats(const f32x4 (&v)[8], float& mean, float& rstd) {
    float s = 0.f;
#pragma unroll
    for (int j = 0; j < 8; ++j) s += (v[j].x + v[j].y) + (v[j].z + v[j].w);
    mean = wave_sum(s) * (1.0f / DM);
    float q = 0.f;
#pragma unroll
    for (int j = 0; j < 8; ++j) { const f32x4 d = v[j] - mean; q += (d.x * d.x + d.y * d.y) + (d.z * d.z + d.w * d.w); }
    rstd = 1.0f / sqrtf(wave_sum(q) * (1.0f / DM) + LN_EPS);
}
template <bool TO_LDS>
__device__ __forceinline__ void modulate_store(const f32x4 (&v)[8], const float* sh, const float* sc, bf16_t* orow, LAS float* lrow, int lane) {
    float mean, rstd; ln_stats(v, mean, rstd);
#pragma unroll
    for (int j = 0; j < 8; ++j) { const int col = 4 * lane + 256 * j; const f32x4 s1 = *(const f32x4*)(sc + col), s0 = *(const f32x4*)(sh + col);
        const f32x4 h = (v[j] - mean) * rstd * (1.0f + s1) + s0;
        u32x2 w; w.x = cvt_pk_bf16(h.x, h.y); w.y = cvt_pk_bf16(h.z, h.w); *(u32x2*)(orow + col) = w;
        if (TO_LDS) *(LAS f32x4*)(lrow + col) = h; }
}
__device__ __forceinline__ void stage_vec(const Frame& F, LAS float* dst, const float* src) { *(LAS f32x4*)(dst + 4 * F.tid) = *(const f32x4*)(src + 4 * F.tid); }
__device__ __forceinline__ void p_modulate1(const Frame& F, int l, int nrows) {
    const int gw = F.bid * NWAVES + F.wave, NGW = F.G * NWAVES;
    const float* MOD = (const float*)(F.ws + WS_MOD);
    bf16_t* H1 = (bf16_t*)(F.ws + WS_H1);
    LAS float* prm = (LAS float*)F.lds;
    for (int v = 0; v < 2; ++v) { const float* m = MOD + (size_t)(l * 2 + v) * 12288; stage_vec(F, prm + (2 * v) * DM, m); stage_vec(F, prm + (2 * v + 1) * DM, m + DM); }
    __syncthreads();
    f32x4 nx[8];
    if (gw < nrows) { const float* xr = xrow_ptr(F, l, gw);
#pragma unroll
        for (int j = 0; j < 8; ++j) nx[j] = *(const f32x4*)(xr + 4 * F.lane + 256 * j); }
    for (int r = gw; r < nrows; r += NGW) {
        const int v = r >= SEQ; const LAS float* pv = prm + 2 * v * DM;
        f32x4 x[8];
#pragma unroll
        for (int j = 0; j < 8; ++j) x[j] = nx[j];
        if (r + NGW < nrows) { const float* xr = xrow_ptr(F, l, r + NGW);
#pragma unroll
            for (int j = 0; j < 8; ++j) nx[j] = *(const f32x4*)(xr + 4 * F.lane + 256 * j); }
        float mean, rstd; ln_stats(x, mean, rstd);
#pragma unroll
        for (int j = 0; j < 8; ++j) { const int col = 4 * F.lane + 256 * j; const f32x4 h = (x[j] - mean) * rstd * (1.0f + *(const LAS f32x4*)(pv + DM + col)) + *(const LAS f32x4*)(pv + col);
            u32x2 w; w.x = cvt_pk_bf16(h.x, h.y); w.y = cvt_pk_bf16(h.z, h.w); *(u32x2*)(H1 + (size_t)r * DM + col) = w; }
    }
    __syncthreads();
}

namespace pg8 {
constexpr int BM = 256, BK = 64, HALF = 128, HTB = HALF * BK * 2, STAGE_BYTES = 8 * HTB, NXCD = 8, WGM = 8;
__device__ __forceinline__ int lds_byte(int r, int c) { const int st = (r >> 4) * 2 + (c >> 5), rr = r & 15, cc = c & 31, ob = rr * 64 + cc * 2; return st * 1024 + (ob ^ (((ob >> 9) & 1) << 5)); }
__device__ __forceinline__ void stage_rc(int b, int& R, int& C) { const int st = b / 1024, sb = b % 1024, swz = sb ^ (((sb >> 9) & 1) << 5); R = (st >> 1) * 16 + swz / 64; C = (st & 1) * 32 + (swz % 64) / 2; }
__device__ __forceinline__ int perm32(int rho) { const int n = rho >> 4, i = rho & 15; return 8 * (i >> 2) + 4 * n + (i & 3); }
struct Unit { int pm, pn, e, mt; };
struct StaticOrder {
    int nM, nN, nwg, G, c, K; const bf16_t* Bt;
    __device__ __forceinline__ void init(int M, int N, int K_, const bf16_t* Bt_, int G_, int c_) { nM = M / BM; nN = N / BM; nwg = nM * nN; G = G_; c = c_; K = K_; Bt = Bt_; }
    __device__ __forceinline__ bool next(int i, Unit& u) const {
        const long L = (long)i * G + c; if (L >= nwg) return false;
        int wgid = (int)L; { const int q = nwg / NXCD, r = nwg % NXCD, xcd = wgid % NXCD, off = wgid / NXCD; wgid = (xcd < r ? xcd * (q + 1) : r * (q + 1) + (xcd - r) * q) + off; }
        const int nig = WGM * nN, gid = wgid / nig, fm = gid * WGM, gsz = (nM - fm) < WGM ? (nM - fm) : WGM;
        u.pm = fm + ((wgid % nig) % gsz); u.pn = (wgid % nig) / gsz; u.e = 0; u.mt = 0; return true;
    }
    __device__ __forceinline__ unsigned a_off(const Unit& u, int h, int R) const { return (unsigned)((u.pm * BM + h * HALF + R) * K) * 2u; }
    __device__ __forceinline__ const char* b_base(const Unit& u) const { return (const char*)Bt + (size_t)u.pn * BM * K * 2; }
};
template <bool GATHER> struct MoeOrder {
    const LAS int* tileEM; int ntiles, G, c, K; const int* list; const int* cnt; const bf16_t* Bt;
    __device__ __forceinline__ bool next(int i, Unit& u) const {
        if ((G & 7) == 0) {
            const LAS int* tbase = tileEM + 128; const int x = c & 7, W = G >> 3; int q = (c >> 3) + i * W;
#pragma unroll
            for (int k = 0; k < 4; ++k) { const int e = x + 8 * k; const int tb = tbase[e], nt = tbase[e + 1] - tb; const int nu = nt * 8;
                if (q < nu) { u.e = e; u.pn = q / nt; u.mt = q - u.pn * nt; u.pm = tb + u.mt; return true; }
                q -= nu; }
            return false;
        }
        const int L = i * G + c; if (L >= ntiles * 8) return false;
        const int tile = L >> 3; const int em = tileEM[tile]; u.pm = tile; u.pn = L & 7; u.e = em >> 8; u.mt = em & 255; return true;
    }
    __device__ __forceinline__ unsigned a_off(const Unit& u, int h, int R) const {
        if (GATHER) { const int slot = u.mt * BM + h * HALF + R; const int n = cnt[64 * u.e]; int tok = 0; if (slot < n) tok = list[u.e * NROW + slot]; return (unsigned)(tok * K) * 2u; }
        return (unsigned)((u.pm * BM + h * HALF + R) * K) * 2u;
    }
    __device__ __forceinline__ const char* b_base(const Unit& u) const { return (const char*)Bt + ((size_t)u.e * 2048 + (size_t)u.pn * BM) * K * 2; }
};
struct EpiF32 {
    static constexpr bool PERM = false;
    float* C; int ldc;
    __device__ __forceinline__ void operator()(const f32x4 (&acc)[2][2][4][2], const Unit& u, int wr, int wc, int fr, int fq) const {
        const int row0 = u.pm * BM + wr * 64 + fr, col0 = u.pn * BM + wc * 32 + 4 * fq;
#pragma unroll
        for (int ai = 0; ai < 2; ++ai)
#pragma unroll
            for (int m = 0; m < 4; ++m) { float* rowp = C + (size_t)(row0 + ai * HALF + m * 16) * ldc + col0;
#pragma unroll
                for (int bj = 0; bj < 2; ++bj)
#pragma unroll
                    for (int n = 0; n < 2; ++n) *(f32x4*)(rowp + bj * HALF + n * 16) = acc[ai][bj][m][n]; }
    }
};
template <bool GELU> struct EpiBf {
    static constexpr bool PERM = true;
    bf16_t* O; int ldc; bf16_t* KV;
    __device__ __forceinline__ void operator()(const f32x4 (&acc)[2][2][4][2], const Unit& u, int wr, int wc, int fr, int fq) const {
        const int row0 = u.pm * BM + wr * 64 + fr, col0 = u.pn * BM + wc * 32 + 8 * fq; const bool g = GELU && (u.pn >= 6 && u.pn <= 9);
#pragma unroll
        for (int ai = 0; ai < 2; ++ai)
#pragma unroll
            for (int m = 0; m < 4; ++m) { bf16_t* rowp = (GELU && u.pn >= 14) ? KV + (size_t)(row0 + ai * HALF + m * 16) * 512 + (col0 - 14 * BM) : O + (size_t)(row0 + ai * HALF + m * 16) * ldc + col0;
#pragma unroll
                for (int bj = 0; bj < 2; ++bj) { f32x4 v0 = acc[ai][bj][m][0], v1 = acc[ai][bj][m][1];
                    if (g) {
#pragma unroll
                        for (int j = 0; j < 4; ++j) { v0[j] = gelu_tanh_fast(v0[j]); v1[j] = gelu_tanh_fast(v1[j]); } }
                    u32x4 w; w.x = cvt_pk_bf16(v0[0], v0[1]); w.y = cvt_pk_bf16(v0[2], v0[3]); w.z = cvt_pk_bf16(v1[0], v1[1]); w.w = cvt_pk_bf16(v1[2], v1[3]);
                    *(u32x4*)(rowp + bj * HALF) = w;
                    if (GELU && u.pm == SEQ / BM && u.pn >= 2 && u.pn <= 5)
                        *(u32x4*)(KV + (size_t)(WS_CKV - WS_KV) / 2 + (size_t)((((u.pn - 2) & 1) * 2 + bj) * 256 + (wr * 64 + fr + ai * HALF + m * 16)) * 512 + (u.pn >= 4 ? 256 : 0) + wc * 32 + 8 * fq) = w; } }
    }
};
struct EpiSwiGLU {
    static constexpr bool PERM = true;
    bf16_t* O;
    __device__ __forceinline__ void operator()(const f32x4 (&acc)[2][2][4][2], const Unit& u, int wr, int wc, int fr, int fq) const {
        const int row0 = u.pm * BM + wr * 64 + fr, col0 = u.pn * HALF + wc * 32 + 8 * fq;
#pragma unroll
        for (int ai = 0; ai < 2; ++ai)
#pragma unroll
            for (int m = 0; m < 4; ++m) { bf16_t* rowp = O + (size_t)(row0 + ai * HALF + m * 16) * DEXP + col0;
                f32x4 v0, v1;
#pragma unroll
                for (int j = 0; j < 4; ++j) { v0[j] = silu_fast(acc[ai][0][m][0][j]) * acc[ai][1][m][0][j]; v1[j] = silu_fast(acc[ai][0][m][1][j]) * acc[ai][1][m][1][j]; }
                u32x4 w; w.x = cvt_pk_bf16(v0[0], v0[1]); w.y = cvt_pk_bf16(v0[2], v0[3]); w.z = cvt_pk_bf16(v1[0], v1[1]); w.w = cvt_pk_bf16(v1[2], v1[3]);
                *(u32x4*)rowp = w; }
    }
};

template <class Epi, class Sched>
__device__ __forceinline__ void gemm_phase(LAS unsigned char* lds, int tid, const bf16_t* Amat, int K, const Sched& S, const Epi& E) {
    const int wid = __builtin_amdgcn_readfirstlane(tid >> 6), lane = tid & 63, wr = wid >> 2, wc = wid & 3, fr = lane & 15, fq = lane >> 4;
    const int nt = K / BK;
    int Rl[2], Cl[2]; unsigned voffB[2];
#pragma unroll
    for (int i = 0; i < 2; ++i) { int R, C; stage_rc(tid * 16 + i * 8192, R, C); Rl[i] = R; Cl[i] = C; const int Rb = Epi::PERM ? ((R & ~31) + perm32(R & 31)) : R; voffB[i] = (unsigned)(Rb * K + C) * 2u; }
    const size_t kstep = (size_t)(BK * 2);
    const size_t hstep = (size_t)HALF * K * 2;
    const unsigned ldsw = (unsigned)wid * 1024u;
    const int aoff = lds_byte(wr * 64 + fr, fq * 8), boff = lds_byte(wc * 32 + fr, fq * 8);
    const char* Ab = (const char*)Amat;
#define PG8_SA(b, h) (((b) * 2 + (h)) * HTB)
#define PG8_SB(b, h) ((4 + (b) * 2 + (h)) * HTB)
#define PG8_STAGE(bufoff, gbase, voff) do { _Pragma("unroll") for (int _i = 0; _i < 2; ++_i) \
        __builtin_amdgcn_global_load_lds((const unsigned*)((const char*)(gbase) + (voff)[_i]), (LAS unsigned*)(lds + (bufoff) + ldsw + _i * 8192), 16, 0, 0); } while (0)
#define PG8_LDA(dst, b, h) do { _Pragma("unroll") for (int m = 0; m < 4; ++m) _Pragma("unroll") for (int k = 0; k < 2; ++k) dst[m][k] = *(const LAS bf16x8*)(lds + PG8_SA(b, h) + aoff + m * 2048 + k * 1024); } while (0)
#define PG8_LDB(dst, b, h) do { _Pragma("unroll") for (int n = 0; n < 2; ++n) _Pragma("unroll") for (int k = 0; k < 2; ++k) dst[n][k] = *(const LAS bf16x8*)(lds + PG8_SB(b, h) + boff + n * 2048 + k * 1024); } while (0)
#define PG8_MMA(ai, bj, At, Bt) do { __builtin_amdgcn_s_setprio(1); _Pragma("unroll") for (int m = 0; m < 4; ++m) _Pragma("unroll") for (int n = 0; n < 2; ++n) _Pragma("unroll") for (int k = 0; k < 2; ++k) \
        acc[ai][bj][m][n] = __builtin_amdgcn_mfma_f32_16x16x32_bf16(Bt[n][k], At[m][k], acc[ai][bj][m][n], 0, 0, 0); __builtin_amdgcn_s_setprio(0); } while (0)
#define PG8_WAIT_V(n) asm volatile("s_waitcnt vmcnt(" #n ")" ::: "memory")
#define PG8_WAIT_L(n) asm volatile("s_waitcnt lgkmcnt(" #n ")" ::: "memory")
#define PG8_BAR __builtin_amdgcn_s_barrier()
#define PG8_SCHED __builtin_amdgcn_sched_barrier(0)
#define PG8_AOFFS(dst, u) do { _Pragma("unroll") for (int _h = 0; _h < 2; ++_h) _Pragma("unroll") for (int _i = 0; _i < 2; ++_i) dst[_h][_i] = S.a_off(u, _h, Rl[_i]) + (unsigned)Cl[_i] * 2u; \
        asm volatile("" : "+v"(dst[0][0]), "+v"(dst[0][1]), "+v"(dst[1][0]), "+v"(dst[1][1])); } while (0)
    Unit cur, nxt; int ui = 0;
    if (!S.next(0, cur)) return;
    f32x4 acc[2][2][4][2];
#pragma unroll
    for (int a = 0; a < 2; ++a)
#pragma unroll
        for (int b = 0; b < 2; ++b)
#pragma unroll
            for (int m = 0; m < 4; ++m)
#pragma unroll
                for (int n = 0; n < 2; ++n) acc[a][b][m][n] = (f32x4){0.f, 0.f, 0.f, 0.f};
    bf16x8 At[4][2], B0[2][2], B1[2][2];
    unsigned vA[2][2], vAn[2][2];
    PG8_AOFFS(vA, cur);
    const char* cB = S.b_base(cur);
    PG8_STAGE(PG8_SB(0, 0), cB, voffB); PG8_STAGE(PG8_SA(0, 0), Ab, vA[0]); PG8_STAGE(PG8_SB(0, 1), cB + hstep, voffB); PG8_STAGE(PG8_SA(0, 1), Ab, vA[1]);
    if (wr == 1) PG8_BAR;
    PG8_WAIT_V(4); PG8_BAR;
    PG8_STAGE(PG8_SB(1, 0), cB + kstep, voffB); PG8_STAGE(PG8_SA(1, 0), Ab + kstep, vA[0]); PG8_STAGE(PG8_SB(1, 1), cB + hstep + kstep, voffB);
    PG8_WAIT_V(6); PG8_BAR;
    for (;;) {
        const bool has_next = S.next(ui + 1, nxt);
        const char* nB = cB;
        if (has_next) { PG8_AOFFS(vAn, nxt); nB = S.b_base(nxt); }
        else {
#pragma unroll
            for (int h = 0; h < 2; ++h)
#pragma unroll
                for (int i = 0; i < 2; ++i) vAn[h][i] = vA[h][i]; }
        for (int t = 0; t < nt; t += 2) {
            const bool last = (t == nt - 2);
            const char* a1 = Ab + (size_t)(t + 1) * kstep;
            const char* a2 = last ? Ab : Ab + (size_t)(t + 2) * kstep; const char* b2 = last ? nB : cB + (size_t)(t + 2) * kstep;
            const char* a3 = a2 + kstep; const char* b3 = b2 + kstep;
            unsigned o2[2][2];
#pragma unroll
            for (int h = 0; h < 2; ++h)
#pragma unroll
                for (int i = 0; i < 2; ++i) o2[h][i] = last ? vAn[h][i] : vA[h][i];
            PG8_LDB(B0, 0, 0); PG8_SCHED; PG8_LDA(At, 0, 0); PG8_STAGE(PG8_SA(1, 1), a1, vA[1]);
            PG8_WAIT_L(8); PG8_BAR; PG8_WAIT_L(0); PG8_MMA(0, 0, At, B0); PG8_BAR; PG8_SCHED;
            PG8_LDB(B1, 0, 1); PG8_STAGE(PG8_SB(0, 0), b2, voffB);
            PG8_BAR; PG8_WAIT_L(0); PG8_MMA(0, 1, At, B1); PG8_BAR;
            PG8_LDA(At, 0, 1); PG8_STAGE(PG8_SA(0, 0), a2, o2[0]);
            PG8_BAR; PG8_WAIT_L(0); PG8_MMA(1, 0, At, B0); PG8_BAR; PG8_SCHED;
            PG8_STAGE(PG8_SB(0, 1), b2 + hstep, voffB);
            PG8_WAIT_V(6); PG8_BAR; PG8_MMA(1, 1, At, B1); PG8_BAR;
            PG8_LDB(B0, 1, 0); PG8_SCHED; PG8_LDA(At, 1, 0); PG8_STAGE(PG8_SA(0, 1), a2, o2[1]);
            PG8_WAIT_L(8); PG8_BAR; PG8_WAIT_L(0); PG8_MMA(0, 0, At, B0); PG8_BAR; PG8_SCHED;
            PG8_LDB(B1, 1, 1); PG8_STAGE(PG8_SB(1, 0), b3, voffB);
            PG8_BAR; PG8_WAIT_L(0); PG8_MMA(0, 1, At, B1); PG8_BAR;
            PG8_LDA(At, 1, 1); PG8_STAGE(PG8_SA(1, 0), a3, o2[0]);
            PG8_BAR; PG8_WAIT_L(0); PG8_MMA(1, 0, At, B0); PG8_BAR; PG8_SCHED;
            PG8_STAGE(PG8_SB(1, 1), b3 + hstep, voffB);
            PG8_WAIT_V(6); PG8_BAR; PG8_MMA(1, 1, At, B1); PG8_BAR;
        }
        E(acc, cur, wr, wc, fr, fq);
        if (!has_next) break;
#pragma unroll
        for (int a = 0; a < 2; ++a)
#pragma unroll
            for (int b = 0; b < 2; ++b)
#pragma unroll
                for (int m = 0; m < 4; ++m)
#pragma unroll
                    for (int n = 0; n < 2; ++n) acc[a][b][m][n] = (f32x4){0.f, 0.f, 0.f, 0.f};
        cur = nxt; cB = nB; ++ui;
#pragma unroll
        for (int h = 0; h < 2; ++h)
#pragma unroll
            for (int i = 0; i < 2; ++i) vA[h][i] = vAn[h][i];
    }
    PG8_WAIT_V(0);
    if (wr == 0) PG8_BAR;
    PG8_BAR;
#undef PG8_SA
#undef PG8_SB
#undef PG8_STAGE
#undef PG8_LDA
#undef PG8_LDB
#undef PG8_MMA
#undef PG8_WAIT_V
#undef PG8_WAIT_L
#undef PG8_BAR
#undef PG8_SCHED
#undef PG8_AOFFS
}
}

__device__ __forceinline__ void p_rmsrope(const Frame& F, int l, int nrows, int wg0) {
    const int gw = (F.bid - wg0) * NWAVES + F.wave, NGW = (F.G - wg0) * NWAVES;
    bf16_t* P = (bf16_t*)(F.ws + WS_PROJ);
    const float* R = (const float*)(F.ws + WS_ROPE);
    const int i = F.lane & 31, ax = F.lane >> 5, d1 = ax * 64 + i, d2 = d1 + 32;
    const float gq1 = F.in[IN_QNG][l * 128 + d1], gq2 = F.in[IN_QNG][l * 128 + d2], gk1 = F.in[IN_KNG][l * 128 + d1], gk2 = F.in[IN_KNG][l * 128 + d2];
    for (int r = gw; r < nrows; r += NGW) {
        float cs = 1.f, sn = 0.f;
        if (r < SEQ) { const int pos = ax == 0 ? (r >> 6) : (r & 63); cs = R[2 * (pos * 32 + i)]; sn = R[2 * (pos * 32 + i) + 1]; }
#pragma unroll
        for (int hh = 0; hh < 10; ++hh) {
            bf16_t* p = P + (size_t)r * INW + (hh < 8 ? 2560 + hh * 128 : 3584 + (hh - 8) * 128);
            float x1 = bf2f(p[d1]), x2 = bf2f(p[d2]);
            const float ss = wave_sum(x1 * x1 + x2 * x2);
            const float rinv = 1.0f / sqrtf(ss * (1.0f / 128.0f) + LN_EPS);
            x1 = x1 * rinv * (hh < 8 ? gq1 : gk1); x2 = x2 * rinv * (hh < 8 ? gq2 : gk2);
            p[d1] = f2bf(x1 * cs - x2 * sn); p[d2] = f2bf(x2 * cs + x1 * sn);
        }
    }
}

__device__ __forceinline__ void rms_rope_tile(const Frame& F, int l, int row0, int pn) {
    bf16_t* P = (bf16_t*)(F.ws + WS_PROJ);
    const float* R = (const float*)(F.ws + WS_ROPE);
    const float* gn = F.in[pn < 14 ? IN_QNG : IN_KNG] + l * 128;
    const int q = F.lane & 3;
    float gv[32];
#pragma unroll
    for (int c = 0; c < 4; ++c) { const f32x4 a = *(const f32x4*)(gn + 32 * c + 8 * q), b2 = *(const f32x4*)(gn + 32 * c + 8 * q + 4);
        gv[8 * c] = a.x; gv[8 * c + 1] = a.y; gv[8 * c + 2] = a.z; gv[8 * c + 3] = a.w; gv[8 * c + 4] = b2.x; gv[8 * c + 5] = b2.y; gv[8 * c + 6] = b2.z; gv[8 * c + 7] = b2.w; }
#pragma unroll 1
    for (int it = 0; it < 4; ++it) {
        const int pr = it * 128 + F.wave * 16 + (F.lane >> 2);
        const int row = row0 + (pr >> 1);
        bf16_t* p = (pn == 14) ? (bf16_t*)(F.ws + WS_KV) + (size_t)row * 512 + (pr & 1) * 128 + 8 * q : P + (size_t)row * INW + pn * 256 + (pr & 1) * 128 + 8 * q;
        float x[32]; float ss = 0.f;
#pragma unroll
        for (int c = 0; c < 4; ++c) { const u32x4 r = *(const u32x4*)(p + 32 * c);
#pragma unroll
            for (int e = 0; e < 4; ++e) { x[8 * c + 2 * e] = bf2f((bf16_t)(r[e] & 0xffffu)); x[8 * c + 2 * e + 1] = bf2f((bf16_t)(r[e] >> 16)); } }
#pragma unroll
        for (int t = 0; t < 32; ++t) ss += x[t] * x[t];
        ss = quad_sum(ss);
        const float rinv = 1.0f / sqrtf(ss * (1.0f / 128.0f) + LN_EPS);
#pragma unroll
        for (int t = 0; t < 32; ++t) x[t] = x[t] * rinv * gv[t];
        if (row < SEQ) {
#pragma unroll
            for (int ax = 0; ax < 2; ++ax) { const int pos = ax == 0 ? (row >> 6) : (row & 63); const float* cs = R + 2 * (pos * 32 + 8 * q);
#pragma unroll
                for (int t4 = 0; t4 < 4; ++t4) { const f32x4 w = *(const f32x4*)(cs + 4 * t4);
#pragma unroll
                    for (int e = 0; e < 2; ++e) { const int t = 2 * t4 + e; const float c0 = e ? w.z : w.x, s0 = e ? w.w : w.y;
                        const float x1 = x[16 * ax + t], x2 = x[16 * ax + 8 + t]; x[16 * ax + t] = x1 * c0 - x2 * s0; x[16 * ax + 8 + t] = x2 * c0 + x1 * s0; } } }
        }
#pragma unroll
        for (int c = 0; c < 4; ++c) { u32x4 o;
#pragma unroll
            for (int e = 0; e < 4; ++e) o[e] = cvt_pk_bf16(x[8 * c + 2 * e], x[8 * c + 2 * e + 1]);
            *(u32x4*)(p + 32 * c) = o; }
    }
}

namespace att {
constexpr int D = 128, NW = 8, QBLK = 32, KVBLK = 64;
constexpr float SCALE = 0.088388347648318440f;
constexpr float THR = 8.f;
constexpr int LDQ = INW, LDO = DM;
constexpr size_t SHM_V = KVBLK * D * 2, SHM_K = KVBLK * D * 2, SHM_ATTN = 2 * SHM_V + 2 * SHM_K + NW * 64 * 4;
#define KSWZ(row, colB) ((row) * 256 + ((colB) ^ (((row) & 7) << 4)))
#define SBAR() __builtin_amdgcn_sched_barrier(0)
__device__ __forceinline__ int crow(int r, int hi) { return (r & 3) + 8 * (r >> 2) + 4 * hi; }
typedef __bf16 bf16v2 __attribute__((ext_vector_type(2)));
typedef float f32v2 __attribute__((ext_vector_type(2)));
__device__ __forceinline__ unsigned cvtpk(float lo, float hi) { const f32v2 v = {lo, hi}; const bf16v2 r = __builtin_convertvector(v, bf16v2); return *reinterpret_cast<const unsigned*>(&r); }
__device__ __forceinline__ void partialSM(f32x16& p0, f32x16& p1, float& m_reg, float& mn, float& alpha) {
  constexpr float C = SCALE * 1.4426950408889634f;
  float pmax = p0[0];
#pragma unroll
  for (int r = 1; r < 16; ++r) pmax = fmaxf(pmax, p0[r]);
#pragma unroll
  for (int r = 0; r < 16; ++r) pmax = fmaxf(pmax, p1[r]);
  { auto rr = __builtin_amdgcn_permlane32_swap(__float_as_uint(pmax), __float_as_uint(pmax), false, false);
    pmax = fmaxf(__uint_as_float(rr[0]), __uint_as_float(rr[1])); }
  if (__builtin_expect(__all(pmax - m_reg <= THR / SCALE), 1)) { mn = m_reg; alpha = 1.f; }
  else { mn = fmaxf(m_reg, pmax); alpha = __builtin_amdgcn_exp2f((m_reg - mn) * C); m_reg = mn; }
  float mnC = -mn * C;
#pragma unroll
  for (int r = 0; r < 16; ++r) p0[r] = fmaf(p0[r], C, mnC);
#pragma unroll
  for (int r = 0; r < 16; ++r) p1[r] = fmaf(p1[r], C, mnC);
#pragma unroll
  for (int r = 0; r < 16; ++r) p0[r] = __builtin_amdgcn_exp2f(p0[r]);
}
struct SMreg { float a[16], b[16]; };
__device__ __forceinline__ void finishSM(SMreg& e, float alpha, float& l_reg, bf16x8& pa0, bf16x8& pa1, bf16x8& pa2, bf16x8& pa3) {
#pragma unroll
  for (int r = 0; r < 16; ++r) e.b[r] = __builtin_amdgcn_exp2f(e.b[r]);
  float ps = 0;
#pragma unroll
  for (int r = 0; r < 16; ++r) ps += e.a[r];
#pragma unroll
  for (int r = 0; r < 16; ++r) ps += e.b[r];
  { auto rr = __builtin_amdgcn_permlane32_swap(__float_as_uint(ps), __float_as_uint(ps), false, false);
    ps = __uint_as_float(rr[0]) + __uint_as_float(rr[1]); }
  l_reg = l_reg * alpha + ps;
#define PK4(P, BASE, OUT) do { unsigned a0 = cvtpk(P[BASE + 0], P[BASE + 1]), a1 = cvtpk(P[BASE + 2], P[BASE + 3]);   \
    unsigned b0 = cvtpk(P[BASE + 4], P[BASE + 5]), b1 = cvtpk(P[BASE + 6], P[BASE + 7]);                              \
    auto r0 = __builtin_amdgcn_permlane32_swap(a0, b0, false, false); auto r1 = __builtin_amdgcn_permlane32_swap(a1, b1, false, false); \
    u32x4 w = {r0[0], r1[0], r0[1], r1[1]}; OUT = *reinterpret_cast<bf16x8*>(&w); } while (0)
  PK4(e.a, 0, pa0); PK4(e.a, 8, pa1); PK4(e.b, 0, pa2); PK4(e.b, 8, pa3);
#undef PK4
}
__device__ __forceinline__ void sm_copy(SMreg& e, const f32x16& p0, const f32x16& p1) {
#pragma unroll
  for (int r = 0; r < 16; ++r) { e.a[r] = p0[r]; e.b[r] = p1[r]; }
}
__device__ __forceinline__ void qkt(f32x16& p0, f32x16& p1, const bf16_t* Ks, const bf16x8* qr, int r32, int hi) {
  p0 = f32x16{}; p1 = f32x16{};
#pragma unroll
  for (int d0 = 0; d0 < 8; ++d0) { int cb = (d0 * 16 + hi * 8) * 2;
    bf16x8 b0 = *reinterpret_cast<const bf16x8*>((const char*)Ks + KSWZ(r32, cb));
    bf16x8 b1 = *reinterpret_cast<const bf16x8*>((const char*)Ks + KSWZ(32 + r32, cb));
    p0 = __builtin_amdgcn_mfma_f32_32x32x16_bf16(b0, qr[d0], p0, 0, 0, 0);
    p1 = __builtin_amdgcn_mfma_f32_32x32x16_bf16(b1, qr[d0], p1, 0, 0, 0); }
}
__device__ __forceinline__ void qk_fin(f32x16& p0, f32x16& p1, const bf16_t* Ks, const bf16x8* qr, int r32, int hi,
                                       SMreg& e, float alpha, float& l_reg, bf16x8& pa0, bf16x8& pa1, bf16x8& pa2, bf16x8& pa3) {
  p0 = f32x16{}; p1 = f32x16{};
  float ps = 0.f;
#define KF(d0, r) (*reinterpret_cast<const bf16x8*>((const char*)Ks + KSWZ((r) + r32, ((d0) * 16 + hi * 8) * 2)))
#define PK4(P, BASE, OUT) do { unsigned a0 = cvtpk(P[BASE + 0], P[BASE + 1]), a1 = cvtpk(P[BASE + 2], P[BASE + 3]);   \
    unsigned b0_ = cvtpk(P[BASE + 4], P[BASE + 5]), b1_ = cvtpk(P[BASE + 6], P[BASE + 7]);                              \
    auto r0 = __builtin_amdgcn_permlane32_swap(a0, b0_, false, false); auto r1 = __builtin_amdgcn_permlane32_swap(a1, b1_, false, false); \
    u32x4 w = {r0[0], r1[0], r0[1], r1[1]}; OUT = *reinterpret_cast<bf16x8*>(&w); } while (0)
#define EX(i) e.b[i] = __builtin_amdgcn_exp2f(e.b[i])
#define QK2(d0) do { p0 = __builtin_amdgcn_mfma_f32_32x32x16_bf16(kb0, qr[d0], p0, 0, 0, 0); p1 = __builtin_amdgcn_mfma_f32_32x32x16_bf16(kb1, qr[d0], p1, 0, 0, 0); } while (0)
#define NXT(d0) const bf16x8 n0_##d0 = KF(d0, 0), n1_##d0 = KF(d0, 32)
#define ADV(d0) do { kb0 = n0_##d0; kb1 = n1_##d0; } while (0)
  bf16x8 kb0 = KF(0, 0), kb1 = KF(0, 32);
  { NXT(1); QK2(0); PK4(e.a, 0, pa0); EX(0); EX(1); EX(2); ADV(1); } SBAR();
  { NXT(2); QK2(1); PK4(e.a, 8, pa1); EX(3); EX(4); EX(5); ADV(2); } SBAR();
  { NXT(3); QK2(2); EX(6); EX(7); EX(8);
    _Pragma("unroll") for (int r = 0; r < 16; ++r) ps += e.a[r];
    ADV(3); } SBAR();
  { NXT(4); QK2(3); EX(9); EX(10); EX(11);
    _Pragma("unroll") for (int r = 0; r < 8; ++r) ps += e.b[r];
    ADV(4); } SBAR();
  { NXT(5); QK2(4); EX(12); EX(13); EX(14); PK4(e.b, 0, pa2); ADV(5); } SBAR();
  { NXT(6); QK2(5); EX(15);
    _Pragma("unroll") for (int r = 8; r < 16; ++r) ps += e.b[r];
    ADV(6); } SBAR();
  { NXT(7); QK2(6); PK4(e.b, 8, pa3);
    { auto rr = __builtin_amdgcn_permlane32_swap(__float_as_uint(ps), __float_as_uint(ps), false, false); ps = __uint_as_float(rr[0]) + __uint_as_float(rr[1]); }
    l_reg = l_reg * alpha + ps; ADV(7); } SBAR();
  QK2(7);
#undef KF
#undef PK4
#undef EX
#undef QK2
#undef NXT
#undef ADV
}
__device__ __forceinline__ int v_st(int k, int c) { const int kk = (k & ~0xC) | ((k & 4) << 1) | ((k & 8) >> 1); return ((kk >> 3) * 4 + (c >> 5)) * 512 + ((kk & 7) * 32 + (c & 31)) * 2; }
__device__ __forceinline__ int v_rd_base(int lane) { return ((lane & 3) << 3) | (((lane >> 2) & 3) << 6) | (((lane >> 4) & 1) << 5) | (((lane >> 5) & 1) << 8); }
constexpr int v_rd_off(int d0, int ks, int half) { return d0 * 512 + ks * 4096 + half * 2048; }
template <int OFF> __device__ __forceinline__ s16x4 tr_read(int vb) {
  s16x4 r; asm volatile("ds_read_b64_tr_b16 %0, %1 offset:%2" : "=&v"(r) : "v"(vb), "i"(OFF) : "memory"); return r;
}
template <int D0> __device__ __forceinline__ void pv_one(f32x16& od, int vb, bf16x8 pa0, bf16x8 pa1, bf16x8 pa2, bf16x8 pa3) {
  const s16x4 l0 = tr_read<v_rd_off(D0, 0, 0)>(vb), h0 = tr_read<v_rd_off(D0, 0, 1)>(vb), l1 = tr_read<v_rd_off(D0, 1, 0)>(vb), h1 = tr_read<v_rd_off(D0, 1, 1)>(vb);
  const s16x4 l2 = tr_read<v_rd_off(D0, 2, 0)>(vb), h2 = tr_read<v_rd_off(D0, 2, 1)>(vb), l3 = tr_read<v_rd_off(D0, 3, 0)>(vb), h3 = tr_read<v_rd_off(D0, 3, 1)>(vb);
  asm volatile("s_waitcnt lgkmcnt(0)" ::: "memory"); SBAR();
#define PK(L, H) (bf16x8){L[0], L[1], L[2], L[3], H[0], H[1], H[2], H[3]}
  od = __builtin_amdgcn_mfma_f32_32x32x16_bf16(pa0, PK(l0, h0), od, 0, 0, 0);
  od = __builtin_amdgcn_mfma_f32_32x32x16_bf16(pa1, PK(l1, h1), od, 0, 0, 0);
  od = __builtin_amdgcn_mfma_f32_32x32x16_bf16(pa2, PK(l2, h2), od, 0, 0, 0);
  od = __builtin_amdgcn_mfma_f32_32x32x16_bf16(pa3, PK(l3, h3), od, 0, 0, 0);
#undef PK
}
__device__ __forceinline__ void pv_d0(f32x16* o, int vb, bf16x8 pa0, bf16x8 pa1, bf16x8 pa2, bf16x8 pa3) {
  pv_one<0>(o[0], vb, pa0, pa1, pa2, pa3); pv_one<1>(o[1], vb, pa0, pa1, pa2, pa3); pv_one<2>(o[2], vb, pa0, pa1, pa2, pa3); pv_one<3>(o[3], vb, pa0, pa1, pa2, pa3);
}
__device__ __forceinline__ void pv_sm(f32x16* o, int vb, bf16x8 pa0, bf16x8 pa1, bf16x8 pa2, bf16x8 pa3, const f32x16& p0, const f32x16& p1, SMreg& e, float& m_reg, float& alpha) {
  constexpr float C = SCALE * 1.4426950408889634f;
#define PK(L, H) (bf16x8){L[0], L[1], L[2], L[3], H[0], H[1], H[2], H[3]}
#define RD(D, n) const s16x4 a##n = tr_read<v_rd_off(D, 0, 0)>(vb), b##n = tr_read<v_rd_off(D, 0, 1)>(vb), c##n = tr_read<v_rd_off(D, 1, 0)>(vb), d##n = tr_read<v_rd_off(D, 1, 1)>(vb), \
                             e##n = tr_read<v_rd_off(D, 2, 0)>(vb), f##n = tr_read<v_rd_off(D, 2, 1)>(vb), g##n = tr_read<v_rd_off(D, 3, 0)>(vb), h##n = tr_read<v_rd_off(D, 3, 1)>(vb)
#define MM(od, n) do { od = __builtin_amdgcn_mfma_f32_32x32x16_bf16(pa0, PK(a##n, b##n), od, 0, 0, 0); od = __builtin_amdgcn_mfma_f32_32x32x16_bf16(pa1, PK(c##n, d##n), od, 0, 0, 0); \
                       od = __builtin_amdgcn_mfma_f32_32x32x16_bf16(pa2, PK(e##n, f##n), od, 0, 0, 0); od = __builtin_amdgcn_mfma_f32_32x32x16_bf16(pa3, PK(g##n, h##n), od, 0, 0, 0); } while (0)
#define SB6() __builtin_amdgcn_sched_barrier(0x406)
#define GRP(od, n, D, m) od = __builtin_amdgcn_mfma_f32_32x32x16_bf16(pa0, PK(a##n, b##n), od, 0, 0, 0); const s16x4 a##m = tr_read<v_rd_off(D, 0, 0)>(vb), b##m = tr_read<v_rd_off(D, 0, 1)>(vb); SB6(); \
                         od = __builtin_amdgcn_mfma_f32_32x32x16_bf16(pa1, PK(c##n, d##n), od, 0, 0, 0); const s16x4 c##m = tr_read<v_rd_off(D, 1, 0)>(vb), d##m = tr_read<v_rd_off(D, 1, 1)>(vb); SB6(); \
                         od = __builtin_amdgcn_mfma_f32_32x32x16_bf16(pa2, PK(e##n, f##n), od, 0, 0, 0); const s16x4 e##m = tr_read<v_rd_off(D, 2, 0)>(vb), f##m = tr_read<v_rd_off(D, 2, 1)>(vb); SB6(); \
                         od = __builtin_amdgcn_mfma_f32_32x32x16_bf16(pa3, PK(g##n, h##n), od, 0, 0, 0); const s16x4 g##m = tr_read<v_rd_off(D, 3, 0)>(vb), h##m = tr_read<v_rd_off(D, 3, 1)>(vb)
#define LW() do { asm volatile("s_waitcnt lgkmcnt(0)" ::: "memory"); SBAR(); } while (0)
#define PIN(x) asm volatile("" : "+v"(x))
  RD(0, 0); LW();
  GRP(o[0], 0, 1, 1);
  float pmax = p0[0];
#pragma unroll
  for (int r = 1; r < 16; ++r) pmax = fmaxf(pmax, p0[r]);
#pragma unroll
  for (int r = 0; r < 16; ++r) pmax = fmaxf(pmax, p1[r]);
  { auto rr = __builtin_amdgcn_permlane32_swap(__float_as_uint(pmax), __float_as_uint(pmax), false, false);
    pmax = fmaxf(__uint_as_float(rr[0]), __uint_as_float(rr[1])); }
  const bool ok = __all(pmax - m_reg <= THR / SCALE);
  const float mn = ok ? m_reg : fmaxf(m_reg, pmax); alpha = __builtin_amdgcn_exp2f((m_reg - mn) * C); m_reg = mn;
  float mnC = -mn * C; PIN(mnC);
  LW();
  GRP(o[1], 1, 2, 2);
#pragma unroll
  for (int r = 0; r < 16; ++r) { float a = fmaf(p0[r], C, mnC), b = fmaf(p1[r], C, mnC); if (r < 2) a = __builtin_amdgcn_exp2f(a); PIN(a); PIN(b); e.a[r] = a; e.b[r] = b; }
  LW();
  GRP(o[2], 2, 3, 3);
#pragma unroll
  for (int r = 2; r < 9; ++r) { float a = __builtin_amdgcn_exp2f(e.a[r]); PIN(a); e.a[r] = a; }
  LW();
  MM(o[3], 3);
#pragma unroll
  for (int r = 9; r < 16; ++r) { float a = __builtin_amdgcn_exp2f(e.a[r]); PIN(a); e.a[r] = a; }
#undef PK
#undef RD
#undef MM
#undef GRP
#undef SB6
#undef LW
#undef PIN
}
struct MapLinear { long base; __device__ __forceinline__ long operator()(int t) const { return base + (long)t * KVBLK; } };
struct MapNA { int rs0; __device__ __forceinline__ long operator()(int t) const { return t < 4 ? (long)SEQ + t * 64 : (long)(rs0 + t - 4) * 64; } };
struct HookNone { __device__ __forceinline__ void operator()(f32x16&, f32x16&, int, int) const {} };
struct HookNA {
  const LAS float* bias; int qr, rs, rs0, cbase  , bbase  ;
  __device__ __forceinline__ void operator()(f32x16& p0, f32x16& p1, int tile, int hi) const {
    if (tile < 4) return;
    const int kr = rs0 + tile - 4; const bool rowok = (kr >= rs) && (kr <= rs + 7);
    int drow = kr - qr + 7; drow = drow < 0 ? 0 : (drow > 14 ? 14 : drow);
    const float ninf = -__builtin_inff();
    const LAS float* bp = bias + drow * 31 + bbase;
#pragma unroll
    for (int r = 0; r < 16; ++r) {
      const int kc = (r & 3) + 8 * (r >> 2);
      const bool ok0 = rowok && (unsigned)(kc + cbase) <= 15u, ok1 = rowok && (unsigned)(kc + 32 + cbase) <= 15u;
      p0[r] = ok0 ? p0[r] + bp[kc] : ninf; p1[r] = ok1 ? p1[r] + bp[kc + 32] : ninf;
    }
  }
};
template <int SDEPTH, int LDK, class Map, class Hook>
__device__ __forceinline__ void attn_body(const bf16_t* __restrict__ Qb, const bf16_t* __restrict__ Kh, const bf16_t* __restrict__ Vh,
                                          bf16_t* __restrict__ Ob, int NT, const Map map, const Hook hook, char* lds, int tid) {
  const int wid = tid >> 6, lane = tid & 63, r32 = lane & 31, hi = lane >> 5;
  bf16_t* V_lds = (bf16_t*)lds; bf16_t* K_lds = (bf16_t*)(lds + 2 * SHM_V);
  float* ws = (float*)(lds + 2 * SHM_V + 2 * SHM_K) + wid * 64; float* li_l = ws; float* al_l = ws + 32;
  float m_reg = -1e30f, l_reg = 0; f32x16 o[4] = {}; bf16x8 qr[8];
  const bf16_t* Qw = Qb + (long)(wid * QBLK + r32) * LDQ + hi * 8;
#pragma unroll
  for (int d0 = 0; d0 < 8; ++d0) qr[d0] = *reinterpret_cast<const bf16x8*>(Qw + d0 * 16);
  const int sr = tid >> 4;
  const unsigned kq = (unsigned)(sr * LDK + (((tid & 15) ^ (sr & 7)) * 8)) * 2u;
  const int kk = ((tid >> 7) << 3) | ((tid & 31) >> 2), kv = (kk & ~0xC) | ((kk & 4) << 1) | ((kk & 8) >> 1);
  const unsigned vq = (unsigned)(kv * LDK + ((tid >> 5) & 3) * 32 + (tid & 3) * 8) * 2u;
  LAS char* ldsw = (LAS char*)lds + (unsigned)__builtin_amdgcn_readfirstlane(wid) * 1024u;
  const int vb0 = (int)(uintptr_t)V_lds + v_rd_base(lane);
#define DMA_K(tile, b) do { const char* _g = (const char*)(Kh + map(tile) * LDK);                                                                        \
    __builtin_amdgcn_global_load_lds((const unsigned*)(_g + kq), (LAS unsigned*)(ldsw + 2 * SHM_V + (b) * SHM_K), 16, 0, 0);                              \
    __builtin_amdgcn_global_load_lds((const unsigned*)(_g + kq + 32 * LDK * 2), (LAS unsigned*)(ldsw + 2 * SHM_V + (b) * SHM_K + 8192), 16, 0, 0); } while (0)
#define DMA_V(tile, b) do { const char* _g = (const char*)(Vh + map(tile) * LDK);                                                                        \
    __builtin_amdgcn_global_load_lds((const unsigned*)(_g + vq), (LAS unsigned*)(ldsw + (b) * SHM_V), 16, 0, 0);                                          \
    __builtin_amdgcn_global_load_lds((const unsigned*)(_g + vq + 32 * LDK * 2), (LAS unsigned*)(ldsw + (b) * SHM_V + 8192), 16, 0, 0); } while (0)
#define DWAIT() do { asm volatile("s_waitcnt vmcnt(0)" ::: "memory"); __syncthreads(); } while (0)
#define RESC(a) do { if (__any((a) < 1.f)) { if (hi == 0) al_l[r32] = (a); asm volatile("s_waitcnt lgkmcnt(0)" ::: "memory"); \
    _Pragma("unroll") for (int d = 0; d < 4; ++d) _Pragma("unroll") for (int r = 0; r < 16; ++r) o[d][r] *= al_l[crow(r, hi)]; } } while (0)
  f32x16 pA0, pA1, pB0, pB1; SMreg eA, eB; float mnA, mnB, alA, alB; bf16x8 pa0, pa1, pa2, pa3;
#define PVSM(vbx, P0, P1, E, MN, AL, T) do { if constexpr (SDEPTH == 2) { hook(P0, P1, T, hi); pv_sm(o, vbx, pa0, pa1, pa2, pa3, P0, P1, E, m_reg, AL); }   \
    else { pv_d0(o, vbx, pa0, pa1, pa2, pa3); hook(P0, P1, T, hi); partialSM(P0, P1, m_reg, MN, AL); sm_copy(E, P0, P1); } } while (0)
  bf16_t* K1_lds = (bf16_t*)((char*)K_lds + SHM_K);
#define QKF(P0, P1, KL, E, AL) do { SBAR(); if constexpr (SDEPTH == 2) qk_fin(P0, P1, KL, qr, r32, hi, E, AL, l_reg, pa0, pa1, pa2, pa3);   \
    else { qkt(P0, P1, KL, qr, r32, hi); finishSM(E, AL, l_reg, pa0, pa1, pa2, pa3); } SBAR(); } while (0)
  DMA_K(0, 0); DMA_V(0, 0); DMA_K(1, 1); DWAIT();
  qkt(pA0, pA1, K_lds, qr, r32, hi); hook(pA0, pA1, 0, hi); partialSM(pA0, pA1, m_reg, mnA, alA); sm_copy(eA, pA0, pA1);
  __syncthreads();
  if (2 < NT) DMA_K(2, 0);
  DMA_V(1, 1);
  for (int j = 1; j + 1 < NT; j += 2) {
    QKF(pB0, pB1, K1_lds, eA, alA);
    PVSM(vb0, pB0, pB1, eB, mnB, alB, j);
    DWAIT();
    DMA_K(j + 2, 1); DMA_V(j + 1, 0);
    RESC(alB);
    QKF(pA0, pA1, K_lds, eB, alB);
    PVSM(vb0 + (int)SHM_V, pA0, pA1, eA, mnA, alA, j + 1);
    DWAIT();
    if (j + 3 < NT) DMA_K(j + 3, 0);
    DMA_V(j + 2, 1);
    RESC(alA);
  }
  QKF(pB0, pB1, K1_lds, eA, alA);
  PVSM(vb0, pB0, pB1, eB, mnB, alB, NT - 1);
  DWAIT(); RESC(alB);
  finishSM(eB, alB, l_reg, pa0, pa1, pa2, pa3); SBAR();
  pv_d0(o, vb0 + (int)SHM_V, pa0, pa1, pa2, pa3);
  if (hi == 0) li_l[r32] = l_reg; asm volatile("s_waitcnt lgkmcnt(0)" ::: "memory");
  float rli[16];
#pragma unroll
  for (int r = 0; r < 16; ++r) rli[r] = __builtin_amdgcn_rcpf(li_l[crow(r, hi)]);
  bf16_t* Ow = Ob + (long)(wid * QBLK) * LDO;
#pragma unroll
  for (int r = 0; r < 16; ++r) { int orow = crow(r, hi);
#pragma unroll
    for (int d0 = 0; d0 < 4; ++d0) Ow[(long)orow * LDO + d0 * 32 + r32] = f2bf(o[d0][r] * rli[r]); }
  __syncthreads();
#undef DMA_K
#undef DMA_V
#undef DWAIT
#undef RESC
#undef PVSM
#undef QKF
}
}

__device__ __forceinline__ void sg_unit(const Frame& F, int l, int c, int g) {
    constexpr int VST = 136;
    LAS bf16_t* vnT = (LAS bf16_t*)F.lds;
    const bf16_t* P = (const bf16_t*)(F.ws + WS_PROJ);
    const int fr = F.lane & 15, fq = F.lane >> 4;
    const float* W = F.in[IN_SGW] + ((size_t)(l * 4 + g) * 128 + 16 * F.wave + fr) * 128 + 8 * fq;
    bf16x8 wf[4];
#pragma unroll
    for (int ks = 0; ks < 4; ++ks) { const f32x4 a = *(const f32x4*)(W + 32 * ks), b2 = *(const f32x4*)(W + 32 * ks + 4);
        u32x4 w; w.x = cvt_pk_bf16(a.x, a.y); w.y = cvt_pk_bf16(a.z, a.w); w.z = cvt_pk_bf16(b2.x, b2.y); w.w = cvt_pk_bf16(b2.z, b2.w); wf[ks] = *reinterpret_cast<bf16x8*>(&w); }
    {
        const int j = 16 * F.wave + (F.lane >> 2), q = F.lane & 3; const size_t p = (size_t)(c * 128 + j);
        const bf16_t* vp = P + p * INW + 2048 + g * 128 + 32 * q;
        float x[32];
#pragma unroll
        for (int t = 0; t < 4; ++t) { const u32x4 r = *(const u32x4*)(vp + 8 * t);
#pragma unroll
            for (int e = 0; e < 4; ++e) { x[8 * t + 2 * e] = bf2f((bf16_t)(r[e] & 0xffffu)); x[8 * t + 2 * e + 1] = bf2f((bf16_t)(r[e] >> 16)); } }
        float sm = 0.f;
#pragma unroll
        for (int t = 0; t < 32; ++t) sm += x[t];
        sm = quad_sum(sm);
        const float mean = sm * (1.0f / 128.0f); float sq = 0.f;
#pragma unroll
        for (int t = 0; t < 32; ++t) { x[t] -= mean; sq += x[t] * x[t]; }
        sq = quad_sum(sq);
        const float rstd = 1.0f / sqrtf(sq * (1.0f / 128.0f) + LN_EPS);
        const float* gp = F.in[IN_SGLNG] + (l * 4 + g) * 128 + 32 * q; const float* bp = F.in[IN_SGLNB] + (l * 4 + g) * 128 + 32 * q;
#pragma unroll
        for (int t = 0; t < 32; ++t) vnT[(32 * q + t) * VST + j] = f2bf(x[t] * rstd * gp[t] + bp[t]);
    }
    __syncthreads();
    bf16_t* MIXp = (bf16_t*)(F.ws + WS_MIX);
    const int i = 16 * F.wave + fr; const size_t pi = (size_t)(c * 128 + i); const float bs = F.in[IN_SGB][(l * 4 + g) * 128 + i];
#pragma unroll
    for (int dt = 0; dt < 8; ++dt) {
        f32x4 acc = {0.f, 0.f, 0.f, 0.f};
#pragma unroll
        for (int ks = 0; ks < 4; ++ks) { const bf16x8 a = *(const LAS bf16x8*)(vnT + (dt * 16 + fr) * VST + 32 * ks + 8 * fq); acc = __builtin_amdgcn_mfma_f32_16x16x32_bf16(a, wf[ks], acc, 0, 0, 0); }
        const int d0 = 16 * dt + 4 * fq; const u32x2 uu = *(const u32x2*)(P + pi * INW + 1536 + g * 128 + d0);
        u32x2 o; o.x = cvt_pk_bf16((acc[0] + bs) * bf2f((bf16_t)(uu.x & 0xffffu)), (acc[1] + bs) * bf2f((bf16_t)(uu.x >> 16)));
        o.y = cvt_pk_bf16((acc[2] + bs) * bf2f((bf16_t)(uu.y & 0xffffu)), (acc[3] + bs) * bf2f((bf16_t)(uu.y >> 16)));
        *(u32x2*)(MIXp + pi * DM + 512 + g * 128 + d0) = o;
    }
    __syncthreads();
}

__device__ __forceinline__ void p_att_dense(const Frame& F, int l) {
    const bf16_t* P = (const bf16_t*)(F.ws + WS_PROJ); bf16_t* MIXp = (bf16_t*)(F.ws + WS_MIX); const bf16_t* KV = (const bf16_t*)(F.ws + WS_KV);
    const int total = 256 + ((l == 0) ? 12 : 0);
    for (int u = F.bid; u < total; u += F.G) {
        int qrow, qcol, ocol, nt; long kbase; const bf16_t* kp;
        if (u < 256) { const int h = u & 7; qrow = (u >> 3) * 256; qcol = 2560 + h * 128; ocol = 1024 + h * 128; nt = NROW / 64; kbase = 0; kp = KV + (h >> 2) * 128; }
        else if (u < 264) { const int h = u - 256; qrow = SEQ; qcol = 2560 + h * 128; ocol = 1024 + h * 128; nt = 4; kbase = SEQ; kp = KV + (h >> 2) * 128; }
        else { const int h = u - 264; qrow = SEQ; qcol = h * 128; ocol = h * 128; nt = 4; kbase = 0; kp = (const bf16_t*)(F.ws + WS_CKV) + (size_t)h * 256 * 512; }
        att::attn_body<2, 512>(P + (size_t)qrow * INW + qcol, kp, kp + 256, MIXp + (size_t)qrow * DM + ocol, nt, att::MapLinear{kbase}, att::HookNone{}, (char*)F.lds, F.tid);
    }
}
__device__ __forceinline__ void p_att_na(const Frame& F, int l) {
    const bf16_t* P = (const bf16_t*)(F.ws + WS_PROJ); bf16_t* MIXp = (bf16_t*)(F.ws + WS_MIX);
    LAS float* bt = (LAS float*)(F.lds + LDS_SC);
    for (int v = F.bid; v < 128; v += F.G) {
        const int h = v & 3, qb = v >> 2, R0 = qb * 4;
        const float* rpb = F.in[IN_RPB] + (size_t)(l * 4 + h) * 15 * 31;
        for (int t = F.tid; t < 640; t += NTHR) { const int q = t - 48; bt[t] = (q >= 0 && q < 15 * 31) ? rpb[q] * (1.0f / att::SCALE) : 0.f; }
        __syncthreads();
        int rs0 = R0 - 4; rs0 = rs0 < 0 ? 0 : (rs0 > 116 ? 116 : rs0);
        const int qr = R0 + (F.wave >> 1), qc = (F.wave & 1) * 32 + (F.lane & 31);
        int rs = qr - 4; rs = rs < 0 ? 0 : (rs > 120 ? 120 : rs);
        int cs = qc - 8; cs = cs < 0 ? 0 : (cs > 48 ? 48 : cs);
        att::attn_body<1, INW>(P + (size_t)(qb * 256) * INW + h * 128, P + 512 + h * 128, P + 1024 + h * 128,
                       MIXp + (size_t)(qb * 256) * DM + h * 128, 16, att::MapNA{rs0}, att::HookNA{bt, qr, rs, rs0, 4 * (F.lane >> 5) - cs, 48 + 15 - qc + 4 * (F.lane >> 5)}, (char*)F.lds, F.tid);
    }
}
__device__ __forceinline__ void p_att_sg(const Frame& F, int l) {
    const int nsg = (l == 0) ? 264 : 256;
    if (F.G >= 256) { for (int v = F.bid - 128; v >= 0 && v < nsg; v += F.G - 128) sg_unit(F, l, v >> 2, v & 3); }
    else { for (int v = F.bid; v < nsg; v += F.G) sg_unit(F, l, v >> 2, v & 3); }
}

#ifdef TSEL_A
#define TSF(F, i) do { if ((F).bid == 0 && (F).tid == 0) __hip_atomic_store((unsigned long long*)((F).ws + WS_CTL + 131072) + (i), (unsigned long long)__builtin_amdgcn_s_memrealtime(), __ATOMIC_RELAXED, __HIP_MEMORY_SCOPE_AGENT); } while (0)
#else
#define TSF(F, i) do { } while (0)
#endif
__device__ __forceinline__ void p_mixln_router(const Frame& F, int l, int nrows) {
    LAS float* plog = (LAS float*)F.lds;
    LAS float* scS = plog + 8 * 48 * 32;
    LAS float* selS = scS + 48 * 32;
    const float* MOD = (const float*)(F.ws + WS_MOD);
    const bf16_t* Y1 = (const bf16_t*)(F.ws + WS_Y1);
    float* XS = (float*)(F.ws + WS_XS);
    bf16_t* H2 = (bf16_t*)(F.ws + WS_H2); bf16_t* H2L = (bf16_t*)(F.ws + WS_H2L);
    const bf16_t* RWH = (const bf16_t*)(F.ws + WS_RWT); const bf16_t* RWL = RWH + 32 * DM;
    const float* RB = F.in[IN_RB];
    const float* lg = F.in[IN_LNMG] + l * DM; const float* lb = F.in[IN_LNMB] + l * DM;
    int* cnt = (int*)(F.ws + WS_CTL) + CW_CNT + l * 2048;
    int* tokE = (int*)(F.ws + WS_TOKE); int* tokP = (int*)(F.ws + WS_TOKP); float* tokG = (float*)(F.ws + WS_TOKG); int* list = (int*)(F.ws + WS_LIST);
    const int rpw = (nrows + F.G - 1) / F.G;
    const int wbeg = F.bid * rpw, wend = (wbeg + rpw < nrows) ? wbeg + rpw : nrows;
    LAS float* prm = (LAS float*)(F.lds + 65536);
    stage_vec(F, prm, lg); stage_vec(F, prm + DM, lb);
    for (int v = 0; v < 2; ++v) { const float* m = MOD + (size_t)(l * 2 + v) * 12288; stage_vec(F, prm + (2 + 3 * v) * DM, m + 2 * DM); stage_vec(F, prm + (3 + 3 * v) * DM, m + 3 * DM); stage_vec(F, prm + (4 + 3 * v) * DM, m + 4 * DM); }
    __syncthreads();
    TSF(F, 30);
    for (int rbeg = wbeg; rbeg < wend; rbeg += 48) {
        const int rend = (rbeg + 48 < wend) ? rbeg + 48 : wend, nr = rend - rbeg;
        f32x4 nx[8]; u32x2 ny[8];
#define P5_LOAD(rr) do { const float* xr_ = xrow_ptr(F, l, (rr)); const bf16_t* yr_ = Y1 + (size_t)(rr) * DM; \
        _Pragma("unroll") for (int j = 0; j < 8; ++j) { const int col = 4 * F.lane + 256 * j; nx[j] = __builtin_nontemporal_load((const f32x4*)(xr_ + col)); ny[j] = __builtin_nontemporal_load((const u32x2*)(yr_ + col)); } } while (0)
        if (rbeg + F.wave < rend) P5_LOAD(rbeg + F.wave);
        for (int r = rbeg + F.wave; r < rend; r += NWAVES) {
            const int v = r >= SEQ; const LAS float* pv = prm + (2 + 3 * v) * DM;
            f32x4 z[8];
#pragma unroll
            for (int j = 0; j < 8; ++j) { const int col = 4 * F.lane + 256 * j; const u32x2 yy = ny[j];
                const f32x4 y = {bf2f((bf16_t)(yy.x & 0xffffu)), bf2f((bf16_t)(yy.x >> 16)), bf2f((bf16_t)(yy.y & 0xffffu)), bf2f((bf16_t)(yy.y >> 16))};
                z[j] = ALPHA * nx[j] + *(const LAS f32x4*)(pv + col) * y; }
            if (r + NWAVES < rend) P5_LOAD(r + NWAVES);
            float mean, rstd; ln_stats(z, mean, rstd);
#pragma unroll
            for (int j = 0; j < 8; ++j) { const int col = 4 * F.lane + 256 * j; z[j] = (z[j] - mean) * rstd * *(const LAS f32x4*)(prm + col) + *(const LAS f32x4*)(prm + DM + col); *(f32x4*)(XS + (size_t)r * DM + col) = z[j]; }
            ln_stats(z, mean, rstd);
#pragma unroll
            for (int j = 0; j < 8; ++j) { const int col = 4 * F.lane + 256 * j; const f32x4 s1 = *(const LAS f32x4*)(pv + 2 * DM + col), s0 = *(const LAS f32x4*)(pv + DM + col);
                const f32x4 h = (z[j] - mean) * rstd * (1.0f + s1) + s0;
                u32x2 hi; hi.x = cvt_pk_bf16(h.x, h.y); hi.y = cvt_pk_bf16(h.z, h.w);
                const f32x4 hf = {bf2f((bf16_t)(hi.x & 0xffffu)), bf2f((bf16_t)(hi.x >> 16)), bf2f((bf16_t)(hi.y & 0xffffu)), bf2f((bf16_t)(hi.y >> 16))};
                const f32x4 d = h - hf; u32x2 lo; lo.x = cvt_pk_bf16(d.x, d.y); lo.y = cvt_pk_bf16(d.z, d.w);
                *(u32x2*)(H2 + (size_t)r * DM + col) = hi; *(u32x2*)(H2L + (size_t)r * DM + col) = lo; }
        }
#undef P5_LOAD
        asm volatile("s_waitcnt vmcnt(0)" ::: "memory");
        __syncthreads();
        TSF(F, 31);
        const int ntile = (nr + 15) >> 4; constexpr int nsl = 8;
        {
            const int fr = F.lane & 15, fq = F.lane >> 4, kb = F.wave * 256 + fq * 8;
            const bf16_t* bh = RWH + (size_t)fr * DM + kb; const bf16_t* bl = RWL + (size_t)fr * DM + kb;
            const bf16_t* ah[3]; const bf16_t* al[3];
#pragma unroll
            for (int t = 0; t < 3; ++t) { int row = rbeg + t * 16 + fr; row = row < rend ? row : rend - 1; ah[t] = H2 + (size_t)row * DM + kb; al[t] = H2L + (size_t)row * DM + kb; }
            f32x4 acc[3][2];
#pragma unroll
            for (int t = 0; t < 3; ++t) { acc[t][0] = (f32x4){0.f, 0.f, 0.f, 0.f}; acc[t][1] = (f32x4){0.f, 0.f, 0.f, 0.f}; }
#pragma unroll 2
            for (int ks = 0; ks < 8; ++ks) { const int off = ks * 32;
                const bf16x8 b_h0 = *(const bf16x8*)(bh + off), b_l0 = *(const bf16x8*)(bl + off), b_h1 = *(const bf16x8*)(bh + 16 * DM + off), b_l1 = *(const bf16x8*)(bl + 16 * DM + off);
#pragma unroll
                for (int t = 0; t < 3; ++t) if (t < ntile) {
                    const bf16x8 a_h = *(const bf16x8*)(ah[t] + off), a_l = *(const bf16x8*)(al[t] + off);
                    acc[t][0] = __builtin_amdgcn_mfma_f32_16x16x32_bf16(a_h, b_h0, acc[t][0], 0, 0, 0); acc[t][0] = __builtin_amdgcn_mfma_f32_16x16x32_bf16(a_h, b_l0, acc[t][0], 0, 0, 0); acc[t][0] = __builtin_amdgcn_mfma_f32_16x16x32_bf16(a_l, b_h0, acc[t][0], 0, 0, 0);
                    acc[t][1] = __builtin_amdgcn_mfma_f32_16x16x32_bf16(a_h, b_h1, acc[t][1], 0, 0, 0); acc[t][1] = __builtin_amdgcn_mfma_f32_16x16x32_bf16(a_h, b_l1, acc[t][1], 0, 0, 0); acc[t][1] = __builtin_amdgcn_mfma_f32_16x16x32_bf16(a_l, b_h1, acc[t][1], 0, 0, 0); } }
#pragma unroll
            for (int t = 0; t < 3; ++t) if (t < ntile) {
#pragma unroll
                for (int q = 0; q < 4; ++q) { LAS float* pr = plog + (F.wave * 48 + t * 16 + 4 * fq + q) * 32; pr[fr] = acc[t][0][q]; pr[16 + fr] = acc[t][1][q]; } }
        }
        __syncthreads();
        TSF(F, 32);
        for (int t = F.tid; t < nr * 32; t += NTHR) { const int e = t & 31; float lg2 = 0.f; for (int q = 0; q < nsl; ++q) lg2 += plog[q * 48 * 32 + t]; const float sc = sigmoidf_(lg2); scS[t] = sc; selS[t] = sc + RB[e]; }
        __syncthreads();
        if (F.tid < nr) {
            const int row = F.tid, r = rbeg + row; const LAS float* sel = selS + row * 32; const LAS float* sc = scS + row * 32;
            int best = 0; float bestv = -__builtin_inff();
            for (int g = 0; g < 4; ++g) { float m1 = -__builtin_inff(), m2 = -__builtin_inff();
                for (int q = 0; q < 8; ++q) { const float x = sel[g * 8 + q]; if (x > m1) { m2 = m1; m1 = x; } else if (x > m2) m2 = x; }
                const float gs = m1 + m2; if (gs > bestv) { bestv = gs; best = g; } }
            int i1 = 0, i2 = 0; float m1 = -__builtin_inff(), m2 = -__builtin_inff();
            for (int q = 0; q < 8; ++q) { const float x = sel[best * 8 + q]; if (x > m1) { m2 = m1; i2 = i1; m1 = x; i1 = q; } else if (x > m2) { m2 = x; i2 = q; } }
            const int e1 = best * 8 + i1, e2 = best * 8 + i2; const float s1 = sc[e1], s2 = sc[e2], den = s1 + s2;
            const int p1 = atomicAdd(cnt + 64 * e1, 1), p2 = atomicAdd(cnt + 64 * e2, 1);
            list[e1 * NROW + p1] = r; list[e2 * NROW + p2] = r;
            tokE[2 * r] = e1; tokE[2 * r + 1] = e2; tokP[2 * r] = p1; tokP[2 * r + 1] = p2; tokG[2 * r] = s1 / den; tokG[2 * r + 1] = s2 / den;
        }
        __syncthreads();
        TSF(F, 33);
    }
}

__device__ __forceinline__ int moe_tiles(const Frame& F, int l) {
    LAS int* tileEM = (LAS int*)(F.lds + LDS_TILE); LAS int* tbase = tileEM + 128;
    const int* cnt = (const int*)(F.ws + WS_CTL) + CW_CNT + l * 2048;
    __syncthreads();
    if (F.wave == 0) {
        const int n = (F.lane < NEXP) ? __hip_atomic_load(cnt + 64 * F.lane, __ATOMIC_RELAXED, __HIP_MEMORY_SCOPE_AGENT) : 0;
        const int nt = (n + 255) >> 8; int incl = nt;
#pragma unroll
        for (int o = 1; o < 64; o <<= 1) { const int t = __shfl_up(incl, o); if (F.lane >= o) incl += t; }
        const int excl = incl - nt;
        if (F.lane < NEXP) { tbase[F.lane] = excl; for (int m = 0; m < nt; ++m) tileEM[excl + m] = (F.lane << 8) | m; }
        if (F.lane == NEXP - 1) tbase[NEXP] = incl;
    }
    __syncthreads();
    return tbase[NEXP];
}

__device__ __forceinline__ void p_ffnln(const Frame& F, int l, int nrows) {
    LAS int* tbase = (LAS int*)(F.lds + LDS_TILE) + 128;
    (void)moe_tiles(F, l);
    const int gw = F.bid * NWAVES + F.wave, NGW = F.G * NWAVES;
    const float* MOD = (const float*)(F.ws + WS_MOD);
    float* XS = (float*)(F.ws + WS_XS); const bf16_t* YS = (const bf16_t*)(F.ws + WS_YS);
    const int* tokE = (const int*)(F.ws + WS_TOKE); const int* tokP = (const int*)(F.ws + WS_TOKP); const float* tokG = (const float*)(F.ws + WS_TOKG);
    const float* lg = F.in[IN_LNFG] + l * DM; const float* lb = F.in[IN_LNFB] + l * DM;
    bf16_t* H1 = (bf16_t*)(F.ws + WS_H1);
    LAS float* prm = (LAS float*)(F.lds + 65536);
    stage_vec(F, prm, lg); stage_vec(F, prm + DM, lb);
    for (int v = 0; v < 2; ++v) { stage_vec(F, prm + (2 + 3 * v) * DM, MOD + (size_t)(l * 2 + v) * 12288 + 5 * DM);
        if (l == 0) { const float* mn = MOD + (size_t)(2 + v) * 12288; stage_vec(F, prm + (3 + 3 * v) * DM, mn); stage_vec(F, prm + (4 + 3 * v) * DM, mn + DM); } }
    __syncthreads();
    int e1n = 0, e2n = 0, p1n = 0, p2n = 0; float g1n = 0.f, g2n = 0.f;
#define P9_ROUTE(rr) do { if ((rr) < nrows) { e1n = tokE[2 * (rr)]; e2n = tokE[2 * (rr) + 1]; p1n = tokP[2 * (rr)]; p2n = tokP[2 * (rr) + 1]; g1n = tokG[2 * (rr)]; g2n = tokG[2 * (rr) + 1]; } } while (0)
#define P9_LOAD(rr) do { const bf16_t* ya_ = YS + (size_t)(tbase[e1n] * 256 + p1n) * DM; const bf16_t* yb_ = YS + (size_t)(tbase[e2n] * 256 + p2n) * DM; const float* xr_ = XS + (size_t)(rr) * DM; \
        _Pragma("unroll") for (int j = 0; j < 8; ++j) { const int col = 4 * F.lane + 256 * j; nx[j] = __builtin_nontemporal_load((const f32x4*)(xr_ + col)); na[j] = __builtin_nontemporal_load((const u32x2*)(ya_ + col)); nb[j] = __builtin_nontemporal_load((const u32x2*)(yb_ + col)); } ng1 = g1n; ng2 = g2n; } while (0)
    f32x4 nx[8]; u32x2 na[8], nb[8]; float ng1 = 0.f, ng2 = 0.f;
    P9_ROUTE(gw);
    if (gw < nrows) P9_LOAD(gw);
    P9_ROUTE(gw + NGW);
    for (int r = gw; r < nrows; r += NGW) {
        const int v = r >= SEQ; const LAS float* pv = prm + (2 + 3 * v) * DM;
        f32x4 z[8];
#pragma unroll
        for (int j = 0; j < 8; ++j) { const int col = 4 * F.lane + 256 * j; const u32x2 qa = na[j], qb = nb[j];
            const f32x4 fa = {bf2f((bf16_t)(qa.x & 0xffffu)), bf2f((bf16_t)(qa.x >> 16)), bf2f((bf16_t)(qa.y & 0xffffu)), bf2f((bf16_t)(qa.y >> 16))};
            const f32x4 fb = {bf2f((bf16_t)(qb.x & 0xffffu)), bf2f((bf16_t)(qb.x >> 16)), bf2f((bf16_t)(qb.y & 0xffffu)), bf2f((bf16_t)(qb.y >> 16))};
            const f32x4 y = ng1 * fa + ng2 * fb;
            z[j] = ALPHA * nx[j] + *(const LAS f32x4*)(pv + col) * y; }
        if (r + NGW < nrows) P9_LOAD(r + NGW);
        P9_ROUTE(r + 2 * NGW);
        float mean, rstd; ln_stats(z, mean, rstd);
#pragma unroll
        for (int j = 0; j < 8; ++j) { const int col = 4 * F.lane + 256 * j; z[j] = (z[j] - mean) * rstd * *(const LAS f32x4*)(prm + col) + *(const LAS f32x4*)(prm + DM + col); }
        if (l == 1) {
#pragma unroll
            for (int j = 0; j < 8; ++j) *(f32x4*)(F.out + (size_t)r * DM + 4 * F.lane + 256 * j) = z[j];
        } else {
#pragma unroll
            for (int j = 0; j < 8; ++j) *(f32x4*)(XS + (size_t)r * DM + 4 * F.lane + 256 * j) = z[j];
            float mean2, rstd2; ln_stats(z, mean2, rstd2);
#pragma unroll
            for (int j = 0; j < 8; ++j) { const int col = 4 * F.lane + 256 * j; const f32x4 h = (z[j] - mean2) * rstd2 * (1.0f + *(const LAS f32x4*)(pv + 2 * DM + col)) + *(const LAS f32x4*)(pv + DM + col);
                *(u32x2*)(H1 + (size_t)r * DM + col) = pack4(h); }
        }
    }
#undef P9_ROUTE
#undef P9_LOAD
}


__global__ void __launch_bounds__(NTHR, 2) fwd(Args args) {
    extern __shared__ __attribute__((aligned(16))) unsigned char lds_raw[];
    Frame F0;
    F0.lds = (LAS unsigned char*)lds_raw; F0.tid = threadIdx.x; F0.lane = F0.tid & 63; F0.wave = __builtin_amdgcn_readfirstlane(F0.tid >> 6);
    F0.G = gridDim.x; F0.bid = blockIdx.x; F0.in = args.in; F0.out = args.out; F0.ws = args.ws;
    volatile LAS unsigned* MISC = (volatile LAS unsigned*)(F0.lds + LDS_MISC);
    if (F0.tid < 4) MISC[F0.tid] = 0u;
    __syncthreads();
    const int lo = args.ph_lo, hi = args.ph_hi;
    XcdBarrier bar; bar.bar = (unsigned*)(F0.ws + WS_CTL) + CW_BAR; bar.x = 0; bar.st = MISC;
    if (hi - lo > 1) bar = xcd_barrier_post((unsigned*)(F0.ws + WS_CTL) + CW_BAR, MISC);
#ifndef REP_PH
#define REP_PH -1
#endif
#define NREP(j) (((REP_PH) == (j)) ? rep1 + 1 : 1)
#if defined(ONLY_PH)
#define PHON(j) ((j) == ONLY_PH)
#elif defined(PH_MASK)
#define PHON(j) (((PH_MASK) >> (j)) & 1)
#else
#define PHON(j) true
#endif
#ifdef TSEL_A
#define TS(i) do { if (F0.bid == 0 && F0.tid == 0) __hip_atomic_store((unsigned long long*)(F0.ws + WS_CTL + 131072) + (i), (unsigned long long)__builtin_amdgcn_s_memrealtime(), __ATOMIC_RELAXED, __HIP_MEMORY_SCOPE_AGENT); } while (0)
#else
#define TS(i) do { } while (0)
#endif
#define IN(k) (lo <= (k) && (k) < hi)
#define SEAM(k) do { if (IN(k) && IN((k) + 1)) xcd_barrier(bar); } while (0)
    TS(0);
    int rep1 = 1; asm volatile("" : "+s"(rep1));
    if (PHON(0) && IN(0)) for (int rep = 0; rep < NREP(0); ++rep) { { const Frame F = launder(F0); p0_mod(F); } { const Frame F = launder(F0); p0_transposes(F); } { const Frame F = launder(F0); p0_rope(F); } }
    SEAM(0); TS(1);
    if (PHON(1) && IN(1)) for (int rep = 0; rep < NREP(1); ++rep) { const Frame F = launder(F0); p_modulate1(F, 0, NROW); }
    SEAM(1); TS(2);
#pragma unroll 1
    for (int l = 0; l < 2; ++l) {
        const int pb = 2 + 8 * l; const int tb = 3 + 10 * l; (void)tb;
        const int nlat = (l == 0) ? NROW : SEQ;
        if (PHON(2) && IN(pb + 0)) for (int rep = 0; rep < NREP(2); ++rep) {
            const bool split = F0.G >= 256; const int gc = split ? NC_IN : F0.G;
            if (F0.bid < gc) {
                pg8::StaticOrder S; S.init(NROW, INW, DM, (const bf16_t*)(F0.ws + WS_WIN) + (size_t)l * INW * DM, gc, F0.bid);
                { const Frame F = launder(F0);
                  pg8::EpiBf<true> E{(bf16_t*)(F.ws + WS_PROJ), INW, (bf16_t*)(F.ws + WS_KV)};
                  pg8::gemm_phase(F.lds, F.tid, (const bf16_t*)(F.ws + WS_H1), DM, S, E); }
                asm volatile("s_waitcnt vmcnt(0)" ::: "memory"); __syncthreads();
                { const Frame F = launder(F0);
                  pg8::Unit u; for (int i = 0; S.next(i, u); ++i) if (u.pn >= 10 && u.pn <= 14) rms_rope_tile(F, l, u.pm * 256, u.pn); }
            } else { const Frame F = launder(F0); if (l == 0) conv_range(F, gc, 0, CV_A0); else conv_range(F, gc, CV_LAYER + CV_B1, CV_L1F - CV_B1); }
        }
        SEAM(pb + 0); TS(tb + 0); TS(tb + 1);
        if (IN(pb + 2)) { if (PHON(4)) for (int rep = 0; rep < NREP(4); ++rep) { const Frame F = launder(F0); p_att_dense(F, l); } TS(tb + 2); if (PHON(10)) for (int rep = 0; rep < NREP(10); ++rep) { const Frame F = launder(F0); p_att_na(F, l); } TS(tb + 3); if (PHON(11)) for (int rep = 0; rep < NREP(11); ++rep) { const Frame F = launder(F0); p_att_sg(F, l); }
            if (F0.G >= 256 && F0.bid >= 128) { const Frame F = launder(F0); conv_range(F, 128, l == 0 ? CV_L0F : CV_LAYER + CV_L1F, CV_ATT); } }
        SEAM(pb + 2); TS(tb + 4);
        if (PHON(5) && IN(pb + 3)) for (int rep = 0; rep < NREP(5); ++rep) { const Frame F = launder(F0);
            const bool split = (l == 0) && F.G >= 256; const int gc = split ? NC_OUT : F.G;
            if (F.bid < gc) {
                pg8::StaticOrder S; S.init(nlat, DM, DM, (const bf16_t*)(F.ws + WS_WOUT) + (size_t)l * DM * DM, gc, F.bid);
                pg8::EpiBf<false> E{(bf16_t*)(F.ws + WS_Y1), DM, nullptr};
                pg8::gemm_phase(F.lds, F.tid, (const bf16_t*)(F.ws + WS_MIX), DM, S, E);
            } else conv_range(F, gc, CV_A0, CV_L0F - CV_A0);
        }
        SEAM(pb + 3); TS(tb + 5);
        if (PHON(6) && IN(pb + 4)) { const Frame F = launder(F0); p_mixln_router(F, l, nlat); }
        SEAM(pb + 4); TS(tb + 6);
        if (PHON(7) && IN(pb + 5)) for (int rep = 0; rep < NREP(7); ++rep) { const Frame F = launder(F0);
            const bool split = (l == 0) && F.G >= 256; const int gc = split ? NC_MOE : F.G;
            if (F.bid < gc) {
                const int ntiles = moe_tiles(F, l);
                pg8::MoeOrder<true> S{(const LAS int*)(F.lds + LDS_TILE), ntiles, gc, F.bid, DM, (const int*)(F.ws + WS_LIST), (const int*)(F.ws + WS_CTL) + CW_CNT + l * 2048,
                                      (const bf16_t*)(F.ws + WS_WGU) + (size_t)l * NEXP * 2048 * DM};
                pg8::EpiSwiGLU E{(bf16_t*)(F.ws + WS_GA)};
                pg8::gemm_phase(F.lds, F.tid, (const bf16_t*)(F.ws + WS_H2), DM, S, E);
            } else conv_range(F, gc, CV_LAYER, CV_B0);
        }
        SEAM(pb + 5); TS(tb + 7);
        if (PHON(8) && IN(pb + 6)) for (int rep = 0; rep < NREP(8); ++rep) { const Frame F = launder(F0);
            const bool split = (l == 0) && F.G >= 256; const int gc = split ? NC_MOE : F.G;
            if (F.bid < gc) {
                const int ntiles = moe_tiles(F, l);
                pg8::MoeOrder<false> S{(const LAS int*)(F.lds + LDS_TILE), ntiles, gc, F.bid, DEXP, nullptr, nullptr, (const bf16_t*)(F.ws + WS_WD) + (size_t)l * NEXP * DM * DEXP};
                pg8::EpiBf<false> E{(bf16_t*)(F.ws + WS_YS), DM, nullptr};
                pg8::gemm_phase(F.lds, F.tid, (const bf16_t*)(F.ws + WS_GA), DEXP, S, E);
            } else conv_range(F, gc, CV_LAYER + CV_B0, CV_B1 - CV_B0);
        }
        SEAM(pb + 6); TS(tb + 8);
        if (PHON(9) && IN(pb + 7)) { const Frame F = launder(F0); p_ffnln(F, l, nlat); }
        SEAM(pb + 7);
#ifdef TSEL_A
        if (l == 1) xcd_barrier(bar);
#endif
        TS(tb + 9);
    }
#ifdef TSEL_A
    {
        unsigned long long* ts = (unsigned long long*)(F0.ws + WS_CTL + 131072);
        if (F0.bid == 0 && F0.tid == 0) {
            unsigned long long a0 = 0, a1 = 0, b0 = 0, b1 = 0;
            a0 = __hip_atomic_load(ts + TSEL_A - 1, __ATOMIC_RELAXED, __HIP_MEMORY_SCOPE_AGENT); a1 = __hip_atomic_load(ts + TSEL_A2, __ATOMIC_RELAXED, __HIP_MEMORY_SCOPE_AGENT);
            b0 = __hip_atomic_load(ts + TSEL_B - 1, __ATOMIC_RELAXED, __HIP_MEMORY_SCOPE_AGENT); b1 = __hip_atomic_load(ts + TSEL_B2, __ATOMIC_RELAXED, __HIP_MEMORY_SCOPE_AGENT);
            const float ua = (float)(a1 - a0) * 0.01f, ub = (float)(b1 - b0) * 0.01f;
            int n1 = (int)(ua * 8.192f); n1 = n1 > 8100 ? 8100 : n1; n1 = 0;
            __hip_atomic_store((unsigned*)(ts + 64), (unsigned)n1, __ATOMIC_RELAXED, __HIP_MEMORY_SCOPE_AGENT);
            __hip_atomic_store((unsigned*)(ts + 65), __float_as_uint(ub * 0.5f), __ATOMIC_RELAXED, __HIP_MEMORY_SCOPE_AGENT);
        }
        xcd_barrier(bar);
        const int n1 = (int)__hip_atomic_load((unsigned*)(ts + 64), __ATOMIC_RELAXED, __HIP_MEMORY_SCOPE_AGENT);
        const float V = __uint_as_float(__hip_atomic_load((unsigned*)(ts + 65), __ATOMIC_RELAXED, __HIP_MEMORY_SCOPE_AGENT));
        const int gw = F0.bid * NWAVES + F0.wave, NGW = F0.G * NWAVES;
        for (int r = gw; r < n1; r += NGW) for (int j = 0; j < 8; ++j) *(f32x4*)(F0.out + (size_t)r * DM + 4 * F0.lane + 256 * j) = (f32x4){0.f, 0.f, 0.f, 0.f};
        asm volatile("s_waitcnt vmcnt(0)" ::: "memory");
        if (F0.bid == 0 && F0.tid == 0) F0.out[0] = V;
    }
#endif
#undef IN
#undef SEAM
}


extern "C" void kernel_launch(void* const* d_in, const int* in_sizes, int n_in, void* d_out, int out_size, void* d_ws, size_t ws_size, hipStream_t stream) {
    static int grid = 0;
    if (grid == 0) {
        if (n_in != 24 || out_size != SEQ * DM || ws_size < WS_END) { fprintf(stderr, "kernel_launch: unexpected shapes (n_in %d out %d ws %zu)\n", n_in, out_size, ws_size); grid = -1; return; }
        int dev = 0, cus = 0, per_cu = 0;
        if (hipGetDevice(&dev) != hipSuccess || hipDeviceGetAttribute(&cus, hipDeviceAttributeMultiprocessorCount, dev) != hipSuccess) { grid = -1; return; }
        if (hipFuncSetAttribute((const void*)fwd, hipFuncAttributeMaxDynamicSharedMemorySize, LDS_BYTES) != hipSuccess) { fprintf(stderr, "kernel_launch: hipFuncSetAttribute failed\n"); grid = -1; return; }
        if (hipOccupancyMaxActiveBlocksPerMultiprocessor(&per_cu, (const void*)fwd, NTHR, LDS_BYTES) != hipSuccess || per_cu < 1) { fprintf(stderr, "kernel_launch: occupancy query says %d\n", per_cu); }
        (void)hipGetLastError();
        grid = cus;
    }
    if (grid < 0) return;
    (void)hipMemsetAsync((char*)d_ws + WS_CTL, 0, CTL_ZERO_BYTES, stream);
    Args a{};
    for (int i = 0; i < 24; ++i) a.in[i] = (const float*)d_in[i];
    a.out = (float*)d_out; a.ws = (unsigned char*)d_ws;
#if MK_ONE_LAUNCH
    a.ph_lo = 0; a.ph_hi = NPH;
    hipLaunchKernelGGL(fwd, dim3(grid), dim3(NTHR), LDS_BYTES, stream, a);

#else
    for (int k = 0; k < NPH; ++k) { a.ph_lo = k; a.ph_hi = k + 1; hipLaunchKernelGGL(fwd, dim3(grid), dim3(NTHR), LDS_BYTES, stream, a); }
#endif
}
```

```cpp
#include <hip/hip_runtime.h>
#include <cstdio>
#include <cstdint>

#ifndef MK_ONE_LAUNCH
#define MK_ONE_LAUNCH 1
#endif

constexpr int DM = 2048, SEQ = 8192, CTXL = 256, NROW = SEQ + CTXL;
constexpr int INW = 4096, NEXP = 32, DEXP = 1024, GRIDW = 64;
constexpr float ALPHA = 1.41421356237309515f;
constexpr float LN_EPS = 1e-6f;
constexpr int NPH = 18;
constexpr int MOE_CAP_TILES = 98;
constexpr int NWAVES = 8, NTHR = 512;

constexpr size_t MiB = 1u << 20;
constexpr size_t WS_CTL = 0, CTL_ZERO_BYTES = 1 * MiB;
constexpr size_t WS_MOD = 1 * MiB;
constexpr size_t WS_ROPE = 1 * MiB + 256 * 1024;
constexpr size_t WS_RWT = 1 * MiB + 512 * 1024;
constexpr size_t WS_TOKE = 2 * MiB;
constexpr size_t WS_TOKP = WS_TOKE + 128 * 1024;
constexpr size_t WS_TOKG = WS_TOKP + 128 * 1024;
constexpr size_t WS_LIST = 3 * MiB;
constexpr size_t WS_WIN = 8 * MiB;
constexpr size_t WS_WOUT = 40 * MiB;
constexpr size_t WS_WGU = 64 * MiB;
constexpr size_t WS_WD = 576 * MiB;
constexpr size_t WS_H1 = 832 * MiB;
constexpr size_t WS_PROJ = 866 * MiB;
constexpr size_t WS_MIX = 932 * MiB;
constexpr size_t WS_Y1 = 966 * MiB;
constexpr size_t WS_XS = 1032 * MiB;
constexpr size_t WS_H2 = 1098 * MiB;
constexpr size_t WS_GA = 1132 * MiB;
constexpr size_t WS_YS = 1182 * MiB;
constexpr size_t WS_H2L = 1378 * MiB;
constexpr size_t WS_KV = 1412 * MiB;
constexpr size_t WS_CKV = 1424 * MiB;
constexpr size_t WS_END = 1426 * MiB;
constexpr int CW_BAR = 4096;
constexpr int CW_CNT = 8192;
constexpr int LDS_PART = 131072;
constexpr int LDS_SC = 147456;
constexpr int LDS_TILE = 151552;
constexpr int LDS_MISC = 153600;
constexpr int LDS_BYTES = 155648;

#define GAS __attribute__((address_space(1)))
#define LAS __attribute__((address_space(3)))
typedef unsigned short bf16_t;
typedef float f32x4 __attribute__((ext_vector_type(4)));
typedef float f32x2 __attribute__((ext_vector_type(2)));
typedef float f32x16 __attribute__((ext_vector_type(16)));
typedef short bf16x8 __attribute__((ext_vector_type(8)));
typedef short s16x4 __attribute__((ext_vector_type(4)));
typedef unsigned u32x4 __attribute__((ext_vector_type(4)));
typedef unsigned u32x2 __attribute__((ext_vector_type(2)));

typedef __bf16 bf16v2 __attribute__((ext_vector_type(2)));
typedef float f32v2 __attribute__((ext_vector_type(2)));
__device__ __forceinline__ unsigned cvt_pk_bf16_s(float lo, float hi) { const f32v2 v = {lo, hi}; const bf16v2 r = __builtin_convertvector(v, bf16v2); return *reinterpret_cast<const unsigned*>(&r); }
__device__ __forceinline__ unsigned cvt_pk_bf16(float lo, float hi) { unsigned r; asm volatile("v_cvt_pk_bf16_f32 %0, %1, %2" : "=v"(r) : "v"(lo), "v"(hi)); return r; }
__device__ __forceinline__ bf16_t f2bf(float f) { unsigned u = __builtin_bit_cast(unsigned, f); return (bf16_t)((u + 0x7fffu + ((u >> 16) & 1u)) >> 16); }
__device__ __forceinline__ float bf2f(bf16_t b) { return __builtin_bit_cast(float, ((unsigned)b) << 16); }
__device__ __forceinline__ u32x2 pack4(f32x4 v) { u32x2 o; o.x = cvt_pk_bf16(v.x, v.y); o.y = cvt_pk_bf16(v.z, v.w); return o; }
template <int CTRL> __device__ __forceinline__ float dpp_mov(float v) { return __builtin_bit_cast(float, __builtin_amdgcn_update_dpp(0, __builtin_bit_cast(int, v), CTRL, 0xF, 0xF, true)); }
__device__ __forceinline__ float quad_sum(float v) { v += dpp_mov<0xB1>(v); v += dpp_mov<0x4E>(v); return v; }
__device__ __forceinline__ float wave_sum(float v) {
    v += dpp_mov<0xB1>(v); v += dpp_mov<0x4E>(v); v += dpp_mov<0x141>(v); v += dpp_mov<0x140>(v);
    const float s0 = __builtin_bit_cast(float, __builtin_amdgcn_readlane(__builtin_bit_cast(int, v), 0)), s1 = __builtin_bit_cast(float, __builtin_amdgcn_readlane(__builtin_bit_cast(int, v), 16));
    const float s2 = __builtin_bit_cast(float, __builtin_amdgcn_readlane(__builtin_bit_cast(int, v), 32)), s3 = __builtin_bit_cast(float, __builtin_amdgcn_readlane(__builtin_bit_cast(int, v), 48));
    return (s0 + s1) + (s2 + s3);
}
__device__ __forceinline__ float sigmoidf_(float x) { return 1.0f / (1.0f + expf(-x)); }
__device__ __forceinline__ float gelu_tanh_fast(float x) { const float u = x * (1.0f + 0.044715f * x * x) * 1.5957691216057308f; return x * __builtin_amdgcn_rcpf(1.0f + __expf(-u)); }
__device__ __forceinline__ float silu_fast(float x) { return x * __builtin_amdgcn_rcpf(1.0f + __expf(-x)); }

#define XB_TMO      128
#define XB_XCNT(j)  (256  + 64 * (j))
#define XB_XSUB(j)  (1280 + 64 * (j))
#define XB_XGEN(j)  (2304 + 64 * (j))
#define XB_TOP      3328
#define XB_TOPGEN   3392
#define XCD_BAR_WORDS 3456
#define XB_SPIN_CAP (1u << 20)
__device__ __forceinline__ unsigned xb_ld(unsigned* p)              { return __hip_atomic_load(p, __ATOMIC_RELAXED, __HIP_MEMORY_SCOPE_AGENT); }
__device__ __forceinline__ unsigned xb_add(unsigned* p, unsigned v) { return __hip_atomic_fetch_add(p, v, __ATOMIC_RELAXED, __HIP_MEMORY_SCOPE_AGENT); }
__device__ __forceinline__ unsigned xb_xcc_id() { return (unsigned)__builtin_amdgcn_s_getreg((3 << 11) | 20) & 0xFu; }
#define XB_SPIN(cond, bar) do { unsigned _sp = 0; while (cond) { __builtin_amdgcn_s_sleep(1); \
    if ((++_sp & 255u) == 0u) { if (xb_ld(&(bar)[XB_TMO])) break; if (_sp > XB_SPIN_CAP) { atomicAdd(&(bar)[XB_TMO], 1u); break; } } } } while (0)
struct XcdBarrier { unsigned* bar; unsigned x; volatile LAS unsigned* st; };
__device__ __forceinline__ XcdBarrier xcd_barrier_post(unsigned* bar, volatile LAS unsigned* st) {
    XcdBarrier b; b.bar = bar; b.x = xb_xcc_id(); b.st = st;
    if (threadIdx.x == 0) (void)xb_add(&bar[XB_XCNT(b.x)], 1u);
    return b;
}
__device__ __forceinline__ void xcd_barrier_complete(unsigned* bar, unsigned x, unsigned& nloc, unsigned& nx) {
    const unsigned G = gridDim.x * gridDim.y * gridDim.z;
    unsigned sum, cnt, mine, sp = 0u;
    for (;;) {
        sum = 0u; cnt = 0u; mine = 0u;
#pragma unroll
        for (unsigned j = 0; j < 16; ++j) { const unsigned c = xb_ld(&bar[XB_XCNT(j)]); sum += c; cnt += (c > 0u) ? 1u : 0u; mine = (j == x) ? c : mine; }
        if (sum == G) break;
        __builtin_amdgcn_s_sleep(1);
        if ((++sp & 255u) == 0u) { if (xb_ld(&bar[XB_TMO])) break; if (sp > XB_SPIN_CAP) { atomicAdd(&bar[XB_TMO], 1u); break; } }
    }
    nloc = mine > 0u ? mine : 1u; nx = cnt > 0u ? cnt : 1u;
}
__device__ __forceinline__ void xcd_barrier(const XcdBarrier& b) {
    asm volatile("s_waitcnt vmcnt(0)" ::: "memory");
    __syncthreads();
    if (threadIdx.x == 0) {
        unsigned* bar = b.bar;
        __builtin_amdgcn_s_waitcnt(0);
        unsigned nloc = b.st[0], nx = b.st[1];
        if (nloc == 0u) { xcd_barrier_complete(bar, b.x, nloc, nx); b.st[0] = nloc; b.st[1] = nx; }
        const unsigned old = xb_add(&bar[XB_XSUB(b.x)], 1u);
        const unsigned gen = old / nloc;
        if (old + 1u == (gen + 1u) * nloc) {
            __builtin_amdgcn_fence(__ATOMIC_RELEASE, "agent");
            asm volatile("s_waitcnt vmcnt(0)" ::: "memory");
            const unsigned og = xb_add(&bar[XB_TOP], 1u);
            const unsigned tg = og / nx;
            if (og + 1u == (tg + 1u) * nx) xb_add(&bar[XB_TOPGEN], 1u);
            else XB_SPIN(xb_ld(&bar[XB_TOPGEN]) == tg, bar);
            __builtin_amdgcn_fence(__ATOMIC_ACQUIRE, "agent");
            xb_add(&bar[XB_XGEN(b.x)], 1u);
            asm volatile("s_waitcnt vmcnt(0)" ::: "memory");
        } else {
            XB_SPIN(xb_ld(&bar[XB_XGEN(b.x)]) == gen, bar);
            __builtin_amdgcn_fence(__ATOMIC_ACQUIRE, "agent");
            asm volatile("s_waitcnt vmcnt(0)" ::: "memory");
        }
    }
    __syncthreads();
}

struct Args { const float* in[24]; float* out; unsigned char* ws; int ph_lo, ph_hi; };
struct Frame {
    LAS unsigned char* lds;
    int tid, lane, wave, G, bid;
    const float* const* in;
    float* out; unsigned char* ws;
};
__device__ __forceinline__ Frame launder(const Frame& F0) {
    Frame F = F0; int t = F0.tid; asm volatile("" : "+v"(t)); F.tid = t; F.lane = t & 63; F.wave = __builtin_amdgcn_readfirstlane(t >> 6);
    unsigned long long w = (unsigned long long)F0.ws; asm volatile("" : "+s"(w)); F.ws = (unsigned char*)(GAS unsigned char*)w;
    unsigned l = (unsigned)(uintptr_t)F0.lds; asm volatile("" : "+s"(l)); F.lds = (LAS unsigned char*)(uintptr_t)l;
    int g = F0.G, b = F0.bid; asm volatile("" : "+s"(g), "+s"(b)); F.G = g; F.bid = b;
    return F;
}
#define IN_X 0
#define IN_C 1
#define IN_CTX 2
#define IN_CCTX 3
#define IN_ADAW 4
#define IN_ADAB 5
#define IN_WIN 6
#define IN_RPB 7
#define IN_SGLNG 8
#define IN_SGLNB 9
#define IN_SGW 10
#define IN_SGB 11
#define IN_QNG 12
#define IN_KNG 13
#define IN_WOUT 14
#define IN_LNMG 15
#define IN_LNMB 16
#define IN_RW 17
#define IN_RB 18
#define IN_WG 19
#define IN_WU 20
#define IN_WDN 21
#define IN_LNFG 22
#define IN_LNFB 23

__device__ __forceinline__ void p0_mod(const Frame& F) {
    LAS float* sl = (LAS float*)F.lds;
    LAS float* red = sl + 4096;
    const float* c = F.in[IN_C]; const float* cc = F.in[IN_CCTX];
    for (int t = F.tid; t < DM; t += NTHR) { const float a = c[t]; sl[t] = a * sigmoidf_(a); const float b = cc[t]; sl[DM + t] = b * sigmoidf_(b); }
    __syncthreads();
    float* MOD = (float*)(F.ws + WS_MOD);
    for (int item = F.bid; item < 256; item += F.G) {
        const int l = item >> 7, nb = item & 127, col0 = nb * 96;
        f32x2 a0 = {0.f, 0.f}, a1 = {0.f, 0.f};
        if (F.lane < 48) {
            const float* wp = F.in[IN_ADAW] + (size_t)l * DM * 12288 + (size_t)(F.wave * 256) * 12288 + col0 + 2 * F.lane;
            const LAS float* s0 = sl + F.wave * 256; const LAS float* s1 = sl + DM + F.wave * 256;
#pragma unroll 8
            for (int k = 0; k < 256; ++k) { const f32x2 w = *(const f32x2*)(wp + (size_t)k * 12288); a0 += s0[k] * w; a1 += s1[k] * w; }
            red[(F.wave * 2 + 0) * 96 + 2 * F.lane] = a0.x; red[(F.wave * 2 + 0) * 96 + 2 * F.lane + 1] = a0.y;
            red[(F.wave * 2 + 1) * 96 + 2 * F.lane] = a1.x; red[(F.wave * 2 + 1) * 96 + 2 * F.lane + 1] = a1.y;
        }
        __syncthreads();
        if (F.tid < 192) { const int v = F.tid / 96, q = F.tid % 96; float s = 0.f;
#pragma unroll
            for (int w = 0; w < 8; ++w) s += red[(w * 2 + v) * 96 + q];
            MOD[(size_t)(l * 2 + v) * 12288 + col0 + q] = s + F.in[IN_ADAB][l * 12288 + col0 + q]; }
        __syncthreads();
    }
}
__device__ __forceinline__ void tr_item(const float* W, int K, int N, bf16_t* WT, int k0, int n0, int drow0, LAS float* scr, int lane) {
    f32x4 v[16];
    const float* wp = W + (size_t)(k0 + (lane >> 4)) * N + n0 + 4 * (lane & 15);
#pragma unroll
    for (int i = 0; i < 16; ++i) v[i] = __builtin_nontemporal_load((const f32x4*)(wp + (size_t)(4 * i) * N));
#pragma unroll
    for (int i = 0; i < 16; ++i) { LAS float* p = scr + (4 * i + (lane >> 4)) * 65 + 4 * (lane & 15); p[0] = v[i].x; p[1] = v[i].y; p[2] = v[i].z; p[3] = v[i].w; }
    asm volatile("s_waitcnt lgkmcnt(0)" ::: "memory");
    const int c = lane & 7;
#pragma unroll
    for (int j = 0; j < 8; ++j) { const int n = (lane >> 3) + 8 * j; const LAS float* s = scr + (8 * c) * 65 + n;
        u32x4 o; o.x = cvt_pk_bf16_s(s[0 * 65], s[1 * 65]); o.y = cvt_pk_bf16_s(s[2 * 65], s[3 * 65]); o.z = cvt_pk_bf16_s(s[4 * 65], s[5 * 65]); o.w = cvt_pk_bf16_s(s[6 * 65], s[7 * 65]);
        *(u32x4*)(WT + (size_t)(drow0 + n) * K + k0 + 8 * c) = o; }
    asm volatile("s_waitcnt lgkmcnt(0)" ::: "memory");
}
struct TrDesc { const float* src; bf16_t* dst; int N, K; };
__device__ __forceinline__ TrDesc moe_item_desc(const Frame& F, int m) {
    const int le = m / 1536, r = m % 1536, which = r >> 9, r2 = r & 511; TrDesc d;
    if (which < 2) { const int kb = r2 >> 4, nb = r2 & 15, n0 = nb * 64; d.N = DEXP; d.K = DM;
        d.src = F.in[which == 0 ? IN_WG : IN_WU] + (size_t)le * DM * DEXP + (size_t)(kb * 64) * DEXP + n0;
        d.dst = (bf16_t*)(F.ws + WS_WGU) + (size_t)le * 2048 * DM + (size_t)((n0 >> 7) * 256 + (n0 & 127) + which * 128) * DM + kb * 64; }
    else { const int kb = r2 >> 5, nb = r2 & 31; d.N = DM; d.K = DEXP;
        d.src = F.in[IN_WDN] + (size_t)le * DEXP * DM + (size_t)(kb * 64) * DM + nb * 64;
        d.dst = (bf16_t*)(F.ws + WS_WD) + (size_t)le * DM * DEXP + (size_t)(nb * 64) * DEXP + kb * 64; }
    return d;
}
__device__ __forceinline__ void tr_load64(const TrDesc& d, f32x4 (&v)[16], int lane) {
    const float* wp = d.src + (size_t)(lane >> 4) * d.N + 4 * (lane & 15);
#pragma unroll
    for (int i = 0; i < 16; ++i) v[i] = __builtin_nontemporal_load((const f32x4*)(wp + (size_t)(4 * i) * d.N));
}
__device__ __forceinline__ void tr_finish64(const TrDesc& d, const f32x4 (&v)[16], LAS float* scr, int lane) {
#pragma unroll
    for (int i = 0; i < 16; ++i) { LAS float* p = scr + (4 * i + (lane >> 4)) * 65 + 4 * (lane & 15); p[0] = v[i].x; p[1] = v[i].y; p[2] = v[i].z; p[3] = v[i].w; }
    asm volatile("s_waitcnt lgkmcnt(0)" ::: "memory");
    const int c = lane & 7;
#pragma unroll
    for (int j = 0; j < 8; ++j) { const int n = (lane >> 3) + 8 * j; const LAS float* s = scr + (8 * c) * 65 + n;
        u32x4 o; o.x = cvt_pk_bf16_s(s[0 * 65], s[1 * 65]); o.y = cvt_pk_bf16_s(s[2 * 65], s[3 * 65]); o.z = cvt_pk_bf16_s(s[4 * 65], s[5 * 65]); o.w = cvt_pk_bf16_s(s[6 * 65], s[7 * 65]);
        *(u32x4*)(d.dst + (size_t)n * d.K + 8 * c) = o; }
    asm volatile("s_waitcnt lgkmcnt(0)" ::: "memory");
}
__device__ __forceinline__ void conv_moe_item(const Frame& F, int m, LAS float* scr) {
    const TrDesc d = moe_item_desc(F, m); f32x4 v[16]; tr_load64(d, v, F.lane); tr_finish64(d, v, scr, F.lane);
}
constexpr int NC_IN = 176, NC_OUT = 192, NC_MOE = 192, NCOMP = 128  ;
constexpr int CV_LAYER = 49152;
constexpr int CV_A0 = 20480, CV_L0F = CV_A0 + 10240;
constexpr int CV_B0 = 16384, CV_B1 = CV_B0 + 10240, CV_L1F = CV_B1 + 16384;
constexpr int CV_ATT = 6144;
static_assert(CV_L0F + CV_ATT <= CV_LAYER && CV_L1F + CV_ATT <= CV_LAYER, "converter ranges");
__device__ __forceinline__ void conv_range(const Frame& F, int ncomp, int first, int count) {
    LAS float* scr = (LAS float*)(F.lds + F.wave * 16896);
    const int cw = (F.bid - ncomp) * NWAVES + F.wave, NCW = (F.G - ncomp) * NWAVES;
    f32x4 va[16], vb[16]; TrDesc d, dn;
    int k = cw;
    if (k >= count) return;
    d = moe_item_desc(F, first + k); tr_load64(d, va, F.lane);
    for (;;) {
        const int kn = k + NCW; const bool hn = kn < count;
        dn = moe_item_desc(F, first + (hn ? kn : k)); tr_load64(dn, vb, F.lane);
        tr_finish64(d, va, scr, F.lane);
        if (!hn) break;
        k = kn + NCW; const bool h2 = k < count;
        d = moe_item_desc(F, first + (h2 ? k : kn)); tr_load64(d, va, F.lane);
        tr_finish64(dn, vb, scr, F.lane);
        if (!h2) break;
    }
}
__device__ __forceinline__ void p0_transposes(const Frame& F) {
    LAS float* scr = (LAS float*)(F.lds + F.wave * 16896);
    const int gw = F.bid * NWAVES + F.wave, NGW = F.G * NWAVES;
    constexpr int NDENSE = 2 * 3072;
    const bool split = F.G >= 256;
    const int r0 = split ? CV_LAYER - CV_L0F - CV_ATT : CV_LAYER, r1 = split ? CV_LAYER - CV_L1F - CV_ATT : CV_LAYER;
    const int NITEMS = NDENSE + r0 + r1;
    for (int it = gw; it < NITEMS; it += NGW) {
        if (it < NDENSE) {
            const int l = it / 3072, r = it % 3072;
            if (r < 2048) { const int kb = r >> 6, nb = r & 63; tr_item(F.in[IN_WIN] + (size_t)l * DM * INW, DM, INW, (bf16_t*)(F.ws + WS_WIN) + (size_t)l * INW * DM, kb * 64, nb * 64, nb * 64, scr, F.lane); }
            else { const int r2 = r - 2048, kb = r2 >> 5, nb = r2 & 31; tr_item(F.in[IN_WOUT] + (size_t)l * DM * DM, DM, DM, (bf16_t*)(F.ws + WS_WOUT) + (size_t)l * DM * DM, kb * 64, nb * 64, nb * 64, scr, F.lane); }
        } else {
            const int q = it - NDENSE;
            const int m = q < r0 ? (CV_LAYER - r0) + q : CV_LAYER + (CV_LAYER - r1) + (q - r0);
            conv_moe_item(F, m, scr);
        }
    }
}
__device__ __forceinline__ void p0_rope(const Frame& F) {
    const int g = F.bid * NTHR + F.tid;
    if (g < 32 * DM) { const int e = g >> 11, k = g & (DM - 1); const float w = F.in[IN_RW][k * 32 + e]; const bf16_t hi = f2bf(w); const bf16_t lo = f2bf(w - bf2f(hi));
        bf16_t* T = (bf16_t*)(F.ws + WS_RWT); T[g] = hi; T[32 * DM + g] = lo; }
    if (g < 128 * 32) { const int pos = g >> 5, i = g & 31; const float inv = powf(10000.0f, -(float)i / 32.0f); const float ang = (float)pos * inv;
        float* R = (float*)(F.ws + WS_ROPE); R[2 * g] = cosf(ang); R[2 * g + 1] = sinf(ang); }
}

__device__ __forceinline__ const float* xrow_ptr(const Frame& F, int l, int r) {
    if (l == 0) return r < SEQ ? F.in[IN_X] + (size_t)r * DM : F.in[IN_CTX] + (size_t)(r - SEQ) * DM;
    return (const float*)(F.ws + WS_XS) + (size_t)r * DM;
}
__device__ __forceinline__ void ln_stats(const f32x4 (&v)[8], float& mean, float& rstd) {
    float s = 0.f;
#pragma unroll
    for (int j = 0; j < 8; ++j) s += (v[j].x + v[j].y) + (v[j].z + v[j].w);
    mean = wave_sum(s) * (1.0f / DM);
    float q = 0.f;
#pragma unroll
    for (int j = 0; j < 8; ++j) { const f32x4 d = v[j] - mean; q += (d.x * d.x + d.y * d.y) + (d.z * d.z + d.w * d.w); }
    rstd = 1.0f / sqrtf(wave_sum(q) * (1.0f / DM) + LN_EPS);
}
template <bool TO_LDS>
__device__ __forceinline__ void modulate_store(const f32x4 (&v)[8], const float* sh, const float* sc, bf16_t* orow, LAS float* lrow, int lane) {
    float mean, rstd; ln_stats(v, mean, rstd);
#pragma unroll
    for (int j = 0; j < 8; ++j) { const int col = 4 * lane + 256 * j; const f32x4 s1 = *(const f32x4*)(sc + col), s0 = *(const f32x4*)(sh + col);
        const f32x4 h = (v[j] - mean) * rstd * (1.0f + s1) + s0;
        u32x2 w; w.x = cvt_pk_bf16(h.x, h.y); w.y = cvt_pk_bf16(h.z, h.w); *(u32x2*)(orow + col) = w;
        if (TO_LDS) *(LAS f32x4*)(lrow + col) = h; }
}
__device__ __forceinline__ void stage_vec(const Frame& F, LAS float* dst, const float* src) { *(LAS f32x4*)(dst + 4 * F.tid) = *(const f32x4*)(src + 4 * F.tid); }
__device__ __forceinline__ void p_modulate1(const Frame& F, int l, int nrows) {
    const int gw = F.bid * NWAVES + F.wave, NGW = F.G * NWAVES;
    const float* MOD = (const float*)(F.ws + WS_MOD);
    bf16_t* H1 = (bf16_t*)(F.ws + WS_H1);
    LAS float* prm = (LAS float*)F.lds;
    for (int v = 0; v < 2; ++v) { const float* m = MOD + (size_t)(l * 2 + v) * 12288; stage_vec(F, prm + (2 * v) * DM, m); stage_vec(F, prm + (2 * v + 1) * DM, m + DM); }
    __syncthreads();
    f32x4 nx[8];
    if (gw < nrows) { const float* xr = xrow_ptr(F, l, gw);
#pragma unroll
        for (int j = 0; j < 8; ++j) nx[j] = *(const f32x4*)(xr + 4 * F.lane + 256 * j); }
    for (int r = gw; r < nrows; r += NGW) {
        const int v = r >= SEQ; const LAS float* pv = prm + 2 * v * DM;
        f32x4 x[8];
#pragma unroll
        for (int j = 0; j < 8; ++j) x[j] = nx[j];
        if (r + NGW < nrows) { const float* xr = xrow_ptr(F, l, r + NGW);
#pragma unroll
            for (int j = 0; j < 8; ++j) nx[j] = *(const f32x4*)(xr + 4 * F.lane + 256 * j); }
        float mean, rstd; ln_stats(x, mean, rstd);
#pragma unroll
        for (int j = 0; j < 8; ++j) { const int col = 4 * F.lane + 256 * j; const f32x4 h = (x[j] - mean) * rstd * (1.0f + *(const LAS f32x4*)(pv + DM + col)) + *(const LAS f32x4*)(pv + col);
            u32x2 w; w.x = cvt_pk_bf16(h.x, h.y); w.y = cvt_pk_bf16(h.z, h.w); *(u32x2*)(H1 + (size_t)r * DM + col) = w; }
    }
    __syncthreads();
}

namespace pg8 {
constexpr int BM = 256, BK = 64, HALF = 128, HTB = HALF * BK * 2, STAGE_BYTES = 8 * HTB, NXCD = 8, WGM = 8;
__device__ __forceinline__ int lds_byte(int r, int c) { const int st = (r >> 4) * 2 + (c >> 5), rr = r & 15, cc = c & 31, ob = rr * 64 + cc * 2; return st * 1024 + (ob ^ (((ob >> 9) & 1) << 5)); }
__device__ __forceinline__ void stage_rc(int b, int& R, int& C) { const int st = b / 1024, sb = b % 1024, swz = sb ^ (((sb >> 9) & 1) << 5); R = (st >> 1) * 16 + swz / 64; C = (st & 1) * 32 + (swz % 64) / 2; }
__device__ __forceinline__ int perm32(int rho) { const int n = rho >> 4, i = rho & 15; return 8 * (i >> 2) + 4 * n + (i & 3); }
struct Unit { int pm, pn, e, mt; };
struct StaticOrder {
    int nM, nN, nwg, G, c, K; const bf16_t* Bt;
    __device__ __forceinline__ void init(int M, int N, int K_, const bf16_t* Bt_, int G_, int c_) { nM = M / BM; nN = N / BM; nwg = nM * nN; G = G_; c = c_; K = K_; Bt = Bt_; }
    __device__ __forceinline__ bool next(int i, Unit& u) const {
        const long L = (long)i * G + c; if (L >= nwg) return false;
        int wgid = (int)L; { const int q = nwg / NXCD, r = nwg % NXCD, xcd = wgid % NXCD, off = wgid / NXCD; wgid = (xcd < r ? xcd * (q + 1) : r * (q + 1) + (xcd - r) * q) + off; }
        const int nig = WGM * nN, gid = wgid / nig, fm = gid * WGM, gsz = (nM - fm) < WGM ? (nM - fm) : WGM;
        u.pm = fm + ((wgid % nig) % gsz); u.pn = (wgid % nig) / gsz; u.e = 0; u.mt = 0; return true;
    }
    __device__ __forceinline__ unsigned a_off(const Unit& u, int h, int R) const { return (unsigned)((u.pm * BM + h * HALF + R) * K) * 2u; }
    __device__ __forceinline__ const char* b_base(const Unit& u) const { return (const char*)Bt + (size_t)u.pn * BM * K * 2; }
};
template <bool GATHER> struct MoeOrder {
    const LAS int* tileEM; int ntiles, G, c, K; const int* list; const int* cnt; const bf16_t* Bt;
    __device__ __forceinline__ bool next(int i, Unit& u) const {
        if ((G & 7) == 0) {
            const LAS int* tbase = tileEM + 128; const int x = c & 7, W = G >> 3; int q = (c >> 3) + i * W;
#pragma unroll
            for (int k = 0; k < 4; ++k) { const int e = x + 8 * k; const int tb = tbase[e], nt = tbase[e + 1] - tb; const int nu = nt * 8;
                if (q < nu) { u.e = e; u.pn = q / nt; u.mt = q - u.pn * nt; u.pm = tb + u.mt; return true; }
                q -= nu; }
            return false;
        }
        const int L = i * G + c; if (L >= ntiles * 8) return false;
        const int tile = L >> 3; const int em = tileEM[tile]; u.pm = tile; u.pn = L & 7; u.e = em >> 8; u.mt = em & 255; return true;
    }
    __device__ __forceinline__ unsigned a_off(const Unit& u, int h, int R) const {
        if (GATHER) { const int slot = u.mt * BM + h * HALF + R; const int n = cnt[64 * u.e]; int tok = 0; if (slot < n) tok = list[u.e * NROW + slot]; return (unsigned)(tok * K) * 2u; }
        return (unsigned)((u.pm * BM + h * HALF + R) * K) * 2u;
    }
    __device__ __forceinline__ const char* b_base(const Unit& u) const { return (const char*)Bt + ((size_t)u.e * 2048 + (size_t)u.pn * BM) * K * 2; }
};
struct EpiF32 {
    static constexpr bool PERM = false;
    float* C; int ldc;
    __device__ __forceinline__ void operator()(const f32x4 (&acc)[2][2][4][2], const Unit& u, int wr, int wc, int fr, int fq) const {
        const int row0 = u.pm * BM + wr * 64 + fr, col0 = u.pn * BM + wc * 32 + 4 * fq;
#pragma unroll
        for (int ai = 0; ai < 2; ++ai)
#pragma unroll
            for (int m = 0; m < 4; ++m) { float* rowp = C + (size_t)(row0 + ai * HALF + m * 16) * ldc + col0;
#pragma unroll
                for (int bj = 0; bj < 2; ++bj)
#pragma unroll
                    for (int n = 0; n < 2; ++n) *(f32x4*)(rowp + bj * HALF + n * 16) = acc[ai][bj][m][n]; }
    }
};
template <bool GELU> struct EpiBf {
    static constexpr bool PERM = true;
    bf16_t* O; int ldc; bf16_t* KV;
    __device__ __forceinline__ void operator()(const f32x4 (&acc)[2][2][4][2], const Unit& u, int wr, int wc, int fr, int fq) const {
        const int row0 = u.pm * BM + wr * 64 + fr, col0 = u.pn * BM + wc * 32 + 8 * fq; const bool g = GELU && (u.pn >= 6 && u.pn <= 9);
#pragma unroll
        for (int ai = 0; ai < 2; ++ai)
#pragma unroll
            for (int m = 0; m < 4; ++m) { bf16_t* rowp = (GELU && u.pn >= 14) ? KV + (size_t)(row0 + ai * HALF + m * 16) * 512 + (col0 - 14 * BM) : O + (size_t)(row0 + ai * HALF + m * 16) * ldc + col0;
#pragma unroll
                for (int bj = 0; bj < 2; ++bj) { f32x4 v0 = acc[ai][bj][m][0], v1 = acc[ai][bj][m][1];
                    if (g) {
#pragma unroll
                        for (int j = 0; j < 4; ++j) { v0[j] = gelu_tanh_fast(v0[j]); v1[j] = gelu_tanh_fast(v1[j]); } }
                    u32x4 w; w.x = cvt_pk_bf16(v0[0], v0[1]); w.y = cvt_pk_bf16(v0[2], v0[3]); w.z = cvt_pk_bf16(v1[0], v1[1]); w.w = cvt_pk_bf16(v1[2], v1[3]);
                    *(u32x4*)(rowp + bj * HALF) = w;
                    if (GELU && u.pm == SEQ / BM && u.pn >= 2 && u.pn <= 5)
                        *(u32x4*)(KV + (size_t)(WS_CKV - WS_KV) / 2 + (size_t)((((u.pn - 2) & 1) * 2 + bj) * 256 + (wr * 64 + fr + ai * HALF + m * 16)) * 512 + (u.pn >= 4 ? 256 : 0) + wc * 32 + 8 * fq) = w; } }
    }
};
struct EpiSwiGLU {
    static constexpr bool PERM = true;
    bf16_t* O;
    __device__ __forceinline__ void operator()(const f32x4 (&acc)[2][2][4][2], const Unit& u, int wr, int wc, int fr, int fq) const {
        const int row0 = u.pm * BM + wr * 64 + fr, col0 = u.pn * HALF + wc * 32 + 8 * fq;
#pragma unroll
        for (int ai = 0; ai < 2; ++ai)
#pragma unroll
            for (int m = 0; m < 4; ++m) { bf16_t* rowp = O + (size_t)(row0 + ai * HALF + m * 16) * DEXP + col0;
                f32x4 v0, v1;
#pragma unroll
                for (int j = 0; j < 4; ++j) { v0[j] = silu_fast(acc[ai][0][m][0][j]) * acc[ai][1][m][0][j]; v1[j] = silu_fast(acc[ai][0][m][1][j]) * acc[ai][1][m][1][j]; }
                u32x4 w; w.x = cvt_pk_bf16(v0[0], v0[1]); w.y = cvt_pk_bf16(v0[2], v0[3]); w.z = cvt_pk_bf16(v1[0], v1[1]); w.w = cvt_pk_bf16(v1[2], v1[3]);
                *(u32x4*)rowp = w; }
    }
};

template <class Epi, class Sched>
__device__ __forceinline__ void gemm_phase(LAS unsigned char* lds, int tid, const bf16_t* Amat, int K, const Sched& S, const Epi& E) {
    const int wid = __builtin_amdgcn_readfirstlane(tid >> 6), lane = tid & 63, wr = wid >> 2, wc = wid & 3, fr = lane & 15, fq = lane >> 4;
    const int nt = K / BK;
    int Rl[2], Cl[2]; unsigned voffB[2];
#pragma unroll
    for (int i = 0; i < 2; ++i) { int R, C; stage_rc(tid * 16 + i * 8192, R, C); Rl[i] = R; Cl[i] = C; const int Rb = Epi::PERM ? ((R & ~31) + perm32(R & 31)) : R; voffB[i] = (unsigned)(Rb * K + C) * 2u; }
    const size_t kstep = (size_t)(BK * 2);
    const size_t hstep = (size_t)HALF * K * 2;
    const unsigned ldsw = (unsigned)wid * 1024u;
    const int aoff = lds_byte(wr * 64 + fr, fq * 8), boff = lds_byte(wc * 32 + fr, fq * 8);
    const char* Ab = (const char*)Amat;
#define PG8_SA(b, h) (((b) * 2 + (h)) * HTB)
#define PG8_SB(b, h) ((4 + (b) * 2 + (h)) * HTB)
#define PG8_STAGE(bufoff, gbase, voff) do { _Pragma("unroll") for (int _i = 0; _i < 2; ++_i) \
        __builtin_amdgcn_global_load_lds((const unsigned*)((const char*)(gbase) + (voff)[_i]), (LAS unsigned*)(lds + (bufoff) + ldsw + _i * 8192), 16, 0, 0); } while (0)
#define PG8_LDA(dst, b, h) do { _Pragma("unroll") for (int m = 0; m < 4; ++m) _Pragma("unroll") for (int k = 0; k < 2; ++k) dst[m][k] = *(const LAS bf16x8*)(lds + PG8_SA(b, h) + aoff + m * 2048 + k * 1024); } while (0)
#define PG8_LDB(dst, b, h) do { _Pragma("unroll") for (int n = 0; n < 2; ++n) _Pragma("unroll") for (int k = 0; k < 2; ++k) dst[n][k] = *(const LAS bf16x8*)(lds + PG8_SB(b, h) + boff + n * 2048 + k * 1024); } while (0)
#define PG8_MMA(ai, bj, At, Bt) do { __builtin_amdgcn_s_setprio(1); _Pragma("unroll") for (int m = 0; m < 4; ++m) _Pragma("unroll") for (int n = 0; n < 2; ++n) _Pragma("unroll") for (int k = 0; k < 2; ++k) \
        acc[ai][bj][m][n] = __builtin_amdgcn_mfma_f32_16x16x32_bf16(Bt[n][k], At[m][k], acc[ai][bj][m][n], 0, 0, 0); __builtin_amdgcn_s_setprio(0); } while (0)
#define PG8_WAIT_V(n) asm volatile("s_waitcnt vmcnt(" #n ")" ::: "memory")
#define PG8_WAIT_L(n) asm volatile("s_waitcnt lgkmcnt(" #n ")" ::: "memory")
#define PG8_BAR __builtin_amdgcn_s_barrier()
#define PG8_SCHED __builtin_amdgcn_sched_barrier(0)
#define PG8_AOFFS(dst, u) do { _Pragma("unroll") for (int _h = 0; _h < 2; ++_h) _Pragma("unroll") for (int _i = 0; _i < 2; ++_i) dst[_h][_i] = S.a_off(u, _h, Rl[_i]) + (unsigned)Cl[_i] * 2u; \
        asm volatile("" : "+v"(dst[0][0]), "+v"(dst[0][1]), "+v"(dst[1][0]), "+v"(dst[1][1])); } while (0)
    Unit cur, nxt; int ui = 0;
    if (!S.next(0, cur)) return;
    f32x4 acc[2][2][4][2];
#pragma unroll
    for (int a = 0; a < 2; ++a)
#pragma unroll
        for (int b = 0; b < 2; ++b)
#pragma unroll
            for (int m = 0; m < 4; ++m)
#pragma unroll
                for (int n = 0; n < 2; ++n) acc[a][b][m][n] = (f32x4){0.f, 0.f, 0.f, 0.f};
    bf16x8 At[4][2], B0[2][2], B1[2][2];
    unsigned vA[2][2], vAn[2][2];
    PG8_AOFFS(vA, cur);
    const char* cB = S.b_base(cur);
    PG8_STAGE(PG8_SB(0, 0), cB, voffB); PG8_STAGE(PG8_SA(0, 0), Ab, vA[0]); PG8_STAGE(PG8_SB(0, 1), cB + hstep, voffB); PG8_STAGE(PG8_SA(0, 1), Ab, vA[1]);
    if (wr == 1) PG8_BAR;
    PG8_WAIT_V(4); PG8_BAR;
    PG8_STAGE(PG8_SB(1, 0), cB + kstep, voffB); PG8_STAGE(PG8_SA(1, 0), Ab + kstep, vA[0]); PG8_STAGE(PG8_SB(1, 1), cB + hstep + kstep, voffB);
    PG8_WAIT_V(6); PG8_BAR;
    for (;;) {
        const bool has_next = S.next(ui + 1, nxt);
        const char* nB = cB;
        if (has_next) { PG8_AOFFS(vAn, nxt); nB = S.b_base(nxt); }
        else {
#pragma unroll
            for (int h = 0; h < 2; ++h)
#pragma unroll
                for (int i = 0; i < 2; ++i) vAn[h][i] = vA[h][i]; }
        for (int t = 0; t < nt; t += 2) {
            const bool last = (t == nt - 2);
            const char* a1 = Ab + (size_t)(t + 1) * kstep;
            const char* a2 = last ? Ab : Ab + (size_t)(t + 2) * kstep; const char* b2 = last ? nB : cB + (size_t)(t + 2) * kstep;
            const char* a3 = a2 + kstep; const char* b3 = b2 + kstep;
            unsigned o2[2][2];
#pragma unroll
            for (int h = 0; h < 2; ++h)
#pragma unroll
                for (int i = 0; i < 2; ++i) o2[h][i] = last ? vAn[h][i] : vA[h][i];
            PG8_LDB(B0, 0, 0); PG8_SCHED; PG8_LDA(At, 0, 0); PG8_STAGE(PG8_SA(1, 1), a1, vA[1]);
            PG8_WAIT_L(8); PG8_BAR; PG8_WAIT_L(0); PG8_MMA(0, 0, At, B0); PG8_BAR; PG8_SCHED;
            PG8_LDB(B1, 0, 1); PG8_STAGE(PG8_SB(0, 0), b2, voffB);
            PG8_BAR; PG8_WAIT_L(0); PG8_MMA(0, 1, At, B1); PG8_BAR;
            PG8_LDA(At, 0, 1); PG8_STAGE(PG8_SA(0, 0), a2, o2[0]);
            PG8_BAR; PG8_WAIT_L(0); PG8_MMA(1, 0, At, B0); PG8_BAR; PG8_SCHED;
            PG8_STAGE(PG8_SB(0, 1), b2 + hstep, voffB);
            PG8_WAIT_V(6); PG8_BAR; PG8_MMA(1, 1, At, B1); PG8_BAR;
            PG8_LDB(B0, 1, 0); PG8_SCHED; PG8_LDA(At, 1, 0); PG8_STAGE(PG8_SA(0, 1), a2, o2[1]);
            PG8_WAIT_L(8); PG8_BAR; PG8_WAIT_L(0); PG8_MMA(0, 0, At, B0); PG8_BAR; PG8_SCHED;
            PG8_LDB(B1, 1, 1); PG8_STAGE(PG8_SB(1, 0), b3, voffB);
            PG8_BAR; PG8_WAIT_L(0); PG8_MMA(0, 1, At, B1); PG8_BAR;
            PG8_LDA(At, 1, 1); PG8_STAGE(PG8_SA(1, 0), a3, o2[0]);
            PG8_BAR; PG8_WAIT_L(0); PG8_MMA(1, 0, At, B0); PG8_BAR; PG8_SCHED;
            PG8_STAGE(PG8_SB(1, 1), b3 + hstep, voffB);
            PG8_WAIT_V(6); PG8_BAR; PG8_MMA(1, 1, At, B1); PG8_BAR;
        }
        E(acc, cur, wr, wc, fr, fq);
        if (!has_next) break;
#pragma unroll
        for (int a = 0; a < 2; ++a)
#pragma unroll
            for (int b = 0; b < 2; ++b)
#pragma unroll
                for (int m = 0; m < 4; ++m)
#pragma unroll
                    for (int n = 0; n < 2; ++n) acc[a][b][m][n] = (f32x4){0.f, 0.f, 0.f, 0.f};
        cur = nxt; cB = nB; ++ui;
#pragma unroll
        for (int h = 0; h < 2; ++h)
#pragma unroll
            for (int i = 0; i < 2; ++i) vA[h][i] = vAn[h][i];
    }
    PG8_WAIT_V(0);
    if (wr == 0) PG8_BAR;
    PG8_BAR;
#undef PG8_SA
#undef PG8_SB
#undef PG8_STAGE
#undef PG8_LDA
#undef PG8_LDB
#undef PG8_MMA
#undef PG8_WAIT_V
#undef PG8_WAIT_L
#undef PG8_BAR
#undef PG8_SCHED
#undef PG8_AOFFS
}
}

__device__ __forceinline__ void p_rmsrope(const Frame& F, int l, int nrows, int wg0) {
    const int gw = (F.bid - wg0) * NWAVES + F.wave, NGW = (F.G - wg0) * NWAVES;
    bf16_t* P = (bf16_t*)(F.ws + WS_PROJ);
    const float* R = (const float*)(F.ws + WS_ROPE);
    const int i = F.lane & 31, ax = F.lane >> 5, d1 = ax * 64 + i, d2 = d1 + 32;
    const float gq1 = F.in[IN_QNG][l * 128 + d1], gq2 = F.in[IN_QNG][l * 128 + d2], gk1 = F.in[IN_KNG][l * 128 + d1], gk2 = F.in[IN_KNG][l * 128 + d2];
    for (int r = gw; r < nrows; r += NGW) {
        float cs = 1.f, sn = 0.f;
        if (r < SEQ) { const int pos = ax == 0 ? (r >> 6) : (r & 63); cs = R[2 * (pos * 32 + i)]; sn = R[2 * (pos * 32 + i) + 1]; }
#pragma unroll
        for (int hh = 0; hh < 10; ++hh) {
            bf16_t* p = P + (size_t)r * INW + (hh < 8 ? 2560 + hh * 128 : 3584 + (hh - 8) * 128);
            float x1 = bf2f(p[d1]), x2 = bf2f(p[d2]);
            const float ss = wave_sum(x1 * x1 + x2 * x2);
            const float rinv = 1.0f / sqrtf(ss * (1.0f / 128.0f) + LN_EPS);
            x1 = x1 * rinv * (hh < 8 ? gq1 : gk1); x2 = x2 * rinv * (hh < 8 ? gq2 : gk2);
            p[d1] = f2bf(x1 * cs - x2 * sn); p[d2] = f2bf(x2 * cs + x1 * sn);
        }
    }
}

__device__ __forceinline__ void rms_rope_tile(const Frame& F, int l, int row0, int pn) {
    bf16_t* P = (bf16_t*)(F.ws + WS_PROJ);
    const float* R = (const float*)(F.ws + WS_ROPE);
    const float* gn = F.in[pn < 14 ? IN_QNG : IN_KNG] + l * 128;
    const int q = F.lane & 3;
    float gv[32];
#pragma unroll
    for (int c = 0; c < 4; ++c) { const f32x4 a = *(const f32x4*)(gn + 32 * c + 8 * q), b2 = *(const f32x4*)(gn + 32 * c + 8 * q + 4);
        gv[8 * c] = a.x; gv[8 * c + 1] = a.y; gv[8 * c + 2] = a.z; gv[8 * c + 3] = a.w; gv[8 * c + 4] = b2.x; gv[8 * c + 5] = b2.y; gv[8 * c + 6] = b2.z; gv[8 * c + 7] = b2.w; }
#pragma unroll 1
    for (int it = 0; it < 4; ++it) {
        const int pr = it * 128 + F.wave * 16 + (F.lane >> 2);
        const int row = row0 + (pr >> 1);
        bf16_t* p = (pn == 14) ? (bf16_t*)(F.ws + WS_KV) + (size_t)row * 512 + (pr & 1) * 128 + 8 * q : P + (size_t)row * INW + pn * 256 + (pr & 1) * 128 + 8 * q;
        float x[32]; float ss = 0.f;
#pragma unroll
        for (int c = 0; c < 4; ++c) { const u32x4 r = *(const u32x4*)(p + 32 * c);
#pragma unroll
            for (int e = 0; e < 4; ++e) { x[8 * c + 2 * e] = bf2f((bf16_t)(r[e] & 0xffffu)); x[8 * c + 2 * e + 1] = bf2f((bf16_t)(r[e] >> 16)); } }
#pragma unroll
        for (int t = 0; t < 32; ++t) ss += x[t] * x[t];
        ss = quad_sum(ss);
        const float rinv = 1.0f / sqrtf(ss * (1.0f / 128.0f) + LN_EPS);
#pragma unroll
        for (int t = 0; t < 32; ++t) x[t] = x[t] * rinv * gv[t];
        if (row < SEQ) {
#pragma unroll
            for (int ax = 0; ax < 2; ++ax) { const int pos = ax == 0 ? (row >> 6) : (row & 63); const float* cs = R + 2 * (pos * 32 + 8 * q);
#pragma unroll
                for (int t4 = 0; t4 < 4; ++t4) { const f32x4 w = *(const f32x4*)(cs + 4 * t4);
#pragma unroll
                    for (int e = 0; e < 2; ++e) { const int t = 2 * t4 + e; const float c0 = e ? w.z : w.x, s0 = e ? w.w : w.y;
                        const float x1 = x[16 * ax + t], x2 = x[16 * ax + 8 + t]; x[16 * ax + t] = x1 * c0 - x2 * s0; x[16 * ax + 8 + t] = x2 * c0 + x1 * s0; } } }
        }
#pragma unroll
        for (int c = 0; c < 4; ++c) { u32x4 o;
#pragma unroll
            for (int e = 0; e < 4; ++e) o[e] = cvt_pk_bf16(x[8 * c + 2 * e], x[8 * c + 2 * e + 1]);
            *(u32x4*)(p + 32 * c) = o; }
    }
}

namespace att {
constexpr int D = 128, NW = 8, QBLK = 32, KVBLK = 64;
constexpr float SCALE = 0.088388347648318440f;
constexpr float THR = 8.f;
constexpr int LDQ = INW, LDO = DM;
constexpr size_t SHM_V = KVBLK * D * 2, SHM_K = KVBLK * D * 2, SHM_ATTN = 2 * SHM_V + 2 * SHM_K + NW * 64 * 4;
#define KSWZ(row, colB) ((row) * 256 + ((colB) ^ (((row) & 7) << 4)))
#define SBAR() __builtin_amdgcn_sched_barrier(0)
__device__ __forceinline__ int crow(int r, int hi) { return (r & 3) + 8 * (r >> 2) + 4 * hi; }
__device__ __forceinline__ unsigned cvtpk(float lo, float hi) { return cvt_pk_bf16(lo, hi); }
__device__ __forceinline__ void partialSM(f32x16& p0, f32x16& p1, float& m_reg, float& mn, float& alpha) {
  constexpr float C = SCALE * 1.4426950408889634f;
  float pmax = p0[0];
#pragma unroll
  for (int r = 1; r < 16; ++r) pmax = fmaxf(pmax, p0[r]);
#pragma unroll
  for (int r = 0; r < 16; ++r) pmax = fmaxf(pmax, p1[r]);
  { auto rr = __builtin_amdgcn_permlane32_swap(__float_as_uint(pmax), __float_as_uint(pmax), false, false);
    pmax = fmaxf(__uint_as_float(rr[0]), __uint_as_float(rr[1])); }
  if (__builtin_expect(__all(pmax - m_reg <= THR / SCALE), 1)) { mn = m_reg; alpha = 1.f; }
  else { mn = fmaxf(m_reg, pmax); alpha = __builtin_amdgcn_exp2f((m_reg - mn) * C); m_reg = mn; }
  float mnC = -mn * C;
#pragma unroll
  for (int r = 0; r < 16; ++r) p0[r] = fmaf(p0[r], C, mnC);
#pragma unroll
  for (int r = 0; r < 16; ++r) p1[r] = fmaf(p1[r], C, mnC);
#pragma unroll
  for (int r = 0; r < 16; ++r) p0[r] = __builtin_amdgcn_exp2f(p0[r]);
}
struct SMreg { float a[16], b[16]; };
__device__ __forceinline__ void finishSM(SMreg& e, float alpha, float& l_reg, bf16x8& pa0, bf16x8& pa1, bf16x8& pa2, bf16x8& pa3) {
#pragma unroll
  for (int r = 0; r < 16; ++r) e.b[r] = __builtin_amdgcn_exp2f(e.b[r]);
  float ps = 0;
#pragma unroll
  for (int r = 0; r < 16; ++r) ps += e.a[r];
#pragma unroll
  for (int r = 0; r < 16; ++r) ps += e.b[r];
  { auto rr = __builtin_amdgcn_permlane32_swap(__float_as_uint(ps), __float_as_uint(ps), false, false);
    ps = __uint_as_float(rr[0]) + __uint_as_float(rr[1]); }
  l_reg = l_reg * alpha + ps;
#define PK4(P, BASE, OUT) do { unsigned a0 = cvtpk(P[BASE + 0], P[BASE + 1]), a1 = cvtpk(P[BASE + 2], P[BASE + 3]);   \
    unsigned b0 = cvtpk(P[BASE + 4], P[BASE + 5]), b1 = cvtpk(P[BASE + 6], P[BASE + 7]);                              \
    auto r0 = __builtin_amdgcn_permlane32_swap(a0, b0, false, false); auto r1 = __builtin_amdgcn_permlane32_swap(a1, b1, false, false); \
    u32x4 w = {r0[0], r1[0], r0[1], r1[1]}; OUT = *reinterpret_cast<bf16x8*>(&w); } while (0)
  PK4(e.a, 0, pa0); PK4(e.a, 8, pa1); PK4(e.b, 0, pa2); PK4(e.b, 8, pa3);
#undef PK4
}
__device__ __forceinline__ void sm_copy(SMreg& e, const f32x16& p0, const f32x16& p1) {
#pragma unroll
  for (int r = 0; r < 16; ++r) { e.a[r] = p0[r]; e.b[r] = p1[r]; }
}
__device__ __forceinline__ void qkt(f32x16& p0, f32x16& p1, const bf16_t* Ks, const bf16x8* qr, int r32, int hi) {
  p0 = f32x16{}; p1 = f32x16{};
#pragma unroll
  for (int d0 = 0; d0 < 8; ++d0) { int cb = (d0 * 16 + hi * 8) * 2;
    bf16x8 b0 = *reinterpret_cast<const bf16x8*>((const char*)Ks + KSWZ(r32, cb));
    bf16x8 b1 = *reinterpret_cast<const bf16x8*>((const char*)Ks + KSWZ(32 + r32, cb));
    p0 = __builtin_amdgcn_mfma_f32_32x32x16_bf16(b0, qr[d0], p0, 0, 0, 0);
    p1 = __builtin_amdgcn_mfma_f32_32x32x16_bf16(b1, qr[d0], p1, 0, 0, 0); }
}
__device__ __forceinline__ int v_st(int k, int c) { const int kk = (k & ~0xC) | ((k & 4) << 1) | ((k & 8) >> 1); return ((kk >> 3) * 4 + (c >> 5)) * 512 + ((kk & 7) * 32 + (c & 31)) * 2; }
__device__ __forceinline__ int v_rd_base(int lane) { return ((lane & 3) << 3) | (((lane >> 2) & 3) << 6) | (((lane >> 4) & 1) << 5) | (((lane >> 5) & 1) << 8); }
constexpr int v_rd_off(int d0, int ks, int half) { return d0 * 512 + ks * 4096 + half * 2048; }
template <int OFF> __device__ __forceinline__ s16x4 tr_read(int vb) {
  s16x4 r; asm volatile("ds_read_b64_tr_b16 %0, %1 offset:%2" : "=&v"(r) : "v"(vb), "i"(OFF) : "memory"); return r;
}
template <int D0> __device__ __forceinline__ void pv_one(f32x16& od, int vb, bf16x8 pa0, bf16x8 pa1, bf16x8 pa2, bf16x8 pa3) {
  const s16x4 l0 = tr_read<v_rd_off(D0, 0, 0)>(vb), h0 = tr_read<v_rd_off(D0, 0, 1)>(vb), l1 = tr_read<v_rd_off(D0, 1, 0)>(vb), h1 = tr_read<v_rd_off(D0, 1, 1)>(vb);
  const s16x4 l2 = tr_read<v_rd_off(D0, 2, 0)>(vb), h2 = tr_read<v_rd_off(D0, 2, 1)>(vb), l3 = tr_read<v_rd_off(D0, 3, 0)>(vb), h3 = tr_read<v_rd_off(D0, 3, 1)>(vb);
  asm volatile("s_waitcnt lgkmcnt(0)" ::: "memory"); SBAR();
#define PK(L, H) (bf16x8){L[0], L[1], L[2], L[3], H[0], H[1], H[2], H[3]}
  od = __builtin_amdgcn_mfma_f32_32x32x16_bf16(pa0, PK(l0, h0), od, 0, 0, 0);
  od = __builtin_amdgcn_mfma_f32_32x32x16_bf16(pa1, PK(l1, h1), od, 0, 0, 0);
  od = __builtin_amdgcn_mfma_f32_32x32x16_bf16(pa2, PK(l2, h2), od, 0, 0, 0);
  od = __builtin_amdgcn_mfma_f32_32x32x16_bf16(pa3, PK(l3, h3), od, 0, 0, 0);
#undef PK
}
__device__ __forceinline__ void pv_d0(f32x16* o, int vb, bf16x8 pa0, bf16x8 pa1, bf16x8 pa2, bf16x8 pa3) {
  pv_one<0>(o[0], vb, pa0, pa1, pa2, pa3); pv_one<1>(o[1], vb, pa0, pa1, pa2, pa3); pv_one<2>(o[2], vb, pa0, pa1, pa2, pa3); pv_one<3>(o[3], vb, pa0, pa1, pa2, pa3);
}
__device__ __forceinline__ void pv_sm(f32x16* o, int vb, bf16x8 pa0, bf16x8 pa1, bf16x8 pa2, bf16x8 pa3, const f32x16& p0, const f32x16& p1, SMreg& e, float& m_reg, float& alpha) {
  constexpr float C = SCALE * 1.4426950408889634f;
#define PK(L, H) (bf16x8){L[0], L[1], L[2], L[3], H[0], H[1], H[2], H[3]}
#define RD(D, n) const s16x4 a##n = tr_read<v_rd_off(D, 0, 0)>(vb), b##n = tr_read<v_rd_off(D, 0, 1)>(vb), c##n = tr_read<v_rd_off(D, 1, 0)>(vb), d##n = tr_read<v_rd_off(D, 1, 1)>(vb), \
                             e##n = tr_read<v_rd_off(D, 2, 0)>(vb), f##n = tr_read<v_rd_off(D, 2, 1)>(vb), g##n = tr_read<v_rd_off(D, 3, 0)>(vb), h##n = tr_read<v_rd_off(D, 3, 1)>(vb)
#define MM(od, n) do { od = __builtin_amdgcn_mfma_f32_32x32x16_bf16(pa0, PK(a##n, b##n), od, 0, 0, 0); od = __builtin_amdgcn_mfma_f32_32x32x16_bf16(pa1, PK(c##n, d##n), od, 0, 0, 0); \
                       od = __builtin_amdgcn_mfma_f32_32x32x16_bf16(pa2, PK(e##n, f##n), od, 0, 0, 0); od = __builtin_amdgcn_mfma_f32_32x32x16_bf16(pa3, PK(g##n, h##n), od, 0, 0, 0); } while (0)
#define SB6() __builtin_amdgcn_sched_barrier(0x406)
#define GRP(od, n, D, m) od = __builtin_amdgcn_mfma_f32_32x32x16_bf16(pa0, PK(a##n, b##n), od, 0, 0, 0); const s16x4 a##m = tr_read<v_rd_off(D, 0, 0)>(vb), b##m = tr_read<v_rd_off(D, 0, 1)>(vb); SB6(); \
                         od = __builtin_amdgcn_mfma_f32_32x32x16_bf16(pa1, PK(c##n, d##n), od, 0, 0, 0); const s16x4 c##m = tr_read<v_rd_off(D, 1, 0)>(vb), d##m = tr_read<v_rd_off(D, 1, 1)>(vb); SB6(); \
                         od = __builtin_amdgcn_mfma_f32_32x32x16_bf16(pa2, PK(e##n, f##n), od, 0, 0, 0); const s16x4 e##m = tr_read<v_rd_off(D, 2, 0)>(vb), f##m = tr_read<v_rd_off(D, 2, 1)>(vb); SB6(); \
                         od = __builtin_amdgcn_mfma_f32_32x32x16_bf16(pa3, PK(g##n, h##n), od, 0, 0, 0); const s16x4 g##m = tr_read<v_rd_off(D, 3, 0)>(vb), h##m = tr_read<v_rd_off(D, 3, 1)>(vb)
#define LW() do { asm volatile("s_waitcnt lgkmcnt(0)" ::: "memory"); SBAR(); } while (0)
#define PIN(x) asm volatile("" : "+v"(x))
  RD(0, 0); LW();
  GRP(o[0], 0, 1, 1);
  float pmax = p0[0];
#pragma unroll
  for (int r = 1; r < 16; ++r) pmax = fmaxf(pmax, p0[r]);
#pragma unroll
  for (int r = 0; r < 16; ++r) pmax = fmaxf(pmax, p1[r]);
  { auto rr = __builtin_amdgcn_permlane32_swap(__float_as_uint(pmax), __float_as_uint(pmax), false, false);
    pmax = fmaxf(__uint_as_float(rr[0]), __uint_as_float(rr[1])); }
  const bool ok = __all(pmax - m_reg <= THR / SCALE);
  const float mn = ok ? m_reg : fmaxf(m_reg, pmax); alpha = __builtin_amdgcn_exp2f((m_reg - mn) * C); m_reg = mn;
  float mnC = -mn * C; PIN(mnC);
  LW();
  GRP(o[1], 1, 2, 2);
#pragma unroll
  for (int r = 0; r < 16; ++r) { float a = fmaf(p0[r], C, mnC), b = fmaf(p1[r], C, mnC); if (r < 2) a = __builtin_amdgcn_exp2f(a); PIN(a); PIN(b); e.a[r] = a; e.b[r] = b; }
  LW();
  GRP(o[2], 2, 3, 3);
#pragma unroll
  for (int r = 2; r < 9; ++r) { float a = __builtin_amdgcn_exp2f(e.a[r]); PIN(a); e.a[r] = a; }
  LW();
  MM(o[3], 3);
#pragma unroll
  for (int r = 9; r < 16; ++r) { float a = __builtin_amdgcn_exp2f(e.a[r]); PIN(a); e.a[r] = a; }
#undef PK
#undef RD
#undef MM
#undef GRP
#undef SB6
#undef LW
#undef PIN
}
struct MapLinear { long base; __device__ __forceinline__ long operator()(int t) const { return base + (long)t * KVBLK; } };
struct MapNA { int rs0; __device__ __forceinline__ long operator()(int t) const { return t < 4 ? (long)SEQ + t * 64 : (long)(rs0 + t - 4) * 64; } };
struct HookNone { __device__ __forceinline__ void operator()(f32x16&, f32x16&, int, int) const {} };
struct HookNA {
  const LAS float* bias; int qr, rs, rs0, cbase  , bbase  ;
  __device__ __forceinline__ void operator()(f32x16& p0, f32x16& p1, int tile, int hi) const {
    if (tile < 4) return;
    const int kr = rs0 + tile - 4; const bool rowok = (kr >= rs) && (kr <= rs + 7);
    int drow = kr - qr + 7; drow = drow < 0 ? 0 : (drow > 14 ? 14 : drow);
    const float ninf = -__builtin_inff();
    const LAS float* bp = bias + drow * 31 + bbase;
#pragma unroll
    for (int r = 0; r < 16; ++r) {
      const int kc = (r & 3) + 8 * (r >> 2);
      const bool ok0 = rowok && (unsigned)(kc + cbase) <= 15u, ok1 = rowok && (unsigned)(kc + 32 + cbase) <= 15u;
      p0[r] = ok0 ? p0[r] + bp[kc] : ninf; p1[r] = ok1 ? p1[r] + bp[kc + 32] : ninf;
    }
  }
};
template <int SDEPTH, int LDK, class Map, class Hook>
__device__ __forceinline__ void attn_body(const bf16_t* __restrict__ Qb, const bf16_t* __restrict__ Kh, const bf16_t* __restrict__ Vh,
                                          bf16_t* __restrict__ Ob, int NT, const Map map, const Hook hook, char* lds, int tid) {
  const int wid = tid >> 6, lane = tid & 63, r32 = lane & 31, hi = lane >> 5;
  bf16_t* V_lds = (bf16_t*)lds; bf16_t* K_lds = (bf16_t*)(lds + 2 * SHM_V);
  float* ws = (float*)(lds + 2 * SHM_V + 2 * SHM_K) + wid * 64; float* li_l = ws; float* al_l = ws + 32;
  float m_reg = -1e30f, l_reg = 0; f32x16 o[4] = {}; bf16x8 qr[8];
  const bf16_t* Qw = Qb + (long)(wid * QBLK + r32) * LDQ + hi * 8;
#pragma unroll
  for (int d0 = 0; d0 < 8; ++d0) qr[d0] = *reinterpret_cast<const bf16x8*>(Qw + d0 * 16);
  const int sr = tid >> 4;
  const unsigned kq = (unsigned)(sr * LDK + (((tid & 15) ^ (sr & 7)) * 8)) * 2u;
  const int kk = ((tid >> 7) << 3) | ((tid & 31) >> 2), kv = (kk & ~0xC) | ((kk & 4) << 1) | ((kk & 8) >> 1);
  const unsigned vq = (unsigned)(kv * LDK + ((tid >> 5) & 3) * 32 + (tid & 3) * 8) * 2u;
  LAS char* ldsw = (LAS char*)lds + (unsigned)__builtin_amdgcn_readfirstlane(wid) * 1024u;
  const int vb0 = (int)(uintptr_t)V_lds + v_rd_base(lane);
#define DMA_K(tile, b) do { const char* _g = (const char*)(Kh + map(tile) * LDK);                                                                        \
    __builtin_amdgcn_global_load_lds((const unsigned*)(_g + kq), (LAS unsigned*)(ldsw + 2 * SHM_V + (b) * SHM_K), 16, 0, 0);                              \
    __builtin_amdgcn_global_load_lds((const unsigned*)(_g + kq + 32 * LDK * 2), (LAS unsigned*)(ldsw + 2 * SHM_V + (b) * SHM_K + 8192), 16, 0, 0); } while (0)
#define DMA_V(tile, b) do { const char* _g = (const char*)(Vh + map(tile) * LDK);                                                                        \
    __builtin_amdgcn_global_load_lds((const unsigned*)(_g + vq), (LAS unsigned*)(ldsw + (b) * SHM_V), 16, 0, 0);                                          \
    __builtin_amdgcn_global_load_lds((const unsigned*)(_g + vq + 32 * LDK * 2), (LAS unsigned*)(ldsw + (b) * SHM_V + 8192), 16, 0, 0); } while (0)
#define DWAIT() do { asm volatile("s_waitcnt vmcnt(0)" ::: "memory"); __syncthreads(); } while (0)
#define RESC(a) do { if (__any((a) < 1.f)) { if (hi == 0) al_l[r32] = (a); asm volatile("s_waitcnt lgkmcnt(0)" ::: "memory"); \
    _Pragma("unroll") for (int d = 0; d < 4; ++d) _Pragma("unroll") for (int r = 0; r < 16; ++r) o[d][r] *= al_l[crow(r, hi)]; } } while (0)
  f32x16 pA0, pA1, pB0, pB1; SMreg eA, eB; float mnA, mnB, alA, alB; bf16x8 pa0, pa1, pa2, pa3;
#define PVSM(vbx, P0, P1, E, MN, AL, T) do { if constexpr (SDEPTH == 2) { hook(P0, P1, T, hi); pv_sm(o, vbx, pa0, pa1, pa2, pa3, P0, P1, E, m_reg, AL); }   \
    else { pv_d0(o, vbx, pa0, pa1, pa2, pa3); hook(P0, P1, T, hi); partialSM(P0, P1, m_reg, MN, AL); sm_copy(E, P0, P1); } } while (0)
  bf16_t* K1_lds = (bf16_t*)((char*)K_lds + SHM_K);
  DMA_K(0, 0); DMA_V(0, 0); DMA_K(1, 1); DWAIT();
  qkt(pA0, pA1, K_lds, qr, r32, hi); hook(pA0, pA1, 0, hi); partialSM(pA0, pA1, m_reg, mnA, alA); sm_copy(eA, pA0, pA1);
  __syncthreads();
  if (2 < NT) DMA_K(2, 0);
  DMA_V(1, 1);
  for (int j = 1; j + 1 < NT; j += 2) {
    SBAR(); qkt(pB0, pB1, K1_lds, qr, r32, hi);
    finishSM(eA, alA, l_reg, pa0, pa1, pa2, pa3); SBAR();
    PVSM(vb0, pB0, pB1, eB, mnB, alB, j);
    DWAIT();
    DMA_K(j + 2, 1); DMA_V(j + 1, 0);
    RESC(alB);
    SBAR(); qkt(pA0, pA1, K_lds, qr, r32, hi);
    finishSM(eB, alB, l_reg, pa0, pa1, pa2, pa3); SBAR();
    PVSM(vb0 + (int)SHM_V, pA0, pA1, eA, mnA, alA, j + 1);
    DWAIT();
    if (j + 3 < NT) DMA_K(j + 3, 0);
    DMA_V(j + 2, 1);
    RESC(alA);
  }
  SBAR(); qkt(pB0, pB1, K1_lds, qr, r32, hi);
  finishSM(eA, alA, l_reg, pa0, pa1, pa2, pa3); SBAR();
  PVSM(vb0, pB0, pB1, eB, mnB, alB, NT - 1);
  DWAIT(); RESC(alB);
  finishSM(eB, alB, l_reg, pa0, pa1, pa2, pa3); SBAR();
  pv_d0(o, vb0 + (int)SHM_V, pa0, pa1, pa2, pa3);
  if (hi == 0) li_l[r32] = l_reg; asm volatile("s_waitcnt lgkmcnt(0)" ::: "memory");
  float rli[16];
#pragma unroll
  for (int r = 0; r < 16; ++r) rli[r] = __builtin_amdgcn_rcpf(li_l[crow(r, hi)]);
  bf16_t* Ow = Ob + (long)(wid * QBLK) * LDO;
#pragma unroll
  for (int r = 0; r < 16; ++r) { int orow = crow(r, hi);
#pragma unroll
    for (int d0 = 0; d0 < 4; ++d0) Ow[(long)orow * LDO + d0 * 32 + r32] = f2bf(o[d0][r] * rli[r]); }
  __syncthreads();
#undef DMA_K
#undef DMA_V
#undef DWAIT
#undef RESC
#undef PVSM
}
}

__device__ __forceinline__ void sg_unit(const Frame& F, int l, int c, int g) {
    constexpr int VST = 136;
    LAS bf16_t* vnT = (LAS bf16_t*)F.lds;
    const bf16_t* P = (const bf16_t*)(F.ws + WS_PROJ);
    const int fr = F.lane & 15, fq = F.lane >> 4;
    const float* W = F.in[IN_SGW] + ((size_t)(l * 4 + g) * 128 + 16 * F.wave + fr) * 128 + 8 * fq;
    bf16x8 wf[4];
#pragma unroll
    for (int ks = 0; ks < 4; ++ks) { const f32x4 a = *(const f32x4*)(W + 32 * ks), b2 = *(const f32x4*)(W + 32 * ks + 4);
        u32x4 w; w.x = cvt_pk_bf16(a.x, a.y); w.y = cvt_pk_bf16(a.z, a.w); w.z = cvt_pk_bf16(b2.x, b2.y); w.w = cvt_pk_bf16(b2.z, b2.w); wf[ks] = *reinterpret_cast<bf16x8*>(&w); }
    {
        const int j = 16 * F.wave + (F.lane >> 2), q = F.lane & 3; const size_t p = (size_t)(c * 128 + j);
        const bf16_t* vp = P + p * INW + 2048 + g * 128 + 32 * q;
        float x[32];
#pragma unroll
        for (int t = 0; t < 4; ++t) { const u32x4 r = *(const u32x4*)(vp + 8 * t);
#pragma unroll
            for (int e = 0; e < 4; ++e) { x[8 * t + 2 * e] = bf2f((bf16_t)(r[e] & 0xffffu)); x[8 * t + 2 * e + 1] = bf2f((bf16_t)(r[e] >> 16)); } }
        float sm = 0.f;
#pragma unroll
        for (int t = 0; t < 32; ++t) sm += x[t];
        sm = quad_sum(sm);
        const float mean = sm * (1.0f / 128.0f); float sq = 0.f;
#pragma unroll
        for (int t = 0; t < 32; ++t) { x[t] -= mean; sq += x[t] * x[t]; }
        sq = quad_sum(sq);
        const float rstd = 1.0f / sqrtf(sq * (1.0f / 128.0f) + LN_EPS);
        const float* gp = F.in[IN_SGLNG] + (l * 4 + g) * 128 + 32 * q; const float* bp = F.in[IN_SGLNB] + (l * 4 + g) * 128 + 32 * q;
#pragma unroll
        for (int t = 0; t < 32; ++t) vnT[(32 * q + t) * VST + j] = f2bf(x[t] * rstd * gp[t] + bp[t]);
    }
    __syncthreads();
    bf16_t* MIXp = (bf16_t*)(F.ws + WS_MIX);
    const int i = 16 * F.wave + fr; const size_t pi = (size_t)(c * 128 + i); const float bs = F.in[IN_SGB][(l * 4 + g) * 128 + i];
#pragma unroll
    for (int dt = 0; dt < 8; ++dt) {
        f32x4 acc = {0.f, 0.f, 0.f, 0.f};
#pragma unroll
        for (int ks = 0; ks < 4; ++ks) { const bf16x8 a = *(const LAS bf16x8*)(vnT + (dt * 16 + fr) * VST + 32 * ks + 8 * fq); acc = __builtin_amdgcn_mfma_f32_16x16x32_bf16(a, wf[ks], acc, 0, 0, 0); }
        const int d0 = 16 * dt + 4 * fq; const u32x2 uu = *(const u32x2*)(P + pi * INW + 1536 + g * 128 + d0);
        u32x2 o; o.x = cvt_pk_bf16((acc[0] + bs) * bf2f((bf16_t)(uu.x & 0xffffu)), (acc[1] + bs) * bf2f((bf16_t)(uu.x >> 16)));
        o.y = cvt_pk_bf16((acc[2] + bs) * bf2f((bf16_t)(uu.y & 0xffffu)), (acc[3] + bs) * bf2f((bf16_t)(uu.y >> 16)));
        *(u32x2*)(MIXp + pi * DM + 512 + g * 128 + d0) = o;
    }
    __syncthreads();
}

__device__ __forceinline__ void p_att_dense(const Frame& F, int l) {
    const bf16_t* P = (const bf16_t*)(F.ws + WS_PROJ); bf16_t* MIXp = (bf16_t*)(F.ws + WS_MIX); const bf16_t* KV = (const bf16_t*)(F.ws + WS_KV);
    const int total = 256 + ((l == 0) ? 12 : 0);
    for (int u = F.bid; u < total; u += F.G) {
        int qrow, qcol, ocol, nt; long kbase; const bf16_t* kp;
        if (u < 256) { const int h = u & 7; qrow = (u >> 3) * 256; qcol = 2560 + h * 128; ocol = 1024 + h * 128; nt = NROW / 64; kbase = 0; kp = KV + (h >> 2) * 128; }
        else if (u < 264) { const int h = u - 256; qrow = SEQ; qcol = 2560 + h * 128; ocol = 1024 + h * 128; nt = 4; kbase = SEQ; kp = KV + (h >> 2) * 128; }
        else { const int h = u - 264; qrow = SEQ; qcol = h * 128; ocol = h * 128; nt = 4; kbase = 0; kp = (const bf16_t*)(F.ws + WS_CKV) + (size_t)h * 256 * 512; }
        att::attn_body<2, 512>(P + (size_t)qrow * INW + qcol, kp, kp + 256, MIXp + (size_t)qrow * DM + ocol, nt, att::MapLinear{kbase}, att::HookNone{}, (char*)F.lds, F.tid);
    }
}
__device__ __forceinline__ void p_att_na(const Frame& F, int l) {
    const bf16_t* P = (const bf16_t*)(F.ws + WS_PROJ); bf16_t* MIXp = (bf16_t*)(F.ws + WS_MIX);
    LAS float* bt = (LAS float*)(F.lds + LDS_SC);
    for (int v = F.bid; v < 128; v += F.G) {
        const int h = v & 3, qb = v >> 2, R0 = qb * 4;
        const float* rpb = F.in[IN_RPB] + (size_t)(l * 4 + h) * 15 * 31;
        for (int t = F.tid; t < 640; t += NTHR) { const int q = t - 48; bt[t] = (q >= 0 && q < 15 * 31) ? rpb[q] * (1.0f / att::SCALE) : 0.f; }
        __syncthreads();
        int rs0 = R0 - 4; rs0 = rs0 < 0 ? 0 : (rs0 > 116 ? 116 : rs0);
        const int qr = R0 + (F.wave >> 1), qc = (F.wave & 1) * 32 + (F.lane & 31);
        int rs = qr - 4; rs = rs < 0 ? 0 : (rs > 120 ? 120 : rs);
        int cs = qc - 8; cs = cs < 0 ? 0 : (cs > 48 ? 48 : cs);
        att::attn_body<1, INW>(P + (size_t)(qb * 256) * INW + h * 128, P + 512 + h * 128, P + 1024 + h * 128,
                       MIXp + (size_t)(qb * 256) * DM + h * 128, 16, att::MapNA{rs0}, att::HookNA{bt, qr, rs, rs0, 4 * (F.lane >> 5) - cs, 48 + 15 - qc + 4 * (F.lane >> 5)}, (char*)F.lds, F.tid);
    }
}
__device__ __forceinline__ void p_att_sg(const Frame& F, int l) {
    const int nsg = (l == 0) ? 264 : 256;
    if (F.G >= 256) { for (int v = F.bid - 128; v >= 0 && v < nsg; v += F.G - 128) sg_unit(F, l, v >> 2, v & 3); }
    else { for (int v = F.bid; v < nsg; v += F.G) sg_unit(F, l, v >> 2, v & 3); }
}

#ifdef TSEL_A
#define TSF(F, i) do { if ((F).bid == 0 && (F).tid == 0) __hip_atomic_store((unsigned long long*)((F).ws + WS_CTL + 131072) + (i), (unsigned long long)__builtin_amdgcn_s_memrealtime(), __ATOMIC_RELAXED, __HIP_MEMORY_SCOPE_AGENT); } while (0)
#else
#define TSF(F, i) do { } while (0)
#endif
__device__ __forceinline__ void p_mixln_router(const Frame& F, int l, int nrows) {
    LAS float* plog = (LAS float*)F.lds;
    LAS float* scS = plog + 8 * 48 * 32;
    LAS float* selS = scS + 48 * 32;
    const float* MOD = (const float*)(F.ws + WS_MOD);
    const bf16_t* Y1 = (const bf16_t*)(F.ws + WS_Y1);
    float* XS = (float*)(F.ws + WS_XS);
    bf16_t* H2 = (bf16_t*)(F.ws + WS_H2); bf16_t* H2L = (bf16_t*)(F.ws + WS_H2L);
    const bf16_t* RWH = (const bf16_t*)(F.ws + WS_RWT); const bf16_t* RWL = RWH + 32 * DM;
    const float* RB = F.in[IN_RB];
    const float* lg = F.in[IN_LNMG] + l * DM; const float* lb = F.in[IN_LNMB] + l * DM;
    int* cnt = (int*)(F.ws + WS_CTL) + CW_CNT + l * 2048;
    int* tokE = (int*)(F.ws + WS_TOKE); int* tokP = (int*)(F.ws + WS_TOKP); float* tokG = (float*)(F.ws + WS_TOKG); int* list = (int*)(F.ws + WS_LIST);
    const int rpw = (nrows + F.G - 1) / F.G;
    const int wbeg = F.bid * rpw, wend = (wbeg + rpw < nrows) ? wbeg + rpw : nrows;
    LAS float* prm = (LAS float*)(F.lds + 65536);
    stage_vec(F, prm, lg); stage_vec(F, prm + DM, lb);
    for (int v = 0; v < 2; ++v) { const float* m = MOD + (size_t)(l * 2 + v) * 12288; stage_vec(F, prm + (2 + 3 * v) * DM, m + 2 * DM); stage_vec(F, prm + (3 + 3 * v) * DM, m + 3 * DM); stage_vec(F, prm + (4 + 3 * v) * DM, m + 4 * DM); }
    __syncthreads();
    TSF(F, 30);
    for (int rbeg = wbeg; rbeg < wend; rbeg += 48) {
        const int rend = (rbeg + 48 < wend) ? rbeg + 48 : wend, nr = rend - rbeg;
        f32x4 nx[8]; u32x2 ny[8];
#define P5_LOAD(rr) do { const float* xr_ = xrow_ptr(F, l, (rr)); const bf16_t* yr_ = Y1 + (size_t)(rr) * DM; \
        _Pragma("unroll") for (int j = 0; j < 8; ++j) { const int col = 4 * F.lane + 256 * j; nx[j] = __builtin_nontemporal_load((const f32x4*)(xr_ + col)); ny[j] = __builtin_nontemporal_load((const u32x2*)(yr_ + col)); } } while (0)
        if (rbeg + F.wave < rend) P5_LOAD(rbeg + F.wave);
        for (int r = rbeg + F.wave; r < rend; r += NWAVES) {
            const int v = r >= SEQ; const LAS float* pv = prm + (2 + 3 * v) * DM;
            f32x4 z[8];
#pragma unroll
            for (int j = 0; j < 8; ++j) { const int col = 4 * F.lane + 256 * j; const u32x2 yy = ny[j];
                const f32x4 y = {bf2f((bf16_t)(yy.x & 0xffffu)), bf2f((bf16_t)(yy.x >> 16)), bf2f((bf16_t)(yy.y & 0xffffu)), bf2f((bf16_t)(yy.y >> 16))};
                z[j] = ALPHA * nx[j] + *(const LAS f32x4*)(pv + col) * y; }
            if (r + NWAVES < rend) P5_LOAD(r + NWAVES);
            float mean, rstd; ln_stats(z, mean, rstd);
#pragma unroll
            for (int j = 0; j < 8; ++j) { const int col = 4 * F.lane + 256 * j; z[j] = (z[j] - mean) * rstd * *(const LAS f32x4*)(prm + col) + *(const LAS f32x4*)(prm + DM + col); *(f32x4*)(XS + (size_t)r * DM + col) = z[j]; }
            ln_stats(z, mean, rstd);
#pragma unroll
            for (int j = 0; j < 8; ++j) { const int col = 4 * F.lane + 256 * j; const f32x4 s1 = *(const LAS f32x4*)(pv + 2 * DM + col), s0 = *(const LAS f32x4*)(pv + DM + col);
                const f32x4 h = (z[j] - mean) * rstd * (1.0f + s1) + s0;
                u32x2 hi; hi.x = cvt_pk_bf16(h.x, h.y); hi.y = cvt_pk_bf16(h.z, h.w);
                const f32x4 hf = {bf2f((bf16_t)(hi.x & 0xffffu)), bf2f((bf16_t)(hi.x >> 16)), bf2f((bf16_t)(hi.y & 0xffffu)), bf2f((bf16_t)(hi.y >> 16))};
                const f32x4 d = h - hf; u32x2 lo; lo.x = cvt_pk_bf16(d.x, d.y); lo.y = cvt_pk_bf16(d.z, d.w);
                *(u32x2*)(H2 + (size_t)r * DM + col) = hi; *(u32x2*)(H2L + (size_t)r * DM + col) = lo; }
        }
#undef P5_LOAD
        asm volatile("s_waitcnt vmcnt(0)" ::: "memory");
        __syncthreads();
        TSF(F, 31);
        const int ntile = (nr + 15) >> 4; constexpr int nsl = 8;
        {
            const int fr = F.lane & 15, fq = F.lane >> 4, kb = F.wave * 256 + fq * 8;
            const bf16_t* bh = RWH + (size_t)fr * DM + kb; const bf16_t* bl = RWL + (size_t)fr * DM + kb;
            const bf16_t* ah[3]; const bf16_t* al[3];
#pragma unroll
            for (int t = 0; t < 3; ++t) { int row = rbeg + t * 16 + fr; row = row < rend ? row : rend - 1; ah[t] = H2 + (size_t)row * DM + kb; al[t] = H2L + (size_t)row * DM + kb; }
            f32x4 acc[3][2];
#pragma unroll
            for (int t = 0; t < 3; ++t) { acc[t][0] = (f32x4){0.f, 0.f, 0.f, 0.f}; acc[t][1] = (f32x4){0.f, 0.f, 0.f, 0.f}; }
#pragma unroll 2
            for (int ks = 0; ks < 8; ++ks) { const int off = ks * 32;
                const bf16x8 b_h0 = *(const bf16x8*)(bh + off), b_l0 = *(const bf16x8*)(bl + off), b_h1 = *(const bf16x8*)(bh + 16 * DM + off), b_l1 = *(const bf16x8*)(bl + 16 * DM + off);
#pragma unroll
                for (int t = 0; t < 3; ++t) if (t < ntile) {
                    const bf16x8 a_h = *(const bf16x8*)(ah[t] + off), a_l = *(const bf16x8*)(al[t] + off);
                    acc[t][0] = __builtin_amdgcn_mfma_f32_16x16x32_bf16(a_h, b_h0, acc[t][0], 0, 0, 0); acc[t][0] = __builtin_amdgcn_mfma_f32_16x16x32_bf16(a_h, b_l0, acc[t][0], 0, 0, 0); acc[t][0] = __builtin_amdgcn_mfma_f32_16x16x32_bf16(a_l, b_h0, acc[t][0], 0, 0, 0);
                    acc[t][1] = __builtin_amdgcn_mfma_f32_16x16x32_bf16(a_h, b_h1, acc[t][1], 0, 0, 0); acc[t][1] = __builtin_amdgcn_mfma_f32_16x16x32_bf16(a_h, b_l1, acc[t][1], 0, 0, 0); acc[t][1] = __builtin_amdgcn_mfma_f32_16x16x32_bf16(a_l, b_h1, acc[t][1], 0, 0, 0); } }
#pragma unroll
            for (int t = 0; t < 3; ++t) if (t < ntile) {
#pragma unroll
                for (int q = 0; q < 4; ++q) { LAS float* pr = plog + (F.wave * 48 + t * 16 + 4 * fq + q) * 32; pr[fr] = acc[t][0][q]; pr[16 + fr] = acc[t][1][q]; } }
        }
        __syncthreads();
        TSF(F, 32);
        for (int t = F.tid; t < nr * 32; t += NTHR) { const int e = t & 31; float lg2 = 0.f; for (int q = 0; q < nsl; ++q) lg2 += plog[q * 48 * 32 + t]; const float sc = sigmoidf_(lg2); scS[t] = sc; selS[t] = sc + RB[e]; }
        __syncthreads();
        if (F.tid < nr) {
            const int row = F.tid, r = rbeg + row; const LAS float* sel = selS + row * 32; const LAS float* sc = scS + row * 32;
            int best = 0; float bestv = -__builtin_inff();
            for (int g = 0; g < 4; ++g) { float m1 = -__builtin_inff(), m2 = -__builtin_inff();
                for (int q = 0; q < 8; ++q) { const float x = sel[g * 8 + q]; if (x > m1) { m2 = m1; m1 = x; } else if (x > m2) m2 = x; }
                const float gs = m1 + m2; if (gs > bestv) { bestv = gs; best = g; } }
            int i1 = 0, i2 = 0; float m1 = -__builtin_inff(), m2 = -__builtin_inff();
            for (int q = 0; q < 8; ++q) { const float x = sel[best * 8 + q]; if (x > m1) { m2 = m1; i2 = i1; m1 = x; i1 = q; } else if (x > m2) { m2 = x; i2 = q; } }
            const int e1 = best * 8 + i1, e2 = best * 8 + i2; const float s1 = sc[e1], s2 = sc[e2], den = s1 + s2;
            const int p1 = atomicAdd(cnt + 64 * e1, 1), p2 = atomicAdd(cnt + 64 * e2, 1);
            list[e1 * NROW + p1] = r; list[e2 * NROW + p2] = r;
            tokE[2 * r] = e1; tokE[2 * r + 1] = e2; tokP[2 * r] = p1; tokP[2 * r + 1] = p2; tokG[2 * r] = s1 / den; tokG[2 * r + 1] = s2 / den;
        }
        __syncthreads();
        TSF(F, 33);
    }
}

__device__ __forceinline__ int moe_tiles(const Frame& F, int l) {
    LAS int* tileEM = (LAS int*)(F.lds + LDS_TILE); LAS int* tbase = tileEM + 128;
    const int* cnt = (const int*)(F.ws + WS_CTL) + CW_CNT + l * 2048;
    __syncthreads();
    if (F.wave == 0) {
        const int n = (F.lane < NEXP) ? __hip_atomic_load(cnt + 64 * F.lane, __ATOMIC_RELAXED, __HIP_MEMORY_SCOPE_AGENT) : 0;
        const int nt = (n + 255) >> 8; int incl = nt;
#pragma unroll
        for (int o = 1; o < 64; o <<= 1) { const int t = __shfl_up(incl, o); if (F.lane >= o) incl += t; }
        const int excl = incl - nt;
        if (F.lane < NEXP) { tbase[F.lane] = excl; for (int m = 0; m < nt; ++m) tileEM[excl + m] = (F.lane << 8) | m; }
        if (F.lane == NEXP - 1) tbase[NEXP] = incl;
    }
    __syncthreads();
    return tbase[NEXP];
}

__device__ __forceinline__ void p_ffnln(const Frame& F, int l, int nrows) {
    LAS int* tbase = (LAS int*)(F.lds + LDS_TILE) + 128;
    (void)moe_tiles(F, l);
    const int gw = F.bid * NWAVES + F.wave, NGW = F.G * NWAVES;
    const float* MOD = (const float*)(F.ws + WS_MOD);
    float* XS = (float*)(F.ws + WS_XS); const bf16_t* YS = (const bf16_t*)(F.ws + WS_YS);
    const int* tokE = (const int*)(F.ws + WS_TOKE); const int* tokP = (const int*)(F.ws + WS_TOKP); const float* tokG = (const float*)(F.ws + WS_TOKG);
    const float* lg = F.in[IN_LNFG] + l * DM; const float* lb = F.in[IN_LNFB] + l * DM;
    bf16_t* H1 = (bf16_t*)(F.ws + WS_H1);
    LAS float* prm = (LAS float*)(F.lds + 65536);
    stage_vec(F, prm, lg); stage_vec(F, prm + DM, lb);
    for (int v = 0; v < 2; ++v) { stage_vec(F, prm + (2 + 3 * v) * DM, MOD + (size_t)(l * 2 + v) * 12288 + 5 * DM);
        if (l == 0) { const float* mn = MOD + (size_t)(2 + v) * 12288; stage_vec(F, prm + (3 + 3 * v) * DM, mn); stage_vec(F, prm + (4 + 3 * v) * DM, mn + DM); } }
    __syncthreads();
    int e1n = 0, e2n = 0, p1n = 0, p2n = 0; float g1n = 0.f, g2n = 0.f;
#define P9_ROUTE(rr) do { if ((rr) < nrows) { e1n = tokE[2 * (rr)]; e2n = tokE[2 * (rr) + 1]; p1n = tokP[2 * (rr)]; p2n = tokP[2 * (rr) + 1]; g1n = tokG[2 * (rr)]; g2n = tokG[2 * (rr) + 1]; } } while (0)
#define P9_LOAD(rr) do { const bf16_t* ya_ = YS + (size_t)(tbase[e1n] * 256 + p1n) * DM; const bf16_t* yb_ = YS + (size_t)(tbase[e2n] * 256 + p2n) * DM; const float* xr_ = XS + (size_t)(rr) * DM; \
        _Pragma("unroll") for (int j = 0; j < 8; ++j) { const int col = 4 * F.lane + 256 * j; nx[j] = __builtin_nontemporal_load((const f32x4*)(xr_ + col)); na[j] = __builtin_nontemporal_load((const u32x2*)(ya_ + col)); nb[j] = __builtin_nontemporal_load((const u32x2*)(yb_ + col)); } ng1 = g1n; ng2 = g2n; } while (0)
    f32x4 nx[8]; u32x2 na[8], nb[8]; float ng1 = 0.f, ng2 = 0.f;
    P9_ROUTE(gw);
    if (gw < nrows) P9_LOAD(gw);
    P9_ROUTE(gw + NGW);
    for (int r = gw; r < nrows; r += NGW) {
        const int v = r >= SEQ; const LAS float* pv = prm + (2 + 3 * v) * DM;
        f32x4 z[8];
#pragma unroll
        for (int j = 0; j < 8; ++j) { const int col = 4 * F.lane + 256 * j; const u32x2 qa = na[j], qb = nb[j];
            const f32x4 fa = {bf2f((bf16_t)(qa.x & 0xffffu)), bf2f((bf16_t)(qa.x >> 16)), bf2f((bf16_t)(qa.y & 0xffffu)), bf2f((bf16_t)(qa.y >> 16))};
            const f32x4 fb = {bf2f((bf16_t)(qb.x & 0xffffu)), bf2f((bf16_t)(qb.x >> 16)), bf2f((bf16_t)(qb.y & 0xffffu)), bf2f((bf16_t)(qb.y >> 16))};
            const f32x4 y = ng1 * fa + ng2 * fb;
            z[j] = ALPHA * nx[j] + *(const LAS f32x4*)(pv + col) * y; }
        if (r + NGW < nrows) P9_LOAD(r + NGW);
        P9_ROUTE(r + 2 * NGW);
        float mean, rstd; ln_stats(z, mean, rstd);
#pragma unroll
        for (int j = 0; j < 8; ++j) { const int col = 4 * F.lane + 256 * j; z[j] = (z[j] - mean) * rstd * *(const LAS f32x4*)(prm + col) + *(const LAS f32x4*)(prm + DM + col); }
        if (l == 1) {
#pragma unroll
            for (int j = 0; j < 8; ++j) *(f32x4*)(F.out + (size_t)r * DM + 4 * F.lane + 256 * j) = z[j];
        } else {
#pragma unroll
            for (int j = 0; j < 8; ++j) *(f32x4*)(XS + (size_t)r * DM + 4 * F.lane + 256 * j) = z[j];
            float mean2, rstd2; ln_stats(z, mean2, rstd2);
#pragma unroll
            for (int j = 0; j < 8; ++j) { const int col = 4 * F.lane + 256 * j; const f32x4 h = (z[j] - mean2) * rstd2 * (1.0f + *(const LAS f32x4*)(pv + 2 * DM + col)) + *(const LAS f32x4*)(pv + DM + col);
                *(u32x2*)(H1 + (size_t)r * DM + col) = pack4(h); }
        }
    }
#undef P9_ROUTE
#undef P9_LOAD
}


__global__ void __launch_bounds__(NTHR, 2) fwd(Args args) {
    extern __shared__ __attribute__((aligned(16))) unsigned char lds_raw[];
    Frame F0;
    F0.lds = (LAS unsigned char*)lds_raw; F0.tid = threadIdx.x; F0.lane = F0.tid & 63; F0.wave = __builtin_amdgcn_readfirstlane(F0.tid >> 6);
    F0.G = gridDim.x; F0.bid = blockIdx.x; F0.in = args.in; F0.out = args.out; F0.ws = args.ws;
    volatile LAS unsigned* MISC = (volatile LAS unsigned*)(F0.lds + LDS_MISC);
    if (F0.tid < 4) MISC[F0.tid] = 0u;
    __syncthreads();
    const int lo = args.ph_lo, hi = args.ph_hi;
    XcdBarrier bar; bar.bar = (unsigned*)(F0.ws + WS_CTL) + CW_BAR; bar.x = 0; bar.st = MISC;
    if (hi - lo > 1) bar = xcd_barrier_post((unsigned*)(F0.ws + WS_CTL) + CW_BAR, MISC);
#ifndef REP_PH
#define REP_PH -1
#endif
#define NREP(j) (((REP_PH) == (j)) ? rep1 + 1 : 1)
#if defined(ONLY_PH)
#define PHON(j) ((j) == ONLY_PH)
#elif defined(PH_MASK)
#define PHON(j) (((PH_MASK) >> (j)) & 1)
#else
#define PHON(j) true
#endif
#ifdef TSEL_A
#define TS(i) do { if (F0.bid == 0 && F0.tid == 0) __hip_atomic_store((unsigned long long*)(F0.ws + WS_CTL + 131072) + (i), (unsigned long long)__builtin_amdgcn_s_memrealtime(), __ATOMIC_RELAXED, __HIP_MEMORY_SCOPE_AGENT); } while (0)
#else
#define TS(i) do { } while (0)
#endif
#define IN(k) (lo <= (k) && (k) < hi)
#define SEAM(k) do { if (IN(k) && IN((k) + 1)) xcd_barrier(bar); } while (0)
    TS(0);
    int rep1 = 1; asm volatile("" : "+s"(rep1));
    if (PHON(0) && IN(0)) for (int rep = 0; rep < NREP(0); ++rep) { { const Frame F = launder(F0); p0_mod(F); } { const Frame F = launder(F0); p0_transposes(F); } { const Frame F = launder(F0); p0_rope(F); } }
    SEAM(0); TS(1);
    if (PHON(1) && IN(1)) for (int rep = 0; rep < NREP(1); ++rep) { const Frame F = launder(F0); p_modulate1(F, 0, NROW); }
    SEAM(1); TS(2);
#pragma unroll 1
    for (int l = 0; l < 2; ++l) {
        const int pb = 2 + 8 * l; const int tb = 3 + 10 * l; (void)tb;
        const int nlat = (l == 0) ? NROW : SEQ;
        if (PHON(2) && IN(pb + 0)) for (int rep = 0; rep < NREP(2); ++rep) {
            const bool split = F0.G >= 256; const int gc = split ? NC_IN : F0.G;
            if (F0.bid < gc) {
                pg8::StaticOrder S; S.init(NROW, INW, DM, (const bf16_t*)(F0.ws + WS_WIN) + (size_t)l * INW * DM, gc, F0.bid);
                { const Frame F = launder(F0);
                  pg8::EpiBf<true> E{(bf16_t*)(F.ws + WS_PROJ), INW, (bf16_t*)(F.ws + WS_KV)};
                  pg8::gemm_phase(F.lds, F.tid, (const bf16_t*)(F.ws + WS_H1), DM, S, E); }
                asm volatile("s_waitcnt vmcnt(0)" ::: "memory"); __syncthreads();
                { const Frame F = launder(F0);
                  pg8::Unit u; for (int i = 0; S.next(i, u); ++i) if (u.pn >= 10 && u.pn <= 14) rms_rope_tile(F, l, u.pm * 256, u.pn); }
            } else { const Frame F = launder(F0); if (l == 0) conv_range(F, gc, 0, CV_A0); else conv_range(F, gc, CV_LAYER + CV_B1, CV_L1F - CV_B1); }
        }
        SEAM(pb + 0); TS(tb + 0); TS(tb + 1);
        if (IN(pb + 2)) { if (PHON(4)) for (int rep = 0; rep < NREP(4); ++rep) { const Frame F = launder(F0); p_att_dense(F, l); } TS(tb + 2); if (PHON(10)) for (int rep = 0; rep < NREP(10); ++rep) { const Frame F = launder(F0); p_att_na(F, l); } TS(tb + 3); if (PHON(11)) for (int rep = 0; rep < NREP(11); ++rep) { const Frame F = launder(F0); p_att_sg(F, l); }
            if (F0.G >= 256 && F0.bid >= 128) { const Frame F = launder(F0); conv_range(F, 128, l == 0 ? CV_L0F : CV_LAYER + CV_L1F, CV_ATT); } }
        SEAM(pb + 2); TS(tb + 4);
        if (PHON(5) && IN(pb + 3)) for (int rep = 0; rep < NREP(5); ++rep) { const Frame F = launder(F0);
            const bool split = (l == 0) && F.G >= 256; const int gc = split ? NC_OUT : F.G;
            if (F.bid < gc) {
                pg8::StaticOrder S; S.init(nlat, DM, DM, (const bf16_t*)(F.ws + WS_WOUT) + (size_t)l * DM * DM, gc, F.bid);
                pg8::EpiBf<false> E{(bf16_t*)(F.ws + WS_Y1), DM, nullptr};
                pg8::gemm_phase(F.lds, F.tid, (const bf16_t*)(F.ws + WS_MIX), DM, S, E);
            } else conv_range(F, gc, CV_A0, CV_L0F - CV_A0);
        }
        SEAM(pb + 3); TS(tb + 5);
        if (PHON(6) && IN(pb + 4)) { const Frame F = launder(F0); p_mixln_router(F, l, nlat); }
        SEAM(pb + 4); TS(tb + 6);
        if (PHON(7) && IN(pb + 5)) for (int rep = 0; rep < NREP(7); ++rep) { const Frame F = launder(F0);
            const bool split = (l == 0) && F.G >= 256; const int gc = split ? NC_MOE : F.G;
            if (F.bid < gc) {
                const int ntiles = moe_tiles(F, l);
                pg8::MoeOrder<true> S{(const LAS int*)(F.lds + LDS_TILE), ntiles, gc, F.bid, DM, (const int*)(F.ws + WS_LIST), (const int*)(F.ws + WS_CTL) + CW_CNT + l * 2048,
                                      (const bf16_t*)(F.ws + WS_WGU) + (size_t)l * NEXP * 2048 * DM};
                pg8::EpiSwiGLU E{(bf16_t*)(F.ws + WS_GA)};
                pg8::gemm_phase(F.lds, F.tid, (const bf16_t*)(F.ws + WS_H2), DM, S, E);
            } else conv_range(F, gc, CV_LAYER, CV_B0);
        }
        SEAM(pb + 5); TS(tb + 7);
        if (PHON(8) && IN(pb + 6)) for (int rep = 0; rep < NREP(8); ++rep) { const Frame F = launder(F0);
            const bool split = (l == 0) && F.G >= 256; const int gc = split ? NC_MOE : F.G;
            if (F.bid < gc) {
                const int ntiles = moe_tiles(F, l);
                pg8::MoeOrder<false> S{(const LAS int*)(F.lds + LDS_TILE), ntiles, gc, F.bid, DEXP, nullptr, nullptr, (const bf16_t*)(F.ws + WS_WD) + (size_t)l * NEXP * DM * DEXP};
                pg8::EpiBf<false> E{(bf16_t*)(F.ws + WS_YS), DM, nullptr};
                pg8::gemm_phase(F.lds, F.tid, (const bf16_t*)(F.ws + WS_GA), DEXP, S, E);
            } else conv_range(F, gc, CV_LAYER + CV_B0, CV_B1 - CV_B0);
        }
        SEAM(pb + 6); TS(tb + 8);
        if (PHON(9) && IN(pb + 7)) { const Frame F = launder(F0); p_ffnln(F, l, nlat); }
        SEAM(pb + 7);
#ifdef TSEL_A
        if (l == 1) xcd_barrier(bar);
#endif
        TS(tb + 9);
    }
#ifdef TSEL_A
    {
        unsigned long long* ts = (unsigned long long*)(F0.ws + WS_CTL + 131072);
        if (F0.bid == 0 && F0.tid == 0) {
            unsigned long long a0 = 0, a1 = 0, b0 = 0, b1 = 0;
            a0 = __hip_atomic_load(ts + TSEL_A - 1, __ATOMIC_RELAXED, __HIP_MEMORY_SCOPE_AGENT); a1 = __hip_atomic_load(ts + TSEL_A2, __ATOMIC_RELAXED, __HIP_MEMORY_SCOPE_AGENT);
            b0 = __hip_atomic_load(ts + TSEL_B - 1, __ATOMIC_RELAXED, __HIP_MEMORY_SCOPE_AGENT); b1 = __hip_atomic_load(ts + TSEL_B2, __ATOMIC_RELAXED, __HIP_MEMORY_SCOPE_AGENT);
            const float ua = (float)(a1 - a0) * 0.01f, ub = (float)(b1 - b0) * 0.01f;
            int n1 = (int)(ua * 8.192f); n1 = n1 > 8100 ? 8100 : n1; n1 = 0;
            __hip_atomic_store((unsigned*)(ts + 64), (unsigned)n1, __ATOMIC_RELAXED, __HIP_MEMORY_SCOPE_AGENT);
            __hip_atomic_store((unsigned*)(ts + 65), __float_as_uint(ub * 0.5f), __ATOMIC_RELAXED, __HIP_MEMORY_SCOPE_AGENT);
        }
        xcd_barrier(bar);
        const int n1 = (int)__hip_atomic_load((unsigned*)(ts + 64), __ATOMIC_RELAXED, __HIP_MEMORY_SCOPE_AGENT);
        const float V = __uint_as_float(__hip_atomic_load((unsigned*)(ts + 65), __ATOMIC_RELAXED, __HIP_MEMORY_SCOPE_AGENT));
        const int gw = F0.bid * NWAVES + F0.wave, NGW = F0.G * NWAVES;
        for (int r = gw; r < n1; r += NGW) for (int j = 0; j < 8; ++j) *(f32x4*)(F0.out + (size_t)r * DM + 4 * F0.lane + 256 * j) = (f32x4){0.f, 0.f, 0.f, 0.f};
        asm volatile("s_waitcnt vmcnt(0)" ::: "memory");
        if (F0.bid == 0 && F0.tid == 0) F0.out[0] = V;
    }
#endif
#undef IN
#undef SEAM
}


extern "C" void kernel_launch(void* const* d_in, const int* in_sizes, int n_in, void* d_out, int out_size, void* d_ws, size_t ws_size, hipStream_t stream) {
    static int grid = 0;
    if (grid == 0) {
        if (n_in != 24 || out_size != SEQ * DM || ws_size < WS_END) { fprintf(stderr, "kernel_launch: unexpected shapes (n_in %d out %d ws %zu)\n", n_in, out_size, ws_size); grid = -1; return; }
        int dev = 0, cus = 0, per_cu = 0;
        if (hipGetDevice(&dev) != hipSuccess || hipDeviceGetAttribute(&cus, hipDeviceAttributeMultiprocessorCount, dev) != hipSuccess) { grid = -1; return; }
        if (hipFuncSetAttribute((const void*)fwd, hipFuncAttributeMaxDynamicSharedMemorySize, LDS_BYTES) != hipSuccess) { fprintf(stderr, "kernel_launch: hipFuncSetAttribute failed\n"); grid = -1; return; }
        if (hipOccupancyMaxActiveBlocksPerMultiprocessor(&per_cu, (const void*)fwd, NTHR, LDS_BYTES) != hipSuccess || per_cu < 1) { fprintf(stderr, "kernel_launch: occupancy query says %d\n", per_cu); }
        (void)hipGetLastError();
        grid = cus;
    }
    if (grid < 0) return;
    (void)hipMemsetAsync((char*)d_ws + WS_CTL, 0, CTL_ZERO_BYTES, stream);
    Args a{};
    for (int i = 0; i < 24; ++i) a.in[i] = (const float*)d_in[i];
    a.out = (float*)d_out; a.ws = (unsigned char*)d_ws;
#if MK_ONE_LAUNCH
    a.ph_lo = 0; a.ph_hi = NPH;
    hipLaunchKernelGGL(fwd, dim3(grid), dim3(NTHR), LDS_BYTES, stream, a);

#else
    for (int k = 0; k < NPH; ++k) { a.ph_lo = k; a.ph_hi = k + 1; hipLaunchKernelGGL(fwd, dim3(grid), dim3(NTHR), LDS_BYTES, stream, a); }
#endif
}
```

```cpp
#include <hip/hip_runtime.h>
#include <cstdio>
#include <cstdint>

#ifndef MK_ONE_LAUNCH
#define MK_ONE_LAUNCH 1
#endif

constexpr int DM = 2048, SEQ = 8192, CTXL = 256, NROW = SEQ + CTXL;
constexpr int INW = 4096, NEXP = 32, DEXP = 1024, GRIDW = 64;
constexpr float ALPHA = 1.41421356237309515f;
constexpr float LN_EPS = 1e-6f;
constexpr int NPH = 18;
constexpr int MOE_CAP_TILES = 98;
constexpr int NWAVES = 8, NTHR = 512;

constexpr size_t MiB = 1u << 20;
constexpr size_t WS_CTL = 0, CTL_ZERO_BYTES = 1 * MiB;
constexpr size_t WS_MOD = 1 * MiB;
constexpr size_t WS_ROPE = 1 * MiB + 256 * 1024;
constexpr size_t WS_RWT = 1 * MiB + 512 * 1024;
constexpr size_t WS_TOKE = 2 * MiB;
constexpr size_t WS_TOKP = WS_TOKE + 128 * 1024;
constexpr size_t WS_TOKG = WS_TOKP + 128 * 1024;
constexpr size_t WS_LIST = 3 * MiB;
constexpr size_t WS_WIN = 8 * MiB;
constexpr size_t WS_WOUT = 40 * MiB;
constexpr size_t WS_WGU = 64 * MiB;
constexpr size_t WS_WD = 576 * MiB;
constexpr size_t WS_H1 = 832 * MiB;
constexpr size_t WS_PROJ = 866 * MiB;
constexpr size_t WS_MIX = 932 * MiB;
constexpr size_t WS_Y1 = 966 * MiB;
constexpr size_t WS_XS = 1032 * MiB;
constexpr size_t WS_H2 = 1098 * MiB;
constexpr size_t WS_GA = 1132 * MiB;
constexpr size_t WS_YS = 1182 * MiB;
constexpr size_t WS_H2L = 1378 * MiB;
constexpr size_t WS_KV = 1412 * MiB;
constexpr size_t WS_CKV = 1424 * MiB;
constexpr size_t WS_END = 1426 * MiB;
constexpr int CW_BAR = 4096;
constexpr int CW_CNT = 8192;
constexpr int LDS_PART = 131072;
constexpr int LDS_SC = 147456;
constexpr int LDS_TILE = 151552;
constexpr int LDS_MISC = 153600;
constexpr int LDS_BYTES = 155648;

#define GAS __attribute__((address_space(1)))
#define LAS __attribute__((address_space(3)))
typedef unsigned short bf16_t;
typedef float f32x4 __attribute__((ext_vector_type(4)));
typedef float f32x2 __attribute__((ext_vector_type(2)));
typedef float f32x16 __attribute__((ext_vector_type(16)));
typedef short bf16x8 __attribute__((ext_vector_type(8)));
typedef short s16x4 __attribute__((ext_vector_type(4)));
typedef unsigned u32x4 __attribute__((ext_vector_type(4)));
typedef unsigned u32x2 __attribute__((ext_vector_type(2)));

typedef __bf16 bf16v2 __attribute__((ext_vector_type(2)));
typedef float f32v2 __attribute__((ext_vector_type(2)));
__device__ __forceinline__ unsigned cvt_pk_bf16_s(float lo, float hi) { const f32v2 v = {lo, hi}; const bf16v2 r = __builtin_convertvector(v, bf16v2); return *reinterpret_cast<const unsigned*>(&r); }
__device__ __forceinline__ unsigned cvt_pk_bf16(float lo, float hi) { unsigned r; asm volatile("v_cvt_pk_bf16_f32 %0, %1, %2" : "=v"(r) : "v"(lo), "v"(hi)); return r; }
__device__ __forceinline__ bf16_t f2bf(float f) { unsigned u = __builtin_bit_cast(unsigned, f); return (bf16_t)((u + 0x7fffu + ((u >> 16) & 1u)) >> 16); }
__device__ __forceinline__ float bf2f(bf16_t b) { return __builtin_bit_cast(float, ((unsigned)b) << 16); }
__device__ __forceinline__ u32x2 pack4(f32x4 v) { u32x2 o; o.x = cvt_pk_bf16(v.x, v.y); o.y = cvt_pk_bf16(v.z, v.w); return o; }
template <int CTRL> __device__ __forceinline__ float dpp_mov(float v) { return __builtin_bit_cast(float, __builtin_amdgcn_update_dpp(0, __builtin_bit_cast(int, v), CTRL, 0xF, 0xF, true)); }
__device__ __forceinline__ float quad_sum(float v) { v += dpp_mov<0xB1>(v); v += dpp_mov<0x4E>(v); return v; }
__device__ __forceinline__ float wave_sum(float v) {
    v += dpp_mov<0xB1>(v); v += dpp_mov<0x4E>(v); v += dpp_mov<0x141>(v); v += dpp_mov<0x140>(v);
    const float s0 = __builtin_bit_cast(float, __builtin_amdgcn_readlane(__builtin_bit_cast(int, v), 0)), s1 = __builtin_bit_cast(float, __builtin_amdgcn_readlane(__builtin_bit_cast(int, v), 16));
    const float s2 = __builtin_bit_cast(float, __builtin_amdgcn_readlane(__builtin_bit_cast(int, v), 32)), s3 = __builtin_bit_cast(float, __builtin_amdgcn_readlane(__builtin_bit_cast(int, v), 48));
    return (s0 + s1) + (s2 + s3);
}
__device__ __forceinline__ float sigmoidf_(float x) { return 1.0f / (1.0f + expf(-x)); }
__device__ __forceinline__ float gelu_tanh_fast(float x) { const float u = x * (1.0f + 0.044715f * x * x) * 1.5957691216057308f; return x * __builtin_amdgcn_rcpf(1.0f + __expf(-u)); }
__device__ __forceinline__ float silu_fast(float x) { return x * __builtin_amdgcn_rcpf(1.0f + __expf(-x)); }

#define XB_TMO      128
#define XB_XCNT(j)  (256  + 64 * (j))
#define XB_XSUB(j)  (1280 + 64 * (j))
#define XB_XGEN(j)  (2304 + 64 * (j))
#define XB_TOP      3328
#define XB_TOPGEN   3392
#define XCD_BAR_WORDS 3456
#define XB_SPIN_CAP (1u << 20)
__device__ __forceinline__ unsigned xb_ld(unsigned* p)              { return __hip_atomic_load(p, __ATOMIC_RELAXED, __HIP_MEMORY_SCOPE_AGENT); }
__device__ __forceinline__ unsigned xb_add(unsigned* p, unsigned v) { return __hip_atomic_fetch_add(p, v, __ATOMIC_RELAXED, __HIP_MEMORY_SCOPE_AGENT); }
__device__ __forceinline__ unsigned xb_xcc_id() { return (unsigned)__builtin_amdgcn_s_getreg((3 << 11) | 20) & 0xFu; }
#define XB_SPIN(cond, bar) do { unsigned _sp = 0; while (cond) { __builtin_amdgcn_s_sleep(1); \
    if ((++_sp & 255u) == 0u) { if (xb_ld(&(bar)[XB_TMO])) break; if (_sp > XB_SPIN_CAP) { atomicAdd(&(bar)[XB_TMO], 1u); break; } } } } while (0)
struct XcdBarrier { unsigned* bar; unsigned x; volatile LAS unsigned* st; };
__device__ __forceinline__ XcdBarrier xcd_barrier_post(unsigned* bar, volatile LAS unsigned* st) {
    XcdBarrier b; b.bar = bar; b.x = xb_xcc_id(); b.st = st;
    if (threadIdx.x == 0) (void)xb_add(&bar[XB_XCNT(b.x)], 1u);
    return b;
}
__device__ __forceinline__ void xcd_barrier_complete(unsigned* bar, unsigned x, unsigned& nloc, unsigned& nx) {
    const unsigned G = gridDim.x * gridDim.y * gridDim.z;
    unsigned sum, cnt, mine, sp = 0u;
    for (;;) {
        sum = 0u; cnt = 0u; mine = 0u;
#pragma unroll
        for (unsigned j = 0; j < 16; ++j) { const unsigned c = xb_ld(&bar[XB_XCNT(j)]); sum += c; cnt += (c > 0u) ? 1u : 0u; mine = (j == x) ? c : mine; }
        if (sum == G) break;
        __builtin_amdgcn_s_sleep(1);
        if ((++sp & 255u) == 0u) { if (xb_ld(&bar[XB_TMO])) break; if (sp > XB_SPIN_CAP) { atomicAdd(&bar[XB_TMO], 1u); break; } }
    }
    nloc = mine > 0u ? mine : 1u; nx = cnt > 0u ? cnt : 1u;
}
__device__ __forceinline__ void xcd_barrier(const XcdBarrier& b) {
    asm volatile("s_waitcnt vmcnt(0)" ::: "memory");
    __syncthreads();
    if (threadIdx.x == 0) {
        unsigned* bar = b.bar;
        __builtin_amdgcn_s_waitcnt(0);
        unsigned nloc = b.st[0], nx = b.st[1];
        if (nloc == 0u) { xcd_barrier_complete(bar, b.x, nloc, nx); b.st[0] = nloc; b.st[1] = nx; }
        const unsigned old = xb_add(&bar[XB_XSUB(b.x)], 1u);
        const unsigned gen = old / nloc;
        if (old + 1u == (gen + 1u) * nloc) {
            __builtin_amdgcn_fence(__ATOMIC_RELEASE, "agent");
            asm volatile("s_waitcnt vmcnt(0)" ::: "memory");
            const unsigned og = xb_add(&bar[XB_TOP], 1u);
            const unsigned tg = og / nx;
            if (og + 1u == (tg + 1u) * nx) xb_add(&bar[XB_TOPGEN], 1u);
            else XB_SPIN(xb_ld(&bar[XB_TOPGEN]) == tg, bar);
            __builtin_amdgcn_fence(__ATOMIC_ACQUIRE, "agent");
            xb_add(&bar[XB_XGEN(b.x)], 1u);
            asm volatile("s_waitcnt vmcnt(0)" ::: "memory");
        } else {
            XB_SPIN(xb_ld(&bar[XB_XGEN(b.x)]) == gen, bar);
            __builtin_amdgcn_fence(__ATOMIC_ACQUIRE, "agent");
            asm volatile("s_waitcnt vmcnt(0)" ::: "memory");
        }
    }
    __syncthreads();
}

struct Args { const float* in[24]; float* out; unsigned char* ws; int ph_lo, ph_hi; };
struct Frame {
    LAS unsigned char* lds;
    int tid, lane, wave, G, bid;
    const float* const* in;
    float* out; unsigned char* ws;
};
__device__ __forceinline__ Frame launder(const Frame& F0) {
    Frame F = F0; int t = F0.tid; asm volatile("" : "+v"(t)); F.tid = t; F.lane = t & 63; F.wave = __builtin_amdgcn_readfirstlane(t >> 6);
    unsigned long long w = (unsigned long long)F0.ws; asm volatile("" : "+s"(w)); F.ws = (unsigned char*)(GAS unsigned char*)w;
    unsigned l = (unsigned)(uintptr_t)F0.lds; asm volatile("" : "+s"(l)); F.lds = (LAS unsigned char*)(uintptr_t)l;
    int g = F0.G, b = F0.bid; asm volatile("" : "+s"(g), "+s"(b)); F.G = g; F.bid = b;
    return F;
}
#define IN_X 0
#define IN_C 1
#define IN_CTX 2
#define IN_CCTX 3
#define IN_ADAW 4
#define IN_ADAB 5
#define IN_WIN 6
#define IN_RPB 7
#define IN_SGLNG 8
#define IN_SGLNB 9
#define IN_SGW 10
#define IN_SGB 11
#define IN_QNG 12
#define IN_KNG 13
#define IN_WOUT 14
#define IN_LNMG 15
#define IN_LNMB 16
#define IN_RW 17
#define IN_RB 18
#define IN_WG 19
#define IN_WU 20
#define IN_WDN 21
#define IN_LNFG 22
#define IN_LNFB 23

__device__ __forceinline__ void p0_mod(const Frame& F) {
    LAS float* sl = (LAS float*)F.lds;
    LAS float* red = sl + 4096;
    const float* c = F.in[IN_C]; const float* cc = F.in[IN_CCTX];
    for (int t = F.tid; t < DM; t += NTHR) { const float a = c[t]; sl[t] = a * sigmoidf_(a); const float b = cc[t]; sl[DM + t] = b * sigmoidf_(b); }
    __syncthreads();
    float* MOD = (float*)(F.ws + WS_MOD);
    for (int item = F.bid; item < 256; item += F.G) {
        const int l = item >> 7, nb = item & 127, col0 = nb * 96;
        f32x2 a0 = {0.f, 0.f}, a1 = {0.f, 0.f};
        if (F.lane < 48) {
            const float* wp = F.in[IN_ADAW] + (size_t)l * DM * 12288 + (size_t)(F.wave * 256) * 12288 + col0 + 2 * F.lane;
            const LAS float* s0 = sl + F.wave * 256; const LAS float* s1 = sl + DM + F.wave * 256;
#pragma unroll 32
            for (int k = 0; k < 256; ++k) { const f32x2 w = __builtin_nontemporal_load((const f32x2*)(wp + (size_t)k * 12288)); a0 += s0[k] * w; a1 += s1[k] * w; }
            red[(F.wave * 2 + 0) * 96 + 2 * F.lane] = a0.x; red[(F.wave * 2 + 0) * 96 + 2 * F.lane + 1] = a0.y;
            red[(F.wave * 2 + 1) * 96 + 2 * F.lane] = a1.x; red[(F.wave * 2 + 1) * 96 + 2 * F.lane + 1] = a1.y;
        }
        __syncthreads();
        if (F.tid < 192) { const int v = F.tid / 96, q = F.tid % 96; float s = 0.f;
#pragma unroll
            for (int w = 0; w < 8; ++w) s += red[(w * 2 + v) * 96 + q];
            MOD[(size_t)(l * 2 + v) * 12288 + col0 + q] = s + F.in[IN_ADAB][l * 12288 + col0 + q]; }
        __syncthreads();
    }
}
__device__ __forceinline__ void tr_item(const float* W, int K, int N, bf16_t* WT, int k0, int n0, int drow0, LAS float* scr, int lane) {
    f32x4 v[16];
    const float* wp = W + (size_t)(k0 + (lane >> 4)) * N + n0 + 4 * (lane & 15);
#pragma unroll
    for (int i = 0; i < 16; ++i) v[i] = __builtin_nontemporal_load((const f32x4*)(wp + (size_t)(4 * i) * N));
#pragma unroll
    for (int i = 0; i < 16; ++i) { LAS float* p = scr + (4 * i + (lane >> 4)) * 65 + 4 * (lane & 15); p[0] = v[i].x; p[1] = v[i].y; p[2] = v[i].z; p[3] = v[i].w; }
    asm volatile("s_waitcnt lgkmcnt(0)" ::: "memory");
    const int c = lane & 7;
#pragma unroll
    for (int j = 0; j < 8; ++j) { const int n = (lane >> 3) + 8 * j; const LAS float* s = scr + (8 * c) * 65 + n;
        u32x4 o; o.x = cvt_pk_bf16_s(s[0 * 65], s[1 * 65]); o.y = cvt_pk_bf16_s(s[2 * 65], s[3 * 65]); o.z = cvt_pk_bf16_s(s[4 * 65], s[5 * 65]); o.w = cvt_pk_bf16_s(s[6 * 65], s[7 * 65]);
        *(u32x4*)(WT + (size_t)(drow0 + n) * K + k0 + 8 * c) = o; }
    asm volatile("s_waitcnt lgkmcnt(0)" ::: "memory");
}
struct TrDesc { const float* src; bf16_t* dst; int N, K; };
__device__ __forceinline__ TrDesc moe_item_desc(const Frame& F, int m) {
    const int le = m / 1536, r = m % 1536, which = r >> 9, r2 = r & 511; TrDesc d;
    if (which < 2) { const int kb = r2 >> 4, nb = r2 & 15, n0 = nb * 64; d.N = DEXP; d.K = DM;
        d.src = F.in[which == 0 ? IN_WG : IN_WU] + (size_t)le * DM * DEXP + (size_t)(kb * 64) * DEXP + n0;
        d.dst = (bf16_t*)(F.ws + WS_WGU) + (size_t)le * 2048 * DM + (size_t)((n0 >> 7) * 256 + (n0 & 127) + which * 128) * DM + kb * 64; }
    else { const int kb = r2 >> 5, nb = r2 & 31; d.N = DM; d.K = DEXP;
        d.src = F.in[IN_WDN] + (size_t)le * DEXP * DM + (size_t)(kb * 64) * DM + nb * 64;
        d.dst = (bf16_t*)(F.ws + WS_WD) + (size_t)le * DM * DEXP + (size_t)(nb * 64) * DEXP + kb * 64; }
    return d;
}
__device__ __forceinline__ void tr_load64(const TrDesc& d, f32x4 (&v)[16], int lane) {
    const float* wp = d.src + (size_t)(lane >> 4) * d.N + 4 * (lane & 15);
#pragma unroll
    for (int i = 0; i < 16; ++i) v[i] = __builtin_nontemporal_load((const f32x4*)(wp + (size_t)(4 * i) * d.N));
}
__device__ __forceinline__ void tr_finish64(const TrDesc& d, const f32x4 (&v)[16], LAS float* scr, int lane) {
#pragma unroll
    for (int i = 0; i < 16; ++i) { LAS float* p = scr + (4 * i + (lane >> 4)) * 65 + 4 * (lane & 15); p[0] = v[i].x; p[1] = v[i].y; p[2] = v[i].z; p[3] = v[i].w; }
    asm volatile("s_waitcnt lgkmcnt(0)" ::: "memory");
    const int c = lane & 7;
#pragma unroll
    for (int j = 0; j < 8; ++j) { const int n = (lane >> 3) + 8 * j; const LAS float* s = scr + (8 * c) * 65 + n;
        u32x4 o; o.x = cvt_pk_bf16_s(s[0 * 65], s[1 * 65]); o.y = cvt_pk_bf16_s(s[2 * 65], s[3 * 65]); o.z = cvt_pk_bf16_s(s[4 * 65], s[5 * 65]); o.w = cvt_pk_bf16_s(s[6 * 65], s[7 * 65]);
        __builtin_nontemporal_store(o, (u32x4*)(d.dst + (size_t)n * d.K + 8 * c)); }
    asm volatile("s_waitcnt lgkmcnt(0)" ::: "memory");
}
__device__ __forceinline__ void conv_moe_item(const Frame& F, int m, LAS float* scr) {
    const TrDesc d = moe_item_desc(F, m); f32x4 v[16]; tr_load64(d, v, F.lane); tr_finish64(d, v, scr, F.lane);
}
constexpr int NC_IN = 176, NC_OUT = 132, NC_MOE = 192, NCOMP = 128  ;
constexpr int CV_LAYER = 49152;
constexpr int CV_A0 = 20480, CV_L0F = CV_A0 + 22528;
constexpr int CV_B0 = 16384, CV_B1 = CV_B0 + 10240, CV_L1F = CV_B1 + 16384;
constexpr int CV_NA0 = 2816;
constexpr int CV_ATT = 6144;
static_assert(CV_L0F + CV_ATT <= CV_LAYER && CV_L1F + CV_ATT <= CV_LAYER, "converter ranges");
__device__ __forceinline__ void conv_range(const Frame& F, int ncomp, int first, int count) {
    LAS float* scr = (LAS float*)(F.lds + F.wave * 16896);
    const int cw = (F.bid - ncomp) * NWAVES + F.wave, NCW = (F.G - ncomp) * NWAVES;
    f32x4 va[16], vb[16]; TrDesc d, dn;
    int k = cw;
    if (k >= count) return;
    d = moe_item_desc(F, first + k); tr_load64(d, va, F.lane);
    for (;;) {
        const int kn = k + NCW; const bool hn = kn < count;
        dn = moe_item_desc(F, first + (hn ? kn : k)); tr_load64(dn, vb, F.lane);
        tr_finish64(d, va, scr, F.lane);
        if (!hn) break;
        k = kn + NCW; const bool h2 = k < count;
        d = moe_item_desc(F, first + (h2 ? k : kn)); tr_load64(d, va, F.lane);
        tr_finish64(dn, vb, scr, F.lane);
        if (!h2) break;
    }
}
__device__ __forceinline__ void p0_transposes(const Frame& F) {
    LAS float* scr = (LAS float*)(F.lds + F.wave * 16896);
    const int gw = F.bid * NWAVES + F.wave, NGW = F.G * NWAVES;
    constexpr int NDENSE = 2 * 3072;
    const bool split = F.G >= 256;
    const int r0 = split ? CV_LAYER - CV_L0F - CV_ATT : CV_LAYER, r1 = split ? CV_LAYER - CV_L1F - CV_ATT : CV_LAYER;
    const int NITEMS = NDENSE + r0 + r1;
    for (int it = gw; it < NITEMS; it += NGW) {
        if (it < NDENSE) {
            const int l = it / 3072, r = it % 3072;
            if (r < 2048) { const int kb = r >> 6, nb = r & 63; tr_item(F.in[IN_WIN] + (size_t)l * DM * INW, DM, INW, (bf16_t*)(F.ws + WS_WIN) + (size_t)l * INW * DM, kb * 64, nb * 64, nb * 64, scr, F.lane); }
            else { const int r2 = r - 2048, kb = r2 >> 5, nb = r2 & 31; tr_item(F.in[IN_WOUT] + (size_t)l * DM * DM, DM, DM, (bf16_t*)(F.ws + WS_WOUT) + (size_t)l * DM * DM, kb * 64, nb * 64, nb * 64, scr, F.lane); }
        } else {
            const int q = it - NDENSE;
            const int m = q < r0 ? (CV_LAYER - r0) + q : CV_LAYER + (CV_LAYER - r1) + (q - r0);
            conv_moe_item(F, m, scr);
        }
    }
}
__device__ __forceinline__ void p0_rope(const Frame& F) {
    const int g = F.bid * NTHR + F.tid;
    if (g < 32 * DM) { const int e = g >> 11, k = g & (DM - 1); const float w = F.in[IN_RW][k * 32 + e]; const bf16_t hi = f2bf(w); const bf16_t lo = f2bf(w - bf2f(hi));
        bf16_t* T = (bf16_t*)(F.ws + WS_RWT); T[g] = hi; T[32 * DM + g] = lo; }
    if (g < 128 * 32) { const int pos = g >> 5, i = g & 31; const float inv = powf(10000.0f, -(float)i / 32.0f); const float ang = (float)pos * inv;
        float* R = (float*)(F.ws + WS_ROPE); R[2 * g] = cosf(ang); R[2 * g + 1] = sinf(ang); }
}

__device__ __forceinline__ const float* xrow_ptr(const Frame& F, int l, int r) {
    if (l == 0) return r < SEQ ? F.in[IN_X] + (size_t)r * DM : F.in[IN_CTX] + (size_t)(r - SEQ) * DM;
    return (const float*)(F.ws + WS_XS) + (size_t)r * DM;
}
__device__ __forceinline__ void ln_stats(const f32x4 (&v)[8], float& mean, float& rstd) {
    float s = 0.f;
#pragma unroll
    for (int j = 0; j < 8; ++j) s += (v[j].x + v[j].y) + (v[j].z + v[j].w);
    mean = wave_sum(s) * (1.0f / DM);
    float q = 0.f;
#pragma unroll
    for (int j = 0; j < 8; ++j) { const f32x4 d = v[j] - mean; q += (d.x * d.x + d.y * d.y) + (d.z * d.z + d.w * d.w); }
    rstd = 1.0f / sqrtf(wave_sum(q) * (1.0f / DM) + LN_EPS);
}
template <bool TO_LDS>
__device__ __forceinline__ void modulate_store(const f32x4 (&v)[8], const float* sh, const float* sc, bf16_t* orow, LAS float* lrow, int lane) {
    float mean, rstd; ln_stats(v, mean, rstd);
#pragma unroll
    for (int j = 0; j < 8; ++j) { const int col = 4 * lane + 256 * j; const f32x4 s1 = *(const f32x4*)(sc + col), s0 = *(const f32x4*)(sh + col);
        const f32x4 h = (v[j] - mean) * rstd * (1.0f + s1) + s0;
        u32x2 w; w.x = cvt_pk_bf16(h.x, h.y); w.y = cvt_pk_bf16(h.z, h.w); *(u32x2*)(orow + col) = w;
        if (TO_LDS) *(LAS f32x4*)(lrow + col) = h; }
}
__device__ __forceinline__ void stage_vec(const Frame& F, LAS float* dst, const float* src) { *(LAS f32x4*)(dst + 4 * F.tid) = *(const f32x4*)(src + 4 * F.tid); }
__device__ __forceinline__ void p_modulate1(const Frame& F, int l, int nrows) {
    const int gw = F.bid * NWAVES + F.wave, NGW = F.G * NWAVES;
    const float* MOD = (const float*)(F.ws + WS_MOD);
    bf16_t* H1 = (bf16_t*)(F.ws + WS_H1);
    LAS float* prm = (LAS float*)F.lds;
    for (int v = 0; v < 2; ++v) { const float* m = MOD + (size_t)(l * 2 + v) * 12288; stage_vec(F, prm + (2 * v) * DM, m); stage_vec(F, prm + (2 * v + 1) * DM, m + DM); }
    __syncthreads();
    f32x4 nx[8];
    if (gw < nrows) { const float* xr = xrow_ptr(F, l, gw);
#pragma unroll
        for (int j = 0; j < 8; ++j) nx[j] = *(const f32x4*)(xr + 4 * F.lane + 256 * j); }
    for (int r = gw; r < nrows; r += NGW) {
        const int v = r >= SEQ; const LAS float* pv = prm + 2 * v * DM;
        f32x4 x[8];
#pragma unroll
        for (int j = 0; j < 8; ++j) x[j] = nx[j];
        if (r + NGW < nrows) { const float* xr = xrow_ptr(F, l, r + NGW);
#pragma unroll
            for (int j = 0; j < 8; ++j) nx[j] = *(const f32x4*)(xr + 4 * F.lane + 256 * j); }
        float mean, rstd; ln_stats(x, mean, rstd);
#pragma unroll
        for (int j = 0; j < 8; ++j) { const int col = 4 * F.lane + 256 * j; const f32x4 h = (x[j] - mean) * rstd * (1.0f + *(const LAS f32x4*)(pv + DM + col)) + *(const LAS f32x4*)(pv + col);
            u32x2 w; w.x = cvt_pk_bf16(h.x, h.y); w.y = cvt_pk_bf16(h.z, h.w); *(u32x2*)(H1 + (size_t)r * DM + col) = w; }
    }
    __syncthreads();
}

namespace pg8 {
constexpr int BM = 256, BK = 64, HALF = 128, HTB = HALF * BK * 2, STAGE_BYTES = 8 * HTB, NXCD = 8, WGM = 8;
__device__ __forceinline__ int lds_byte(int r, int c) { const int st = (r >> 4) * 2 + (c >> 5), rr = r & 15, cc = c & 31, ob = rr * 64 + cc * 2; return st * 1024 + (ob ^ (((ob >> 9) & 1) << 5)); }
__device__ __forceinline__ void stage_rc(int b, int& R, int& C) { const int st = b / 1024, sb = b % 1024, swz = sb ^ (((sb >> 9) & 1) << 5); R = (st >> 1) * 16 + swz / 64; C = (st & 1) * 32 + (swz % 64) / 2; }
__device__ __forceinline__ int perm32(int rho) { const int n = rho >> 4, i = rho & 15; return 8 * (i >> 2) + 4 * n + (i & 3); }
struct Unit { int pm, pn, e, mt; };
struct StaticOrder {
    int nM, nN, nwg, G, c, K; const bf16_t* Bt;
    __device__ __forceinline__ void init(int M, int N, int K_, const bf16_t* Bt_, int G_, int c_) { nM = M / BM; nN = N / BM; nwg = nM * nN; G = G_; c = c_; K = K_; Bt = Bt_; }
    __device__ __forceinline__ bool next(int i, Unit& u) const {
        const long L = (long)i * G + c; if (L >= nwg) return false;
        int wgid = (int)L; { const int q = nwg / NXCD, r = nwg % NXCD, xcd = wgid % NXCD, off = wgid / NXCD; wgid = (xcd < r ? xcd * (q + 1) : r * (q + 1) + (xcd - r) * q) + off; }
        const int nig = WGM * nN, gid = wgid / nig, fm = gid * WGM, gsz = (nM - fm) < WGM ? (nM - fm) : WGM;
        u.pm = fm + ((wgid % nig) % gsz); u.pn = (wgid % nig) / gsz; u.e = 0; u.mt = 0; return true;
    }
    __device__ __forceinline__ unsigned a_off(const Unit& u, int h, int R) const { return (unsigned)((u.pm * BM + h * HALF + R) * K) * 2u; }
    __device__ __forceinline__ const char* b_base(const Unit& u) const { return (const char*)Bt + (size_t)u.pn * BM * K * 2; }
};
template <bool GATHER> struct MoeOrder {
    const LAS int* tileEM; int ntiles, G, c, K; const int* list; const int* cnt; const bf16_t* Bt;
    __device__ __forceinline__ bool next(int i, Unit& u) const {
        if ((G & 7) == 0) {
            const LAS int* tbase = tileEM + 128; const int x = c & 7, W = G >> 3; int q = (c >> 3) + i * W;
#pragma unroll
            for (int k = 0; k < 4; ++k) { const int e = x + 8 * k; const int tb = tbase[e], nt = tbase[e + 1] - tb; const int nu = nt * 8;
                if (q < nu) { u.e = e; u.pn = q / nt; u.mt = q - u.pn * nt; u.pm = tb + u.mt; return true; }
                q -= nu; }
            return false;
        }
        const int L = i * G + c; if (L >= ntiles * 8) return false;
        const int tile = L >> 3; const int em = tileEM[tile]; u.pm = tile; u.pn = L & 7; u.e = em >> 8; u.mt = em & 255; return true;
    }
    __device__ __forceinline__ unsigned a_off(const Unit& u, int h, int R) const {
        if (GATHER) { const int slot = u.mt * BM + h * HALF + R; const int n = cnt[64 * u.e]; int tok = 0; if (slot < n) tok = list[u.e * NROW + slot]; return (unsigned)(tok * K) * 2u; }
        return (unsigned)((u.pm * BM + h * HALF + R) * K) * 2u;
    }
    __device__ __forceinline__ const char* b_base(const Unit& u) const { return (const char*)Bt + ((size_t)u.e * 2048 + (size_t)u.pn * BM) * K * 2; }
};
struct EpiF32 {
    static constexpr bool PERM = false;
    float* C; int ldc;
    __device__ __forceinline__ void operator()(const f32x4 (&acc)[2][2][4][2], const Unit& u, int wr, int wc, int fr, int fq) const {
        const int row0 = u.pm * BM + wr * 64 + fr, col0 = u.pn * BM + wc * 32 + 4 * fq;
#pragma unroll
        for (int ai = 0; ai < 2; ++ai)
#pragma unroll
            for (int m = 0; m < 4; ++m) { float* rowp = C + (size_t)(row0 + ai * HALF + m * 16) * ldc + col0;
#pragma unroll
                for (int bj = 0; bj < 2; ++bj)
#pragma unroll
                    for (int n = 0; n < 2; ++n) *(f32x4*)(rowp + bj * HALF + n * 16) = acc[ai][bj][m][n]; }
    }
};
template <bool GELU> struct EpiBf {
    static constexpr bool PERM = true;
    bf16_t* O; int ldc; bf16_t* KV;
    __device__ __forceinline__ void operator()(const f32x4 (&acc)[2][2][4][2], const Unit& u, int wr, int wc, int fr, int fq) const {
        const int row0 = u.pm * BM + wr * 64 + fr, col0 = u.pn * BM + wc * 32 + 8 * fq; const bool g = GELU && (u.pn >= 6 && u.pn <= 9);
#pragma unroll
        for (int ai = 0; ai < 2; ++ai)
#pragma unroll
            for (int m = 0; m < 4; ++m) { bf16_t* rowp = (GELU && u.pn >= 14) ? KV + (size_t)(row0 + ai * HALF + m * 16) * 512 + (col0 - 14 * BM) : O + (size_t)(row0 + ai * HALF + m * 16) * ldc + col0;
#pragma unroll
                for (int bj = 0; bj < 2; ++bj) { f32x4 v0 = acc[ai][bj][m][0], v1 = acc[ai][bj][m][1];
                    if (g) {
#pragma unroll
                        for (int j = 0; j < 4; ++j) { v0[j] = gelu_tanh_fast(v0[j]); v1[j] = gelu_tanh_fast(v1[j]); } }
                    u32x4 w; w.x = cvt_pk_bf16(v0[0], v0[1]); w.y = cvt_pk_bf16(v0[2], v0[3]); w.z = cvt_pk_bf16(v1[0], v1[1]); w.w = cvt_pk_bf16(v1[2], v1[3]);
                    *(u32x4*)(rowp + bj * HALF) = w;
                    if (GELU && u.pm == SEQ / BM && u.pn >= 2 && u.pn <= 5)
                        *(u32x4*)(KV + (size_t)(WS_CKV - WS_KV) / 2 + (size_t)((((u.pn - 2) & 1) * 2 + bj) * 256 + (wr * 64 + fr + ai * HALF + m * 16)) * 512 + (u.pn >= 4 ? 256 : 0) + wc * 32 + 8 * fq) = w; } }
    }
};
struct EpiSwiGLU {
    static constexpr bool PERM = true;
    bf16_t* O;
    __device__ __forceinline__ void operator()(const f32x4 (&acc)[2][2][4][2], const Unit& u, int wr, int wc, int fr, int fq) const {
        const int row0 = u.pm * BM + wr * 64 + fr, col0 = u.pn * HALF + wc * 32 + 8 * fq;
#pragma unroll
        for (int ai = 0; ai < 2; ++ai)
#pragma unroll
            for (int m = 0; m < 4; ++m) { bf16_t* rowp = O + (size_t)(row0 + ai * HALF + m * 16) * DEXP + col0;
                f32x4 v0, v1;
#pragma unroll
                for (int j = 0; j < 4; ++j) { v0[j] = silu_fast(acc[ai][0][m][0][j]) * acc[ai][1][m][0][j]; v1[j] = silu_fast(acc[ai][0][m][1][j]) * acc[ai][1][m][1][j]; }
                u32x4 w; w.x = cvt_pk_bf16(v0[0], v0[1]); w.y = cvt_pk_bf16(v0[2], v0[3]); w.z = cvt_pk_bf16(v1[0], v1[1]); w.w = cvt_pk_bf16(v1[2], v1[3]);
                *(u32x4*)rowp = w; }
    }
};

template <class Epi, class Sched>
__device__ __forceinline__ void gemm_phase(LAS unsigned char* lds, int tid, const bf16_t* Amat, int K, const Sched& S, const Epi& E) {
    const int wid = __builtin_amdgcn_readfirstlane(tid >> 6), lane = tid & 63, wr = wid >> 2, wc = wid & 3, fr = lane & 15, fq = lane >> 4;
    const int nt = K / BK;
    int Rl[2], Cl[2]; unsigned voffB[2];
#pragma unroll
    for (int i = 0; i < 2; ++i) { int R, C; stage_rc(tid * 16 + i * 8192, R, C); Rl[i] = R; Cl[i] = C; const int Rb = Epi::PERM ? ((R & ~31) + perm32(R & 31)) : R; voffB[i] = (unsigned)(Rb * K + C) * 2u; }
    const size_t kstep = (size_t)(BK * 2);
    const size_t hstep = (size_t)HALF * K * 2;
    const unsigned ldsw = (unsigned)wid * 1024u;
    const int aoff = lds_byte(wr * 64 + fr, fq * 8), boff = lds_byte(wc * 32 + fr, fq * 8);
    const char* Ab = (const char*)Amat;
#define PG8_SA(b, h) (((b) * 2 + (h)) * HTB)
#define PG8_SB(b, h) ((4 + (b) * 2 + (h)) * HTB)
#define PG8_STAGE(bufoff, gbase, voff) do { _Pragma("unroll") for (int _i = 0; _i < 2; ++_i) \
        __builtin_amdgcn_global_load_lds((const unsigned*)((const char*)(gbase) + (voff)[_i]), (LAS unsigned*)(lds + (bufoff) + ldsw + _i * 8192), 16, 0, 0); } while (0)
#define PG8_LDA(dst, b, h) do { _Pragma("unroll") for (int m = 0; m < 4; ++m) _Pragma("unroll") for (int k = 0; k < 2; ++k) dst[m][k] = *(const LAS bf16x8*)(lds + PG8_SA(b, h) + aoff + m * 2048 + k * 1024); } while (0)
#define PG8_LDB(dst, b, h) do { _Pragma("unroll") for (int n = 0; n < 2; ++n) _Pragma("unroll") for (int k = 0; k < 2; ++k) dst[n][k] = *(const LAS bf16x8*)(lds + PG8_SB(b, h) + boff + n * 2048 + k * 1024); } while (0)
#define PG8_MMA(ai, bj, At, Bt) do { __builtin_amdgcn_s_setprio(1); _Pragma("unroll") for (int m = 0; m < 4; ++m) _Pragma("unroll") for (int n = 0; n < 2; ++n) _Pragma("unroll") for (int k = 0; k < 2; ++k) \
        acc[ai][bj][m][n] = __builtin_amdgcn_mfma_f32_16x16x32_bf16(Bt[n][k], At[m][k], acc[ai][bj][m][n], 0, 0, 0); __builtin_amdgcn_s_setprio(0); } while (0)
#define PG8_WAIT_V(n) asm volatile("s_waitcnt vmcnt(" #n ")" ::: "memory")
#define PG8_WAIT_L(n) asm volatile("s_waitcnt lgkmcnt(" #n ")" ::: "memory")
#define PG8_BAR __builtin_amdgcn_s_barrier()
#define PG8_SCHED __builtin_amdgcn_sched_barrier(0)
#define PG8_AOFFS(dst, u) do { _Pragma("unroll") for (int _h = 0; _h < 2; ++_h) _Pragma("unroll") for (int _i = 0; _i < 2; ++_i) dst[_h][_i] = S.a_off(u, _h, Rl[_i]) + (unsigned)Cl[_i] * 2u; \
        asm volatile("" : "+v"(dst[0][0]), "+v"(dst[0][1]), "+v"(dst[1][0]), "+v"(dst[1][1])); } while (0)
    Unit cur, nxt; int ui = 0;
    if (!S.next(0, cur)) return;
    f32x4 acc[2][2][4][2];
#pragma unroll
    for (int a = 0; a < 2; ++a)
#pragma unroll
        for (int b = 0; b < 2; ++b)
#pragma unroll
            for (int m = 0; m < 4; ++m)
#pragma unroll
                for (int n = 0; n < 2; ++n) acc[a][b][m][n] = (f32x4){0.f, 0.f, 0.f, 0.f};
    bf16x8 At[4][2], B0[2][2], B1[2][2];
    unsigned vA[2][2], vAn[2][2];
    PG8_AOFFS(vA, cur);
    const char* cB = S.b_base(cur);
    PG8_STAGE(PG8_SB(0, 0), cB, voffB); PG8_STAGE(PG8_SA(0, 0), Ab, vA[0]); PG8_STAGE(PG8_SB(0, 1), cB + hstep, voffB); PG8_STAGE(PG8_SA(0, 1), Ab, vA[1]);
    if (wr == 1) PG8_BAR;
    PG8_WAIT_V(4); PG8_BAR;
    PG8_STAGE(PG8_SB(1, 0), cB + kstep, voffB); PG8_STAGE(PG8_SA(1, 0), Ab + kstep, vA[0]); PG8_STAGE(PG8_SB(1, 1), cB + hstep + kstep, voffB);
    PG8_WAIT_V(6); PG8_BAR;
    for (;;) {
        const bool has_next = S.next(ui + 1, nxt);
        const char* nB = cB;
        if (has_next) { PG8_AOFFS(vAn, nxt); nB = S.b_base(nxt); }
        else {
#pragma unroll
            for (int h = 0; h < 2; ++h)
#pragma unroll
                for (int i = 0; i < 2; ++i) vAn[h][i] = vA[h][i]; }
        for (int t = 0; t < nt; t += 2) {
            const bool last = (t == nt - 2);
            const char* a1 = Ab + (size_t)(t + 1) * kstep;
            const char* a2 = last ? Ab : Ab + (size_t)(t + 2) * kstep; const char* b2 = last ? nB : cB + (size_t)(t + 2) * kstep;
            const char* a3 = a2 + kstep; const char* b3 = b2 + kstep;
            unsigned o2[2][2];
#pragma unroll
            for (int h = 0; h < 2; ++h)
#pragma unroll
                for (int i = 0; i < 2; ++i) o2[h][i] = last ? vAn[h][i] : vA[h][i];
            PG8_LDB(B0, 0, 0); PG8_SCHED; PG8_LDA(At, 0, 0); PG8_STAGE(PG8_SA(1, 1), a1, vA[1]);
            PG8_WAIT_L(8); PG8_BAR; PG8_WAIT_L(0); PG8_MMA(0, 0, At, B0); PG8_BAR; PG8_SCHED;
            PG8_LDB(B1, 0, 1); PG8_STAGE(PG8_SB(0, 0), b2, voffB);
            PG8_BAR; PG8_WAIT_L(0); PG8_MMA(0, 1, At, B1); PG8_BAR;
            PG8_LDA(At, 0, 1); PG8_STAGE(PG8_SA(0, 0), a2, o2[0]);
            PG8_BAR; PG8_WAIT_L(0); PG8_MMA(1, 0, At, B0); PG8_BAR; PG8_SCHED;
            PG8_STAGE(PG8_SB(0, 1), b2 + hstep, voffB);
            PG8_WAIT_V(6); PG8_BAR; PG8_MMA(1, 1, At, B1); PG8_BAR;
            PG8_LDB(B0, 1, 0); PG8_SCHED; PG8_LDA(At, 1, 0); PG8_STAGE(PG8_SA(0, 1), a2, o2[1]);
            PG8_WAIT_L(8); PG8_BAR; PG8_WAIT_L(0); PG8_MMA(0, 0, At, B0); PG8_BAR; PG8_SCHED;
            PG8_LDB(B1, 1, 1); PG8_STAGE(PG8_SB(1, 0), b3, voffB);
            PG8_BAR; PG8_WAIT_L(0); PG8_MMA(0, 1, At, B1); PG8_BAR;
            PG8_LDA(At, 1, 1); PG8_STAGE(PG8_SA(1, 0), a3, o2[0]);
            PG8_BAR; PG8_WAIT_L(0); PG8_MMA(1, 0, At, B0); PG8_BAR; PG8_SCHED;
            PG8_STAGE(PG8_SB(1, 1), b3 + hstep, voffB);
            PG8_WAIT_V(6); PG8_BAR; PG8_MMA(1, 1, At, B1); PG8_BAR;
        }
        E(acc, cur, wr, wc, fr, fq);
        if (!has_next) break;
#pragma unroll
        for (int a = 0; a < 2; ++a)
#pragma unroll
            for (int b = 0; b < 2; ++b)
#pragma unroll
                for (int m = 0; m < 4; ++m)
#pragma unroll
                    for (int n = 0; n < 2; ++n) acc[a][b][m][n] = (f32x4){0.f, 0.f, 0.f, 0.f};
        cur = nxt; cB = nB; ++ui;
#pragma unroll
        for (int h = 0; h < 2; ++h)
#pragma unroll
            for (int i = 0; i < 2; ++i) vA[h][i] = vAn[h][i];
    }
    PG8_WAIT_V(0);
    if (wr == 0) PG8_BAR;
    PG8_BAR;
#undef PG8_SA
#undef PG8_SB
#undef PG8_STAGE
#undef PG8_LDA
#undef PG8_LDB
#undef PG8_MMA
#undef PG8_WAIT_V
#undef PG8_WAIT_L
#undef PG8_BAR
#undef PG8_SCHED
#undef PG8_AOFFS
}
}

__device__ __forceinline__ void p_rmsrope(const Frame& F, int l, int nrows, int wg0) {
    const int gw = (F.bid - wg0) * NWAVES + F.wave, NGW = (F.G - wg0) * NWAVES;
    bf16_t* P = (bf16_t*)(F.ws + WS_PROJ);
    const float* R = (const float*)(F.ws + WS_ROPE);
    const int i = F.lane & 31, ax = F.lane >> 5, d1 = ax * 64 + i, d2 = d1 + 32;
    const float gq1 = F.in[IN_QNG][l * 128 + d1], gq2 = F.in[IN_QNG][l * 128 + d2], gk1 = F.in[IN_KNG][l * 128 + d1], gk2 = F.in[IN_KNG][l * 128 + d2];
    for (int r = gw; r < nrows; r += NGW) {
        float cs = 1.f, sn = 0.f;
        if (r < SEQ) { const int pos = ax == 0 ? (r >> 6) : (r & 63); cs = R[2 * (pos * 32 + i)]; sn = R[2 * (pos * 32 + i) + 1]; }
#pragma unroll
        for (int hh = 0; hh < 10; ++hh) {
            bf16_t* p = P + (size_t)r * INW + (hh < 8 ? 2560 + hh * 128 : 3584 + (hh - 8) * 128);
            float x1 = bf2f(p[d1]), x2 = bf2f(p[d2]);
            const float ss = wave_sum(x1 * x1 + x2 * x2);
            const float rinv = 1.0f / sqrtf(ss * (1.0f / 128.0f) + LN_EPS);
            x1 = x1 * rinv * (hh < 8 ? gq1 : gk1); x2 = x2 * rinv * (hh < 8 ? gq2 : gk2);
            p[d1] = f2bf(x1 * cs - x2 * sn); p[d2] = f2bf(x2 * cs + x1 * sn);
        }
    }
}

__device__ __forceinline__ void rms_rope_tile(const Frame& F, int l, int row0, int pn) {
    bf16_t* P = (bf16_t*)(F.ws + WS_PROJ);
    const float* R = (const float*)(F.ws + WS_ROPE);
    const float* gn = F.in[pn < 14 ? IN_QNG : IN_KNG] + l * 128;
    const int q = F.lane & 3;
    float gv[32];
#pragma unroll
    for (int c = 0; c < 4; ++c) { const f32x4 a = *(const f32x4*)(gn + 32 * c + 8 * q), b2 = *(const f32x4*)(gn + 32 * c + 8 * q + 4);
        gv[8 * c] = a.x; gv[8 * c + 1] = a.y; gv[8 * c + 2] = a.z; gv[8 * c + 3] = a.w; gv[8 * c + 4] = b2.x; gv[8 * c + 5] = b2.y; gv[8 * c + 6] = b2.z; gv[8 * c + 7] = b2.w; }
#pragma unroll 1
    for (int it = 0; it < 4; ++it) {
        const int pr = it * 128 + F.wave * 16 + (F.lane >> 2);
        const int row = row0 + (pr >> 1);
        bf16_t* p = (pn == 14) ? (bf16_t*)(F.ws + WS_KV) + (size_t)row * 512 + (pr & 1) * 128 + 8 * q : P + (size_t)row * INW + pn * 256 + (pr & 1) * 128 + 8 * q;
        float x[32]; float ss = 0.f;
#pragma unroll
        for (int c = 0; c < 4; ++c) { const u32x4 r = *(const u32x4*)(p + 32 * c);
#pragma unroll
            for (int e = 0; e < 4; ++e) { x[8 * c + 2 * e] = bf2f((bf16_t)(r[e] & 0xffffu)); x[8 * c + 2 * e + 1] = bf2f((bf16_t)(r[e] >> 16)); } }
#pragma unroll
        for (int t = 0; t < 32; ++t) ss += x[t] * x[t];
        ss = quad_sum(ss);
        const float rinv = 1.0f / sqrtf(ss * (1.0f / 128.0f) + LN_EPS);
#pragma unroll
        for (int t = 0; t < 32; ++t) x[t] = x[t] * rinv * gv[t];
        if (row < SEQ) {
#pragma unroll
            for (int ax = 0; ax < 2; ++ax) { const int pos = ax == 0 ? (row >> 6) : (row & 63); const float* cs = R + 2 * (pos * 32 + 8 * q);
#pragma unroll
                for (int t4 = 0; t4 < 4; ++t4) { const f32x4 w = *(const f32x4*)(cs + 4 * t4);
#pragma unroll
                    for (int e = 0; e < 2; ++e) { const int t = 2 * t4 + e; const float c0 = e ? w.z : w.x, s0 = e ? w.w : w.y;
                        const float x1 = x[16 * ax + t], x2 = x[16 * ax + 8 + t]; x[16 * ax + t] = x1 * c0 - x2 * s0; x[16 * ax + 8 + t] = x2 * c0 + x1 * s0; } } }
        }
#pragma unroll
        for (int c = 0; c < 4; ++c) { u32x4 o;
#pragma unroll
            for (int e = 0; e < 4; ++e) o[e] = cvt_pk_bf16(x[8 * c + 2 * e], x[8 * c + 2 * e + 1]);
            *(u32x4*)(p + 32 * c) = o; }
    }
}

namespace att {
constexpr int D = 128, NW = 8, QBLK = 32, KVBLK = 64;
constexpr float SCALE = 0.088388347648318440f;
constexpr float THR = 8.f;
constexpr int LDQ = INW, LDO = DM;
constexpr size_t SHM_V = KVBLK * D * 2, SHM_K = KVBLK * D * 2, SHM_ATTN = 2 * SHM_V + 2 * SHM_K + NW * 64 * 4;
#define KSWZ(row, colB) ((row) * 256 + ((colB) ^ (((row) & 7) << 4)))
#define SBAR() __builtin_amdgcn_sched_barrier(0)
__device__ __forceinline__ int crow(int r, int hi) { return (r & 3) + 8 * (r >> 2) + 4 * hi; }
__device__ __forceinline__ unsigned cvtpk(float lo, float hi) { return cvt_pk_bf16(lo, hi); }
__device__ __forceinline__ void partialSM(f32x16& p0, f32x16& p1, float& m_reg, float& mn, float& alpha) {
  constexpr float C = SCALE * 1.4426950408889634f;
  float pmax = p0[0];
#pragma unroll
  for (int r = 1; r < 16; ++r) pmax = fmaxf(pmax, p0[r]);
#pragma unroll
  for (int r = 0; r < 16; ++r) pmax = fmaxf(pmax, p1[r]);
  { auto rr = __builtin_amdgcn_permlane32_swap(__float_as_uint(pmax), __float_as_uint(pmax), false, false);
    pmax = fmaxf(__uint_as_float(rr[0]), __uint_as_float(rr[1])); }
  if (__builtin_expect(__all(pmax - m_reg <= THR / SCALE), 1)) { mn = m_reg; alpha = 1.f; }
  else { mn = fmaxf(m_reg, pmax); alpha = __builtin_amdgcn_exp2f((m_reg - mn) * C); m_reg = mn; }
  float mnC = -mn * C;
#pragma unroll
  for (int r = 0; r < 16; ++r) p0[r] = fmaf(p0[r], C, mnC);
#pragma unroll
  for (int r = 0; r < 16; ++r) p1[r] = fmaf(p1[r], C, mnC);
#pragma unroll
  for (int r = 0; r < 16; ++r) p0[r] = __builtin_amdgcn_exp2f(p0[r]);
}
struct SMreg { float a[16], b[16]; };
__device__ __forceinline__ void finishSM(SMreg& e, float alpha, float& l_reg, bf16x8& pa0, bf16x8& pa1, bf16x8& pa2, bf16x8& pa3) {
#pragma unroll
  for (int r = 0; r < 16; ++r) e.b[r] = __builtin_amdgcn_exp2f(e.b[r]);
  float ps = 0;
#pragma unroll
  for (int r = 0; r < 16; ++r) ps += e.a[r];
#pragma unroll
  for (int r = 0; r < 16; ++r) ps += e.b[r];
  { auto rr = __builtin_amdgcn_permlane32_swap(__float_as_uint(ps), __float_as_uint(ps), false, false);
    ps = __uint_as_float(rr[0]) + __uint_as_float(rr[1]); }
  l_reg = l_reg * alpha + ps;
#define PK4(P, BASE, OUT) do { unsigned a0 = cvtpk(P[BASE + 0], P[BASE + 1]), a1 = cvtpk(P[BASE + 2], P[BASE + 3]);   \
    unsigned b0 = cvtpk(P[BASE + 4], P[BASE + 5]), b1 = cvtpk(P[BASE + 6], P[BASE + 7]);                              \
    auto r0 = __builtin_amdgcn_permlane32_swap(a0, b0, false, false); auto r1 = __builtin_amdgcn_permlane32_swap(a1, b1, false, false); \
    u32x4 w = {r0[0], r1[0], r0[1], r1[1]}; OUT = *reinterpret_cast<bf16x8*>(&w); } while (0)
  PK4(e.a, 0, pa0); PK4(e.a, 8, pa1); PK4(e.b, 0, pa2); PK4(e.b, 8, pa3);
#undef PK4
}
__device__ __forceinline__ void sm_copy(SMreg& e, const f32x16& p0, const f32x16& p1) {
#pragma unroll
  for (int r = 0; r < 16; ++r) { e.a[r] = p0[r]; e.b[r] = p1[r]; }
}
__device__ __forceinline__ void qkt(f32x16& p0, f32x16& p1, const bf16_t* Ks, const bf16x8* qr, int r32, int hi) {
  p0 = f32x16{}; p1 = f32x16{};
#pragma unroll
  for (int d0 = 0; d0 < 8; ++d0) { int cb = (d0 * 16 + hi * 8) * 2;
    bf16x8 b0 = *reinterpret_cast<const bf16x8*>((const char*)Ks + KSWZ(r32, cb));
    bf16x8 b1 = *reinterpret_cast<const bf16x8*>((const char*)Ks + KSWZ(32 + r32, cb));
    p0 = __builtin_amdgcn_mfma_f32_32x32x16_bf16(b0, qr[d0], p0, 0, 0, 0);
    p1 = __builtin_amdgcn_mfma_f32_32x32x16_bf16(b1, qr[d0], p1, 0, 0, 0); }
}
__device__ __forceinline__ int v_st(int k, int c) { const int kk = (k & ~0xC) | ((k & 4) << 1) | ((k & 8) >> 1); return ((kk >> 3) * 4 + (c >> 5)) * 512 + ((kk & 7) * 32 + (c & 31)) * 2; }
__device__ __forceinline__ int v_rd_base(int lane) { return ((lane & 3) << 3) | (((lane >> 2) & 3) << 6) | (((lane >> 4) & 1) << 5) | (((lane >> 5) & 1) << 8); }
constexpr int v_rd_off(int d0, int ks, int half) { return d0 * 512 + ks * 4096 + half * 2048; }
template <int OFF> __device__ __forceinline__ s16x4 tr_read(int vb) {
  s16x4 r; asm volatile("ds_read_b64_tr_b16 %0, %1 offset:%2" : "=&v"(r) : "v"(vb), "i"(OFF) : "memory"); return r;
}
template <int D0> __device__ __forceinline__ void pv_one(f32x16& od, int vb, bf16x8 pa0, bf16x8 pa1, bf16x8 pa2, bf16x8 pa3) {
  const s16x4 l0 = tr_read<v_rd_off(D0, 0, 0)>(vb), h0 = tr_read<v_rd_off(D0, 0, 1)>(vb), l1 = tr_read<v_rd_off(D0, 1, 0)>(vb), h1 = tr_read<v_rd_off(D0, 1, 1)>(vb);
  const s16x4 l2 = tr_read<v_rd_off(D0, 2, 0)>(vb), h2 = tr_read<v_rd_off(D0, 2, 1)>(vb), l3 = tr_read<v_rd_off(D0, 3, 0)>(vb), h3 = tr_read<v_rd_off(D0, 3, 1)>(vb);
  asm volatile("s_waitcnt lgkmcnt(0)" ::: "memory"); SBAR();
#define PK(L, H) (bf16x8){L[0], L[1], L[2], L[3], H[0], H[1], H[2], H[3]}
  od = __builtin_amdgcn_mfma_f32_32x32x16_bf16(pa0, PK(l0, h0), od, 0, 0, 0);
  od = __builtin_amdgcn_mfma_f32_32x32x16_bf16(pa1, PK(l1, h1), od, 0, 0, 0);
  od = __builtin_amdgcn_mfma_f32_32x32x16_bf16(pa2, PK(l2, h2), od, 0, 0, 0);
  od = __builtin_amdgcn_mfma_f32_32x32x16_bf16(pa3, PK(l3, h3), od, 0, 0, 0);
#undef PK
}
__device__ __forceinline__ void pv_d0(f32x16* o, int vb, bf16x8 pa0, bf16x8 pa1, bf16x8 pa2, bf16x8 pa3) {
  pv_one<0>(o[0], vb, pa0, pa1, pa2, pa3); pv_one<1>(o[1], vb, pa0, pa1, pa2, pa3); pv_one<2>(o[2], vb, pa0, pa1, pa2, pa3); pv_one<3>(o[3], vb, pa0, pa1, pa2, pa3);
}
__device__ __forceinline__ void pv_sm(f32x16* o, int vb, bf16x8 pa0, bf16x8 pa1, bf16x8 pa2, bf16x8 pa3, const f32x16& p0, const f32x16& p1, SMreg& e, float& m_reg, float& alpha) {
  constexpr float C = SCALE * 1.4426950408889634f;
#define PK(L, H) (bf16x8){L[0], L[1], L[2], L[3], H[0], H[1], H[2], H[3]}
#define RD(D, n) const s16x4 a##n = tr_read<v_rd_off(D, 0, 0)>(vb), b##n = tr_read<v_rd_off(D, 0, 1)>(vb), c##n = tr_read<v_rd_off(D, 1, 0)>(vb), d##n = tr_read<v_rd_off(D, 1, 1)>(vb), \
                             e##n = tr_read<v_rd_off(D, 2, 0)>(vb), f##n = tr_read<v_rd_off(D, 2, 1)>(vb), g##n = tr_read<v_rd_off(D, 3, 0)>(vb), h##n = tr_read<v_rd_off(D, 3, 1)>(vb)
#define MM(od, n) do { od = __builtin_amdgcn_mfma_f32_32x32x16_bf16(pa0, PK(a##n, b##n), od, 0, 0, 0); od = __builtin_amdgcn_mfma_f32_32x32x16_bf16(pa1, PK(c##n, d##n), od, 0, 0, 0); \
                       od = __builtin_amdgcn_mfma_f32_32x32x16_bf16(pa2, PK(e##n, f##n), od, 0, 0, 0); od = __builtin_amdgcn_mfma_f32_32x32x16_bf16(pa3, PK(g##n, h##n), od, 0, 0, 0); } while (0)
#define SB6() __builtin_amdgcn_sched_barrier(0x406)
#define GRP(od, n, D, m) od = __builtin_amdgcn_mfma_f32_32x32x16_bf16(pa0, PK(a##n, b##n), od, 0, 0, 0); const s16x4 a##m = tr_read<v_rd_off(D, 0, 0)>(vb), b##m = tr_read<v_rd_off(D, 0, 1)>(vb); SB6(); \
                         od = __builtin_amdgcn_mfma_f32_32x32x16_bf16(pa1, PK(c##n, d##n), od, 0, 0, 0); const s16x4 c##m = tr_read<v_rd_off(D, 1, 0)>(vb), d##m = tr_read<v_rd_off(D, 1, 1)>(vb); SB6(); \
                         od = __builtin_amdgcn_mfma_f32_32x32x16_bf16(pa2, PK(e##n, f##n), od, 0, 0, 0); const s16x4 e##m = tr_read<v_rd_off(D, 2, 0)>(vb), f##m = tr_read<v_rd_off(D, 2, 1)>(vb); SB6(); \
                         od = __builtin_amdgcn_mfma_f32_32x32x16_bf16(pa3, PK(g##n, h##n), od, 0, 0, 0); const s16x4 g##m = tr_read<v_rd_off(D, 3, 0)>(vb), h##m = tr_read<v_rd_off(D, 3, 1)>(vb)
#define LW() do { asm volatile("s_waitcnt lgkmcnt(0)" ::: "memory"); SBAR(); } while (0)
#define PIN(x) asm volatile("" : "+v"(x))
  RD(0, 0); LW();
  GRP(o[0], 0, 1, 1);
  float pmax = p0[0];
#pragma unroll
  for (int r = 1; r < 16; ++r) pmax = fmaxf(pmax, p0[r]);
#pragma unroll
  for (int r = 0; r < 16; ++r) pmax = fmaxf(pmax, p1[r]);
  { auto rr = __builtin_amdgcn_permlane32_swap(__float_as_uint(pmax), __float_as_uint(pmax), false, false);
    pmax = fmaxf(__uint_as_float(rr[0]), __uint_as_float(rr[1])); }
  const bool ok = __all(pmax - m_reg <= THR / SCALE);
  const float mn = ok ? m_reg : fmaxf(m_reg, pmax); alpha = __builtin_amdgcn_exp2f((m_reg - mn) * C); m_reg = mn;
  float mnC = -mn * C; PIN(mnC);
  LW();
  GRP(o[1], 1, 2, 2);
#pragma unroll
  for (int r = 0; r < 16; ++r) { float a = fmaf(p0[r], C, mnC), b = fmaf(p1[r], C, mnC); if (r < 2) a = __builtin_amdgcn_exp2f(a); PIN(a); PIN(b); e.a[r] = a; e.b[r] = b; }
  LW();
  GRP(o[2], 2, 3, 3);
#pragma unroll
  for (int r = 2; r < 9; ++r) { float a = __builtin_amdgcn_exp2f(e.a[r]); PIN(a); e.a[r] = a; }
  LW();
  MM(o[3], 3);
#pragma unroll
  for (int r = 9; r < 16; ++r) { float a = __builtin_amdgcn_exp2f(e.a[r]); PIN(a); e.a[r] = a; }
#undef PK
#undef RD
#undef MM
#undef GRP
#undef SB6
#undef LW
#undef PIN
}
struct MapLinear { long base; __device__ __forceinline__ long operator()(int t) const { return base + (long)t * KVBLK; } };
struct MapNA { int rs0; __device__ __forceinline__ long operator()(int t) const { return t < 4 ? (long)SEQ + t * 64 : (long)(rs0 + t - 4) * 64; } };
struct HookNone { __device__ __forceinline__ void operator()(f32x16&, f32x16&, int, int) const {} };
struct HookNA {
  const LAS float* bias; int qr, rs, rs0, cbase  , bbase  ;
  __device__ __forceinline__ void operator()(f32x16& p0, f32x16& p1, int tile, int hi) const {
    if (tile < 4) return;
    const int kr = rs0 + tile - 4; const bool rowok = (kr >= rs) && (kr <= rs + 7);
    int drow = kr - qr + 7; drow = drow < 0 ? 0 : (drow > 14 ? 14 : drow);
    const float ninf = -__builtin_inff();
    const LAS float* bp = bias + drow * 31 + bbase;
#pragma unroll
    for (int r = 0; r < 16; ++r) {
      const int kc = (r & 3) + 8 * (r >> 2);
      const bool ok0 = rowok && (unsigned)(kc + cbase) <= 15u, ok1 = rowok && (unsigned)(kc + 32 + cbase) <= 15u;
      p0[r] = ok0 ? p0[r] + bp[kc] : ninf; p1[r] = ok1 ? p1[r] + bp[kc + 32] : ninf;
    }
  }
};
template <int SDEPTH, int LDK, class Map, class Hook>
__device__ __forceinline__ void attn_body(const bf16_t* __restrict__ Qb, const bf16_t* __restrict__ Kh, const bf16_t* __restrict__ Vh,
                                          bf16_t* __restrict__ Ob, int NT, const Map map, const Hook hook, char* lds, int tid) {
  const int wid = tid >> 6, lane = tid & 63, r32 = lane & 31, hi = lane >> 5;
  bf16_t* V_lds = (bf16_t*)lds; bf16_t* K_lds = (bf16_t*)(lds + 2 * SHM_V);
  float* ws = (float*)(lds + 2 * SHM_V + 2 * SHM_K) + wid * 64; float* li_l = ws; float* al_l = ws + 32;
  float m_reg = -1e30f, l_reg = 0; f32x16 o[4] = {}; bf16x8 qr[8];
  const bf16_t* Qw = Qb + (long)(wid * QBLK + r32) * LDQ + hi * 8;
#pragma unroll
  for (int d0 = 0; d0 < 8; ++d0) qr[d0] = *reinterpret_cast<const bf16x8*>(Qw + d0 * 16);
  const int sr = tid >> 4;
  const unsigned kq = (unsigned)(sr * LDK + (((tid & 15) ^ (sr & 7)) * 8)) * 2u;
  const int kk = ((tid >> 7) << 3) | ((tid & 31) >> 2), kv = (kk & ~0xC) | ((kk & 4) << 1) | ((kk & 8) >> 1);
  const unsigned vq = (unsigned)(kv * LDK + ((tid >> 5) & 3) * 32 + (tid & 3) * 8) * 2u;
  LAS char* ldsw = (LAS char*)lds + (unsigned)__builtin_amdgcn_readfirstlane(wid) * 1024u;
  const int vb0 = (int)(uintptr_t)V_lds + v_rd_base(lane);
#define DMA_K(tile, b) do { const char* _g = (const char*)(Kh + map(tile) * LDK);                                                                        \
    __builtin_amdgcn_global_load_lds((const unsigned*)(_g + kq), (LAS unsigned*)(ldsw + 2 * SHM_V + (b) * SHM_K), 16, 0, 0);                              \
    __builtin_amdgcn_global_load_lds((const unsigned*)(_g + kq + 32 * LDK * 2), (LAS unsigned*)(ldsw + 2 * SHM_V + (b) * SHM_K + 8192), 16, 0, 0); } while (0)
#define DMA_V(tile, b) do { const char* _g = (const char*)(Vh + map(tile) * LDK);                                                                        \
    __builtin_amdgcn_global_load_lds((const unsigned*)(_g + vq), (LAS unsigned*)(ldsw + (b) * SHM_V), 16, 0, 0);                                          \
    __builtin_amdgcn_global_load_lds((const unsigned*)(_g + vq + 32 * LDK * 2), (LAS unsigned*)(ldsw + (b) * SHM_V + 8192), 16, 0, 0); } while (0)
#define DWAIT() do { asm volatile("s_waitcnt vmcnt(0)" ::: "memory"); __syncthreads(); } while (0)
#define RESC(a) do { if (__any((a) < 1.f)) { if (hi == 0) al_l[r32] = (a); asm volatile("s_waitcnt lgkmcnt(0)" ::: "memory"); \
    _Pragma("unroll") for (int d = 0; d < 4; ++d) _Pragma("unroll") for (int r = 0; r < 16; ++r) o[d][r] *= al_l[crow(r, hi)]; } } while (0)
  f32x16 pA0, pA1, pB0, pB1; SMreg eA, eB; float mnA, mnB, alA, alB; bf16x8 pa0, pa1, pa2, pa3;
#define PVSM(vbx, P0, P1, E, MN, AL, T) do { if constexpr (SDEPTH == 2) { hook(P0, P1, T, hi); pv_sm(o, vbx, pa0, pa1, pa2, pa3, P0, P1, E, m_reg, AL); }   \
    else { pv_d0(o, vbx, pa0, pa1, pa2, pa3); hook(P0, P1, T, hi); partialSM(P0, P1, m_reg, MN, AL); sm_copy(E, P0, P1); } } while (0)
  bf16_t* K1_lds = (bf16_t*)((char*)K_lds + SHM_K);
  DMA_K(0, 0); DMA_V(0, 0); DMA_K(1, 1); DWAIT();
  qkt(pA0, pA1, K_lds, qr, r32, hi); hook(pA0, pA1, 0, hi); partialSM(pA0, pA1, m_reg, mnA, alA); sm_copy(eA, pA0, pA1);
  __syncthreads();
  if (2 < NT) DMA_K(2, 0);
  DMA_V(1, 1);
  for (int j = 1; j + 1 < NT; j += 2) {
    SBAR(); qkt(pB0, pB1, K1_lds, qr, r32, hi);
    finishSM(eA, alA, l_reg, pa0, pa1, pa2, pa3); SBAR();
    PVSM(vb0, pB0, pB1, eB, mnB, alB, j);
    DWAIT();
    DMA_K(j + 2, 1); DMA_V(j + 1, 0);
    RESC(alB);
    SBAR(); qkt(pA0, pA1, K_lds, qr, r32, hi);
    finishSM(eB, alB, l_reg, pa0, pa1, pa2, pa3); SBAR();
    PVSM(vb0 + (int)SHM_V, pA0, pA1, eA, mnA, alA, j + 1);
    DWAIT();
    if (j + 3 < NT) DMA_K(j + 3, 0);
    DMA_V(j + 2, 1);
    RESC(alA);
  }
  SBAR(); qkt(pB0, pB1, K1_lds, qr, r32, hi);
  finishSM(eA, alA, l_reg, pa0, pa1, pa2, pa3); SBAR();
  PVSM(vb0, pB0, pB1, eB, mnB, alB, NT - 1);
  DWAIT(); RESC(alB);
  finishSM(eB, alB, l_reg, pa0, pa1, pa2, pa3); SBAR();
  pv_d0(o, vb0 + (int)SHM_V, pa0, pa1, pa2, pa3);
  if (hi == 0) li_l[r32] = l_reg; asm volatile("s_waitcnt lgkmcnt(0)" ::: "memory");
  float rli[16];
#pragma unroll
  for (int r = 0; r < 16; ++r) rli[r] = __builtin_amdgcn_rcpf(li_l[crow(r, hi)]);
  bf16_t* Ow = Ob + (long)(wid * QBLK) * LDO;
#pragma unroll
  for (int r = 0; r < 16; ++r) { int orow = crow(r, hi);
#pragma unroll
    for (int d0 = 0; d0 < 4; ++d0) Ow[(long)orow * LDO + d0 * 32 + r32] = f2bf(o[d0][r] * rli[r]); }
  __syncthreads();
#undef DMA_K
#undef DMA_V
#undef DWAIT
#undef RESC
#undef PVSM
}
}

__device__ __forceinline__ void sg_unit(const Frame& F, int l, int c, int g) {
    constexpr int VST = 136;
    LAS bf16_t* vnT = (LAS bf16_t*)F.lds;
    const bf16_t* P = (const bf16_t*)(F.ws + WS_PROJ);
    const int fr = F.lane & 15, fq = F.lane >> 4;
    const float* W = F.in[IN_SGW] + ((size_t)(l * 4 + g) * 128 + 16 * F.wave + fr) * 128 + 8 * fq;
    bf16x8 wf[4];
#pragma unroll
    for (int ks = 0; ks < 4; ++ks) { const f32x4 a = *(const f32x4*)(W + 32 * ks), b2 = *(const f32x4*)(W + 32 * ks + 4);
        u32x4 w; w.x = cvt_pk_bf16(a.x, a.y); w.y = cvt_pk_bf16(a.z, a.w); w.z = cvt_pk_bf16(b2.x, b2.y); w.w = cvt_pk_bf16(b2.z, b2.w); wf[ks] = *reinterpret_cast<bf16x8*>(&w); }
    {
        const int j = 16 * F.wave + (F.lane >> 2), q = F.lane & 3; const size_t p = (size_t)(c * 128 + j);
        const bf16_t* vp = P + p * INW + 2048 + g * 128 + 32 * q;
        float x[32];
#pragma unroll
        for (int t = 0; t < 4; ++t) { const u32x4 r = *(const u32x4*)(vp + 8 * t);
#pragma unroll
            for (int e = 0; e < 4; ++e) { x[8 * t + 2 * e] = bf2f((bf16_t)(r[e] & 0xffffu)); x[8 * t + 2 * e + 1] = bf2f((bf16_t)(r[e] >> 16)); } }
        float sm = 0.f;
#pragma unroll
        for (int t = 0; t < 32; ++t) sm += x[t];
        sm = quad_sum(sm);
        const float mean = sm * (1.0f / 128.0f); float sq = 0.f;
#pragma unroll
        for (int t = 0; t < 32; ++t) { x[t] -= mean; sq += x[t] * x[t]; }
        sq = quad_sum(sq);
        const float rstd = 1.0f / sqrtf(sq * (1.0f / 128.0f) + LN_EPS);
        const float* gp = F.in[IN_SGLNG] + (l * 4 + g) * 128 + 32 * q; const float* bp = F.in[IN_SGLNB] + (l * 4 + g) * 128 + 32 * q;
#pragma unroll
        for (int t = 0; t < 32; ++t) vnT[(32 * q + t) * VST + j] = f2bf(x[t] * rstd * gp[t] + bp[t]);
    }
    __syncthreads();
    bf16_t* MIXp = (bf16_t*)(F.ws + WS_MIX);
    const int i = 16 * F.wave + fr; const size_t pi = (size_t)(c * 128 + i); const float bs = F.in[IN_SGB][(l * 4 + g) * 128 + i];
#pragma unroll
    for (int dt = 0; dt < 8; ++dt) {
        f32x4 acc = {0.f, 0.f, 0.f, 0.f};
#pragma unroll
        for (int ks = 0; ks < 4; ++ks) { const bf16x8 a = *(const LAS bf16x8*)(vnT + (dt * 16 + fr) * VST + 32 * ks + 8 * fq); acc = __builtin_amdgcn_mfma_f32_16x16x32_bf16(a, wf[ks], acc, 0, 0, 0); }
        const int d0 = 16 * dt + 4 * fq; const u32x2 uu = *(const u32x2*)(P + pi * INW + 1536 + g * 128 + d0);
        u32x2 o; o.x = cvt_pk_bf16((acc[0] + bs) * bf2f((bf16_t)(uu.x & 0xffffu)), (acc[1] + bs) * bf2f((bf16_t)(uu.x >> 16)));
        o.y = cvt_pk_bf16((acc[2] + bs) * bf2f((bf16_t)(uu.y & 0xffffu)), (acc[3] + bs) * bf2f((bf16_t)(uu.y >> 16)));
        *(u32x2*)(MIXp + pi * DM + 512 + g * 128 + d0) = o;
    }
    __syncthreads();
}

__device__ __forceinline__ void p_att_dense(const Frame& F, int l) {
    const bf16_t* P = (const bf16_t*)(F.ws + WS_PROJ); bf16_t* MIXp = (bf16_t*)(F.ws + WS_MIX); const bf16_t* KV = (const bf16_t*)(F.ws + WS_KV);
    const int total = 256 + ((l == 0) ? 12 : 0);
    for (int u = F.bid; u < total; u += F.G) {
        int qrow, qcol, ocol, nt; long kbase; const bf16_t* kp;
        if (u < 256) { const int h = u & 7; qrow = (u >> 3) * 256; qcol = 2560 + h * 128; ocol = 1024 + h * 128; nt = NROW / 64; kbase = 0; kp = KV + (h >> 2) * 128; }
        else if (u < 264) { const int h = u - 256; qrow = SEQ; qcol = 2560 + h * 128; ocol = 1024 + h * 128; nt = 4; kbase = SEQ; kp = KV + (h >> 2) * 128; }
        else { const int h = u - 264; qrow = SEQ; qcol = h * 128; ocol = h * 128; nt = 4; kbase = 0; kp = (const bf16_t*)(F.ws + WS_CKV) + (size_t)h * 256 * 512; }
        att::attn_body<2, 512>(P + (size_t)qrow * INW + qcol, kp, kp + 256, MIXp + (size_t)qrow * DM + ocol, nt, att::MapLinear{kbase}, att::HookNone{}, (char*)F.lds, F.tid);
    }
}
__device__ __forceinline__ void p_att_na(const Frame& F, int l) {
    const bf16_t* P = (const bf16_t*)(F.ws + WS_PROJ); bf16_t* MIXp = (bf16_t*)(F.ws + WS_MIX);
    LAS float* bt = (LAS float*)(F.lds + LDS_SC);
    for (int v = F.bid; v < 128; v += F.G) {
        const int h = v & 3, qb = v >> 2, R0 = qb * 4;
        const float* rpb = F.in[IN_RPB] + (size_t)(l * 4 + h) * 15 * 31;
        for (int t = F.tid; t < 640; t += NTHR) { const int q = t - 48; bt[t] = (q >= 0 && q < 15 * 31) ? rpb[q] * (1.0f / att::SCALE) : 0.f; }
        __syncthreads();
        int rs0 = R0 - 4; rs0 = rs0 < 0 ? 0 : (rs0 > 116 ? 116 : rs0);
        const int qr = R0 + (F.wave >> 1), qc = (F.wave & 1) * 32 + (F.lane & 31);
        int rs = qr - 4; rs = rs < 0 ? 0 : (rs > 120 ? 120 : rs);
        int cs = qc - 8; cs = cs < 0 ? 0 : (cs > 48 ? 48 : cs);
        att::attn_body<1, INW>(P + (size_t)(qb * 256) * INW + h * 128, P + 512 + h * 128, P + 1024 + h * 128,
                       MIXp + (size_t)(qb * 256) * DM + h * 128, 16, att::MapNA{rs0}, att::HookNA{bt, qr, rs, rs0, 4 * (F.lane >> 5) - cs, 48 + 15 - qc + 4 * (F.lane >> 5)}, (char*)F.lds, F.tid);
    }
}
__device__ __forceinline__ void p_att_sg(const Frame& F, int l) {
    const int nsg = (l == 0) ? 264 : 256;
    if (F.G >= 256) { for (int v = F.bid - 128; v >= 0 && v < nsg; v += F.G - 128) sg_unit(F, l, v >> 2, v & 3); }
    else { for (int v = F.bid; v < nsg; v += F.G) sg_unit(F, l, v >> 2, v & 3); }
}

#ifdef TSEL_A
#define TSF(F, i) do { if ((F).bid == 0 && (F).tid == 0) __hip_atomic_store((unsigned long long*)((F).ws + WS_CTL + 131072) + (i), (unsigned long long)__builtin_amdgcn_s_memrealtime(), __ATOMIC_RELAXED, __HIP_MEMORY_SCOPE_AGENT); } while (0)
#else
#define TSF(F, i) do { } while (0)
#endif
__device__ __forceinline__ void p_mixln_router(const Frame& F, int l, int nrows) {
    LAS float* plog = (LAS float*)F.lds;
    LAS float* scS = plog + 8 * 48 * 32;
    LAS float* selS = scS + 48 * 32;
    const float* MOD = (const float*)(F.ws + WS_MOD);
    const bf16_t* Y1 = (const bf16_t*)(F.ws + WS_Y1);
    float* XS = (float*)(F.ws + WS_XS);
    bf16_t* H2 = (bf16_t*)(F.ws + WS_H2); bf16_t* H2L = (bf16_t*)(F.ws + WS_H2L);
    const bf16_t* RWH = (const bf16_t*)(F.ws + WS_RWT); const bf16_t* RWL = RWH + 32 * DM;
    const float* RB = F.in[IN_RB];
    const float* lg = F.in[IN_LNMG] + l * DM; const float* lb = F.in[IN_LNMB] + l * DM;
    int* cnt = (int*)(F.ws + WS_CTL) + CW_CNT + l * 2048;
    int* tokE = (int*)(F.ws + WS_TOKE); int* tokP = (int*)(F.ws + WS_TOKP); float* tokG = (float*)(F.ws + WS_TOKG); int* list = (int*)(F.ws + WS_LIST);
    const int rpw = (nrows + F.G - 1) / F.G;
    const int wbeg = F.bid * rpw, wend = (wbeg + rpw < nrows) ? wbeg + rpw : nrows;
    LAS float* prm = (LAS float*)(F.lds + 65536);
    stage_vec(F, prm, lg); stage_vec(F, prm + DM, lb);
    for (int v = 0; v < 2; ++v) { const float* m = MOD + (size_t)(l * 2 + v) * 12288; stage_vec(F, prm + (2 + 3 * v) * DM, m + 2 * DM); stage_vec(F, prm + (3 + 3 * v) * DM, m + 3 * DM); stage_vec(F, prm + (4 + 3 * v) * DM, m + 4 * DM); }
    __syncthreads();
    TSF(F, 30);
    for (int rbeg = wbeg; rbeg < wend; rbeg += 48) {
        const int rend = (rbeg + 48 < wend) ? rbeg + 48 : wend, nr = rend - rbeg;
        f32x4 nx[8]; u32x2 ny[8];
#define P5_LOAD(rr) do { const float* xr_ = xrow_ptr(F, l, (rr)); const bf16_t* yr_ = Y1 + (size_t)(rr) * DM; \
        _Pragma("unroll") for (int j = 0; j < 8; ++j) { const int col = 4 * F.lane + 256 * j; nx[j] = __builtin_nontemporal_load((const f32x4*)(xr_ + col)); ny[j] = __builtin_nontemporal_load((const u32x2*)(yr_ + col)); } } while (0)
        if (rbeg + F.wave < rend) P5_LOAD(rbeg + F.wave);
        for (int r = rbeg + F.wave; r < rend; r += NWAVES) {
            const int v = r >= SEQ; const LAS float* pv = prm + (2 + 3 * v) * DM;
            f32x4 z[8];
#pragma unroll
            for (int j = 0; j < 8; ++j) { const int col = 4 * F.lane + 256 * j; const u32x2 yy = ny[j];
                const f32x4 y = {bf2f((bf16_t)(yy.x & 0xffffu)), bf2f((bf16_t)(yy.x >> 16)), bf2f((bf16_t)(yy.y & 0xffffu)), bf2f((bf16_t)(yy.y >> 16))};
                z[j] = ALPHA * nx[j] + *(const LAS f32x4*)(pv + col) * y; }
            if (r + NWAVES < rend) P5_LOAD(r + NWAVES);
            float mean, rstd; ln_stats(z, mean, rstd);
#pragma unroll
            for (int j = 0; j < 8; ++j) { const int col = 4 * F.lane + 256 * j; z[j] = (z[j] - mean) * rstd * *(const LAS f32x4*)(prm + col) + *(const LAS f32x4*)(prm + DM + col); __builtin_nontemporal_store(z[j], (f32x4*)(XS + (size_t)r * DM + col)); }
            ln_stats(z, mean, rstd);
#pragma unroll
            for (int j = 0; j < 8; ++j) { const int col = 4 * F.lane + 256 * j; const f32x4 s1 = *(const LAS f32x4*)(pv + 2 * DM + col), s0 = *(const LAS f32x4*)(pv + DM + col);
                const f32x4 h = (z[j] - mean) * rstd * (1.0f + s1) + s0;
                u32x2 hi; hi.x = cvt_pk_bf16(h.x, h.y); hi.y = cvt_pk_bf16(h.z, h.w);
                const f32x4 hf = {bf2f((bf16_t)(hi.x & 0xffffu)), bf2f((bf16_t)(hi.x >> 16)), bf2f((bf16_t)(hi.y & 0xffffu)), bf2f((bf16_t)(hi.y >> 16))};
                const f32x4 d = h - hf; u32x2 lo; lo.x = cvt_pk_bf16(d.x, d.y); lo.y = cvt_pk_bf16(d.z, d.w);
                *(u32x2*)(H2 + (size_t)r * DM + col) = hi; *(u32x2*)(H2L + (size_t)r * DM + col) = lo; }
        }
#undef P5_LOAD
        asm volatile("s_waitcnt vmcnt(0)" ::: "memory");
        __syncthreads();
        TSF(F, 31);
        const int ntile = (nr + 15) >> 4; constexpr int nsl = 8;
        {
            const int fr = F.lane & 15, fq = F.lane >> 4, kb = F.wave * 256 + fq * 8;
            const bf16_t* bh = RWH + (size_t)fr * DM + kb; const bf16_t* bl = RWL + (size_t)fr * DM + kb;
            const bf16_t* ah[3]; const bf16_t* al[3];
#pragma unroll
            for (int t = 0; t < 3; ++t) { int row = rbeg + t * 16 + fr; row = row < rend ? row : rend - 1; ah[t] = H2 + (size_t)row * DM + kb; al[t] = H2L + (size_t)row * DM + kb; }
            f32x4 acc[3][2];
#pragma unroll
            for (int t = 0; t < 3; ++t) { acc[t][0] = (f32x4){0.f, 0.f, 0.f, 0.f}; acc[t][1] = (f32x4){0.f, 0.f, 0.f, 0.f}; }
#pragma unroll 2
            for (int ks = 0; ks < 8; ++ks) { const int off = ks * 32;
                const bf16x8 b_h0 = *(const bf16x8*)(bh + off), b_l0 = *(const bf16x8*)(bl + off), b_h1 = *(const bf16x8*)(bh + 16 * DM + off), b_l1 = *(const bf16x8*)(bl + 16 * DM + off);
#pragma unroll
                for (int t = 0; t < 3; ++t) if (t < ntile) {
                    const bf16x8 a_h = *(const bf16x8*)(ah[t] + off), a_l = *(const bf16x8*)(al[t] + off);
                    acc[t][0] = __builtin_amdgcn_mfma_f32_16x16x32_bf16(a_h, b_h0, acc[t][0], 0, 0, 0); acc[t][0] = __builtin_amdgcn_mfma_f32_16x16x32_bf16(a_h, b_l0, acc[t][0], 0, 0, 0); acc[t][0] = __builtin_amdgcn_mfma_f32_16x16x32_bf16(a_l, b_h0, acc[t][0], 0, 0, 0);
                    acc[t][1] = __builtin_amdgcn_mfma_f32_16x16x32_bf16(a_h, b_h1, acc[t][1], 0, 0, 0); acc[t][1] = __builtin_amdgcn_mfma_f32_16x16x32_bf16(a_h, b_l1, acc[t][1], 0, 0, 0); acc[t][1] = __builtin_amdgcn_mfma_f32_16x16x32_bf16(a_l, b_h1, acc[t][1], 0, 0, 0); } }
#pragma unroll
            for (int t = 0; t < 3; ++t) if (t < ntile) {
#pragma unroll
                for (int q = 0; q < 4; ++q) { LAS float* pr = plog + (F.wave * 48 + t * 16 + 4 * fq + q) * 32; pr[fr] = acc[t][0][q]; pr[16 + fr] = acc[t][1][q]; } }
        }
        __syncthreads();
        TSF(F, 32);
        for (int t = F.tid; t < nr * 32; t += NTHR) { const int e = t & 31; float lg2 = 0.f; for (int q = 0; q < nsl; ++q) lg2 += plog[q * 48 * 32 + t]; const float sc = sigmoidf_(lg2); scS[t] = sc; selS[t] = sc + RB[e]; }
        __syncthreads();
        if (F.tid < nr) {
            const int row = F.tid, r = rbeg + row; const LAS float* sel = selS + row * 32; const LAS float* sc = scS + row * 32;
            int best = 0; float bestv = -__builtin_inff();
            for (int g = 0; g < 4; ++g) { float m1 = -__builtin_inff(), m2 = -__builtin_inff();
                for (int q = 0; q < 8; ++q) { const float x = sel[g * 8 + q]; if (x > m1) { m2 = m1; m1 = x; } else if (x > m2) m2 = x; }
                const float gs = m1 + m2; if (gs > bestv) { bestv = gs; best = g; } }
            int i1 = 0, i2 = 0; float m1 = -__builtin_inff(), m2 = -__builtin_inff();
            for (int q = 0; q < 8; ++q) { const float x = sel[best * 8 + q]; if (x > m1) { m2 = m1; i2 = i1; m1 = x; i1 = q; } else if (x > m2) { m2 = x; i2 = q; } }
            const int e1 = best * 8 + i1, e2 = best * 8 + i2; const float s1 = sc[e1], s2 = sc[e2], den = s1 + s2;
            const int p1 = atomicAdd(cnt + 64 * e1, 1), p2 = atomicAdd(cnt + 64 * e2, 1);
            list[e1 * NROW + p1] = r; list[e2 * NROW + p2] = r;
            tokE[2 * r] = e1; tokE[2 * r + 1] = e2; tokP[2 * r] = p1; tokP[2 * r + 1] = p2; tokG[2 * r] = s1 / den; tokG[2 * r + 1] = s2 / den;
        }
        __syncthreads();
        TSF(F, 33);
    }
}

__device__ __forceinline__ int moe_tiles(const Frame& F, int l) {
    LAS int* tileEM = (LAS int*)(F.lds + LDS_TILE); LAS int* tbase = tileEM + 128;
    const int* cnt = (const int*)(F.ws + WS_CTL) + CW_CNT + l * 2048;
    __syncthreads();
    if (F.wave == 0) {
        const int n = (F.lane < NEXP) ? __hip_atomic_load(cnt + 64 * F.lane, __ATOMIC_RELAXED, __HIP_MEMORY_SCOPE_AGENT) : 0;
        const int nt = (n + 255) >> 8; int incl = nt;
#pragma unroll
        for (int o = 1; o < 64; o <<= 1) { const int t = __shfl_up(incl, o); if (F.lane >= o) incl += t; }
        const int excl = incl - nt;
        if (F.lane < NEXP) { tbase[F.lane] = excl; for (int m = 0; m < nt; ++m) tileEM[excl + m] = (F.lane << 8) | m; }
        if (F.lane == NEXP - 1) tbase[NEXP] = incl;
    }
    __syncthreads();
    return tbase[NEXP];
}

__device__ __forceinline__ void p_ffnln(const Frame& F, int l, int nrows) {
    LAS int* tbase = (LAS int*)(F.lds + LDS_TILE) + 128;
    (void)moe_tiles(F, l);
    const int gw = F.bid * NWAVES + F.wave, NGW = F.G * NWAVES;
    const float* MOD = (const float*)(F.ws + WS_MOD);
    float* XS = (float*)(F.ws + WS_XS); const bf16_t* YS = (const bf16_t*)(F.ws + WS_YS);
    const int* tokE = (const int*)(F.ws + WS_TOKE); const int* tokP = (const int*)(F.ws + WS_TOKP); const float* tokG = (const float*)(F.ws + WS_TOKG);
    const float* lg = F.in[IN_LNFG] + l * DM; const float* lb = F.in[IN_LNFB] + l * DM;
    bf16_t* H1 = (bf16_t*)(F.ws + WS_H1);
    LAS float* prm = (LAS float*)(F.lds + 65536);
    stage_vec(F, prm, lg); stage_vec(F, prm + DM, lb);
    for (int v = 0; v < 2; ++v) { stage_vec(F, prm + (2 + 3 * v) * DM, MOD + (size_t)(l * 2 + v) * 12288 + 5 * DM);
        if (l == 0) { const float* mn = MOD + (size_t)(2 + v) * 12288; stage_vec(F, prm + (3 + 3 * v) * DM, mn); stage_vec(F, prm + (4 + 3 * v) * DM, mn + DM); } }
    __syncthreads();
    int e1n = 0, e2n = 0, p1n = 0, p2n = 0; float g1n = 0.f, g2n = 0.f;
#define P9_ROUTE(rr) do { if ((rr) < nrows) { e1n = tokE[2 * (rr)]; e2n = tokE[2 * (rr) + 1]; p1n = tokP[2 * (rr)]; p2n = tokP[2 * (rr) + 1]; g1n = tokG[2 * (rr)]; g2n = tokG[2 * (rr) + 1]; } } while (0)
#define P9_LOAD(rr) do { const bf16_t* ya_ = YS + (size_t)(tbase[e1n] * 256 + p1n) * DM; const bf16_t* yb_ = YS + (size_t)(tbase[e2n] * 256 + p2n) * DM; const float* xr_ = XS + (size_t)(rr) * DM; \
        _Pragma("unroll") for (int j = 0; j < 8; ++j) { const int col = 4 * F.lane + 256 * j; nx[j] = __builtin_nontemporal_load((const f32x4*)(xr_ + col)); na[j] = __builtin_nontemporal_load((const u32x2*)(ya_ + col)); nb[j] = __builtin_nontemporal_load((const u32x2*)(yb_ + col)); } ng1 = g1n; ng2 = g2n; } while (0)
    f32x4 nx[8]; u32x2 na[8], nb[8]; float ng1 = 0.f, ng2 = 0.f;
    P9_ROUTE(gw);
    if (gw < nrows) P9_LOAD(gw);
    P9_ROUTE(gw + NGW);
    for (int r = gw; r < nrows; r += NGW) {
        const int v = r >= SEQ; const LAS float* pv = prm + (2 + 3 * v) * DM;
        f32x4 z[8];
#pragma unroll
        for (int j = 0; j < 8; ++j) { const int col = 4 * F.lane + 256 * j; const u32x2 qa = na[j], qb = nb[j];
            const f32x4 fa = {bf2f((bf16_t)(qa.x & 0xffffu)), bf2f((bf16_t)(qa.x >> 16)), bf2f((bf16_t)(qa.y & 0xffffu)), bf2f((bf16_t)(qa.y >> 16))};
            const f32x4 fb = {bf2f((bf16_t)(qb.x & 0xffffu)), bf2f((bf16_t)(qb.x >> 16)), bf2f((bf16_t)(qb.y & 0xffffu)), bf2f((bf16_t)(qb.y >> 16))};
            const f32x4 y = ng1 * fa + ng2 * fb;
            z[j] = ALPHA * nx[j] + *(const LAS f32x4*)(pv + col) * y; }
        if (r + NGW < nrows) P9_LOAD(r + NGW);
        P9_ROUTE(r + 2 * NGW);
        float mean, rstd; ln_stats(z, mean, rstd);
#pragma unroll
        for (int j = 0; j < 8; ++j) { const int col = 4 * F.lane + 256 * j; z[j] = (z[j] - mean) * rstd * *(const LAS f32x4*)(prm + col) + *(const LAS f32x4*)(prm + DM + col); }
        if (l == 1) {
#pragma unroll
            for (int j = 0; j < 8; ++j) __builtin_nontemporal_store(z[j], (f32x4*)(F.out + (size_t)r * DM + 4 * F.lane + 256 * j));
        } else {
#pragma unroll
            for (int j = 0; j < 8; ++j) __builtin_nontemporal_store(z[j], (f32x4*)(XS + (size_t)r * DM + 4 * F.lane + 256 * j));
            float mean2, rstd2; ln_stats(z, mean2, rstd2);
#pragma unroll
            for (int j = 0; j < 8; ++j) { const int col = 4 * F.lane + 256 * j; const f32x4 h = (z[j] - mean2) * rstd2 * (1.0f + *(const LAS f32x4*)(pv + 2 * DM + col)) + *(const LAS f32x4*)(pv + DM + col);
                *(u32x2*)(H1 + (size_t)r * DM + col) = pack4(h); }
        }
    }
#undef P9_ROUTE
#undef P9_LOAD
}


__global__ void __launch_bounds__(NTHR, 2) fwd(Args args) {
    extern __shared__ __attribute__((aligned(16))) unsigned char lds_raw[];
    Frame F0;
    F0.lds = (LAS unsigned char*)lds_raw; F0.tid = threadIdx.x; F0.lane = F0.tid & 63; F0.wave = __builtin_amdgcn_readfirstlane(F0.tid >> 6);
    F0.G = gridDim.x; F0.bid = blockIdx.x; F0.in = args.in; F0.out = args.out; F0.ws = args.ws;
    volatile LAS unsigned* MISC = (volatile LAS unsigned*)(F0.lds + LDS_MISC);
    if (F0.tid < 4) MISC[F0.tid] = 0u;
    __syncthreads();
    const int lo = args.ph_lo, hi = args.ph_hi;
    XcdBarrier bar; bar.bar = (unsigned*)(F0.ws + WS_CTL) + CW_BAR; bar.x = 0; bar.st = MISC;
    if (hi - lo > 1) bar = xcd_barrier_post((unsigned*)(F0.ws + WS_CTL) + CW_BAR, MISC);
#ifndef REP_PH
#define REP_PH -1
#endif
#define NREP(j) (((REP_PH) == (j)) ? rep1 + 1 : 1)
#if defined(ONLY_PH)
#define PHON(j) ((j) == ONLY_PH)
#elif defined(PH_MASK)
#define PHON(j) (((PH_MASK) >> (j)) & 1)
#else
#define PHON(j) true
#endif
#ifdef TSEL_A
#define TS(i) do { if (F0.bid == 0 && F0.tid == 0) __hip_atomic_store((unsigned long long*)(F0.ws + WS_CTL + 131072) + (i), (unsigned long long)__builtin_amdgcn_s_memrealtime(), __ATOMIC_RELAXED, __HIP_MEMORY_SCOPE_AGENT); } while (0)
#else
#define TS(i) do { } while (0)
#endif
#define IN(k) (lo <= (k) && (k) < hi)
#define SEAM(k) do { if (IN(k) && IN((k) + 1)) xcd_barrier(bar); } while (0)
    TS(0);
    int rep1 = 1; asm volatile("" : "+s"(rep1));
    if (PHON(0) && IN(0)) for (int rep = 0; rep < NREP(0); ++rep) { { const Frame F = launder(F0); p0_mod(F); } { const Frame F = launder(F0); p0_transposes(F); } { const Frame F = launder(F0); p0_rope(F); } }
    SEAM(0); TS(1);
    if (PHON(1) && IN(1)) for (int rep = 0; rep < NREP(1); ++rep) { const Frame F = launder(F0); p_modulate1(F, 0, NROW); }
    SEAM(1); TS(2);
#pragma unroll 1
    for (int l = 0; l < 2; ++l) {
        const int pb = 2 + 8 * l; const int tb = 3 + 10 * l; (void)tb;
        const int nlat = (l == 0) ? NROW : SEQ;
        if (PHON(2) && IN(pb + 0)) for (int rep = 0; rep < NREP(2); ++rep) {
            const bool split = F0.G >= 256; const int gc = split ? NC_IN : F0.G;
            if (F0.bid < gc) {
                pg8::StaticOrder S; S.init(NROW, INW, DM, (const bf16_t*)(F0.ws + WS_WIN) + (size_t)l * INW * DM, gc, F0.bid);
                { const Frame F = launder(F0);
                  pg8::EpiBf<true> E{(bf16_t*)(F.ws + WS_PROJ), INW, (bf16_t*)(F.ws + WS_KV)};
                  pg8::gemm_phase(F.lds, F.tid, (const bf16_t*)(F.ws + WS_H1), DM, S, E); }
                asm volatile("s_waitcnt vmcnt(0)" ::: "memory"); __syncthreads();
                { const Frame F = launder(F0);
                  pg8::Unit u; for (int i = 0; S.next(i, u); ++i) if (u.pn >= 10 && u.pn <= 14) rms_rope_tile(F, l, u.pm * 256, u.pn); }
            } else { const Frame F = launder(F0); if (l == 0) conv_range(F, gc, 0, CV_A0); else conv_range(F, gc, CV_LAYER + CV_B1, CV_L1F - CV_B1); }
        }
        SEAM(pb + 0); TS(tb + 0); TS(tb + 1);
        if (IN(pb + 2)) { if (PHON(4)) for (int rep = 0; rep < NREP(4); ++rep) { const Frame F = launder(F0); p_att_dense(F, l); } TS(tb + 2); if (PHON(10)) for (int rep = 0; rep < NREP(10); ++rep) { const Frame F = launder(F0); p_att_na(F, l); } TS(tb + 3); if (PHON(11)) for (int rep = 0; rep < NREP(11); ++rep) { const Frame F = launder(F0); p_att_sg(F, l); }
            if (F0.G >= 256 && F0.bid >= 128) { const Frame F = launder(F0); conv_range(F, 128, l == 0 ? CV_L0F : CV_LAYER + CV_L1F, CV_ATT); }
            else if (F0.G >= 256 && l == 0) { Frame F = launder(F0); F.bid += 128; conv_range(F, 128, CV_L0F - CV_NA0, CV_NA0); } }
        SEAM(pb + 2); TS(tb + 4);
        if (PHON(5) && IN(pb + 3)) for (int rep = 0; rep < NREP(5); ++rep) { const Frame F = launder(F0);
            const bool split = (l == 0) && F.G >= 256; const int gc = split ? NC_OUT : F.G;
            if (F.bid < gc) {
                pg8::StaticOrder S; S.init(nlat, DM, DM, (const bf16_t*)(F.ws + WS_WOUT) + (size_t)l * DM * DM, gc, F.bid);
                pg8::EpiBf<false> E{(bf16_t*)(F.ws + WS_Y1), DM, nullptr};
                pg8::gemm_phase(F.lds, F.tid, (const bf16_t*)(F.ws + WS_MIX), DM, S, E);
            } else conv_range(F, gc, CV_A0, CV_L0F - CV_A0 - CV_NA0);
        }
        SEAM(pb + 3); TS(tb + 5);
        if (PHON(6) && IN(pb + 4)) { const Frame F = launder(F0); p_mixln_router(F, l, nlat); }
        SEAM(pb + 4); TS(tb + 6);
        if (PHON(7) && IN(pb + 5)) for (int rep = 0; rep < NREP(7); ++rep) { const Frame F = launder(F0);
            const bool split = (l == 0) && F.G >= 256; const int gc = split ? NC_MOE : F.G;
            if (F.bid < gc) {
                const int ntiles = moe_tiles(F, l);
                pg8::MoeOrder<true> S{(const LAS int*)(F.lds + LDS_TILE), ntiles, gc, F.bid, DM, (const int*)(F.ws + WS_LIST), (const int*)(F.ws + WS_CTL) + CW_CNT + l * 2048,
                                      (const bf16_t*)(F.ws + WS_WGU) + (size_t)l * NEXP * 2048 * DM};
                pg8::EpiSwiGLU E{(bf16_t*)(F.ws + WS_GA)};
                pg8::gemm_phase(F.lds, F.tid, (const bf16_t*)(F.ws + WS_H2), DM, S, E);
            } else conv_range(F, gc, CV_LAYER, CV_B0);
        }
        SEAM(pb + 5); TS(tb + 7);
        if (PHON(8) && IN(pb + 6)) for (int rep = 0; rep < NREP(8); ++rep) { const Frame F = launder(F0);
            const bool split = (l == 0) && F.G >= 256; const int gc = split ? NC_MOE : F.G;
            if (F.bid < gc) {
                const int ntiles = moe_tiles(F, l);
                pg8::MoeOrder<false> S{(const LAS int*)(F.lds + LDS_TILE), ntiles, gc, F.bid, DEXP, nullptr, nullptr, (const bf16_t*)(F.ws + WS_WD) + (size_t)l * NEXP * DM * DEXP};
                pg8::EpiBf<false> E{(bf16_t*)(F.ws + WS_YS), DM, nullptr};
                pg8::gemm_phase(F.lds, F.tid, (const bf16_t*)(F.ws + WS_GA), DEXP, S, E);
            } else conv_range(F, gc, CV_LAYER + CV_B0, CV_B1 - CV_B0);
        }
        SEAM(pb + 6); TS(tb + 8);
        if (PHON(9) && IN(pb + 7)) { const Frame F = launder(F0); p_ffnln(F, l, nlat); }
        SEAM(pb + 7);
#ifdef TSEL_A
        if (l == 1) xcd_barrier(bar);
#endif
        TS(tb + 9);
    }
#ifdef TSEL_A
    {
        unsigned long long* ts = (unsigned long long*)(F0.ws + WS_CTL + 131072);
        if (F0.bid == 0 && F0.tid == 0) {
            unsigned long long a0 = 0, a1 = 0, b0 = 0, b1 = 0;
            a0 = __hip_atomic_load(ts + TSEL_A - 1, __ATOMIC_RELAXED, __HIP_MEMORY_SCOPE_AGENT); a1 = __hip_atomic_load(ts + TSEL_A2, __ATOMIC_RELAXED, __HIP_MEMORY_SCOPE_AGENT);
            b0 = __hip_atomic_load(ts + TSEL_B - 1, __ATOMIC_RELAXED, __HIP_MEMORY_SCOPE_AGENT); b1 = __hip_atomic_load(ts + TSEL_B2, __ATOMIC_RELAXED, __HIP_MEMORY_SCOPE_AGENT);
            const float ua = (float)(a1 - a0) * 0.01f, ub = (float)(b1 - b0) * 0.01f;
            int n1 = (int)(ua * 8.192f); n1 = n1 > 8100 ? 8100 : n1; n1 = 0;
            __hip_atomic_store((unsigned*)(ts + 64), (unsigned)n1, __ATOMIC_RELAXED, __HIP_MEMORY_SCOPE_AGENT);
            __hip_atomic_store((unsigned*)(ts + 65), __float_as_uint(ub * 0.5f), __ATOMIC_RELAXED, __HIP_MEMORY_SCOPE_AGENT);
        }
        xcd_barrier(bar);
        const int n1 = (int)__hip_atomic_load((unsigned*)(ts + 64), __ATOMIC_RELAXED, __HIP_MEMORY_SCOPE_AGENT);
        const float V = __uint_as_float(__hip_atomic_load((unsigned*)(ts + 65), __ATOMIC_RELAXED, __HIP_MEMORY_SCOPE_AGENT));
        const int gw = F0.bid * NWAVES + F0.wave, NGW = F0.G * NWAVES;
        for (int r = gw; r < n1; r += NGW) for (int j = 0; j < 8; ++j) *(f32x4*)(F0.out + (size_t)r * DM + 4 * F0.lane + 256 * j) = (f32x4){0.f, 0.f, 0.f, 0.f};
        asm volatile("s_waitcnt vmcnt(0)" ::: "memory");
        if (F0.bid == 0 && F0.tid == 0) F0.out[0] = V;
    }
#endif
#undef IN
#undef SEAM
}


extern "C" void kernel_launch(void* const* d_in, const int* in_sizes, int n_in, void* d_out, int out_size, void* d_ws, size_t ws_size, hipStream_t stream) {
    static int grid = 0;
    if (grid == 0) {
        if (n_in != 24 || out_size != SEQ * DM || ws_size < WS_END) { fprintf(stderr, "kernel_launch: unexpected shapes (n_in %d out %d ws %zu)\n", n_in, out_size, ws_size); grid = -1; return; }
        int dev = 0, cus = 0, per_cu = 0;
        if (hipGetDevice(&dev) != hipSuccess || hipDeviceGetAttribute(&cus, hipDeviceAttributeMultiprocessorCount, dev) != hipSuccess) { grid = -1; return; }
        if (hipFuncSetAttribute((const void*)fwd, hipFuncAttributeMaxDynamicSharedMemorySize, LDS_BYTES) != hipSuccess) { fprintf(stderr, "kernel_launch: hipFuncSetAttribute failed\n"); grid = -1; return; }
        if (hipOccupancyMaxActiveBlocksPerMultiprocessor(&per_cu, (const void*)fwd, NTHR, LDS_BYTES) != hipSuccess || per_cu < 1) { fprintf(stderr, "kernel_launch: occupancy query says %d\n", per_cu); }
        (void)hipGetLastError();
        grid = cus;
    }
    if (grid < 0) return;
    (void)hipMemsetAsync((char*)d_ws + WS_CTL, 0, CTL_ZERO_BYTES, stream);
    Args a{};
    for (int i = 0; i < 24; ++i) a.in[i] = (const float*)d_in[i];
    a.out = (float*)d_out; a.ws = (unsigned char*)d_ws;
#if MK_ONE_LAUNCH
    a.ph_lo = 0; a.ph_hi = NPH;
    hipLaunchKernelGGL(fwd, dim3(grid), dim3(NTHR), LDS_BYTES, stream, a);

#else
    for (int k = 0; k < NPH; ++k) { a.ph_lo = k; a.ph_hi = k + 1; hipLaunchKernelGGL(fwd, dim3(grid), dim3(NTHR), LDS_BYTES, stream, a); }
#endif
}
```
